# Optimizing an MI355X kernel written in HIP

```python
import math
import jax, jax.numpy as jnp
from jax import lax
import numpy as np

D_MODEL = 1024
BATCH = 8
SEQ = 4096
DEPTH = 1

PLE_DIM = 256
EPS = 1e-6
NEG_INF = -1e30

A_HEADS = 8
A_HEAD_DIM = 64
A_WIDTH = A_HEADS * A_HEAD_DIM
DILATED_BRANCHES = ((128, 1), (512, 4), (2048, 16))

B_HEADS = 8
B_NOPE = 64
B_ROPE = 32
B_VDIM = 64
B_WIDTH = B_HEADS * B_VDIM
Q_LORA = 384
KV_LORA = 256
ROPE_THETA = 10000.0
Q_BLOCK = 128

MIX_WIDTH = A_WIDTH + B_WIDTH
IN_WIDTH = 3 * A_WIDTH + Q_LORA + KV_LORA + B_ROPE

N_GROUPS = 4
EXPERTS_PER_GROUP = 8
N_EXPERTS = N_GROUPS * EXPERTS_PER_GROUP
TOP_K_INNER = 2
EXPERT_FF = 256

kernel_name = "hymba_dilated_mla_hmoe_encoder"


def rms_norm(x, g):
    xf = x.astype(jnp.float32)
    y = xf * lax.rsqrt(jnp.mean(xf * xf, axis=-1, keepdims=True) + EPS)
    return (y * g.astype(jnp.float32)).astype(x.dtype)


def alibi_slopes(n_heads):
    return jnp.exp2(-8.0 * (jnp.arange(n_heads, dtype=jnp.float32) + 1.0) / n_heads)


def rope_tables(seq, dim):
    inv_freq = 1.0 / (ROPE_THETA ** (jnp.arange(0, dim, 2, dtype=jnp.float32) / dim))
    ang = jnp.arange(seq, dtype=jnp.float32)[:, None] * inv_freq[None, :]
    return jnp.cos(ang), jnp.sin(ang)


def apply_rope(x, cos, sin):
    half = x.shape[-1] // 2
    x1 = x[..., :half].astype(jnp.float32)
    x2 = x[..., half:].astype(jnp.float32)
    return jnp.concatenate([x1 * cos - x2 * sin, x1 * sin + x2 * cos], axis=-1).astype(x.dtype)


def banded_attention(q, k, v, dist_slopes, half):
    N, L, H, Dh = q.shape
    W = half
    nb = -(-L // W)
    Lp = nb * W
    qb = jnp.pad(q, ((0, 0), (0, Lp - L), (0, 0), (0, 0))).reshape(N, nb, W, H, Dh)
    pad_kv = ((0, 0), (W, Lp - L + W), (0, 0), (0, 0))
    kp = jnp.pad(k, pad_kv)
    vp = jnp.pad(v, pad_kv)
    kb = jnp.concatenate([kp[:, s * W: s * W + Lp].reshape(N, nb, W, H, Dh) for s in range(3)], axis=2)
    vb = jnp.concatenate([vp[:, s * W: s * W + Lp].reshape(N, nb, W, H, Dh) for s in range(3)], axis=2)
    scores = jnp.einsum('nbqhd,nbkhd->nbhqk', qb, kb).astype(jnp.float32)
    qi = jnp.arange(W)[:, None]
    kc = jnp.arange(3 * W)[None, :]
    rel = kc - W - qi
    j = jnp.arange(nb)[:, None] * W + jnp.arange(3 * W)[None, :] - W
    mask = (jnp.abs(rel) <= half)[None, :, :] & ((j >= 0) & (j < L))[:, None, :]
    bias = -dist_slopes[:, None, None] * jnp.abs(rel).astype(jnp.float32)[None]
    scores = jnp.where(mask[None, :, None], scores + bias[None, None], NEG_INF)
    m = jnp.max(scores, axis=-1, keepdims=True)
    e = jnp.exp(scores - m)
    s = jnp.sum(e, axis=-1, keepdims=True)
    out = jnp.einsum('nbhqk,nbkhd->nbqhd', (e / s).astype(v.dtype), vb)
    lse = (m + jnp.log(s))[..., 0]
    out = out.reshape(N, Lp, H, Dh)[:, :L]
    lse = lse.transpose(0, 1, 3, 2).reshape(N, Lp, H)[:, :L]
    return out, lse


def dilated_mixture_attention(q, k, v):
    B, S, H, Dh = q.shape
    q = q * (Dh ** -0.5)
    slopes = alibi_slopes(H)
    outs, lses = [], []
    for window, dil in DILATED_BRANCHES:
        half = window // (2 * dil)
        L = S // dil

        def to_sub(t):
            return t.reshape(B, L, dil, H, Dh).transpose(0, 2, 1, 3, 4).reshape(B * dil, L, H, Dh)

        o, lse = banded_attention(to_sub(q), to_sub(k), to_sub(v), slopes * dil, half)
        outs.append(o.reshape(B, dil, L, H, Dh).transpose(0, 2, 1, 3, 4).reshape(B, S, H, Dh))
        lses.append(lse.reshape(B, dil, L, H).transpose(0, 2, 1, 3).reshape(B, S, H))
    w = jax.nn.softmax(jnp.stack(lses), axis=0)
    return jnp.einsum('nbsh,nbshd->bshd', w.astype(q.dtype), jnp.stack(outs))


def mla_attention(qn, qr, kn, kr, v):
    B, S, H, _ = qn.shape
    scale = (B_NOPE + B_ROPE) ** -0.5
    nq = S // Q_BLOCK
    qn_b = qn.reshape(B, nq, Q_BLOCK, H, B_NOPE).transpose(1, 0, 2, 3, 4)
    qr_b = qr.reshape(B, nq, Q_BLOCK, H, B_ROPE).transpose(1, 0, 2, 3, 4)

    def attend(args):
        qn_i, qr_i = args
        s = jnp.einsum('bqhd,bkhd->bhqk', qn_i, kn) + jnp.einsum('bqhr,bkr->bhqk', qr_i, kr)
        pr = jax.nn.softmax(s.astype(jnp.float32) * scale, axis=-1).astype(v.dtype)
        return jnp.einsum('bhqk,bkhd->bqhd', pr, v)

    out = lax.map(attend, (qn_b, qr_b))
    return out.transpose(1, 0, 2, 3, 4).reshape(B, S, H * B_VDIM)


def hierarchical_moe(t, w_r1, b_r1, w_r2, b_r2, w_e_gate, w_e_up, w_e_down):
    l1 = (t @ w_r1 + b_r1).astype(jnp.float32)
    p1 = jax.nn.softmax(l1, axis=-1)
    g_val, g_idx = lax.top_k(p1, 1)
    l2_all = jnp.einsum('td,gde->tge', t, w_r2) + b_r2
    l2 = jnp.take_along_axis(l2_all, g_idx[:, :, None], axis=1)[:, 0].astype(jnp.float32)
    p2 = jax.nn.softmax(l2, axis=-1)
    e_val, e_idx = lax.top_k(p2, TOP_K_INNER)
    gate = g_val * e_val / jnp.sum(e_val, axis=-1, keepdims=True)
    eid = g_idx * EXPERTS_PER_GROUP + e_idx
    cw = jnp.sum(jax.nn.one_hot(eid, N_EXPERTS, dtype=jnp.float32) * gate[:, :, None], axis=1)
    cw = cw.astype(t.dtype)
    y = jnp.zeros_like(t)
    for e in range(N_EXPERTS):
        h = jax.nn.silu(t @ w_e_gate[e]) * (t @ w_e_up[e])
        y = y + cw[:, e:e + 1] * (h @ w_e_down[e])
    return y


def setup_inputs(seed: int = 0) -> dict:
    key = jax.random.key(seed)
    ks = jax.random.split(key, 24)
    f32 = jnp.float32

    def nrm(k, shape, fan_in):
        return jax.random.normal(k, shape, f32) * (fan_in ** -0.5)

    def gain(k, shape):
        return 1.0 + 0.02 * jax.random.normal(k, shape, f32)

    return {
        "x": jax.random.normal(ks[0], (BATCH, SEQ, D_MODEL), f32),
        "p": jax.random.normal(ks[1], (DEPTH, BATCH, SEQ, PLE_DIM), f32),
        "g_mix": gain(ks[2], (DEPTH, D_MODEL)),
        "w_in": nrm(ks[3], (DEPTH, D_MODEL, IN_WIDTH), D_MODEL),
        "g_cq": gain(ks[4], (DEPTH, Q_LORA)),
        "w_uq": nrm(ks[5], (DEPTH, Q_LORA, B_HEADS * (B_NOPE + B_ROPE)), Q_LORA),
        "g_ckv": gain(ks[6], (DEPTH, KV_LORA)),
        "w_ukv": nrm(ks[7], (DEPTH, KV_LORA, B_HEADS * (B_NOPE + B_VDIM)), KV_LORA),
        "g_out_a": gain(ks[8], (DEPTH, A_WIDTH)),
        "g_out_b": gain(ks[9], (DEPTH, B_WIDTH)),
        "w_o": nrm(ks[10], (DEPTH, MIX_WIDTH, D_MODEL), MIX_WIDTH),
        "g_ffn": gain(ks[11], (DEPTH, D_MODEL)),
        "w_r1": nrm(ks[12], (DEPTH, D_MODEL, N_GROUPS), D_MODEL),
        "b_r1": 0.01 * jax.random.normal(ks[13], (DEPTH, N_GROUPS), f32),
        "w_r2": nrm(ks[14], (DEPTH, N_GROUPS, D_MODEL, EXPERTS_PER_GROUP), D_MODEL),
        "b_r2": 0.01 * jax.random.normal(ks[15], (DEPTH, N_GROUPS, EXPERTS_PER_GROUP), f32),
        "w_e_gate": nrm(ks[16], (DEPTH, N_EXPERTS, D_MODEL, EXPERT_FF), D_MODEL),
        "w_e_up": nrm(ks[17], (DEPTH, N_EXPERTS, D_MODEL, EXPERT_FF), D_MODEL),
        "w_e_down": nrm(ks[18], (DEPTH, N_EXPERTS, EXPERT_FF, D_MODEL), EXPERT_FF),
        "g_ple": gain(ks[19], (DEPTH, D_MODEL)),
        "w_ple_gate": nrm(ks[20], (DEPTH, D_MODEL, D_MODEL), D_MODEL),
        "w_ple_proj": nrm(ks[21], (DEPTH, PLE_DIM, D_MODEL), PLE_DIM),
        "g_final": gain(ks[22], (D_MODEL,)),
    }


def reference(x, p, g_mix, w_in, g_cq, w_uq, g_ckv, w_ukv, g_out_a, g_out_b, w_o,
              g_ffn, w_r1, b_r1, w_r2, b_r2, w_e_gate, w_e_up, w_e_down,
              g_ple, w_ple_gate, w_ple_proj, g_final):
    B, S, D = x.shape
    cos, sin = rope_tables(S, B_ROPE)
    h = x
    for i in range(DEPTH):
        a = rms_norm(h, g_mix[i])
        proj = a @ w_in[i]
        o = 0
        qa = proj[..., o:o + A_WIDTH].reshape(B, S, A_HEADS, A_HEAD_DIM); o += A_WIDTH
        ka = proj[..., o:o + A_WIDTH].reshape(B, S, A_HEADS, A_HEAD_DIM); o += A_WIDTH
        va = proj[..., o:o + A_WIDTH].reshape(B, S, A_HEADS, A_HEAD_DIM); o += A_WIDTH
        c_q = proj[..., o:o + Q_LORA]; o += Q_LORA
        c_kv = proj[..., o:o + KV_LORA]; o += KV_LORA
        k_rope = proj[..., o:o + B_ROPE]

        out_a = dilated_mixture_attention(qa, ka, va).reshape(B, S, A_WIDTH)

        q_b = (rms_norm(c_q, g_cq[i]) @ w_uq[i]).reshape(B, S, B_HEADS, B_NOPE + B_ROPE)
        q_nope = q_b[..., :B_NOPE]
        q_rope = apply_rope(q_b[..., B_NOPE:], cos[:, None, :], sin[:, None, :])
        kv_b = (rms_norm(c_kv, g_ckv[i]) @ w_ukv[i]).reshape(B, S, B_HEADS, B_NOPE + B_VDIM)
        k_nope = kv_b[..., :B_NOPE]
        v_b = kv_b[..., B_NOPE:]
        k_rope = apply_rope(k_rope, cos, sin)
        out_b = mla_attention(q_nope, q_rope, k_nope, k_rope, v_b)

        mixed = jnp.concatenate([rms_norm(out_a, g_out_a[i]), rms_norm(out_b, g_out_b[i])], axis=-1)
        h = h + mixed @ w_o[i]

        m = rms_norm(h, g_ffn[i]).reshape(B * S, D)
        h = h + hierarchical_moe(m, w_r1[i], b_r1[i], w_r2[i], b_r2[i],
                                 w_e_gate[i], w_e_up[i], w_e_down[i]).reshape(B, S, D)

        gate = jax.nn.sigmoid(rms_norm(h, g_ple[i]) @ w_ple_gate[i])
        h = h + gate * (p[i] @ w_ple_proj[i])
    return rms_norm(h, g_final)
```

```cpp
#include <hip/hip_runtime.h>
#include <cstdint>
#include <cstdio>
#include <cmath>

#define LAS __attribute__((address_space(3)))
#define GAS __attribute__((address_space(1)))
typedef unsigned short bf16_t;
typedef short bf16x8 __attribute__((ext_vector_type(8)));
typedef short s16x4 __attribute__((ext_vector_type(4)));
typedef float f32x2 __attribute__((ext_vector_type(2)));
typedef float f32x4 __attribute__((ext_vector_type(4)));
typedef float f32x16 __attribute__((ext_vector_type(16)));
typedef unsigned u32x2 __attribute__((ext_vector_type(2)));
typedef unsigned u32x4 __attribute__((ext_vector_type(4)));

__device__ __forceinline__ unsigned cvt_pk_bf16(float lo, float hi) { unsigned r; asm volatile("v_cvt_pk_bf16_f32 %0, %1, %2" : "=v"(r) : "v"(lo), "v"(hi)); return r; }
__device__ __forceinline__ float bf16lo(unsigned w) { return __uint_as_float(w << 16); }
__device__ __forceinline__ float bf16hi(unsigned w) { return __uint_as_float(w & 0xffff0000u); }
__device__ __forceinline__ int lane_id() { int r; asm volatile("v_mbcnt_lo_u32_b32 %0, -1, 0\n\tv_mbcnt_hi_u32_b32 %0, -1, %0" : "=v"(r)); return r; }
__device__ __forceinline__ float wsum64(float v) {
#pragma unroll
    for (int o = 1; o < 64; o <<= 1) v += __shfl_xor(v, o);
    return v;
}

namespace pg {
constexpr int BM = 256, BK = 64, HALF = 128, HTB = HALF * BK * 2, STAGE_BYTES = 8 * HTB, NXCD = 8, WGM = 8;
__host__ __device__ __forceinline__ int lds_byte(int r, int c) { const int st = (r >> 4) * 2 + (c >> 5), rr = r & 15, cc = c & 31, ob = rr * 64 + cc * 2; return st * 1024 + (ob ^ (((ob >> 9) & 1) << 5)); }
__host__ __device__ __forceinline__ void stage_rc(int b, int& R, int& C) { const int st = b / 1024, sb = b % 1024, swz = sb ^ (((sb >> 9) & 1) << 5); R = (st >> 1) * 16 + swz / 64; C = (st & 1) * 32 + (swz % 64) / 2; }
__host__ __device__ __forceinline__ int perm32(int rho) { const int n = rho >> 4, i = rho & 15; return 8 * (i >> 2) + 4 * n + (i & 3); }

struct Unit { int pm, pn, aux; };

__device__ __forceinline__ bool static_unit(int nM, int nN, int G, int c, int i, int& pm, int& pn) {
    const int nwg = nM * nN; const long L = (long)i * G + c; if (L >= nwg) return false;
    int wgid = (int)L; { const int q = nwg / NXCD, r = nwg % NXCD, xcd = wgid % NXCD, off = wgid / NXCD; wgid = (xcd < r ? xcd * (q + 1) : r * (q + 1) + (xcd - r) * q) + off; }
    const int nig = WGM * nN, gid = wgid / nig, fm = gid * WGM, gsz = (nM - fm) < WGM ? (nM - fm) : WGM;
    pm = fm + ((wgid % nig) % gsz); pn = (wgid % nig) / gsz; return true;
}

struct DenseSched {
    static constexpr bool GATHER = false;
    const char* A; const char* Bt; int lda, K, nM, nN, G, c;
    __device__ __forceinline__ bool next(int i, Unit& u) const { u.aux = 0; return static_unit(nM, nN, G, c, i, u.pm, u.pn); }
    __device__ __forceinline__ int a_ld() const { return lda; }
    __device__ __forceinline__ void addr(const Unit& u, const char*& abase, const char*& bbase) const {
        abase = A + (size_t)u.pm * BM * lda * 2; bbase = Bt + (size_t)u.pn * BM * K * 2; }
    __device__ __forceinline__ void addr_g(const Unit&, const int (&)[2], const int (&)[2], unsigned (&)[2][2], const char*&) const {}
    __device__ __forceinline__ const char* abase() const { return A; }
};

constexpr int EPI_STAGE_OFF = 139264, EPI_ROWB = 528;
template <class StoreFn>
__device__ __forceinline__ void staged_rows(LAS unsigned char* stage, u32x4 w0, u32x4 w1, int ai, int m, int wid, int lane, const StoreFn& store) {
    const int wr = wid >> 2, wc = wid & 3, fr = lane & 15, fq = lane >> 4, rr = 16 * wr + fr;
    *(LAS u32x4*)(stage + rr * EPI_ROWB + (32 * wc + 8 * fq) * 2) = w0;
    *(LAS u32x4*)(stage + rr * EPI_ROWB + (128 + 32 * wc + 8 * fq) * 2) = w1;
    asm volatile("s_waitcnt lgkmcnt(0)\n\ts_barrier" ::: "memory");
#pragma unroll
    for (int i = 0; i < 2; ++i) { const int r2 = 4 * wid + 2 * i + (lane >> 5), ch = lane & 31;
        const u32x4 v = *(const LAS u32x4*)(stage + r2 * EPI_ROWB + ch * 16);
        store(128 * ai + 64 * (r2 >> 4) + 16 * m + (r2 & 15), ch, v); }
    asm volatile("s_waitcnt lgkmcnt(0)\n\ts_barrier" ::: "memory");
}

template <class Epi, class Sched>
__device__ __forceinline__ void gemm_phase(LAS unsigned char* lds, const Sched& S, const Epi& E, int K, int wid) {
    const int lane = lane_id(), tid = wid * 64 + lane, wr = wid >> 2, wc = wid & 3, fr = lane & 15, fq = lane >> 4;
    const int nt = K / BK;
    int Rr[2], Cc[2]; unsigned voffB[2];
#pragma unroll
    for (int i = 0; i < 2; ++i) { int R, C; stage_rc(tid * 16 + i * 8192, R, C); Rr[i] = R; Cc[i] = C; const int Rb = (R & ~31) + perm32(R & 31); voffB[i] = (unsigned)(Rb * K + C) * 2u; }
    const size_t kstep = (size_t)(BK * 2);
    const size_t hstepB = (size_t)HALF * K * 2;
    const unsigned ldsw = (unsigned)wid * 1024u;
    const int aoff = lds_byte(wr * 64 + fr, fq * 8), boff = lds_byte(wc * 32 + fr, fq * 8);
    const char* const Ab = S.abase();
    constexpr bool GATHER = Sched::GATHER;
    unsigned voffA[2];
#pragma unroll
    for (int i = 0; i < 2; ++i) voffA[i] = (unsigned)(Rr[i] * S.a_ld() + Cc[i]) * 2u;
    const size_t hstepA = (size_t)HALF * S.a_ld() * 2;
#define PG_SA(b, h) (((b) * 2 + (h)) * HTB)
#define PG_SB(b, h) ((4 + (b) * 2 + (h)) * HTB)
#define PG_STAGEB(bufoff, gbase) do { _Pragma("unroll") for (int _i = 0; _i < 2; ++_i) \
        __builtin_amdgcn_global_load_lds((const unsigned*)((const char*)(gbase) + voffB[_i]), (LAS unsigned*)(lds + (bufoff) + ldsw + _i * 8192), 16, 0, 0); } while (0)
#define PG_STAGEA(bufoff, uptr, offs, h, kb) do { _Pragma("unroll") for (int _i = 0; _i < 2; ++_i) { \
        const char* _src; if constexpr (GATHER) _src = Ab + (size_t)(offs)[h][_i] + (kb); else _src = (uptr) + (h) * hstepA + (kb) + voffA[_i]; \
        __builtin_amdgcn_global_load_lds((const unsigned*)_src, (LAS unsigned*)(lds + (bufoff) + ldsw + _i * 8192), 16, 0, 0); } } while (0)
#define PG_LDA(dst, b, h) do { _Pragma("unroll") for (int m = 0; m < 4; ++m) _Pragma("unroll") for (int k = 0; k < 2; ++k) dst[m][k] = *(const LAS bf16x8*)(lds + PG_SA(b, h) + aoff + m * 2048 + k * 1024); } while (0)
#define PG_LDB(dst, b, h) do { _Pragma("unroll") for (int n = 0; n < 2; ++n) _Pragma("unroll") for (int k = 0; k < 2; ++k) dst[n][k] = *(const LAS bf16x8*)(lds + PG_SB(b, h) + boff + n * 2048 + k * 1024); } while (0)
#define PG_MMA(ai, bj, At, Bt_) do { __builtin_amdgcn_s_setprio(1); _Pragma("unroll") for (int m = 0; m < 4; ++m) _Pragma("unroll") for (int n = 0; n < 2; ++n) _Pragma("unroll") for (int k = 0; k < 2; ++k) \
        acc[ai][bj][m][n] = __builtin_amdgcn_mfma_f32_16x16x32_bf16(Bt_[n][k], At[m][k], acc[ai][bj][m][n], 0, 0, 0); __builtin_amdgcn_s_setprio(0); } while (0)
#define PG_WAIT_V(n) asm volatile("s_waitcnt vmcnt(" #n ")" ::: "memory")
#define PG_WAIT_L(n) asm volatile("s_waitcnt lgkmcnt(" #n ")" ::: "memory")
#define PG_BAR __builtin_amdgcn_s_barrier()
#define PG_SCHED __builtin_amdgcn_sched_barrier(0)
    Unit cur, nxt; int ui = 0;
    if (!S.next(0, cur)) return;
    f32x4 acc[2][2][4][2];
#pragma unroll
    for (int a = 0; a < 2; ++a)
#pragma unroll
        for (int b = 0; b < 2; ++b)
#pragma unroll
            for (int m = 0; m < 4; ++m)
#pragma unroll
                for (int n = 0; n < 2; ++n) acc[a][b][m][n] = (f32x4){0.f, 0.f, 0.f, 0.f};
    bf16x8 At[4][2], B0[2][2], B1[2][2];
    unsigned cao[2][2], nao[2][2]; const char* cA = nullptr; const char* nA = nullptr; const char* cB; const char* nB;
    if constexpr (GATHER) S.addr_g(cur, Rr, Cc, cao, cB); else S.addr(cur, cA, cB);
    PG_STAGEB(PG_SB(0, 0), cB); PG_STAGEB(PG_SB(0, 1), cB + hstepB); PG_STAGEA(PG_SA(0, 0), cA, cao, 0, 0); PG_STAGEA(PG_SA(0, 1), cA, cao, 1, 0);
    if (wr == 1) PG_BAR;
    PG_WAIT_V(2); PG_BAR;
    PG_STAGEB(PG_SB(1, 0), cB + kstep); PG_STAGEA(PG_SA(1, 0), cA, cao, 0, kstep); PG_STAGEB(PG_SB(1, 1), cB + hstepB + kstep);
    PG_WAIT_V(6); PG_BAR;
    for (;;) {
        const bool has_next = S.next(ui + 1, nxt);
        if (has_next) { if constexpr (GATHER) S.addr_g(nxt, Rr, Cc, nao, nB); else S.addr(nxt, nA, nB); }
        else { nB = cB; nA = cA;
            if constexpr (GATHER) {
#pragma unroll
                for (int h = 0; h < 2; ++h)
#pragma unroll
                    for (int i = 0; i < 2; ++i) nao[h][i] = cao[h][i]; } }
#pragma clang loop unroll(disable)
        for (int t = 0; t < nt; t += 2) {
            const bool last = (t == nt - 2);
            const size_t k1 = (size_t)(t + 1) * kstep;
            const size_t k2 = last ? 0 : (size_t)(t + 2) * kstep, k3 = k2 + kstep;
            const char* b2 = last ? nB : cB + (size_t)(t + 2) * kstep; const char* b3 = b2 + kstep;
            unsigned a2o[2][2]; const char* a2 = last ? nA : cA;
            if constexpr (GATHER) {
#pragma unroll
                for (int h = 0; h < 2; ++h)
#pragma unroll
                    for (int i = 0; i < 2; ++i) a2o[h][i] = last ? nao[h][i] : cao[h][i]; }
            PG_LDB(B0, 0, 0); PG_LDB(B1, 0, 1); PG_SCHED; PG_LDA(At, 0, 0); PG_STAGEA(PG_SA(1, 1), cA, cao, 1, k1);
            PG_WAIT_V(8); PG_WAIT_L(0); PG_BAR; PG_MMA(0, 0, At, B0); PG_MMA(0, 1, At, B1); PG_BAR; PG_SCHED;
            PG_LDA(At, 0, 1); PG_STAGEB(PG_SB(0, 0), b2); PG_STAGEB(PG_SB(0, 1), b2 + hstepB); PG_STAGEA(PG_SA(0, 0), a2, a2o, 0, k2);
            PG_WAIT_V(8); PG_WAIT_L(0); PG_BAR; PG_MMA(1, 0, At, B0); PG_MMA(1, 1, At, B1); PG_BAR; PG_SCHED;
            PG_LDB(B0, 1, 0); PG_LDB(B1, 1, 1); PG_SCHED; PG_LDA(At, 1, 0); PG_STAGEA(PG_SA(0, 1), a2, a2o, 1, k2);
            PG_WAIT_V(8); PG_WAIT_L(0); PG_BAR; PG_MMA(0, 0, At, B0); PG_MMA(0, 1, At, B1); PG_BAR; PG_SCHED;
            PG_LDA(At, 1, 1); PG_STAGEB(PG_SB(1, 0), b3); PG_STAGEB(PG_SB(1, 1), b3 + hstepB); PG_STAGEA(PG_SA(1, 0), a2, a2o, 0, k3);
            PG_WAIT_V(8); PG_WAIT_L(0); PG_BAR; PG_MMA(1, 0, At, B0); PG_MMA(1, 1, At, B1); PG_BAR; PG_SCHED;
        }
        if (wr == 0) PG_BAR;
        { const int l2 = lane_id();
          E(acc, cur, wr, wc, l2 & 15, l2 >> 4, lds + EPI_STAGE_OFF, wid); }
        if (!has_next) break;
#pragma unroll
        for (int a = 0; a < 2; ++a)
#pragma unroll
            for (int b = 0; b < 2; ++b)
#pragma unroll
                for (int m = 0; m < 4; ++m)
#pragma unroll
                    for (int n = 0; n < 2; ++n) acc[a][b][m][n] = (f32x4){0.f, 0.f, 0.f, 0.f};
        cur = nxt; cB = nB; cA = nA;
        if constexpr (GATHER) {
#pragma unroll
            for (int h = 0; h < 2; ++h)
#pragma unroll
                for (int i = 0; i < 2; ++i) cao[h][i] = nao[h][i]; }
        ++ui;
        if (wr == 1) PG_BAR;
    }
    PG_WAIT_V(0);
    PG_BAR;
#undef PG_SA
#undef PG_SB
#undef PG_STAGEA
#undef PG_STAGEB
#undef PG_LDA
#undef PG_LDB
#undef PG_MMA
#undef PG_WAIT_V
#undef PG_WAIT_L
#undef PG_BAR
#undef PG_SCHED
}
}

#define XB_TMO      128
#define XB_XCNT(j)  (256  + 64 * (j))
#define XB_XSUB(j)  (1280 + 64 * (j))
#define XB_XGEN(j)  (2304 + 64 * (j))
#define XB_TOP      3328
#define XB_TOPGEN   3392
#define XCD_BAR_WORDS 3456
#define XB_SPIN_CAP (1u << 22)
__device__ __forceinline__ unsigned xb_ld(unsigned* p)              { return __hip_atomic_load(p, __ATOMIC_RELAXED, __HIP_MEMORY_SCOPE_AGENT); }
__device__ __forceinline__ unsigned xb_add(unsigned* p, unsigned v) { return __hip_atomic_fetch_add(p, v, __ATOMIC_RELAXED, __HIP_MEMORY_SCOPE_AGENT); }
__device__ __forceinline__ unsigned xb_xcc_id() { return (unsigned)__builtin_amdgcn_s_getreg((3 << 11) | 20) & 0xFu; }
#define XB_SPIN(cond, bar) do { unsigned _sp = 0; while (cond) { __builtin_amdgcn_s_sleep(1); \
    if ((++_sp & 255u) == 0u) { if (xb_ld(&(bar)[XB_TMO])) break; if (_sp > XB_SPIN_CAP) { atomicAdd(&(bar)[XB_TMO], 1u); break; } } } } while (0)
struct XcdBarrier { unsigned* bar; unsigned x; volatile LAS unsigned* st; };
__device__ __forceinline__ XcdBarrier xcd_barrier_post(unsigned* bar, volatile LAS unsigned* st) {
    XcdBarrier b; b.bar = bar; b.x = xb_xcc_id(); b.st = st;
    if (threadIdx.x == 0) (void)xb_add(&bar[XB_XCNT(b.x)], 1u);
    return b;
}
__device__ __forceinline__ void xcd_barrier_complete(unsigned* bar, unsigned x, unsigned& nloc, unsigned& nx) {
    const unsigned G = gridDim.x * gridDim.y * gridDim.z;
    unsigned sum, cnt, mine, sp = 0u;
    for (;;) {
        sum = 0u; cnt = 0u; mine = 0u;
#pragma unroll
        for (unsigned j = 0; j < 16; ++j) { const unsigned c = xb_ld(&bar[XB_XCNT(j)]); sum += c; cnt += (c > 0u) ? 1u : 0u; mine = (j == x) ? c : mine; }
        if (sum == G) break;
        __builtin_amdgcn_s_sleep(1);
        if ((++sp & 255u) == 0u) { if (xb_ld(&bar[XB_TMO])) break; if (sp > XB_SPIN_CAP) { atomicAdd(&bar[XB_TMO], 1u); break; } }
    }
    nloc = mine > 0u ? mine : 1u; nx = cnt > 0u ? cnt : 1u;
}
__device__ __forceinline__ void xcd_barrier(const XcdBarrier& b) {
    asm volatile("s_waitcnt vmcnt(0)" ::: "memory");
    __syncthreads();
    if (threadIdx.x == 0) {
        unsigned* bar = b.bar;
        __builtin_amdgcn_s_waitcnt(0);
        unsigned nloc = b.st[0], nx = b.st[1];
        if (nloc == 0u) { xcd_barrier_complete(bar, b.x, nloc, nx); b.st[0] = nloc; b.st[1] = nx; }
        const unsigned old = xb_add(&bar[XB_XSUB(b.x)], 1u);
        const unsigned gen = old / nloc;
        if (old + 1u == (gen + 1u) * nloc) {
            __builtin_amdgcn_fence(__ATOMIC_RELEASE, "agent");
            asm volatile("s_waitcnt vmcnt(0)" ::: "memory");
            const unsigned og = xb_add(&bar[XB_TOP], 1u);
            const unsigned tg = og / nx;
            if (og + 1u == (tg + 1u) * nx) xb_add(&bar[XB_TOPGEN], 1u);
            else XB_SPIN(xb_ld(&bar[XB_TOPGEN]) == tg, bar);
            __builtin_amdgcn_fence(__ATOMIC_ACQUIRE, "agent");
            xb_add(&bar[XB_XGEN(b.x)], 1u);
            asm volatile("s_waitcnt vmcnt(0)" ::: "memory");
        } else {
            XB_SPIN(xb_ld(&bar[XB_XGEN(b.x)]) == gen, bar);
            __builtin_amdgcn_fence(__ATOMIC_ACQUIRE, "agent");
            asm volatile("s_waitcnt vmcnt(0)" ::: "memory");
        }
    }
    __syncthreads();
}

constexpr int NB = 8, SEQ = 4096, T = NB * SEQ, DM = 1024;
constexpr int INW = 2208, INWP = 2304;
constexpr int QLORA = 384, KVLORA = 256;
constexpr float EPS = 1e-6f;
constexpr float LOG2E = 1.4426950408889634f;
constexpr float QA_SCALE = 0.125f * LOG2E;
constexpr float MLA_QSCALE = 0.10206207261596577f * LOG2E;
constexpr int NWAVES = 8;

constexpr size_t MiB = 1u << 20;
constexpr size_t WS_CTL = 0, CTL_ZERO_BYTES = 1 * MiB;
constexpr size_t WS_ROPE = 1 * MiB;
constexpr size_t WS_SSQ = 2 * MiB;
constexpr size_t WS_WIN = 5 * MiB, WS_WUQ = 10 * MiB, WS_WUKV = 11 * MiB, WS_WO = 12 * MiB, WS_WPG = 14 * MiB, WS_WPP = 16 * MiB, WS_WGU = 17 * MiB, WS_WD = 49 * MiB;
constexpr size_t WS_XN = 65 * MiB;
constexpr size_t WS_P16 = 129 * MiB;
constexpr size_t WS_PP = 145 * MiB;
constexpr size_t WS_QA = 209 * MiB, WS_KA = 241 * MiB, WS_VA = 273 * MiB;
static_assert(WS_KA - WS_QA == (size_t)T * 512 * 2 && WS_VA - WS_KA == (size_t)T * 512 * 2, "QA|KA|VA contiguous");
constexpr size_t WS_CQKV = 305 * MiB;
constexpr size_t WS_QB = 345 * MiB, WS_KB = 393 * MiB;
constexpr size_t WS_VB = 441 * MiB;
constexpr size_t WS_OB = 473 * MiB;
constexpr size_t WS_OAP0 = 65 * MiB, WS_OAP1 = 97 * MiB, WS_OAP2 = 305 * MiB;
constexpr size_t WS_LSE = 129 * MiB;
constexpr size_t WS_MIXED = 209 * MiB;
constexpr size_t WS_M = 65 * MiB;
constexpr size_t WS_Y = 209 * MiB;
constexpr size_t WS_HID = 353 * MiB;
constexpr size_t WS_LIST = 132 * MiB;
constexpr size_t WS_RS2 = 136 * MiB + 896 * 1024;
constexpr size_t WS_TOKINFO = 136 * MiB;
constexpr int CW_BAR = 4096, CW_CNT = 16384, CW_Q = 20480;

constexpr int RING_BYTES = 131072;
constexpr int LDSCTL_OFF = RING_BYTES, MISC_OFF = LDSCTL_OFF + 320;
constexpr int LDS_BYTES = 163840;

struct Args { const float* in[23]; float* out; unsigned char* ws; int ph_lo, ph_hi, li, pad; };
struct Frame {
    LAS unsigned char* lds;
    int wave, vcu, G;
    unsigned char* ws; unsigned* ctl;
};

__device__ __forceinline__ void p0_transpose_item(const float* __restrict__ W, int ldw, int k0, int n0, bf16_t* WT, int ldd, int drow0, const float* __restrict__ gain, LAS float* scr, int lane) {
    const int kq = lane >> 3, n4 = (lane & 7) * 4;
    f32x4 v[8];
#pragma unroll
    for (int i = 0; i < 8; ++i) v[i] = *(const f32x4*)(W + (size_t)(k0 + kq + 8 * i) * ldw + n0 + n4);
#pragma unroll
    for (int i = 0; i < 8; ++i) { const int kk = kq + 8 * i; f32x4 x = v[i]; if (gain) x = x * gain[k0 + kk];
        scr[kk * 33 + n4] = x[0]; scr[kk * 33 + n4 + 1] = x[1]; scr[kk * 33 + n4 + 2] = x[2]; scr[kk * 33 + n4 + 3] = x[3]; }
    asm volatile("s_waitcnt lgkmcnt(0)" ::: "memory");
    const int c = lane & 7;
#pragma unroll
    for (int j = 0; j < 4; ++j) { const int n = (lane >> 3) + 8 * j; const LAS float* s = scr + (8 * c) * 33 + n;
        u32x4 o; o.x = cvt_pk_bf16(s[0 * 33], s[1 * 33]); o.y = cvt_pk_bf16(s[2 * 33], s[3 * 33]); o.z = cvt_pk_bf16(s[4 * 33], s[5 * 33]); o.w = cvt_pk_bf16(s[6 * 33], s[7 * 33]);
        *(u32x4*)(WT + (size_t)(drow0 + n) * ldd + k0 + 8 * c) = o; }
    asm volatile("s_waitcnt lgkmcnt(0)" ::: "memory");
}
__device__ __forceinline__ void rms_row_to_bf16(const float* xrow, const float* __restrict__ g, bf16_t* orow, int lane) {
    const f32x4* xr = (const f32x4*)xrow + lane; const f32x4* gr = (const f32x4*)g + lane;
    f32x4 v[4]; float s = 0.f;
#pragma unroll
    for (int j = 0; j < 4; ++j) { v[j] = xr[64 * j]; s += (v[j].x * v[j].x + v[j].y * v[j].y) + (v[j].z * v[j].z + v[j].w * v[j].w); }
    const float rstd = 1.0f / sqrtf(wsum64(s) * (1.f / 1024.f) + EPS);
    u32x2* o8 = (u32x2*)orow + lane;
#pragma unroll
    for (int j = 0; j < 4; ++j) { const f32x4 gg = gr[64 * j]; u32x2 w; w.x = cvt_pk_bf16(v[j].x * rstd * gg.x, v[j].y * rstd * gg.y); w.y = cvt_pk_bf16(v[j].z * rstd * gg.z, v[j].w * rstd * gg.w); o8[64 * j] = w; }
}

__device__ __forceinline__ void p0_prologue(const Frame& F, const Args& a) {
    LAS float* scr = (LAS float*)(F.lds + F.wave * 16384);
    const int gw = F.vcu * NWAVES + F.wave, NGW = F.G * NWAVES, lane = lane_id();
    unsigned char* ws = F.ws;
    const float* w_in = a.in[3]; const float* g_cq = a.in[4]; const float* w_uq = a.in[5]; const float* g_ckv = a.in[6]; const float* w_ukv = a.in[7];
    const float* w_o = a.in[10]; const float* w_eg = a.in[16]; const float* w_eu = a.in[17]; const float* w_ed = a.in[18]; const float* w_pg = a.in[20]; const float* w_pp = a.in[21];
    constexpr int I_IN = 16 * 69, I_UQ = 6 * 24, I_UKV = 4 * 32, I_O = 16 * 32, I_PG = 16 * 32, I_PP = 4 * 32, I_EG = 32 * 16 * 8, I_EU = I_EG, I_ED = 32 * 4 * 32;
    constexpr int NITEMS = I_IN + I_UQ + I_UKV + I_O + I_PG + I_PP + I_EG + I_EU + I_ED;
    for (int it = gw; it < NITEMS; it += NGW) {
        int r = it;
        if (r < I_IN) { const int kb = r / 69, nb = r % 69; p0_transpose_item(w_in, INW, 64 * kb, 32 * nb, (bf16_t*)(ws + WS_WIN), 1024, 32 * nb, nullptr, scr, lane); continue; } r -= I_IN;
        if (r < I_UQ) { const int kb = r / 24, nb = r % 24; p0_transpose_item(w_uq, 768, 64 * kb, 32 * nb, (bf16_t*)(ws + WS_WUQ), QLORA, 32 * nb, g_cq, scr, lane); continue; } r -= I_UQ;
        if (r < I_UKV) { const int kb = r / 32, nb = r % 32; p0_transpose_item(w_ukv, 1024, 64 * kb, 32 * nb, (bf16_t*)(ws + WS_WUKV), KVLORA, 32 * nb, g_ckv, scr, lane); continue; } r -= I_UKV;
        if (r < I_O) { const int kb = r / 32, nb = r % 32; p0_transpose_item(w_o, 1024, 64 * kb, 32 * nb, (bf16_t*)(ws + WS_WO), 1024, 32 * nb, nullptr, scr, lane); continue; } r -= I_O;
        if (r < I_PG) { const int kb = r / 32, nb = r % 32; p0_transpose_item(w_pg, 1024, 64 * kb, 32 * nb, (bf16_t*)(ws + WS_WPG), 1024, 32 * nb, a.in[19], scr, lane); continue; } r -= I_PG;
        if (r < I_PP) { const int kb = r / 32, nb = r % 32; p0_transpose_item(w_pp, 1024, 64 * kb, 32 * nb, (bf16_t*)(ws + WS_WPP), 256, 32 * nb, nullptr, scr, lane); continue; } r -= I_PP;
        if (r < I_EG + I_EU) {
            const int up = r >= I_EG; if (up) r -= I_EG;
            const int e = r / 128, q = r % 128, kb = q / 8, nb = q % 8, n0 = 32 * nb;
            const int drow = (n0 >> 7) * 256 + (up ? 128 : 0) + (n0 & 127);
            p0_transpose_item((up ? w_eu : w_eg) + (size_t)e * 1024 * 256, 256, 64 * kb, n0, (bf16_t*)(ws + WS_WGU) + (size_t)e * 512 * 1024, 1024, drow, a.in[11], scr, lane); continue; }
        r -= I_EG + I_EU;
        { const int e = r / 128, q = r % 128, kb = q / 32, nb = q % 32;
          p0_transpose_item(w_ed + (size_t)e * 256 * 1024, 1024, 64 * kb, 32 * nb, (bf16_t*)(ws + WS_WD) + (size_t)e * 1024 * 256, 256, 32 * nb, nullptr, scr, lane); }
    }
    for (int i = gw * 64 + lane; i < 96 * 128; i += NGW * 64) ((u32x4*)((bf16_t*)(ws + WS_WIN) + (size_t)INW * 1024))[i] = (u32x4){0u, 0u, 0u, 0u};
    { const float* x = a.in[0]; const float* g_mix = a.in[2]; bf16_t* XN = (bf16_t*)(ws + WS_XN);
      f32x4 gg[4];
#pragma unroll
      for (int j = 0; j < 4; ++j) gg[j] = ((const f32x4*)g_mix)[lane + 64 * j];
      for (int m = gw * 2; m < T; m += NGW * 2) {
          f32x4 v0[4], v1[4]; float s0 = 0.f, s1 = 0.f;
#pragma unroll
          for (int j = 0; j < 4; ++j) { v0[j] = ((const f32x4*)(x + (size_t)m * DM))[lane + 64 * j]; v1[j] = ((const f32x4*)(x + (size_t)(m + 1) * DM))[lane + 64 * j]; }
#pragma unroll
          for (int j = 0; j < 4; ++j) { s0 += (v0[j].x * v0[j].x + v0[j].y * v0[j].y) + (v0[j].z * v0[j].z + v0[j].w * v0[j].w); s1 += (v1[j].x * v1[j].x + v1[j].y * v1[j].y) + (v1[j].z * v1[j].z + v1[j].w * v1[j].w); }
          const float r0 = 1.0f / sqrtf(wsum64(s0) * (1.f / 1024.f) + EPS), r1 = 1.0f / sqrtf(wsum64(s1) * (1.f / 1024.f) + EPS);
#pragma unroll
          for (int j = 0; j < 4; ++j) { u32x2 w0, w1;
              w0.x = cvt_pk_bf16(v0[j].x * r0 * gg[j].x, v0[j].y * r0 * gg[j].y); w0.y = cvt_pk_bf16(v0[j].z * r0 * gg[j].z, v0[j].w * r0 * gg[j].w);
              w1.x = cvt_pk_bf16(v1[j].x * r1 * gg[j].x, v1[j].y * r1 * gg[j].y); w1.y = cvt_pk_bf16(v1[j].z * r1 * gg[j].z, v1[j].w * r1 * gg[j].w);
              ((u32x2*)(XN + (size_t)m * DM))[lane + 64 * j] = w0; ((u32x2*)(XN + (size_t)(m + 1) * DM))[lane + 64 * j] = w1; } } }
    { const float* p = a.in[1]; bf16_t* P16 = (bf16_t*)(ws + WS_P16);
      for (size_t i = (size_t)gw * 64 + lane; i < (size_t)T * 256 / 8; i += (size_t)NGW * 64) {
          const f32x4 v0 = ((const f32x4*)p)[2 * i], v1 = ((const f32x4*)p)[2 * i + 1];
          u32x4 o; o.x = cvt_pk_bf16(v0.x, v0.y); o.y = cvt_pk_bf16(v0.z, v0.w); o.z = cvt_pk_bf16(v1.x, v1.y); o.w = cvt_pk_bf16(v1.z, v1.w);
          ((u32x4*)P16)[i] = o; } }
    { float* cs = (float*)(ws + WS_ROPE); float* sn = cs + SEQ * 16;
      for (int idx = gw * 64 + lane; idx < SEQ * 16; idx += NGW * 64) {
          const int pos = idx >> 4, i = idx & 15;
          const float inv = 1.0f / powf(10000.0f, (float)(2 * i) / 32.0f);
          const float ang = (float)pos * inv;
          cs[idx] = (float)cos((double)ang); sn[idx] = (float)sin((double)ang); } }
}

struct EpiInProj {
    bf16_t *QA, *CQKV, *KB; float* SSQ; const float* CS; const float* SN;
    __device__ __forceinline__ void operator()(const f32x4 (&acc)[2][2][4][2], const pg::Unit& u, int wr, int wc, int fr, int fq, LAS unsigned char* stage, int wid) const {
        const int pn = u.pn;
        if (pn < 6) {
            bf16_t* const tile = QA + (size_t)(pn >> 1) * ((size_t)T * 512) + (size_t)u.pm * 256 * 512 + (pn & 1) * 256; const float sc = (pn < 2) ? QA_SCALE : 1.f;
            const int lane = fr + 16 * fq;
#pragma unroll
            for (int ai = 0; ai < 2; ++ai)
#pragma unroll
                for (int m = 0; m < 4; ++m) { u32x4 w[2];
#pragma unroll
                    for (int bj = 0; bj < 2; ++bj) { const f32x4 v0 = acc[ai][bj][m][0] * sc, v1 = acc[ai][bj][m][1] * sc;
                        w[bj].x = cvt_pk_bf16(v0[0], v0[1]); w[bj].y = cvt_pk_bf16(v0[2], v0[3]); w[bj].z = cvt_pk_bf16(v1[0], v1[1]); w[bj].w = cvt_pk_bf16(v1[2], v1[3]); }
                    pg::staged_rows(stage, w[0], w[1], ai, m, wid, lane, [tile](int trow, int ch, u32x4 v) { __builtin_nontemporal_store(v, (u32x4*)(tile + (size_t)trow * 512 + ch * 8)); }); }
        } else {
#pragma unroll
            for (int ai = 0; ai < 2; ++ai)
#pragma unroll
                for (int m = 0; m < 4; ++m) { const int row = u.pm * 256 + ai * 128 + wr * 64 + m * 16 + fr;
#pragma unroll
                    for (int bj = 0; bj < 2; ++bj) {
                        const f32x4 v0 = acc[ai][bj][m][0], v1 = acc[ai][bj][m][1];
                        if (pn < 8 || bj == 0) {
                            const int col = (pn - 6) * 256 + bj * 128 + wc * 32 + 8 * fq; u32x4 w;
                            w.x = cvt_pk_bf16(v0[0], v0[1]); w.y = cvt_pk_bf16(v0[2], v0[3]); w.z = cvt_pk_bf16(v1[0], v1[1]); w.w = cvt_pk_bf16(v1[2], v1[3]);
                            *(u32x4*)(CQKV + (size_t)row * 640 + col) = w;
                            float s = (v0[0] * v0[0] + v0[1] * v0[1]) + (v0[2] * v0[2] + v0[3] * v0[3]) + (v1[0] * v1[0] + v1[1] * v1[1]) + (v1[2] * v1[2] + v1[3] * v1[3]);
                            s += __shfl_xor(s, 16); s += __shfl_xor(s, 32);
                            if (fq == 0) SSQ[(size_t)row * 20 + (pn - 6) * 8 + bj * 4 + wc] = s;
                        } else if (wc == 0) {
                            const int pos = row & (SEQ - 1); const int ci = pos * 16 + 8 * (fq & 1);
                            const f32x4 c0 = *(const f32x4*)(CS + ci), c1 = *(const f32x4*)(CS + ci + 4), s0 = *(const f32x4*)(SN + ci), s1 = *(const f32x4*)(SN + ci + 4);
                            f32x4 p0, p1;
#pragma unroll
                            for (int j = 0; j < 4; ++j) { p0[j] = __shfl_xor(v0[j], 32); p1[j] = __shfl_xor(v1[j], 32); }
                            f32x4 o0, o1;
                            if (fq < 2) { o0 = v0 * c0 - p0 * s0; o1 = v1 * c1 - p1 * s1; }
                            else        { o0 = p0 * s0 + v0 * c0; o1 = p1 * s1 + v1 * c1; }
                            u32x4 w; w.x = cvt_pk_bf16(o0[0], o0[1]); w.y = cvt_pk_bf16(o0[2], o0[3]); w.z = cvt_pk_bf16(o1[0], o1[1]); w.w = cvt_pk_bf16(o1[2], o1[3]);
#pragma unroll
                            for (int h = 0; h < 8; ++h) *(u32x4*)(KB + (size_t)row * 768 + h * 96 + 64 + 8 * fq) = w;
                        }
                    } }
        }
    }
};
struct EpiStoreBf16 {
    bf16_t* O; int ldc;
    __device__ __forceinline__ void operator()(const f32x4 (&acc)[2][2][4][2], const pg::Unit& u, int wr, int wc, int fr, int fq, LAS unsigned char* stage, int wid) const {
        const int lane = fr + 16 * fq; bf16_t* const tile = O + (size_t)u.pm * 256 * ldc + u.pn * 256; const int ld = ldc;
#pragma unroll
        for (int ai = 0; ai < 2; ++ai)
#pragma unroll
            for (int m = 0; m < 4; ++m) { u32x4 w[2];
#pragma unroll
                for (int bj = 0; bj < 2; ++bj) { const f32x4 v0 = acc[ai][bj][m][0], v1 = acc[ai][bj][m][1];
                    w[bj].x = cvt_pk_bf16(v0[0], v0[1]); w[bj].y = cvt_pk_bf16(v0[2], v0[3]); w[bj].z = cvt_pk_bf16(v1[0], v1[1]); w[bj].w = cvt_pk_bf16(v1[2], v1[3]); }
                pg::staged_rows(stage, w[0], w[1], ai, m, wid, lane, [tile, ld](int trow, int ch, u32x4 v) { __builtin_nontemporal_store(v, (u32x4*)(tile + (size_t)trow * ld + ch * 8)); }); }
    }
};
struct EpiQUp {
    bf16_t* QB; const float* SSQ; const float* CS; const float* SN;
    __device__ __forceinline__ void operator()(const f32x4 (&acc)[2][2][4][2], const pg::Unit& u, int wr, int wc, int fr, int fq, LAS unsigned char* stage, int wid) const {
        float rstd[2][4];
#pragma unroll
        for (int ai = 0; ai < 2; ++ai)
#pragma unroll
            for (int m = 0; m < 4; ++m) { const int row = u.pm * 256 + ai * 128 + wr * 64 + m * 16 + fr;
                const f32x4 q0 = *(const f32x4*)(SSQ + (size_t)row * 20), q1 = *(const f32x4*)(SSQ + (size_t)row * 20 + 4), q2 = *(const f32x4*)(SSQ + (size_t)row * 20 + 8);
                const float ss = ((q0[0] + q0[1]) + (q0[2] + q0[3])) + ((q1[0] + q1[1]) + (q1[2] + q1[3])) + ((q2[0] + q2[1]) + (q2[2] + q2[3]));
                rstd[ai][m] = 1.0f / sqrtf(ss * (1.f / 384.f) + EPS);
                if (m == 3) asm volatile("" : "+v"(rstd[ai][0]), "+v"(rstd[ai][1]), "+v"(rstd[ai][2]), "+v"(rstd[ai][3]) :: "memory"); }
        const int G0 = u.pn * 8 + wc;
        const int rbj = (G0 % 3 == 2) ? 0 : (((G0 + 4) % 3 == 2) ? 1 : -1);
#pragma unroll
        for (int ai = 0; ai < 2; ++ai)
#pragma unroll
          for (int mh = 0; mh < 2; ++mh) {
            f32x4 c0[2], c1[2], s0[2], s1[2];
#pragma unroll
            for (int m = 0; m < 2; ++m) { c0[m] = f32x4{0.f, 0.f, 0.f, 0.f}; c1[m] = c0[m]; s0[m] = c0[m]; s1[m] = c0[m]; }
            if (rbj >= 0) {
#pragma unroll
                for (int m = 0; m < 2; ++m) { const int row = u.pm * 256 + ai * 128 + wr * 64 + (2 * mh + m) * 16 + fr;
                    const int pos = row & (SEQ - 1); const int ci = pos * 16 + 8 * (fq & 1);
                    c0[m] = *(const f32x4*)(CS + ci); c1[m] = *(const f32x4*)(CS + ci + 4); s0[m] = *(const f32x4*)(SN + ci); s1[m] = *(const f32x4*)(SN + ci + 4); }
            }
#pragma unroll
            for (int mm = 0; mm < 2; ++mm) { const int m = 2 * mh + mm; const int row = u.pm * 256 + ai * 128 + wr * 64 + m * 16 + fr;
#pragma unroll
                for (int bj = 0; bj < 2; ++bj) { const int G = G0 + bj * 4;
                    f32x4 v0 = acc[ai][bj][m][0] * rstd[ai][m], v1 = acc[ai][bj][m][1] * rstd[ai][m];
                    if (bj == rbj) {
                        f32x4 p0, p1;
#pragma unroll
                        for (int j = 0; j < 4; ++j) { p0[j] = __shfl_xor(v0[j], 32); p1[j] = __shfl_xor(v1[j], 32); }
                        if (fq < 2) { v0 = v0 * c0[mm] - p0 * s0[mm]; v1 = v1 * c1[mm] - p1 * s1[mm]; }
                        else        { v0 = p0 * s0[mm] + v0 * c0[mm]; v1 = p1 * s1[mm] + v1 * c1[mm]; }
                    }
                    v0 = v0 * MLA_QSCALE; v1 = v1 * MLA_QSCALE;
                    u32x4 w; w.x = cvt_pk_bf16(v0[0], v0[1]); w.y = cvt_pk_bf16(v0[2], v0[3]); w.z = cvt_pk_bf16(v1[0], v1[1]); w.w = cvt_pk_bf16(v1[2], v1[3]);
                    *(u32x4*)(QB + (size_t)row * 768 + G * 32 + 8 * fq) = w; } }
          }
    }
};
struct EpiKVUp {
    bf16_t *KB, *VB; const float* SSQ;
    __device__ __forceinline__ void operator()(const f32x4 (&acc)[2][2][4][2], const pg::Unit& u, int wr, int wc, int fr, int fq, LAS unsigned char* stage, int wid) const {
        float rstd[2][4];
#pragma unroll
        for (int ai = 0; ai < 2; ++ai)
#pragma unroll
            for (int m = 0; m < 4; ++m) { const int row = u.pm * 256 + ai * 128 + wr * 64 + m * 16 + fr;
                const f32x4 q0 = *(const f32x4*)(SSQ + (size_t)row * 20 + 12), q1 = *(const f32x4*)(SSQ + (size_t)row * 20 + 16);
                const float ss = ((q0[0] + q0[1]) + (q0[2] + q0[3])) + ((q1[0] + q1[1]) + (q1[2] + q1[3]));
                rstd[ai][m] = 1.0f / sqrtf(ss * (1.f / 256.f) + EPS);
                if (m == 3) asm volatile("" : "+v"(rstd[ai][0]), "+v"(rstd[ai][1]), "+v"(rstd[ai][2]), "+v"(rstd[ai][3]) :: "memory"); }
#pragma unroll
        for (int ai = 0; ai < 2; ++ai)
#pragma unroll
            for (int m = 0; m < 4; ++m) { const int row = u.pm * 256 + ai * 128 + wr * 64 + m * 16 + fr;
#pragma unroll
                for (int bj = 0; bj < 2; ++bj) { const int G = u.pn * 8 + bj * 4 + wc;
                    const int h = G >> 2, part = G & 3;
                    const f32x4 v0 = acc[ai][bj][m][0] * rstd[ai][m], v1 = acc[ai][bj][m][1] * rstd[ai][m];
                    u32x4 w; w.x = cvt_pk_bf16(v0[0], v0[1]); w.y = cvt_pk_bf16(v0[2], v0[3]); w.z = cvt_pk_bf16(v1[0], v1[1]); w.w = cvt_pk_bf16(v1[2], v1[3]);
                    if (part < 2) *(u32x4*)(KB + (size_t)row * 768 + h * 96 + part * 32 + 8 * fq) = w;
                    else          *(u32x4*)(VB + (size_t)row * 512 + h * 64 + (part - 2) * 32 + 8 * fq) = w; } }
    }
};

struct PPSched {
    static constexpr bool GATHER = false;
    const char* A; const char* Bt; int q, nP, first, last;
    __device__ __forceinline__ bool next(int i, pg::Unit& u) const { if (q < 0) return false; const int L = first + i * nP + q; if (L >= last) return false; u.aux = 0; u.pm = L >> 2; u.pn = L & 3; return true; }
    __device__ __forceinline__ int a_ld() const { return 256; }
    __device__ __forceinline__ void addr(const pg::Unit& u, const char*& abase, const char*& bbase) const { abase = A + (size_t)u.pm * pg::BM * 256 * 2; bbase = Bt + (size_t)u.pn * pg::BM * 256 * 2; }
    __device__ __forceinline__ void addr_g(const pg::Unit&, const int (&)[2], const int (&)[2], unsigned (&)[2][2], const char*&) const {}
    __device__ __forceinline__ const char* abase() const { return A; }
};
__device__ __forceinline__ void pp_units(const Frame& F, bool second) {
    unsigned char* ws = F.ws; const int c0 = F.G / 2, nP = F.G - c0, n1 = (2 * nP < 512) ? 2 * nP : 512;
    PPSched S{(const char*)(ws + WS_P16), (const char*)(ws + WS_WPP), (int)blockIdx.x - c0, nP, second ? n1 : 0, second ? 512 : n1};
    EpiStoreBf16 E{(bf16_t*)(ws + WS_PP), 1024};
    pg::gemm_phase(F.lds, S, E, 256, F.wave);
}
__device__ __forceinline__ void p1_inproj(const Frame& F) {
    unsigned char* ws = F.ws;
    { pg::DenseSched S{(const char*)(ws + WS_XN), (const char*)(ws + WS_WIN), 1024, 1024, T / 256, INWP / 256, F.G, (int)blockIdx.x};
      EpiInProj E{(bf16_t*)(ws + WS_QA), (bf16_t*)(ws + WS_CQKV), (bf16_t*)(ws + WS_KB), (float*)(ws + WS_SSQ), (const float*)(ws + WS_ROPE), (const float*)(ws + WS_ROPE) + SEQ * 16};
      pg::gemm_phase(F.lds, S, E, 1024, F.wave); }
    pp_units(F, false);
}
__device__ __forceinline__ void p2_upproj(const Frame& F) {
    unsigned char* ws = F.ws;
    { pg::DenseSched S{(const char*)(ws + WS_CQKV), (const char*)(ws + WS_WUQ), 640, QLORA, T / 256, 3, F.G, (int)blockIdx.x};
      EpiQUp E{(bf16_t*)(ws + WS_QB), (const float*)(ws + WS_SSQ), (const float*)(ws + WS_ROPE), (const float*)(ws + WS_ROPE) + SEQ * 16};
      pg::gemm_phase(F.lds, S, E, QLORA, F.wave); }
    { pg::DenseSched S{(const char*)(ws + WS_CQKV) + 384 * 2, (const char*)(ws + WS_WUKV), 640, KVLORA, T / 256, 4, F.G, (int)blockIdx.x};
      EpiKVUp E{(bf16_t*)(ws + WS_KB), (bf16_t*)(ws + WS_VB), (const float*)(ws + WS_SSQ)};
      pg::gemm_phase(F.lds, S, E, KVLORA, F.wave); }
    pp_units(F, true);
}

namespace mla {
constexpr int QBLK = 32, KVBLK = 64, LDQ = 768, LDKk = 768, LDV = 512, LDO = 512;
constexpr float SCALE = 0.10206207261596577f;
constexpr int SHM_V = KVBLK * 64 * 2  , SHM_K = KVBLK * 256  ;
#define KSWZ(row, colB) ((row) * 256 + ((colB) ^ (((row) & 15) << 4)))
#define SBAR() __builtin_amdgcn_sched_barrier(0)
__device__ __forceinline__ int crow(int r, int hi) { return (r & 3) + 8 * (r >> 2) + 4 * hi; }

__device__ __forceinline__ int v_rd_base(int lane) { return ((lane & 3) << 3) | (((lane >> 2) & 3) << 6) | (((lane >> 4) & 1) << 5) | (((lane >> 5) & 1) << 8); }
constexpr int v_rd_off(int d0, int ks, int half) { return d0 * 512 + ks * 2048 + half * 1024; }
#define MLA_EXP2(x) __builtin_amdgcn_exp2f(x)
constexpr float THR2 = 8.f;
#define MX3(a, b, c) __builtin_fmaxf(__builtin_fmaxf((a), (b)), (c))
__device__ __forceinline__ void soft4(f32x16& p0, f32x16& p1, float& m_reg, float& l_reg, f32x16& negm, f32x16* o, float* al_l, bool first, bf16x8& pa0, bf16x8& pa1, bf16x8& pa2, bf16x8& pa3, int r32, int hi) {
  float ma = MX3(p0[0], p0[1], p0[2]), mb = MX3(p0[3], p0[4], p0[5]), mc = MX3(p0[6], p0[7], p0[8]), md = MX3(p0[9], p0[10], p0[11]);
  ma = MX3(ma, p0[12], p0[13]); mb = MX3(mb, p0[14], p0[15]); mc = MX3(mc, p1[0], p1[1]); md = MX3(md, p1[2], p1[3]);
  ma = MX3(ma, p1[4], p1[5]); mb = MX3(mb, p1[6], p1[7]); mc = MX3(mc, p1[8], p1[9]); md = MX3(md, p1[10], p1[11]);
  ma = MX3(ma, p1[12], p1[13]); mb = MX3(mb, p1[14], p1[15]);
  float pmax = __builtin_fmaxf(MX3(ma, mb, mc), md);
  { auto rr = __builtin_amdgcn_permlane32_swap(__float_as_uint(pmax), __float_as_uint(pmax), false, false);
    pmax = fmaxf(__uint_as_float(rr[0]), __uint_as_float(rr[1])); }
  if (__builtin_expect(first || !__all(pmax <= THR2), 0)) {
    const float dl = first ? pmax : fmaxf(pmax, 0.f);
    m_reg += dl;
#pragma unroll
    for (int r = 0; r < 16; ++r) { p0[r] -= dl; p1[r] -= dl; negm[r] = -m_reg; }
    if (!first) { const float alpha = __builtin_amdgcn_exp2f(-dl); l_reg *= alpha;
      if (hi == 0) al_l[r32] = alpha; asm volatile("s_waitcnt lgkmcnt(0)" ::: "memory");
#pragma unroll
      for (int r = 0; r < 16; ++r) { const float a = al_l[crow(r, hi)]; o[0][r] *= a; o[1][r] *= a; } }
  }
  asm volatile("" : "+v"(negm));
#pragma unroll
  for (int r = 0; r < 16; ++r) { p0[r] = MLA_EXP2(p0[r]); p1[r] = MLA_EXP2(p1[r]); }
  float s0 = p0[0] + p1[0], s1 = p0[1] + p1[1], s2 = p0[2] + p1[2], s3 = p0[3] + p1[3];
#pragma unroll
  for (int r = 4; r < 16; r += 4) { s0 += p0[r] + p1[r]; s1 += p0[r + 1] + p1[r + 1]; s2 += p0[r + 2] + p1[r + 2]; s3 += p0[r + 3] + p1[r + 3]; }
  l_reg += (s0 + s1) + (s2 + s3);
#define PK8(P, BASE, OUT) do { u32x4 w = {cvt_pk_bf16(P[BASE + 0], P[BASE + 1]), cvt_pk_bf16(P[BASE + 2], P[BASE + 3]), cvt_pk_bf16(P[BASE + 4], P[BASE + 5]), cvt_pk_bf16(P[BASE + 6], P[BASE + 7])}; \
    OUT = __builtin_bit_cast(bf16x8, w); } while (0)
  PK8(p0, 0, pa0); PK8(p0, 8, pa1); PK8(p1, 0, pa2); PK8(p1, 8, pa3);
#undef PK8
}
#undef MX3
typedef short v4i16_t __attribute__((ext_vector_type(4)));
typedef __attribute__((address_space(3))) const char* lds_cptr;
__device__ __forceinline__ s16x4 vtr(lds_cptr p) { return __builtin_bit_cast(s16x4, __builtin_amdgcn_ds_read_tr16_b64_v4i16((__attribute__((address_space(3))) v4i16_t*)p)); }
#define VFRAG(L, H) (bf16x8){L[0], L[1], L[2], L[3], H[0], H[1], H[2], H[3]}
__device__ __forceinline__ void mprefetch(bf16x8 (&fk)[12], lds_cptr Ks, int r32, int hi) {
#define KOFF(row, d0) KSWZ(row, ((d0) * 16 + hi * 8) * 2)
#pragma unroll
  for (int d0 = 0; d0 < 6; ++d0) { fk[2 * d0] = *(const __attribute__((address_space(3))) bf16x8*)(Ks + KOFF(r32, d0)); fk[2 * d0 + 1] = *(const __attribute__((address_space(3))) bf16x8*)(Ks + KOFF(32 + r32, d0)); }
#undef KOFF
}
template <bool HAS_PV>
__device__ __forceinline__ void mstage5(f32x16* o, f32x16& p0, f32x16& p1, bf16x8 (&fk)[12], lds_cptr vp, lds_cptr Ks, const bf16x8* qr, const f32x16& negm,
                                        bf16x8 pa0, bf16x8 pa1, bf16x8 pa2, bf16x8 pa3, int r32, int hi) {
  s16x4 vl[8], vh[8];
  if (HAS_PV) {
#pragma unroll
    for (int d0 = 0; d0 < 2; ++d0)
#pragma unroll
      for (int ks = 0; ks < 4; ++ks) { vl[d0 * 4 + ks] = vtr(vp + v_rd_off(d0, ks, 0)); vh[d0 * 4 + ks] = vtr(vp + v_rd_off(d0, ks, 1)); }
    SBAR(); }
  p0 = __builtin_amdgcn_mfma_f32_32x32x16_bf16(fk[0], qr[0], negm, 0, 0, 0); p1 = __builtin_amdgcn_mfma_f32_32x32x16_bf16(fk[1], qr[0], negm, 0, 0, 0);
#pragma unroll
  for (int d0 = 1; d0 < 6; ++d0) { p0 = __builtin_amdgcn_mfma_f32_32x32x16_bf16(fk[2 * d0], qr[d0], p0, 0, 0, 0); p1 = __builtin_amdgcn_mfma_f32_32x32x16_bf16(fk[2 * d0 + 1], qr[d0], p1, 0, 0, 0); }
  if (HAS_PV) {
    SBAR();
#pragma unroll
    for (int d0 = 0; d0 < 2; ++d0) {
      o[d0] = __builtin_amdgcn_mfma_f32_32x32x16_bf16(pa0, VFRAG(vl[d0 * 4 + 0], vh[d0 * 4 + 0]), o[d0], 0, 0, 0); o[d0] = __builtin_amdgcn_mfma_f32_32x32x16_bf16(pa1, VFRAG(vl[d0 * 4 + 1], vh[d0 * 4 + 1]), o[d0], 0, 0, 0);
      o[d0] = __builtin_amdgcn_mfma_f32_32x32x16_bf16(pa2, VFRAG(vl[d0 * 4 + 2], vh[d0 * 4 + 2]), o[d0], 0, 0, 0); o[d0] = __builtin_amdgcn_mfma_f32_32x32x16_bf16(pa3, VFRAG(vl[d0 * 4 + 3], vh[d0 * 4 + 3]), o[d0], 0, 0, 0); }
  }
}
__device__ __forceinline__ void pvlast4(f32x16* o, lds_cptr vp, bf16x8 pa0, bf16x8 pa1, bf16x8 pa2, bf16x8 pa3) {
  s16x4 vl[8], vh[8];
#pragma unroll
  for (int d0 = 0; d0 < 2; ++d0)
#pragma unroll
    for (int ks = 0; ks < 4; ++ks) { vl[d0 * 4 + ks] = vtr(vp + v_rd_off(d0, ks, 0)); vh[d0 * 4 + ks] = vtr(vp + v_rd_off(d0, ks, 1)); }
#pragma unroll
  for (int d0 = 0; d0 < 2; ++d0) {
    o[d0] = __builtin_amdgcn_mfma_f32_32x32x16_bf16(pa0, VFRAG(vl[d0 * 4 + 0], vh[d0 * 4 + 0]), o[d0], 0, 0, 0); o[d0] = __builtin_amdgcn_mfma_f32_32x32x16_bf16(pa1, VFRAG(vl[d0 * 4 + 1], vh[d0 * 4 + 1]), o[d0], 0, 0, 0);
    o[d0] = __builtin_amdgcn_mfma_f32_32x32x16_bf16(pa2, VFRAG(vl[d0 * 4 + 2], vh[d0 * 4 + 2]), o[d0], 0, 0, 0); o[d0] = __builtin_amdgcn_mfma_f32_32x32x16_bf16(pa3, VFRAG(vl[d0 * 4 + 3], vh[d0 * 4 + 3]), o[d0], 0, 0, 0); }
}
constexpr int NSLOT = 4, SLOT_K = SHM_K, SLOT_V = SHM_V;
constexpr int OFF2_K = 0, OFF2_V = NSLOT * SLOT_K, OFF2_WS = OFF2_V + NSLOT * SLOT_V, LDS2_TOTAL = OFF2_WS + NWAVES * 256;
#define MLA_BAR() asm volatile("s_waitcnt lgkmcnt(0)\n\ts_barrier" ::: "memory")

__device__ __forceinline__ void unit(const bf16_t* __restrict__ Qb, const bf16_t* __restrict__ Kh, const bf16_t* __restrict__ Vh, bf16_t* __restrict__ Ob, int seq, char* lds, int wid) {
  const int lane = lane_id(), r32 = lane & 31, hi = lane >> 5;
  const bool hb = wid >= 4;
  char* K_lds = lds + OFF2_K; char* V_lds = lds + OFF2_V;
  float* al_l = (float*)(lds + OFF2_WS) + wid * 64;
  float m_reg = 0.f, l_reg = 0.f; f32x16 o[2] = {}; f32x16 negm = {}; bf16x8 qr[6];
  const bf16_t* Qw = Qb + (long)(wid * QBLK + r32) * LDQ + hi * 8;
#pragma unroll
  for (int d0 = 0; d0 < 6; ++d0) qr[d0] = *reinterpret_cast<const bf16x8*>(Qw + d0 * 16);
  unsigned koA, koB, vo; bool kvA, kvB;
  { const int rA = 8 * wid + (lane >> 4), rB = rA + 4, cp = lane & 15;
    const int cA = cp ^ (rA & 15), cB = cp ^ (rB & 15); kvA = cA < 12; kvB = cB < 12;
    koA = (unsigned)(rA * LDKk * 2 + cA * 16); koB = (unsigned)(rB * LDKk * 2 + cB * 16);
    const int jv = 64 * wid + lane, sub = jv >> 5, within = jv & 31, k = (sub >> 1) * 8 + (within >> 2), c = (sub & 1) * 32 + (within & 3) * 8;
    vo = (unsigned)(k * LDV * 2 + c * 2); }
  const __attribute__((address_space(3))) char* lds3 = (const __attribute__((address_space(3))) char*)(lds_cptr)lds;
#define DMA_TILE(u) do { const char* kt_ = (const char*)(Kh + (long)(u) * KVBLK * LDKk); const char* vt_ = (const char*)(Vh + (long)(u) * KVBLK * LDV); const int sl_ = (u) & 3; \
    if (kvA) __builtin_amdgcn_global_load_lds((const unsigned*)(kt_ + koA), (__attribute__((address_space(3))) unsigned*)(lds3 + OFF2_K + sl_ * SLOT_K + (2 * wid) * 1024), 16, 0, 0); \
    if (kvB) __builtin_amdgcn_global_load_lds((const unsigned*)(kt_ + koB), (__attribute__((address_space(3))) unsigned*)(lds3 + OFF2_K + sl_ * SLOT_K + (2 * wid + 1) * 1024), 16, 0, 0); \
    __builtin_amdgcn_global_load_lds((const unsigned*)(vt_ + vo), (__attribute__((address_space(3))) unsigned*)(lds3 + OFF2_V + sl_ * SLOT_V + wid * 1024), 16, 0, 0); } while (0)
#define DMA_WAIT() asm volatile("s_waitcnt vmcnt(0)" ::: "memory")
  const lds_cptr vp0 = (lds_cptr)V_lds + v_rd_base(lane); const lds_cptr kp0 = (lds_cptr)K_lds;
  f32x16 p0, p1; bf16x8 pa0, pa1, pa2, pa3; const int NT = seq / KVBLK;
  bf16x8 fka[12];
  DMA_WAIT();
  DMA_TILE(0); DMA_TILE(1); DMA_WAIT();
  MLA_BAR();
  if (hb) MLA_BAR();
  DMA_TILE(2);
  mprefetch(fka, kp0, r32, hi);
  mstage5<false>(o, p0, p1, fka, vp0, kp0, qr, negm, pa0, pa1, pa2, pa3, r32, hi);

  MLA_BAR();
  soft4(p0, p1, m_reg, l_reg, negm, o, al_l, true, pa0, pa1, pa2, pa3, r32, hi);
  mprefetch(fka, kp0 + SLOT_K, r32, hi);
  DMA_WAIT();
  MLA_BAR();
#pragma clang loop unroll(disable)
  for (int t = 1; t < NT; ++t) {
    if (t + 2 < NT) DMA_TILE(t + 2);
    SBAR(); mstage5<true>(o, p0, p1, fka, vp0 + ((t - 1) & 3) * SLOT_V, kp0 + (t & 3) * SLOT_K, qr, negm, pa0, pa1, pa2, pa3, r32, hi);

    MLA_BAR();
    soft4(p0, p1, m_reg, l_reg, negm, o, al_l, false, pa0, pa1, pa2, pa3, r32, hi);
    if (t + 1 < NT) mprefetch(fka, kp0 + ((t + 1) & 3) * SLOT_K, r32, hi);
    DMA_WAIT();
    MLA_BAR();
  }
  SBAR(); pvlast4(o, vp0 + ((NT - 1) & 3) * SLOT_V, pa0, pa1, pa2, pa3);
  if (!hb) MLA_BAR();
  MLA_BAR();
  { auto rr = __builtin_amdgcn_permlane32_swap(__float_as_uint(l_reg), __float_as_uint(l_reg), false, false); l_reg = __uint_as_float(rr[0]) + __uint_as_float(rr[1]); }
  if (hi == 0) al_l[r32] = l_reg; asm volatile("s_waitcnt lgkmcnt(0)" ::: "memory");
  float rli[16];
#pragma unroll
  for (int r = 0; r < 16; ++r) rli[r] = __builtin_amdgcn_rcpf(al_l[crow(r, hi)]);
  { bf16_t* stg = (bf16_t*)(lds) + wid * 2048;
#pragma unroll
    for (int r = 0; r < 16; ++r) { const int orow = crow(r, hi);
#pragma unroll
      for (int d0 = 0; d0 < 2; ++d0) stg[orow * 64 + d0 * 32 + r32] = (bf16_t)(cvt_pk_bf16(o[d0][r] * rli[r], 0.f) & 0xffffu); }
    asm volatile("s_waitcnt lgkmcnt(0)" ::: "memory");
    bf16_t* Ow = Ob + (long)(wid * QBLK) * LDO;
#pragma unroll
    for (int i = 0; i < 4; ++i) { const int row = i * 8 + (lane >> 3), ch = lane & 7; const u32x4 v = *(const u32x4*)(stg + row * 64 + ch * 8); *(u32x4*)(Ow + (long)row * LDO + ch * 8) = v; } }
  MLA_BAR();
#undef DMA_TILE
#undef DMA_WAIT
}
#undef KSWZ
#undef SBAR
}

__device__ __forceinline__ void p3_mla(const Frame& F) {
    unsigned char* ws = F.ws;
    const bf16_t* QB = (const bf16_t*)(ws + WS_QB); const bf16_t* KB = (const bf16_t*)(ws + WS_KB); const bf16_t* VB = (const bf16_t*)(ws + WS_VB); bf16_t* OB = (bf16_t*)(ws + WS_OB);
    const int G = F.G;
    if (G == 256) {
        const int x = F.vcu >> 5, c = F.vcu & 31;
        for (int i = 0; i < 4; ++i) {
            const int pair = x * 8 + 2 * i + (c >> 4), qb = c & 15, b = pair >> 3, h = pair & 7;
            const long row0 = (long)b * SEQ;
            mla::unit(QB + (row0 + qb * 256) * 768 + h * 96, KB + row0 * 768 + h * 96, VB + row0 * 512 + h * 64, OB + (row0 + qb * 256) * 512 + h * 64, SEQ, (char*)F.lds, F.wave);
        }
    } else {
        for (int u = F.vcu; u < 1024; u += G) {
            const int pair = u >> 4, qb = u & 15, b = pair >> 3, h = pair & 7; const long row0 = (long)b * SEQ;
            mla::unit(QB + (row0 + qb * 256) * 768 + h * 96, KB + row0 * 768 + h * 96, VB + row0 * 512 + h * 64, OB + (row0 + qb * 256) * 512 + h * 64, SEQ, (char*)F.lds, F.wave);
        }
    }
}

namespace mxa {
#define SBAR() __builtin_amdgcn_sched_barrier(0)
typedef short v4i16_t __attribute__((ext_vector_type(4)));
typedef __attribute__((address_space(3))) const char* lds_cptr;
__device__ __forceinline__ s16x4 vtr(lds_cptr p) { return __builtin_bit_cast(s16x4, __builtin_amdgcn_ds_read_tr16_b64_v4i16((__attribute__((address_space(3))) v4i16_t*)p)); }
__device__ __forceinline__ int crow(int r, int hi) { return (r & 3) + 8 * (r >> 2) + 4 * hi; }
#define KSW2(row, colB) ((row) * 128 + ((colB) ^ ((((row) >> 1) & 7) << 4)))
__device__ __forceinline__ int v_rd_base(int lane) { return ((lane & 3) << 3) | (((lane >> 2) & 3) << 6) | (((lane >> 4) & 1) << 5) | (((lane >> 5) & 1) << 8); }
constexpr int v_rd_off(int d0, int ks, int half) { return d0 * 512 + ks * 2048 + half * 1024; }
constexpr int BUFB = 8192;
#define VFRAG(L, H) (bf16x8){L[0], L[1], L[2], L[3], H[0], H[1], H[2], H[3]}
__device__ __forceinline__ void step(f32x16& o0, f32x16& o1, float& m_reg, float& l_reg, const bf16x8* qr, lds_cptr Kb, lds_cptr Vb, float* al_l, float basef, float sl2, bool first, int r32, int hi) {
  constexpr float THR = 8.f;
  bf16x8 kf[4]; s16x4 vl[4], vh[4];
#pragma unroll
  for (int d0 = 0; d0 < 4; ++d0) kf[d0] = *(const __attribute__((address_space(3))) bf16x8*)(Kb + KSW2(r32, (d0 * 16 + hi * 8) * 2));
#pragma unroll
  for (int d0 = 0; d0 < 2; ++d0)
#pragma unroll
    for (int ks = 0; ks < 2; ++ks) { vl[d0 * 2 + ks] = vtr(Vb + v_rd_off(d0, ks, 0)); vh[d0 * 2 + ks] = vtr(Vb + v_rd_off(d0, ks, 1)); }
  f32x16 p;
  { const float nm = first ? 0.f : -m_reg;
#pragma unroll
    for (int r = 0; r < 16; ++r) p[r] = nm; }
#pragma unroll
  for (int d0 = 0; d0 < 4; ++d0) p = __builtin_amdgcn_mfma_f32_32x32x16_bf16(kf[d0], qr[d0], p, 0, 0, 0);
  const float nsl = -sl2;
  float pmax = -1e30f;
#pragma unroll
  for (int r = 0; r < 16; ++r) {
    const float df = basef - (float)((r & 3) + 8 * (r >> 2)), ad = __builtin_fabsf(df);
    const float sv = fmaf(nsl, ad, p[r]);
    p[r] = (ad <= 64.f) ? sv : -1e30f;
    pmax = fmaxf(pmax, p[r]);
  }
  { auto rr = __builtin_amdgcn_permlane32_swap(__float_as_uint(pmax), __float_as_uint(pmax), false, false);
    pmax = fmaxf(__uint_as_float(rr[0]), __uint_as_float(rr[1])); }
  if (first || !__all(pmax <= THR)) {
    const float dl = first ? pmax : fmaxf(pmax, 0.f);
    m_reg += dl;
#pragma unroll
    for (int r = 0; r < 16; ++r) p[r] -= dl;
    if (!first) { const float alpha = __builtin_amdgcn_exp2f(-dl); l_reg *= alpha;
      if (hi == 0) al_l[r32] = alpha; asm volatile("s_waitcnt lgkmcnt(0)" ::: "memory");
#pragma unroll
      for (int r = 0; r < 16; ++r) { const float a = al_l[crow(r, hi)]; o0[r] *= a; o1[r] *= a; } }
  }
  float ps = 0.f;
#pragma unroll
  for (int r = 0; r < 16; ++r) { p[r] = __builtin_amdgcn_exp2f(p[r]); ps += p[r]; }
  l_reg += ps;
  u32x4 w0 = {cvt_pk_bf16(p[0], p[1]), cvt_pk_bf16(p[2], p[3]), cvt_pk_bf16(p[4], p[5]), cvt_pk_bf16(p[6], p[7])};
  u32x4 w1 = {cvt_pk_bf16(p[8], p[9]), cvt_pk_bf16(p[10], p[11]), cvt_pk_bf16(p[12], p[13]), cvt_pk_bf16(p[14], p[15])};
  const bf16x8 pa0 = __builtin_bit_cast(bf16x8, w0), pa1 = __builtin_bit_cast(bf16x8, w1);
  o0 = __builtin_amdgcn_mfma_f32_32x32x16_bf16(pa0, VFRAG(vl[0], vh[0]), o0, 0, 0, 0); o0 = __builtin_amdgcn_mfma_f32_32x32x16_bf16(pa1, VFRAG(vl[1], vh[1]), o0, 0, 0, 0);
  o1 = __builtin_amdgcn_mfma_f32_32x32x16_bf16(pa0, VFRAG(vl[2], vh[2]), o1, 0, 0, 0); o1 = __builtin_amdgcn_mfma_f32_32x32x16_bf16(pa1, VFRAG(vl[3], vh[3]), o1, 0, 0, 0);
}

__device__ __forceinline__ void task(const bf16_t* __restrict__ QA, const bf16_t* __restrict__ KA, const bf16_t* __restrict__ VA, bf16_t* __restrict__ OP, float* __restrict__ LS,
                                     int b, int h, int n, int rres, int qb, char* wl, float* al) {
  const int lane = lane_id(), r32 = lane & 31, hi = lane >> 5;
  const int dil = (n == 0) ? 1 : (n == 1 ? 4 : 16), L = SEQ / dil, l0 = qb * 64;
  const float sl2 = exp2f(-(float)(h + 1)) * (float)dil * LOG2E;
  const long rowb = (long)b * SEQ;
  const lds_cptr wl3 = (lds_cptr)wl;
  const lds_cptr vrd = wl3 + 4096 + v_rd_base(lane);
  asm volatile("s_waitcnt vmcnt(0)" ::: "memory");
  unsigned ko[4], vo[4];
#pragma unroll
  for (int pc = 0; pc < 4; ++pc) {
    const int kr = 8 * pc + (lane >> 3), c = (lane & 7) ^ ((kr >> 1) & 7);
    ko[pc] = (unsigned)(kr * dil * 1024 + h * 128 + c * 16);
    const int jv = 64 * pc + lane, sub = jv >> 5, within = jv & 31, vk = (sub >> 1) * 8 + (within >> 2), vc = (sub & 1) * 32 + (within & 3) * 8;
    vo[pc] = (unsigned)(vk * dil * 1024 + h * 128 + vc * 2); }
#define MXA_DMA(lk0_, buf_) do { const size_t rb_ = (size_t)(rowb + (long)(lk0_) * dil + rres) * 1024; const char* kb_ = (const char*)KA + rb_; const char* vb_ = (const char*)VA + rb_; \
    _Pragma("unroll") for (int pc = 0; pc < 4; ++pc) { \
      __builtin_amdgcn_global_load_lds((const unsigned*)(kb_ + ko[pc]), (__attribute__((address_space(3))) unsigned*)(wl3 + (buf_) * BUFB + pc * 1024), 16, 0, 0); \
      __builtin_amdgcn_global_load_lds((const unsigned*)(vb_ + vo[pc]), (__attribute__((address_space(3))) unsigned*)(wl3 + (buf_) * BUFB + 4096 + pc * 1024), 16, 0, 0); } } while (0)
  const bool has_behind = (l0 >= 64), has_ahead = (l0 + 64 < L);
  const int nblk = 2 + (has_behind ? 2 : 0) + (has_ahead ? 2 : 0);
  auto blk_at = [&](int i) -> int { if (i < 2) return 2 + i; if (has_behind && has_ahead) return (i == 2) ? 1 : (i == 3 ? 4 : (i == 4 ? 0 : 5)); if (has_behind) return (i == 2) ? 1 : 0; return (i == 2) ? 4 : 5; };
  MXA_DMA(l0, 0);
  bf16x8 q0[4], q1[4];
  { const long ra = rowb + (long)(l0 + r32) * dil + rres, rb2 = rowb + (long)(l0 + 32 + r32) * dil + rres;
#pragma unroll
    for (int d0 = 0; d0 < 4; ++d0) { q0[d0] = *reinterpret_cast<const bf16x8*>(QA + ra * 512 + h * 64 + d0 * 16 + hi * 8); q1[d0] = *reinterpret_cast<const bf16x8*>(QA + rb2 * 512 + h * 64 + d0 * 16 + hi * 8); } }
  asm volatile("s_waitcnt vmcnt(0)" ::: "memory");
  f32x16 oa0 = f32x16{}, oa1 = f32x16{}, ob0 = f32x16{}, ob1 = f32x16{};
  float ma = 0.f, la = 0.f, mb = 0.f, lb = 0.f;
#pragma clang loop unroll(disable)
  for (int i = 0; i < nblk; ++i) {
    const int j = blk_at(i), buf = i & 1;
    if (i + 1 < nblk) { MXA_DMA(l0 - 64 + 32 * blk_at(i + 1), buf ^ 1); }
    if (i > 0) { if (i + 1 < nblk) asm volatile("s_waitcnt vmcnt(8)" ::: "memory"); else asm volatile("s_waitcnt vmcnt(0)" ::: "memory"); }
    const lds_cptr Kb = wl3 + buf * BUFB, Vb = vrd + buf * BUFB;
    const int dk = -64 + 32 * j;
    if (j <= 4) step(oa0, oa1, ma, la, q0, Kb, Vb, al, (float)(r32 - 4 * hi - dk), sl2, i == 0, r32, hi);
    if (j >= 1) step(ob0, ob1, mb, lb, q1, Kb, Vb, al, (float)(32 + r32 - 4 * hi - dk), sl2, i == 0, r32, hi);
    asm volatile("s_waitcnt lgkmcnt(0)" ::: "memory");
  }
#undef MXA_DMA
#pragma unroll
  for (int qs = 0; qs < 2; ++qs) {
    float l_reg = qs ? lb : la; const float m_reg = qs ? mb : ma;
    { auto rr = __builtin_amdgcn_permlane32_swap(__float_as_uint(l_reg), __float_as_uint(l_reg), false, false); l_reg = __uint_as_float(rr[0]) + __uint_as_float(rr[1]); }
    if (hi == 0) { al[r32] = l_reg; const long row = rowb + (long)(l0 + qs * 32 + r32) * dil + rres; LS[row * 8 + h] = m_reg + __builtin_amdgcn_logf(l_reg); }
    asm volatile("s_waitcnt lgkmcnt(0)" ::: "memory");
    bf16_t* stg = (bf16_t*)wl;
#pragma unroll
    for (int r = 0; r < 16; ++r) { const int orow = crow(r, hi); const float rl = __builtin_amdgcn_rcpf(al[orow]);
      stg[orow * 64 + r32] = (bf16_t)(cvt_pk_bf16((qs ? ob0[r] : oa0[r]) * rl, 0.f) & 0xffffu);
      stg[orow * 64 + 32 + r32] = (bf16_t)(cvt_pk_bf16((qs ? ob1[r] : oa1[r]) * rl, 0.f) & 0xffffu); }
    asm volatile("s_waitcnt lgkmcnt(0)" ::: "memory");
#pragma unroll
    for (int i = 0; i < 4; ++i) { const int rw = i * 8 + (lane >> 3), ch = lane & 7; const u32x4 v = *(const u32x4*)(stg + rw * 64 + ch * 8);
      const long row = rowb + (long)(l0 + qs * 32 + rw) * dil + rres; *(u32x4*)(OP + row * 512 + h * 64 + ch * 8) = v; }
    asm volatile("s_waitcnt lgkmcnt(0)" ::: "memory");
  }
}
#undef KSW2
#undef VFRAG
#undef SBAR
}

__device__ __forceinline__ void p3_mixerA(const Frame& F) {
    unsigned char* ws = F.ws;
    const bf16_t* QA = (const bf16_t*)(ws + WS_QA); const bf16_t* KA = (const bf16_t*)(ws + WS_KA); const bf16_t* VA = (const bf16_t*)(ws + WS_VA);
    float* LSE = (float*)(ws + WS_LSE);
    char* wl = (char*)F.lds + F.wave * 16384; float* al = (float*)((char*)F.lds + RING_BYTES + 2048) + F.wave * 64;
    const int x = (F.G == 256) ? (F.vcu >> 5) : 0; const int ngrp = (F.G == 256) ? 8 : 1, per = 64 * 192 / ngrp;
    unsigned* qctr = F.ctl + CW_Q + 64 * x;
    for (;;) {
        unsigned ti = 0; if (lane_id() == 0) ti = atomicAdd(qctr, 1u);
        ti = (unsigned)__builtin_amdgcn_readfirstlane((int)ti);
        if (ti >= (unsigned)per) break;
        const int t = x * per + (int)ti;
        const int pair = t / 192, tt = t % 192, n = tt >> 6, idx = tt & 63;
        const int rres = (n == 0) ? 0 : (n == 1 ? (idx >> 4) : (idx >> 2)), qb = (n == 0) ? idx : (n == 1 ? (idx & 15) : (idx & 3));
        bf16_t* OP = (bf16_t*)(ws + (n == 2 ? WS_OAP2 : WS_OAP0)) + (n == 1 ? (size_t)T * 512 : 0);
        mxa::task(QA, KA, VA, OP, LSE + (size_t)n * ((size_t)T * 8), pair >> 3, pair & 7, n, rres, qb, wl, al);
    }
}
static_assert(WS_OAP1 - WS_OAP0 == (size_t)T * 512 * 2, "OAP0|OAP1 contiguous");

__device__ __forceinline__ void p35_mix(const Frame& F, const Args& a) {
    unsigned char* ws = F.ws; const int lane = lane_id();
    const bf16_t* OB = (const bf16_t*)(ws + WS_OB); const float* LSE = (const float*)(ws + WS_LSE); bf16_t* MIXED = (bf16_t*)(ws + WS_MIXED);
    const bf16_t* OAPn[3] = {(const bf16_t*)(ws + WS_OAP0), (const bf16_t*)(ws + WS_OAP1), (const bf16_t*)(ws + WS_OAP2)};
    const float* g_a = a.in[8]; const float* g_b = a.in[9];
    const int gw = F.vcu * NWAVES + F.wave, NGW = F.G * NWAVES;
    const int h = lane >> 3;
    const f32x4 ga0 = *(const f32x4*)(g_a + lane * 8), ga1 = *(const f32x4*)(g_a + lane * 8 + 4), gb0 = *(const f32x4*)(g_b + lane * 8), gb1 = *(const f32x4*)(g_b + lane * 8 + 4);
    for (int row = gw; row < T; row += NGW) {
        float ls[3]; u32x4 ov[3];
#pragma unroll
        for (int n = 0; n < 3; ++n) { ls[n] = LSE[((size_t)n * T + row) * 8 + h]; ov[n] = *(const u32x4*)(OAPn[n] + (size_t)row * 512 + lane * 8); }
        const u32x4 bv = *(const u32x4*)(OB + (size_t)row * 512 + lane * 8);
        const float mx = fmaxf(ls[0], fmaxf(ls[1], ls[2]));
        float w[3]; float wsum = 0.f;
#pragma unroll
        for (int n = 0; n < 3; ++n) { w[n] = __builtin_amdgcn_exp2f(ls[n] - mx); wsum += w[n]; }
        const float inv = 1.f / wsum;
        float oa[8] = {0.f, 0.f, 0.f, 0.f, 0.f, 0.f, 0.f, 0.f};
#pragma unroll
        for (int n = 0; n < 3; ++n) { const float wn = w[n] * inv;
#pragma unroll
            for (int j = 0; j < 4; ++j) { oa[2 * j] += wn * bf16lo(ov[n][j]); oa[2 * j + 1] += wn * bf16hi(ov[n][j]); } }
        float obv[8];
#pragma unroll
        for (int j = 0; j < 4; ++j) { obv[2 * j] = bf16lo(bv[j]); obv[2 * j + 1] = bf16hi(bv[j]); }
        float sa = 0.f, sb = 0.f;
#pragma unroll
        for (int j = 0; j < 8; ++j) { sa += oa[j] * oa[j]; sb += obv[j] * obv[j]; }
        sa = wsum64(sa); sb = wsum64(sb);
        const float ra = 1.0f / sqrtf(sa * (1.f / 512.f) + EPS), rb = 1.0f / sqrtf(sb * (1.f / 512.f) + EPS);
        u32x4 wa, wb;
        wa.x = cvt_pk_bf16(oa[0] * ra * ga0[0], oa[1] * ra * ga0[1]); wa.y = cvt_pk_bf16(oa[2] * ra * ga0[2], oa[3] * ra * ga0[3]);
        wa.z = cvt_pk_bf16(oa[4] * ra * ga1[0], oa[5] * ra * ga1[1]); wa.w = cvt_pk_bf16(oa[6] * ra * ga1[2], oa[7] * ra * ga1[3]);
        wb.x = cvt_pk_bf16(obv[0] * rb * gb0[0], obv[1] * rb * gb0[1]); wb.y = cvt_pk_bf16(obv[2] * rb * gb0[2], obv[3] * rb * gb0[3]);
        wb.z = cvt_pk_bf16(obv[4] * rb * gb1[0], obv[5] * rb * gb1[1]); wb.w = cvt_pk_bf16(obv[6] * rb * gb1[2], obv[7] * rb * gb1[3]);
        *(u32x4*)(MIXED + (size_t)row * 1024 + lane * 8) = wa;
        *(u32x4*)(MIXED + (size_t)row * 1024 + 512 + lane * 8) = wb;
    }
}

constexpr size_t WS_WRT = 4 * MiB + 512 * 1024;
constexpr size_t WS_RS = 137 * MiB;
constexpr size_t WS_GS = 141 * MiB;
constexpr size_t WS_H2B = 384 * MiB;
constexpr size_t WS_D = 448 * MiB;
constexpr int MOE_TAB = MISC_OFF + 256;

__device__ __forceinline__ void p0_router_table(const Frame& F, const Args& a) {
    const float* w_r1 = a.in[12]; const float* w_r2 = a.in[14]; const float* g_ffn = a.in[11]; bf16_t* WRH = (bf16_t*)(F.ws + WS_WRT); bf16_t* WRL = WRH + 48 * 1024;
    const int gw = F.vcu * NWAVES + F.wave, NGW = F.G * NWAVES, lane = lane_id();
    for (int idx = gw * 64 + lane; idx < 48 * 1024; idx += NGW * 64) {
        const int o = idx >> 10, k = idx & 1023;
        float w = 0.f;
        if (o < 4) w = w_r1[k * 4 + o]; else if (o < 36) w = w_r2[((size_t)((o - 4) >> 3) * 1024 + k) * 8 + ((o - 4) & 7)];
        w *= g_ffn[k];
        const unsigned hi = cvt_pk_bf16(w, 0.f) & 0xffffu; const float rem = w - __uint_as_float(hi << 16);
        WRH[idx] = (bf16_t)hi; WRL[idx] = (bf16_t)(cvt_pk_bf16(rem, 0.f) & 0xffffu);
    }
}

__device__ __forceinline__ void p4_wo(const Frame& F, const Args& a) {
    unsigned char* ws = F.ws;
    pg::DenseSched S{(const char*)(ws + WS_MIXED), (const char*)(ws + WS_WO), 1024, 1024, T / 256, 4, F.G, (int)blockIdx.x};
    EpiStoreBf16 E{(bf16_t*)(ws + WS_D), 1024};
    pg::gemm_phase(F.lds, S, E, 1024, F.wave);
}

__device__ __forceinline__ void p5_router(const Frame& F, const Args& a) {
    unsigned char* ws = F.ws; const int lane = lane_id(), wid = F.wave;
    const float* X = a.in[0]; const bf16_t* Dm = (const bf16_t*)(ws + WS_D); const float* g_ffn = a.in[11]; const float* b_r1 = a.in[13]; const float* b_r2 = a.in[15];
    const bf16_t* WRH = (const bf16_t*)(ws + WS_WRT); const bf16_t* WRL = WRH + 48 * 1024; bf16_t* MU = (bf16_t*)(ws + WS_M);
    int* LIST = (int*)(ws + WS_LIST); float* RS = (float*)(ws + WS_RS); float* GS = (float*)(ws + WS_GS); int* TOK = (int*)(ws + WS_TOKINFO);
    unsigned* cnt = F.ctl + CW_CNT;
    LAS int* LG = (LAS int*)(F.lds);
    LAS int* SSQ_ = (LAS int*)(F.lds + 26 * 1024);
    LAS unsigned* hist = (LAS unsigned*)(F.lds + 27 * 1024);
    LAS unsigned* gbase = hist + 32;
    const int tr = lane & 15, kg = lane >> 4, tid = wid * 64 + lane;
    const int kw = 128 * wid;
    for (int chunk = F.vcu; chunk < T / 128; chunk += F.G) {
        const int base = chunk * 128;
        for (int i = tid; i < 128 * 49 + 128; i += 512) { if (i < 128 * 49) LG[i] = 0; else SSQ_[i - 128 * 49] = 0; }
        if (tid < 32) hist[tid] = 0u;
        __syncthreads();
        bf16x8 bh[4][3], bl[4][3];
#pragma unroll
        for (int ks = 0; ks < 4; ++ks)
#pragma unroll
            for (int nb = 0; nb < 3; ++nb) { const size_t wo = (size_t)(nb * 16 + tr) * 1024 + kw + ks * 32 + 8 * kg; bh[ks][nb] = *(const bf16x8*)(WRH + wo); bl[ks][nb] = *(const bf16x8*)(WRL + wo); }
#pragma unroll 2
        for (int mb = 0; mb < 8; ++mb) {
            const size_t ro = (size_t)(base + 16 * mb + tr) * 1024 + kw + 8 * kg;
            f32x4 acc0 = {0.f, 0.f, 0.f, 0.f}, acc1 = acc0, acc2 = acc0; float ss = 0.f;
#pragma unroll
            for (int ks = 0; ks < 4; ++ks) {
                f32x4 v0 = *(const f32x4*)(X + ro + ks * 32), v1 = *(const f32x4*)(X + ro + ks * 32 + 4);
                { const u32x4 dd = *(const u32x4*)(Dm + ro + ks * 32);
                  v0[0] += bf16lo(dd.x); v0[1] += bf16hi(dd.x); v0[2] += bf16lo(dd.y); v0[3] += bf16hi(dd.y); v1[0] += bf16lo(dd.z); v1[1] += bf16hi(dd.z); v1[2] += bf16lo(dd.w); v1[3] += bf16hi(dd.w); }
                ss += (v0[0] * v0[0] + v0[1] * v0[1]) + (v0[2] * v0[2] + v0[3] * v0[3]) + (v1[0] * v1[0] + v1[1] * v1[1]) + (v1[2] * v1[2] + v1[3] * v1[3]);
                u32x4 hi; hi.x = cvt_pk_bf16(v0[0], v0[1]); hi.y = cvt_pk_bf16(v0[2], v0[3]); hi.z = cvt_pk_bf16(v1[0], v1[1]); hi.w = cvt_pk_bf16(v1[2], v1[3]);
                u32x4 lo; lo.x = cvt_pk_bf16(v0[0] - bf16lo(hi.x), v0[1] - bf16hi(hi.x)); lo.y = cvt_pk_bf16(v0[2] - bf16lo(hi.y), v0[3] - bf16hi(hi.y));
                lo.z = cvt_pk_bf16(v1[0] - bf16lo(hi.z), v1[1] - bf16hi(hi.z)); lo.w = cvt_pk_bf16(v1[2] - bf16lo(hi.w), v1[3] - bf16hi(hi.w));
                *(u32x4*)(MU + ro + ks * 32) = hi;
                const bf16x8 ah = __builtin_bit_cast(bf16x8, hi), al = __builtin_bit_cast(bf16x8, lo);
                acc0 = __builtin_amdgcn_mfma_f32_16x16x32_bf16(ah, bh[ks][0], acc0, 0, 0, 0); acc0 = __builtin_amdgcn_mfma_f32_16x16x32_bf16(al, bh[ks][0], acc0, 0, 0, 0); acc0 = __builtin_amdgcn_mfma_f32_16x16x32_bf16(ah, bl[ks][0], acc0, 0, 0, 0);
                acc1 = __builtin_amdgcn_mfma_f32_16x16x32_bf16(ah, bh[ks][1], acc1, 0, 0, 0); acc1 = __builtin_amdgcn_mfma_f32_16x16x32_bf16(al, bh[ks][1], acc1, 0, 0, 0); acc1 = __builtin_amdgcn_mfma_f32_16x16x32_bf16(ah, bl[ks][1], acc1, 0, 0, 0);
                acc2 = __builtin_amdgcn_mfma_f32_16x16x32_bf16(ah, bh[ks][2], acc2, 0, 0, 0); acc2 = __builtin_amdgcn_mfma_f32_16x16x32_bf16(al, bh[ks][2], acc2, 0, 0, 0); acc2 = __builtin_amdgcn_mfma_f32_16x16x32_bf16(ah, bl[ks][2], acc2, 0, 0, 0);
            }
            ss += __shfl_xor(ss, 16); ss += __shfl_xor(ss, 32);
            if (kg == 0) atomicAdd((int*)(SSQ_ + 16 * mb + tr), __float2int_rn(ss * 16384.0f));
#pragma unroll
            for (int r = 0; r < 4; ++r) { const int tk = 16 * mb + 4 * kg + r;
                atomicAdd((int*)(LG + tk * 49 + tr), __float2int_rn(acc0[r] * 1048576.0f)); atomicAdd((int*)(LG + tk * 49 + 16 + tr), __float2int_rn(acc1[r] * 1048576.0f)); if (tr < 4) atomicAdd((int*)(LG + tk * 49 + 32 + tr), __float2int_rn(acc2[r] * 1048576.0f)); }
        }
        __syncthreads();
        int ea = 0, eb = 0; unsigned la = 0u, lb = 0u; float w0 = 0.f, w1 = 0.f, rstd = 0.f;
        if (tid < 128) {
            rstd = 1.0f / sqrtf((float)SSQ_[tid] * (1.f / 16384.f) * (1.f / 1024.f) + EPS);
            const LAS int* lg = LG + tid * 49; const float rq = rstd * (1.f / 1048576.f);
            const float l0 = (float)lg[0] * rq + b_r1[0], l1 = (float)lg[1] * rq + b_r1[1], l2 = (float)lg[2] * rq + b_r1[2], l3 = (float)lg[3] * rq + b_r1[3];
            int gi = 0; float gm = l0; if (l1 > gm) { gm = l1; gi = 1; } if (l2 > gm) { gm = l2; gi = 2; } if (l3 > gm) { gm = l3; gi = 3; }
            const float gs = __expf(l0 - gm) + __expf(l1 - gm) + __expf(l2 - gm) + __expf(l3 - gm);
            const float g_val = 1.0f / gs;
            float lv[8];
#pragma unroll
            for (int e = 0; e < 8; ++e) lv[e] = (float)lg[4 + 8 * gi + e] * rq + b_r2[8 * gi + e];
            int e0 = 0; float m0 = lv[0];
#pragma unroll
            for (int e = 1; e < 8; ++e) if (lv[e] > m0) { m0 = lv[e]; e0 = e; }
            int e1 = -1; float m1 = -3.0e38f;
#pragma unroll
            for (int e = 0; e < 8; ++e) if (e != e0 && lv[e] > m1) { m1 = lv[e]; e1 = e; }
            const float x1 = __expf(m1 - m0);
            w0 = g_val / (1.0f + x1); w1 = g_val * x1 / (1.0f + x1);
            ea = gi * 8 + e0; eb = gi * 8 + e1;
            la = atomicAdd((unsigned*)(hist + ea), 1u); lb = atomicAdd((unsigned*)(hist + eb), 1u);
        }
        __syncthreads();
        if (tid < 32) { const unsigned c = hist[tid]; gbase[tid] = c ? atomicAdd(cnt + 64 * tid, c) : 0u; }
        __syncthreads();
        if (tid < 128) {
            const int tok = base + tid; const int ra = (int)(gbase[ea] + la), rb = (int)(gbase[eb] + lb);
            LIST[(size_t)ea * T + ra] = tok; RS[(size_t)ea * T + ra] = rstd; GS[(size_t)ea * T + ra] = w0;
            LIST[(size_t)eb * T + rb] = tok; RS[(size_t)eb * T + rb] = rstd; GS[(size_t)eb * T + rb] = w1;
            TOK[tok * 4 + 0] = ea; TOK[tok * 4 + 1] = ra; TOK[tok * 4 + 2] = eb; TOK[tok * 4 + 3] = rb;
        }
        __syncthreads();
    }
}

__device__ __forceinline__ void moe_build_tables(const Frame& F) {
    LAS int* tab = (LAS int*)(F.lds + MOE_TAB);
    if (F.wave == 0 && lane_id() == 0) {
        int off = 0, cp = 0;
        for (int e = 0; e < 32; ++e) { const int c = (int)__hip_atomic_load(F.ctl + CW_CNT + 64 * e, __ATOMIC_RELAXED, __HIP_MEMORY_SCOPE_AGENT); const int nch = (c + 255) >> 8;
            tab[e] = off; tab[40 + e] = c; tab[80 + e] = cp; off += nch * 256; cp += nch; }
        tab[32] = off; tab[80 + 32] = cp;
    }
    __syncthreads();
}
struct MoeSched1 {
    static constexpr bool GATHER = true;
    const char* A; const char* Bt; const int* LIST; LAS const int* tab; int G, c;
    __device__ __forceinline__ int a_ld() const { return 1024; }
    __device__ __forceinline__ const char* abase() const { return A; }
    __device__ __forceinline__ bool next(int i, pg::Unit& u) const {
        const int nun = tab[80 + 32] * 2; const long L = (long)i * G + c; if (L >= nun) return false;
        const int ci = (int)L >> 1; u.pn = (int)L & 1;
        int e = 0;
#pragma unroll 1
        for (int k = 1; k < 32; ++k) if (tab[80 + k] <= ci) e = k;
        u.aux = e; u.pm = ci - tab[80 + e]; return true;
    }
    __device__ __forceinline__ void addr(const pg::Unit&, const char*&, const char*&) const {}
    __device__ __forceinline__ void addr_g(const pg::Unit& u, const int (&R)[2], const int (&C)[2], unsigned (&aoff)[2][2], const char*& bbase) const {
        const int e = u.aux, cn = tab[40 + e];
#pragma unroll
        for (int h = 0; h < 2; ++h)
#pragma unroll
            for (int i = 0; i < 2; ++i) { const int rk = u.pm * 256 + h * 128 + R[i]; const int tok = (rk < cn) ? LIST[(size_t)e * T + rk] : 0; aoff[h][i] = (unsigned)((tok * 1024 + C[i]) * 2); }
        bbase = Bt + ((size_t)e * 512 + (size_t)u.pn * 256) * 1024 * 2;
    }
};
struct EpiMoe1 {
    bf16_t* HID; const float* RS; LAS const int* tab;
    __device__ __forceinline__ void operator()(const f32x4 (&acc)[2][2][4][2], const pg::Unit& u, int wr, int wc, int fr, int fq, LAS unsigned char* stage, int wid) const {
        const int e = u.aux, cn = tab[40 + e], off = tab[e];
        float rsv[2][4];
#pragma unroll
        for (int ai = 0; ai < 2; ++ai)
#pragma unroll
            for (int m = 0; m < 4; ++m) { const int rk = u.pm * 256 + ai * 128 + wr * 64 + m * 16 + fr; rsv[ai][m] = (rk < cn) ? RS[(size_t)e * T + rk] : 0.f; }
#pragma unroll
        for (int ai = 0; ai < 2; ++ai)
#pragma unroll
            for (int m = 0; m < 4; ++m) { const int rk = u.pm * 256 + ai * 128 + wr * 64 + m * 16 + fr;
                if (rk < cn) { const float rs = rsv[ai][m]; float hv[8];
#pragma unroll
                    for (int n = 0; n < 2; ++n)
#pragma unroll
                        for (int j = 0; j < 4; ++j) { const float gg = acc[ai][0][m][n][j] * rs, uu = acc[ai][1][m][n][j] * rs; hv[4 * n + j] = gg / (1.0f + __expf(-gg)) * uu; }
                    u32x4 w; w.x = cvt_pk_bf16(hv[0], hv[1]); w.y = cvt_pk_bf16(hv[2], hv[3]); w.z = cvt_pk_bf16(hv[4], hv[5]); w.w = cvt_pk_bf16(hv[6], hv[7]);
                    *(u32x4*)(HID + (size_t)(off + rk) * 256 + u.pn * 128 + wc * 32 + 8 * fq) = w; } }
    }
};
struct MoeSched2 {
    static constexpr bool GATHER = false;
    const char* A; const char* Bt; LAS const int* tab; int G, c;
    __device__ __forceinline__ int a_ld() const { return 256; }
    __device__ __forceinline__ const char* abase() const { return A; }
    __device__ __forceinline__ bool next(int i, pg::Unit& u) const {
        const int nun = tab[80 + 32] * 4; const long L = (long)i * G + c; if (L >= nun) return false;
        const int ci = (int)L >> 2; u.pn = (int)L & 3;
        int e = 0;
#pragma unroll 1
        for (int k = 1; k < 32; ++k) if (tab[80 + k] <= ci) e = k;
        u.aux = e; u.pm = ci - tab[80 + e]; return true;
    }
    __device__ __forceinline__ void addr(const pg::Unit& u, const char*& abase_, const char*& bbase) const {
        abase_ = A + (size_t)(tab[u.aux] + u.pm * 256) * 256 * 2; bbase = Bt + ((size_t)u.aux * 1024 + (size_t)u.pn * 256) * 256 * 2; }
    __device__ __forceinline__ void addr_g(const pg::Unit&, const int (&)[2], const int (&)[2], unsigned (&)[2][2], const char*&) const {}
};
struct EpiMoe2 {
    bf16_t* Y; const float* GS; LAS const int* tab;
    __device__ __forceinline__ void operator()(const f32x4 (&acc)[2][2][4][2], const pg::Unit& u, int wr, int wc, int fr, int fq, LAS unsigned char* stage, int wid) const {
        const int e = u.aux, cn = tab[40 + e], off = tab[e], lane = fr + 16 * fq, rk0 = u.pm * 256;
        bf16_t* const tile = Y + (size_t)(off + rk0) * 1024 + u.pn * 256; const int nvalid = cn - rk0;
        float gtv[2][4];
#pragma unroll
        for (int ai = 0; ai < 2; ++ai)
#pragma unroll
            for (int m = 0; m < 4; ++m) { const int rk = rk0 + ai * 128 + wr * 64 + m * 16 + fr; gtv[ai][m] = (rk < cn) ? GS[(size_t)e * T + rk] : 0.f; }
#pragma unroll
        for (int ai = 0; ai < 2; ++ai)
#pragma unroll
            for (int m = 0; m < 4; ++m) {
                const float gt = gtv[ai][m]; u32x4 w[2];
#pragma unroll
                for (int bj = 0; bj < 2; ++bj) { const f32x4 v0 = acc[ai][bj][m][0] * gt, v1 = acc[ai][bj][m][1] * gt;
                    w[bj].x = cvt_pk_bf16(v0[0], v0[1]); w[bj].y = cvt_pk_bf16(v0[2], v0[3]); w[bj].z = cvt_pk_bf16(v1[0], v1[1]); w[bj].w = cvt_pk_bf16(v1[2], v1[3]); }
                pg::staged_rows(stage, w[0], w[1], ai, m, wid, lane, [tile, nvalid](int trow, int ch, u32x4 v) { if (trow < nvalid) __builtin_nontemporal_store(v, (u32x4*)(tile + (size_t)trow * 1024 + ch * 8)); }); }
    }
};
__device__ __forceinline__ void p6a_moe_up(const Frame& F) {
    unsigned char* ws = F.ws; moe_build_tables(F);
    LAS const int* tab = (LAS const int*)(F.lds + MOE_TAB);
    MoeSched1 S{(const char*)(ws + WS_M), (const char*)(ws + WS_WGU), (const int*)(ws + WS_LIST), tab, F.G, F.vcu};
    EpiMoe1 E{(bf16_t*)(ws + WS_HID), (const float*)(ws + WS_RS), tab};
    pg::gemm_phase(F.lds, S, E, 1024, F.wave);
}
__device__ __forceinline__ void p6b_moe_down(const Frame& F) {
    unsigned char* ws = F.ws; moe_build_tables(F);
    LAS const int* tab = (LAS const int*)(F.lds + MOE_TAB);
    MoeSched2 S{(const char*)(ws + WS_HID), (const char*)(ws + WS_WD), tab, F.G, F.vcu};
    EpiMoe2 E{(bf16_t*)(ws + WS_Y), (const float*)(ws + WS_GS), tab};
    pg::gemm_phase(F.lds, S, E, 256, F.wave);
}
__device__ __forceinline__ void p7_combine(const Frame& F, const Args& a) {
    unsigned char* ws = F.ws; const int lane = lane_id();
    bf16_t* H2B = (bf16_t*)(ws + WS_H2B); const bf16_t* MU = (const bf16_t*)(ws + WS_M); const bf16_t* Y = (const bf16_t*)(ws + WS_Y); const int* TOK = (const int*)(ws + WS_TOKINFO); float* RS2 = (float*)(ws + WS_RS2);
    moe_build_tables(F);
    LAS const int* tab = (LAS const int*)(F.lds + MOE_TAB);
    const int gw = F.vcu * NWAVES + F.wave, NGW = F.G * NWAVES;
    for (int row0 = gw * 2; row0 < T; row0 += NGW * 2) {
        f32x4 v[2][4]; float s[2] = {0.f, 0.f};
#pragma unroll
        for (int rr = 0; rr < 2; ++rr) { const int row = row0 + rr;
            const int ea = TOK[row * 4], ra = TOK[row * 4 + 1], eb = TOK[row * 4 + 2], rb = TOK[row * 4 + 3];
            const size_t sa = (size_t)(tab[ea] + ra), sb = (size_t)(tab[eb] + rb);
#pragma unroll
            for (int j = 0; j < 4; ++j) {
                const u32x2 ya = __builtin_nontemporal_load((const u32x2*)(Y + sa * 1024) + lane + 64 * j), yb = __builtin_nontemporal_load((const u32x2*)(Y + sb * 1024) + lane + 64 * j), hh = ((const u32x2*)(MU + (size_t)row * 1024))[lane + 64 * j];
                v[rr][j].x = bf16lo(hh.x) + (bf16lo(ya.x) + bf16lo(yb.x)); v[rr][j].y = bf16hi(hh.x) + (bf16hi(ya.x) + bf16hi(yb.x)); v[rr][j].z = bf16lo(hh.y) + (bf16lo(ya.y) + bf16lo(yb.y)); v[rr][j].w = bf16hi(hh.y) + (bf16hi(ya.y) + bf16hi(yb.y));
                s[rr] += (v[rr][j].x * v[rr][j].x + v[rr][j].y * v[rr][j].y) + (v[rr][j].z * v[rr][j].z + v[rr][j].w * v[rr][j].w); } }
#pragma unroll
        for (int rr = 0; rr < 2; ++rr) { const int row = row0 + rr;
            const float rstd = 1.0f / sqrtf(wsum64(s[rr]) * (1.f / 1024.f) + EPS);
            if (lane == 0) RS2[row] = rstd;
#pragma unroll
            for (int j = 0; j < 4; ++j) { u32x2 hw; hw.x = cvt_pk_bf16(v[rr][j].x, v[rr][j].y); hw.y = cvt_pk_bf16(v[rr][j].z, v[rr][j].w); ((u32x2*)(H2B + (size_t)row * 1024))[lane + 64 * j] = hw; } }
    }
}
struct EpiPle {
    bf16_t* G; const bf16_t* PP; const float* RS2;
    __device__ __forceinline__ void operator()(const f32x4 (&acc)[2][2][4][2], const pg::Unit& u, int wr, int wc, int fr, int fq, LAS unsigned char* stage, int wid) const {
        float rs[2][4];
#pragma unroll
        for (int ai = 0; ai < 2; ++ai)
#pragma unroll
            for (int m = 0; m < 4; ++m) rs[ai][m] = -RS2[u.pm * 256 + ai * 128 + wr * 64 + m * 16 + fr];
#pragma unroll
        for (int ai = 0; ai < 2; ++ai) {
            u32x4 pp[4][2];
#pragma unroll
            for (int m = 0; m < 4; ++m) { const int row = u.pm * 256 + ai * 128 + wr * 64 + m * 16 + fr;
#pragma unroll
                for (int bj = 0; bj < 2; ++bj) pp[m][bj] = *(const u32x4*)(PP + (size_t)row * 1024 + u.pn * 256 + bj * 128 + wc * 32 + 8 * fq); }
#pragma unroll
            for (int m = 0; m < 4; ++m) { const int row = u.pm * 256 + ai * 128 + wr * 64 + m * 16 + fr; const float nr = rs[ai][m];
#pragma unroll
                for (int bj = 0; bj < 2; ++bj) { const size_t off = (size_t)row * 1024 + u.pn * 256 + bj * 128 + wc * 32 + 8 * fq;
                    const u32x4 p4 = pp[m][bj];
                    const f32x4 a0 = acc[ai][bj][m][0] * nr, a1 = acc[ai][bj][m][1] * nr; u32x4 w;
                    w.x = cvt_pk_bf16(bf16lo(p4.x) / (1.0f + __expf(a0[0])), bf16hi(p4.x) / (1.0f + __expf(a0[1])));
                    w.y = cvt_pk_bf16(bf16lo(p4.y) / (1.0f + __expf(a0[2])), bf16hi(p4.y) / (1.0f + __expf(a0[3])));
                    w.z = cvt_pk_bf16(bf16lo(p4.z) / (1.0f + __expf(a1[0])), bf16hi(p4.z) / (1.0f + __expf(a1[1])));
                    w.w = cvt_pk_bf16(bf16lo(p4.w) / (1.0f + __expf(a1[2])), bf16hi(p4.w) / (1.0f + __expf(a1[3])));
                    *(u32x4*)(G + off) = w; } }
            asm volatile("" ::: "memory");
        }
    }
};
__device__ __forceinline__ void p8_ple(const Frame& F, const Args& a) {
    unsigned char* ws = F.ws;
    pg::DenseSched S{(const char*)(ws + WS_H2B), (const char*)(ws + WS_WPG), 1024, 1024, T / 256, 4, F.G, (int)blockIdx.x};
    EpiPle E{(bf16_t*)(ws + WS_D), (const bf16_t*)(ws + WS_PP), (const float*)(ws + WS_RS2)};
    pg::gemm_phase(F.lds, S, E, 1024, F.wave);
}
__device__ __forceinline__ void p9_final(const Frame& F, const Args& a) {
    const int lane = lane_id(); float* H = a.out; const float* gf = a.in[22]; const bf16_t* Gm = (const bf16_t*)(F.ws + WS_D); const bf16_t* H2B = (const bf16_t*)(F.ws + WS_H2B);
    const int gw = F.vcu * NWAVES + F.wave, NGW = F.G * NWAVES;
    f32x4 g[4];
#pragma unroll
    for (int j = 0; j < 4; ++j) g[j] = ((const f32x4*)gf)[lane + 64 * j];
    for (int row = gw; row < T; row += NGW) {
        f32x4 v[4]; float s = 0.f;
#pragma unroll
        for (int j = 0; j < 4; ++j) { const u32x2 hh = ((const u32x2*)(H2B + (size_t)row * 1024))[lane + 64 * j], gg = ((const u32x2*)(Gm + (size_t)row * 1024))[lane + 64 * j];
            v[j].x = bf16lo(hh.x) + bf16lo(gg.x); v[j].y = bf16hi(hh.x) + bf16hi(gg.x); v[j].z = bf16lo(hh.y) + bf16lo(gg.y); v[j].w = bf16hi(hh.y) + bf16hi(gg.y);
            s += (v[j].x * v[j].x + v[j].y * v[j].y) + (v[j].z * v[j].z + v[j].w * v[j].w); }
        const float rstd = 1.0f / sqrtf(wsum64(s) * (1.f / 1024.f) + EPS);
#pragma unroll
        for (int j = 0; j < 4; ++j) ((f32x4*)(H + (size_t)row * 1024))[lane + 64 * j] = v[j] * rstd * g[j];
    }
}

__global__ void __launch_bounds__(512, 2) mega(Args args) {
    extern __shared__ __attribute__((aligned(16))) unsigned char lds_raw[];
    Frame F;
    F.lds = (LAS unsigned char*)lds_raw;
    F.wave = __builtin_amdgcn_readfirstlane(threadIdx.x >> 6);
    F.G = gridDim.x; { const int bx = blockIdx.x; F.vcu = (F.G % 8 == 0) ? (bx % 8) * (F.G / 8) + bx / 8 : bx; }
    F.ws = args.ws; F.ctl = (unsigned*)(args.ws + WS_CTL);
    volatile LAS unsigned* MISC = (volatile LAS unsigned*)(F.lds + MISC_OFF);
    for (int u = threadIdx.x; u < (LDS_BYTES - LDSCTL_OFF) / 4; u += NWAVES * 64) ((LAS unsigned*)(F.lds + LDSCTL_OFF))[u] = 0u;
    __syncthreads();
    XcdBarrier bar = xcd_barrier_post(F.ctl + CW_BAR + args.li * XCD_BAR_WORDS, MISC + 8);
    const int lo = args.ph_lo, hi = args.ph_hi;
#define IN(k) (lo <= (k) && (k) < hi)
#define BOTH(k) (IN(k) && IN((k) + 1))
    if (IN(0)) { p0_prologue(F, args); p0_router_table(F, args); if (BOTH(0)) xcd_barrier(bar); }
    if (IN(1)) { p1_inproj(F); if (BOTH(1)) xcd_barrier(bar); }
    if (IN(2)) { p2_upproj(F); if (BOTH(2)) xcd_barrier(bar); }
    if (IN(3)) { p3_mla(F); p3_mixerA(F); if (BOTH(3)) xcd_barrier(bar); }
    if (IN(4)) { p35_mix(F, args); if (BOTH(4)) xcd_barrier(bar); }
    if (IN(5)) { p4_wo(F, args); if (BOTH(5)) xcd_barrier(bar); }
    if (IN(6)) { p5_router(F, args); if (BOTH(6)) xcd_barrier(bar); }
    if (IN(7)) { p6a_moe_up(F); if (BOTH(7)) xcd_barrier(bar); }
    if (IN(8)) { p6b_moe_down(F); if (BOTH(8)) xcd_barrier(bar); }
    if (IN(9)) { p7_combine(F, args); if (BOTH(9)) xcd_barrier(bar); }
    if (IN(10)) { p8_ple(F, args); if (BOTH(10)) xcd_barrier(bar); }
    if (IN(11)) { p9_final(F, args); }
#undef IN
#undef BOTH
}
constexpr int NPHASES = 12;

extern "C" void kernel_launch(void* const* d_in, const int* in_sizes, int n_in, void* d_out, int out_size, void* d_ws, size_t ws_size, hipStream_t stream) {
    static int grid = 0;
    if (grid == 0) {
        if (n_in != 23 || ws_size < (size_t)512 * MiB || out_size != T * DM) { fprintf(stderr, "kernel_launch: unexpected n_in %d / ws_size %zu / out_size %d\n", n_in, ws_size, out_size); grid = -1; return; }
        int dev = 0, cus = 0;
        if (hipGetDevice(&dev) != hipSuccess || hipDeviceGetAttribute(&cus, hipDeviceAttributeMultiprocessorCount, dev) != hipSuccess) { grid = -1; return; }
        if (hipFuncSetAttribute((const void*)mega, hipFuncAttributeMaxDynamicSharedMemorySize, LDS_BYTES) != hipSuccess) { fprintf(stderr, "kernel_launch: hipFuncSetAttribute failed\n"); grid = -1; return; }
        int per_cu = 0;
        if (hipOccupancyMaxActiveBlocksPerMultiprocessor(&per_cu, (const void*)mega, NWAVES * 64, LDS_BYTES) != hipSuccess || per_cu < 1) { fprintf(stderr, "kernel_launch: occupancy query says %d\n", per_cu); }
        (void)hipGetLastError();
        grid = cus;
    }
    if (grid < 0) return;
    unsigned char* ws = (unsigned char*)d_ws;
    hipMemsetAsync(ws + WS_CTL, 0, CTL_ZERO_BYTES, stream);
    Args a{};
    for (int i = 0; i < 23; ++i) a.in[i] = (const float*)d_in[i];
    a.out = (float*)d_out; a.ws = ws; a.ph_lo = 0; a.ph_hi = NPHASES; a.li = 0; a.pad = 0;
    hipLaunchKernelGGL(mega, dim3(grid), dim3(NWAVES * 64), LDS_BYTES, stream, a);
}
```

```cpp
#include <hip/hip_runtime.h>
#include <cstdint>
#include <cstdio>
#include <cmath>

#define LAS __attribute__((address_space(3)))
#define GAS __attribute__((address_space(1)))
typedef unsigned short bf16_t;
typedef short bf16x8 __attribute__((ext_vector_type(8)));
typedef short s16x4 __attribute__((ext_vector_type(4)));
typedef float f32x2 __attribute__((ext_vector_type(2)));
typedef float f32x4 __attribute__((ext_vector_type(4)));
typedef float f32x16 __attribute__((ext_vector_type(16)));
typedef unsigned u32x2 __attribute__((ext_vector_type(2)));
typedef unsigned u32x4 __attribute__((ext_vector_type(4)));

__device__ __forceinline__ unsigned cvt_pk_bf16(float lo, float hi) { unsigned r; asm volatile("v_cvt_pk_bf16_f32 %0, %1, %2" : "=v"(r) : "v"(lo), "v"(hi)); return r; }
__device__ __forceinline__ float bf16lo(unsigned w) { return __uint_as_float(w << 16); }
__device__ __forceinline__ float bf16hi(unsigned w) { return __uint_as_float(w & 0xffff0000u); }
__device__ __forceinline__ int lane_id() { int r; asm volatile("v_mbcnt_lo_u32_b32 %0, -1, 0\n\tv_mbcnt_hi_u32_b32 %0, -1, %0" : "=v"(r)); return r; }
__device__ __forceinline__ float wsum64(float v) {
#pragma unroll
    for (int o = 1; o < 64; o <<= 1) v += __shfl_xor(v, o);
    return v;
}

namespace pg {
constexpr int BM = 256, BK = 64, HALF = 128, HTB = HALF * BK * 2, STAGE_BYTES = 8 * HTB, NXCD = 8, WGM = 8;
__host__ __device__ __forceinline__ int lds_byte(int r, int c) { const int st = (r >> 4) * 2 + (c >> 5), rr = r & 15, cc = c & 31, ob = rr * 64 + cc * 2; return st * 1024 + (ob ^ (((ob >> 9) & 1) << 5)); }
__host__ __device__ __forceinline__ void stage_rc(int b, int& R, int& C) { const int st = b / 1024, sb = b % 1024, swz = sb ^ (((sb >> 9) & 1) << 5); R = (st >> 1) * 16 + swz / 64; C = (st & 1) * 32 + (swz % 64) / 2; }
__host__ __device__ __forceinline__ int perm32(int rho) { const int n = rho >> 4, i = rho & 15; return 8 * (i >> 2) + 4 * n + (i & 3); }

struct Unit { int pm, pn, aux; };

__device__ __forceinline__ bool static_unit(int nM, int nN, int G, int c, int i, int& pm, int& pn) {
    const int nwg = nM * nN; const long L = (long)i * G + c; if (L >= nwg) return false;
    int wgid = (int)L; { const int q = nwg / NXCD, r = nwg % NXCD, xcd = wgid % NXCD, off = wgid / NXCD; wgid = (xcd < r ? xcd * (q + 1) : r * (q + 1) + (xcd - r) * q) + off; }
    const int nig = WGM * nN, gid = wgid / nig, fm = gid * WGM, gsz = (nM - fm) < WGM ? (nM - fm) : WGM;
    pm = fm + ((wgid % nig) % gsz); pn = (wgid % nig) / gsz; return true;
}

struct DenseSched {
    static constexpr bool GATHER = false; static constexpr int KSPLIT = 0;
    const char* A; const char* Bt; int lda, K, nM, nN, G, c;
    __device__ __forceinline__ bool next(int i, Unit& u) const { u.aux = 0; return static_unit(nM, nN, G, c, i, u.pm, u.pn); }
    __device__ __forceinline__ int a_ld() const { return lda; }
    __device__ __forceinline__ void addr(const Unit& u, const char*& abase, const char*& bbase) const {
        abase = A + (size_t)u.pm * BM * lda * 2; bbase = Bt + (size_t)u.pn * BM * K * 2; }
    __device__ __forceinline__ void addr_g(const Unit&, const int (&)[2], const int (&)[2], unsigned (&)[2][2], const char*&) const {}
    __device__ __forceinline__ const char* abase() const { return A; }
};

constexpr int EPI_STAGE_OFF = 139264, EPI_ROWB = 528;
template <class StoreFn>
__device__ __forceinline__ void staged_rows(LAS unsigned char* stage, u32x4 w0, u32x4 w1, int ai, int m, int wid, int lane, const StoreFn& store) {
    const int wr = wid >> 2, wc = wid & 3, fr = lane & 15, fq = lane >> 4, rr = 16 * wr + fr;
    *(LAS u32x4*)(stage + rr * EPI_ROWB + (32 * wc + 8 * fq) * 2) = w0;
    *(LAS u32x4*)(stage + rr * EPI_ROWB + (128 + 32 * wc + 8 * fq) * 2) = w1;
    asm volatile("s_waitcnt lgkmcnt(0)\n\ts_barrier" ::: "memory");
#pragma unroll
    for (int i = 0; i < 2; ++i) { const int r2 = 4 * wid + 2 * i + (lane >> 5), ch = lane & 31;
        const u32x4 v = *(const LAS u32x4*)(stage + r2 * EPI_ROWB + ch * 16);
        store(128 * ai + 64 * (r2 >> 4) + 16 * m + (r2 & 15), ch, v); }
    asm volatile("s_waitcnt lgkmcnt(0)\n\ts_barrier" ::: "memory");
}

template <class Epi, class Sched>
__device__ __forceinline__ void gemm_phase(LAS unsigned char* lds, const Sched& S, const Epi& E, int K, int wid) {
    const int lane = lane_id(), tid = wid * 64 + lane, wr = wid >> 2, wc = wid & 3, fr = lane & 15, fq = lane >> 4;
    const int nt = K / BK;
    constexpr int KSPLIT = Sched::KSPLIT;
    const int KB = KSPLIT > 0 ? KSPLIT * BK : K;
    int Rr[2], Cc[2]; unsigned voffB[2];
#pragma unroll
    for (int i = 0; i < 2; ++i) { int R, C; stage_rc(tid * 16 + i * 8192, R, C); Rr[i] = R; Cc[i] = C; const int Rb = (R & ~31) + perm32(R & 31); voffB[i] = (unsigned)(Rb * KB + C) * 2u; }
    const size_t kstep = (size_t)(BK * 2);
    const size_t hstepB = (size_t)HALF * KB * 2;
    const unsigned ldsw = (unsigned)wid * 1024u;
    const int aoff = lds_byte(wr * 64 + fr, fq * 8), boff = lds_byte(wc * 32 + fr, fq * 8);
    const char* const Ab = S.abase();
    constexpr bool GATHER = Sched::GATHER;
    unsigned voffA[2];
#pragma unroll
    for (int i = 0; i < 2; ++i) voffA[i] = (unsigned)(Rr[i] * S.a_ld() + Cc[i]) * 2u;
    const size_t hstepA = (size_t)HALF * S.a_ld() * 2;
#define PG_SA(b, h) (((b) * 2 + (h)) * HTB)
#define PG_SB(b, h) ((4 + (b) * 2 + (h)) * HTB)
#define PG_STAGEB(bufoff, gbase) do { _Pragma("unroll") for (int _i = 0; _i < 2; ++_i) \
        __builtin_amdgcn_global_load_lds((const unsigned*)((const char*)(gbase) + voffB[_i]), (LAS unsigned*)(lds + (bufoff) + ldsw + _i * 8192), 16, 0, 0); } while (0)
#define PG_STAGEA(bufoff, uptr, offs, h, kb) do { _Pragma("unroll") for (int _i = 0; _i < 2; ++_i) { \
        const char* _src; if constexpr (GATHER) _src = Ab + (size_t)(offs)[h][_i] + (kb); else _src = (uptr) + (h) * hstepA + (kb) + voffA[_i]; \
        __builtin_amdgcn_global_load_lds((const unsigned*)_src, (LAS unsigned*)(lds + (bufoff) + ldsw + _i * 8192), 16, 0, 0); } } while (0)
#define PG_LDA(dst, b, h) do { _Pragma("unroll") for (int m = 0; m < 4; ++m) _Pragma("unroll") for (int k = 0; k < 2; ++k) dst[m][k] = *(const LAS bf16x8*)(lds + PG_SA(b, h) + aoff + m * 2048 + k * 1024); } while (0)
#define PG_LDB(dst, b, h) do { _Pragma("unroll") for (int n = 0; n < 2; ++n) _Pragma("unroll") for (int k = 0; k < 2; ++k) dst[n][k] = *(const LAS bf16x8*)(lds + PG_SB(b, h) + boff + n * 2048 + k * 1024); } while (0)
#define PG_MMA(ai, bj, At, Bt_) do { __builtin_amdgcn_s_setprio(1); _Pragma("unroll") for (int m = 0; m < 4; ++m) _Pragma("unroll") for (int n = 0; n < 2; ++n) _Pragma("unroll") for (int k = 0; k < 2; ++k) \
        acc[ai][bj][m][n] = __builtin_amdgcn_mfma_f32_16x16x32_bf16(Bt_[n][k], At[m][k], acc[ai][bj][m][n], 0, 0, 0); __builtin_amdgcn_s_setprio(0); } while (0)
#define PG_WAIT_V(n) asm volatile("s_waitcnt vmcnt(" #n ")" ::: "memory")
#define PG_WAIT_L(n) asm volatile("s_waitcnt lgkmcnt(" #n ")" ::: "memory")
#define PG_BAR __builtin_amdgcn_s_barrier()
#define PG_SCHED __builtin_amdgcn_sched_barrier(0)
    Unit cur, nxt; int ui = 0;
    if (!S.next(0, cur)) return;
    f32x4 acc[2][2][4][2];
#pragma unroll
    for (int a = 0; a < 2; ++a)
#pragma unroll
        for (int b = 0; b < 2; ++b)
#pragma unroll
            for (int m = 0; m < 4; ++m)
#pragma unroll
                for (int n = 0; n < 2; ++n) acc[a][b][m][n] = (f32x4){0.f, 0.f, 0.f, 0.f};
    bf16x8 At[4][2], B0[2][2], B1[2][2];
    unsigned cao[2][2], nao[2][2]; const char* cA = nullptr; const char* nA = nullptr; const char* cB; const char* nB; const char* cB2 = nullptr; const char* nB2 = nullptr;
    if constexpr (GATHER) S.addr_g(cur, Rr, Cc, cao, cB); else if constexpr (KSPLIT > 0) S.addr(cur, cA, cB, cB2); else S.addr(cur, cA, cB);
    PG_STAGEB(PG_SB(0, 0), cB); PG_STAGEB(PG_SB(0, 1), cB + hstepB); PG_STAGEA(PG_SA(0, 0), cA, cao, 0, 0); PG_STAGEA(PG_SA(0, 1), cA, cao, 1, 0);
    if (wr == 1) PG_BAR;
    PG_WAIT_V(2); PG_BAR;
    PG_STAGEB(PG_SB(1, 0), cB + kstep); PG_STAGEA(PG_SA(1, 0), cA, cao, 0, kstep); PG_STAGEB(PG_SB(1, 1), cB + hstepB + kstep);
    PG_WAIT_V(6); PG_BAR;
    for (;;) {
        const bool has_next = S.next(ui + 1, nxt);
        if (has_next) { if constexpr (GATHER) S.addr_g(nxt, Rr, Cc, nao, nB); else if constexpr (KSPLIT > 0) S.addr(nxt, nA, nB, nB2); else S.addr(nxt, nA, nB); }
        else { nB = cB; nA = cA; nB2 = cB2;
            if constexpr (GATHER) {
#pragma unroll
                for (int h = 0; h < 2; ++h)
#pragma unroll
                    for (int i = 0; i < 2; ++i) nao[h][i] = cao[h][i]; } }
#pragma clang loop unroll(disable)
        for (int t = 0; t < nt; t += 2) {
            const bool last = (t == nt - 2);
            const size_t k1 = (size_t)(t + 1) * kstep;
            const size_t k2 = last ? 0 : (size_t)(t + 2) * kstep, k3 = k2 + kstep;
            const char* b2;
            if constexpr (KSPLIT > 0) b2 = last ? nB : ((t + 2 >= KSPLIT) ? cB2 + (size_t)(t + 2 - KSPLIT) * kstep : cB + (size_t)(t + 2) * kstep);
            else b2 = last ? nB : cB + (size_t)(t + 2) * kstep;
            const char* b3 = b2 + kstep;
            unsigned a2o[2][2]; const char* a2 = last ? nA : cA;
            if constexpr (GATHER) {
#pragma unroll
                for (int h = 0; h < 2; ++h)
#pragma unroll
                    for (int i = 0; i < 2; ++i) a2o[h][i] = last ? nao[h][i] : cao[h][i]; }
            PG_LDB(B0, 0, 0); PG_LDB(B1, 0, 1); PG_SCHED; PG_LDA(At, 0, 0); PG_STAGEA(PG_SA(1, 1), cA, cao, 1, k1);
            PG_WAIT_V(8); PG_WAIT_L(0); PG_BAR; PG_MMA(0, 0, At, B0); PG_MMA(0, 1, At, B1); PG_BAR; PG_SCHED;
            PG_LDA(At, 0, 1); PG_STAGEB(PG_SB(0, 0), b2); PG_STAGEB(PG_SB(0, 1), b2 + hstepB); PG_STAGEA(PG_SA(0, 0), a2, a2o, 0, k2);
            PG_WAIT_V(8); PG_WAIT_L(0); PG_BAR; PG_MMA(1, 0, At, B0); PG_MMA(1, 1, At, B1); PG_BAR; PG_SCHED;
            PG_LDB(B0, 1, 0); PG_LDB(B1, 1, 1); PG_SCHED; PG_LDA(At, 1, 0); PG_STAGEA(PG_SA(0, 1), a2, a2o, 1, k2);
            PG_WAIT_V(8); PG_WAIT_L(0); PG_BAR; PG_MMA(0, 0, At, B0); PG_MMA(0, 1, At, B1); PG_BAR; PG_SCHED;
            PG_LDA(At, 1, 1); PG_STAGEB(PG_SB(1, 0), b3); PG_STAGEB(PG_SB(1, 1), b3 + hstepB); PG_STAGEA(PG_SA(1, 0), a2, a2o, 0, k3);
            PG_WAIT_V(8); PG_WAIT_L(0); PG_BAR; PG_MMA(1, 0, At, B0); PG_MMA(1, 1, At, B1); PG_BAR; PG_SCHED;
        }
        if (wr == 0) PG_BAR;
        { const int l2 = lane_id();
          E(acc, cur, wr, wc, l2 & 15, l2 >> 4, lds + EPI_STAGE_OFF, wid); }
        if (!has_next) break;
#pragma unroll
        for (int a = 0; a < 2; ++a)
#pragma unroll
            for (int b = 0; b < 2; ++b)
#pragma unroll
                for (int m = 0; m < 4; ++m)
#pragma unroll
                    for (int n = 0; n < 2; ++n) acc[a][b][m][n] = (f32x4){0.f, 0.f, 0.f, 0.f};
        cur = nxt; cB = nB; cA = nA; cB2 = nB2;
        if constexpr (GATHER) {
#pragma unroll
            for (int h = 0; h < 2; ++h)
#pragma unroll
                for (int i = 0; i < 2; ++i) cao[h][i] = nao[h][i]; }
        ++ui;
        if (wr == 1) PG_BAR;
    }
    PG_WAIT_V(0);
    PG_BAR;
#undef PG_SA
#undef PG_SB
#undef PG_STAGEA
#undef PG_STAGEB
#undef PG_LDA
#undef PG_LDB
#undef PG_MMA
#undef PG_WAIT_V
#undef PG_WAIT_L
#undef PG_BAR
#undef PG_SCHED
}
}

#define XB_TMO      128
#define XB_XCNT(j)  (256  + 64 * (j))
#define XB_XSUB(j)  (1280 + 64 * (j))
#define XB_XGEN(j)  (2304 + 64 * (j))
#define XB_TOP      3328
#define XB_TOPGEN   3392
#define XCD_BAR_WORDS 3456
#define XB_SPIN_CAP (1u << 22)
__device__ __forceinline__ unsigned xb_ld(unsigned* p)              { return __hip_atomic_load(p, __ATOMIC_RELAXED, __HIP_MEMORY_SCOPE_AGENT); }
__device__ __forceinline__ unsigned xb_add(unsigned* p, unsigned v) { return __hip_atomic_fetch_add(p, v, __ATOMIC_RELAXED, __HIP_MEMORY_SCOPE_AGENT); }
__device__ __forceinline__ unsigned xb_xcc_id() { return (unsigned)__builtin_amdgcn_s_getreg((3 << 11) | 20) & 0xFu; }
#define XB_SPIN(cond, bar) do { unsigned _sp = 0; while (cond) { __builtin_amdgcn_s_sleep(1); \
    if ((++_sp & 255u) == 0u) { if (xb_ld(&(bar)[XB_TMO])) break; if (_sp > XB_SPIN_CAP) { atomicAdd(&(bar)[XB_TMO], 1u); break; } } } } while (0)
struct XcdBarrier { unsigned* bar; unsigned x; volatile LAS unsigned* st; };
__device__ __forceinline__ XcdBarrier xcd_barrier_post(unsigned* bar, volatile LAS unsigned* st) {
    XcdBarrier b; b.bar = bar; b.x = xb_xcc_id(); b.st = st;
    if (threadIdx.x == 0) (void)xb_add(&bar[XB_XCNT(b.x)], 1u);
    return b;
}
__device__ __forceinline__ void xcd_barrier_complete(unsigned* bar, unsigned x, unsigned& nloc, unsigned& nx) {
    const unsigned G = gridDim.x * gridDim.y * gridDim.z;
    unsigned sum, cnt, mine, sp = 0u;
    for (;;) {
        sum = 0u; cnt = 0u; mine = 0u;
#pragma unroll
        for (unsigned j = 0; j < 16; ++j) { const unsigned c = xb_ld(&bar[XB_XCNT(j)]); sum += c; cnt += (c > 0u) ? 1u : 0u; mine = (j == x) ? c : mine; }
        if (sum == G) break;
        __builtin_amdgcn_s_sleep(1);
        if ((++sp & 255u) == 0u) { if (xb_ld(&bar[XB_TMO])) break; if (sp > XB_SPIN_CAP) { atomicAdd(&bar[XB_TMO], 1u); break; } }
    }
    nloc = mine > 0u ? mine : 1u; nx = cnt > 0u ? cnt : 1u;
}
__device__ __forceinline__ void xcd_barrier(const XcdBarrier& b) {
    asm volatile("s_waitcnt vmcnt(0)" ::: "memory");
    __syncthreads();
    if (threadIdx.x == 0) {
        unsigned* bar = b.bar;
        __builtin_amdgcn_s_waitcnt(0);
        unsigned nloc = b.st[0], nx = b.st[1];
        if (nloc == 0u) { xcd_barrier_complete(bar, b.x, nloc, nx); b.st[0] = nloc; b.st[1] = nx; }
        const unsigned old = xb_add(&bar[XB_XSUB(b.x)], 1u);
        const unsigned gen = old / nloc;
        if (old + 1u == (gen + 1u) * nloc) {
            __builtin_amdgcn_fence(__ATOMIC_RELEASE, "agent");
            asm volatile("s_waitcnt vmcnt(0)" ::: "memory");
            const unsigned og = xb_add(&bar[XB_TOP], 1u);
            const unsigned tg = og / nx;
            if (og + 1u == (tg + 1u) * nx) xb_add(&bar[XB_TOPGEN], 1u);
            else XB_SPIN(xb_ld(&bar[XB_TOPGEN]) == tg, bar);
            __builtin_amdgcn_fence(__ATOMIC_ACQUIRE, "agent");
            xb_add(&bar[XB_XGEN(b.x)], 1u);
            asm volatile("s_waitcnt vmcnt(0)" ::: "memory");
        } else {
            XB_SPIN(xb_ld(&bar[XB_XGEN(b.x)]) == gen, bar);
            __builtin_amdgcn_fence(__ATOMIC_ACQUIRE, "agent");
            asm volatile("s_waitcnt vmcnt(0)" ::: "memory");
        }
    }
    __syncthreads();
}

constexpr int NB = 8, SEQ = 4096, T = NB * SEQ, DM = 1024;
constexpr int INW = 2208, INWP = 2304;
constexpr int QLORA = 384, KVLORA = 256;
constexpr float EPS = 1e-6f;
constexpr float LOG2E = 1.4426950408889634f;
constexpr float QA_SCALE = 0.125f * LOG2E;
constexpr float MLA_QSCALE = 0.10206207261596577f * LOG2E;
constexpr int NWAVES = 8;

constexpr size_t MiB = 1u << 20;
constexpr size_t WS_CTL = 0, CTL_ZERO_BYTES = 1 * MiB;
constexpr size_t WS_ROPE = 1 * MiB;
constexpr size_t WS_SSQ = 2 * MiB;
constexpr size_t WS_WIN = 5 * MiB, WS_WUQ = 10 * MiB, WS_WUKV = 11 * MiB, WS_WO = 12 * MiB, WS_WPG = 14 * MiB, WS_WPP = 16 * MiB, WS_WGU = 17 * MiB, WS_WD = 49 * MiB;
constexpr size_t WS_XN = 65 * MiB;
constexpr size_t WS_P16 = 129 * MiB;
constexpr size_t WS_PP = 145 * MiB;
constexpr size_t WS_QA = 209 * MiB, WS_KA = 241 * MiB, WS_VA = 273 * MiB;
static_assert(WS_KA - WS_QA == (size_t)T * 512 * 2 && WS_VA - WS_KA == (size_t)T * 512 * 2, "QA|KA|VA contiguous");
constexpr size_t WS_CQKV = 305 * MiB;
constexpr size_t WS_QB = 345 * MiB, WS_KB = 393 * MiB;
constexpr size_t WS_VB = 441 * MiB;
constexpr size_t WS_OB = 473 * MiB;
constexpr size_t WS_OAP0 = 65 * MiB, WS_OAP1 = 97 * MiB, WS_OAP2 = 305 * MiB;
constexpr size_t WS_LSE = 129 * MiB;
constexpr size_t WS_MIXED = 209 * MiB;
constexpr size_t WS_M = 65 * MiB;
constexpr size_t WS_Y = 209 * MiB;
constexpr size_t WS_HID = 353 * MiB;
constexpr size_t WS_LIST = 132 * MiB;
constexpr size_t WS_RS2 = 136 * MiB + 896 * 1024;
constexpr size_t WS_TOKINFO = 136 * MiB;
constexpr int CW_BAR = 4096, CW_CNT = 16384, CW_Q = 20480;

constexpr int RING_BYTES = 131072;
constexpr int LDSCTL_OFF = RING_BYTES, MISC_OFF = LDSCTL_OFF + 320;
constexpr int LDS_BYTES = 163840;

struct Args { const float* in[23]; float* out; unsigned char* ws; int ph_lo, ph_hi, li, pad; };
struct Frame {
    LAS unsigned char* lds;
    int wave, vcu, G;
    unsigned char* ws; unsigned* ctl;
};

__device__ __forceinline__ void p0_transpose_item(const float* __restrict__ W, int ldw, int k0, int n0, bf16_t* WT, int ldd, int drow0, const float* __restrict__ gain, LAS float* scr, int lane) {
    const int kq = lane >> 3, n4 = (lane & 7) * 4;
    f32x4 v[8];
#pragma unroll
    for (int i = 0; i < 8; ++i) v[i] = *(const f32x4*)(W + (size_t)(k0 + kq + 8 * i) * ldw + n0 + n4);
#pragma unroll
    for (int i = 0; i < 8; ++i) { const int kk = kq + 8 * i; f32x4 x = v[i]; if (gain) x = x * gain[k0 + kk];
        scr[kk * 33 + n4] = x[0]; scr[kk * 33 + n4 + 1] = x[1]; scr[kk * 33 + n4 + 2] = x[2]; scr[kk * 33 + n4 + 3] = x[3]; }
    asm volatile("s_waitcnt lgkmcnt(0)" ::: "memory");
    const int c = lane & 7;
#pragma unroll
    for (int j = 0; j < 4; ++j) { const int n = (lane >> 3) + 8 * j; const LAS float* s = scr + (8 * c) * 33 + n;
        u32x4 o; o.x = cvt_pk_bf16(s[0 * 33], s[1 * 33]); o.y = cvt_pk_bf16(s[2 * 33], s[3 * 33]); o.z = cvt_pk_bf16(s[4 * 33], s[5 * 33]); o.w = cvt_pk_bf16(s[6 * 33], s[7 * 33]);
        *(u32x4*)(WT + (size_t)(drow0 + n) * ldd + k0 + 8 * c) = o; }
    asm volatile("s_waitcnt lgkmcnt(0)" ::: "memory");
}
__device__ __forceinline__ void rms_row_to_bf16(const float* xrow, const float* __restrict__ g, bf16_t* orow, int lane) {
    const f32x4* xr = (const f32x4*)xrow + lane; const f32x4* gr = (const f32x4*)g + lane;
    f32x4 v[4]; float s = 0.f;
#pragma unroll
    for (int j = 0; j < 4; ++j) { v[j] = xr[64 * j]; s += (v[j].x * v[j].x + v[j].y * v[j].y) + (v[j].z * v[j].z + v[j].w * v[j].w); }
    const float rstd = 1.0f / sqrtf(wsum64(s) * (1.f / 1024.f) + EPS);
    u32x2* o8 = (u32x2*)orow + lane;
#pragma unroll
    for (int j = 0; j < 4; ++j) { const f32x4 gg = gr[64 * j]; u32x2 w; w.x = cvt_pk_bf16(v[j].x * rstd * gg.x, v[j].y * rstd * gg.y); w.y = cvt_pk_bf16(v[j].z * rstd * gg.z, v[j].w * rstd * gg.w); o8[64 * j] = w; }
}

__device__ __forceinline__ void p0_prologue(const Frame& F, const Args& a) {
    LAS float* scr = (LAS float*)(F.lds + F.wave * 16384);
    const int gw = F.vcu * NWAVES + F.wave, NGW = F.G * NWAVES, lane = lane_id();
    unsigned char* ws = F.ws;
    const float* w_in = a.in[3]; const float* g_cq = a.in[4]; const float* w_uq = a.in[5]; const float* g_ckv = a.in[6]; const float* w_ukv = a.in[7];
    const float* w_o = a.in[10]; const float* w_eg = a.in[16]; const float* w_eu = a.in[17]; const float* w_ed = a.in[18]; const float* w_pg = a.in[20]; const float* w_pp = a.in[21];
    constexpr int I_IN = 16 * 69, I_UQ = 6 * 24, I_UKV = 4 * 32, I_O = 16 * 32, I_PG = 16 * 32, I_PP = 4 * 32, I_EG = 32 * 16 * 8, I_EU = I_EG, I_ED = 32 * 4 * 32;
    constexpr int NITEMS = I_IN + I_UQ + I_UKV + I_O + I_PG + I_PP + I_EG + I_EU + I_ED;
    for (int it = gw; it < NITEMS; it += NGW) {
        int r = it;
        if (r < I_IN) { const int kb = r / 69, nb = r % 69; p0_transpose_item(w_in, INW, 64 * kb, 32 * nb, (bf16_t*)(ws + WS_WIN), 1024, 32 * nb, nullptr, scr, lane); continue; } r -= I_IN;
        if (r < I_UQ) { const int kb = r / 24, nb = r % 24; p0_transpose_item(w_uq, 768, 64 * kb, 32 * nb, (bf16_t*)(ws + WS_WUQ), QLORA, 32 * nb, g_cq, scr, lane); continue; } r -= I_UQ;
        if (r < I_UKV) { const int kb = r / 32, nb = r % 32; p0_transpose_item(w_ukv, 1024, 64 * kb, 32 * nb, (bf16_t*)(ws + WS_WUKV), KVLORA, 32 * nb, g_ckv, scr, lane); continue; } r -= I_UKV;
        if (r < I_O) { const int kb = r / 32, nb = r % 32; p0_transpose_item(w_o, 1024, 64 * kb, 32 * nb, (bf16_t*)(ws + WS_WO), 1024, 32 * nb, nullptr, scr, lane); continue; } r -= I_O;
        if (r < I_PG) { const int kb = r / 32, nb = r % 32; p0_transpose_item(w_pg, 1024, 64 * kb, 32 * nb, (bf16_t*)(ws + WS_WPG), 1024, 32 * nb, a.in[19], scr, lane); continue; } r -= I_PG;
        if (r < I_PP) { const int kb = r / 32, nb = r % 32; p0_transpose_item(w_pp, 1024, 64 * kb, 32 * nb, (bf16_t*)(ws + WS_WPP), 256, 32 * nb, nullptr, scr, lane); continue; } r -= I_PP;
        if (r < I_EG + I_EU) {
            const int up = r >= I_EG; if (up) r -= I_EG;
            const int e = r / 128, q = r % 128, kb = q / 8, nb = q % 8, n0 = 32 * nb;
            const int drow = (n0 >> 7) * 256 + (up ? 128 : 0) + (n0 & 127);
            p0_transpose_item((up ? w_eu : w_eg) + (size_t)e * 1024 * 256, 256, 64 * kb, n0, (bf16_t*)(ws + WS_WGU) + (size_t)e * 512 * 1024, 1024, drow, a.in[11], scr, lane); continue; }
        r -= I_EG + I_EU;
        { const int e = r / 128, q = r % 128, kb = q / 32, nb = q % 32;
          p0_transpose_item(w_ed + (size_t)e * 256 * 1024, 1024, 64 * kb, 32 * nb, (bf16_t*)(ws + WS_WD) + (size_t)e * 1024 * 256, 256, 32 * nb, nullptr, scr, lane); }
    }
    for (int i = gw * 64 + lane; i < 96 * 128; i += NGW * 64) ((u32x4*)((bf16_t*)(ws + WS_WIN) + (size_t)INW * 1024))[i] = (u32x4){0u, 0u, 0u, 0u};
    { const float* x = a.in[0]; const float* g_mix = a.in[2]; bf16_t* XN = (bf16_t*)(ws + WS_XN);
      f32x4 gg[4];
#pragma unroll
      for (int j = 0; j < 4; ++j) gg[j] = ((const f32x4*)g_mix)[lane + 64 * j];
      for (int m = gw * 2; m < T; m += NGW * 2) {
          f32x4 v0[4], v1[4]; float s0 = 0.f, s1 = 0.f;
#pragma unroll
          for (int j = 0; j < 4; ++j) { v0[j] = ((const f32x4*)(x + (size_t)m * DM))[lane + 64 * j]; v1[j] = ((const f32x4*)(x + (size_t)(m + 1) * DM))[lane + 64 * j]; }
#pragma unroll
          for (int j = 0; j < 4; ++j) { s0 += (v0[j].x * v0[j].x + v0[j].y * v0[j].y) + (v0[j].z * v0[j].z + v0[j].w * v0[j].w); s1 += (v1[j].x * v1[j].x + v1[j].y * v1[j].y) + (v1[j].z * v1[j].z + v1[j].w * v1[j].w); }
          const float r0 = 1.0f / sqrtf(wsum64(s0) * (1.f / 1024.f) + EPS), r1 = 1.0f / sqrtf(wsum64(s1) * (1.f / 1024.f) + EPS);
#pragma unroll
          for (int j = 0; j < 4; ++j) { u32x2 w0, w1;
              w0.x = cvt_pk_bf16(v0[j].x * r0 * gg[j].x, v0[j].y * r0 * gg[j].y); w0.y = cvt_pk_bf16(v0[j].z * r0 * gg[j].z, v0[j].w * r0 * gg[j].w);
              w1.x = cvt_pk_bf16(v1[j].x * r1 * gg[j].x, v1[j].y * r1 * gg[j].y); w1.y = cvt_pk_bf16(v1[j].z * r1 * gg[j].z, v1[j].w * r1 * gg[j].w);
              ((u32x2*)(XN + (size_t)m * DM))[lane + 64 * j] = w0; ((u32x2*)(XN + (size_t)(m + 1) * DM))[lane + 64 * j] = w1; } } }
    { const float* p = a.in[1]; bf16_t* P16 = (bf16_t*)(ws + WS_P16);
      for (size_t i = (size_t)gw * 64 + lane; i < (size_t)T * 256 / 8; i += (size_t)NGW * 64) {
          const f32x4 v0 = ((const f32x4*)p)[2 * i], v1 = ((const f32x4*)p)[2 * i + 1];
          u32x4 o; o.x = cvt_pk_bf16(v0.x, v0.y); o.y = cvt_pk_bf16(v0.z, v0.w); o.z = cvt_pk_bf16(v1.x, v1.y); o.w = cvt_pk_bf16(v1.z, v1.w);
          ((u32x4*)P16)[i] = o; } }
    { float* cs = (float*)(ws + WS_ROPE); float* sn = cs + SEQ * 16;
      for (int idx = gw * 64 + lane; idx < SEQ * 16; idx += NGW * 64) {
          const int pos = idx >> 4, i = idx & 15;
          const float inv = 1.0f / powf(10000.0f, (float)(2 * i) / 32.0f);
          const float ang = (float)pos * inv;
          cs[idx] = (float)cos((double)ang); sn[idx] = (float)sin((double)ang); } }
}

struct EpiInProj {
    bf16_t *QA, *CQKV, *KB; float* SSQ; const float* CS; const float* SN;
    __device__ __forceinline__ void operator()(const f32x4 (&acc)[2][2][4][2], const pg::Unit& u, int wr, int wc, int fr, int fq, LAS unsigned char* stage, int wid) const {
        const int pn = u.pn;
        if (pn < 6) {
            bf16_t* const tile = QA + (size_t)(pn >> 1) * ((size_t)T * 512) + (size_t)u.pm * 256 * 512 + (pn & 1) * 256; const float sc = (pn < 2) ? QA_SCALE : 1.f;
            const int lane = fr + 16 * fq;
#pragma unroll
            for (int ai = 0; ai < 2; ++ai)
#pragma unroll
                for (int m = 0; m < 4; ++m) { u32x4 w[2];
#pragma unroll
                    for (int bj = 0; bj < 2; ++bj) { const f32x4 v0 = acc[ai][bj][m][0] * sc, v1 = acc[ai][bj][m][1] * sc;
                        w[bj].x = cvt_pk_bf16(v0[0], v0[1]); w[bj].y = cvt_pk_bf16(v0[2], v0[3]); w[bj].z = cvt_pk_bf16(v1[0], v1[1]); w[bj].w = cvt_pk_bf16(v1[2], v1[3]); }
                    pg::staged_rows(stage, w[0], w[1], ai, m, wid, lane, [tile](int trow, int ch, u32x4 v) { __builtin_nontemporal_store(v, (u32x4*)(tile + (size_t)trow * 512 + ch * 8)); }); }
        } else {
#pragma unroll
            for (int ai = 0; ai < 2; ++ai)
#pragma unroll
                for (int m = 0; m < 4; ++m) { const int row = u.pm * 256 + ai * 128 + wr * 64 + m * 16 + fr;
#pragma unroll
                    for (int bj = 0; bj < 2; ++bj) {
                        const f32x4 v0 = acc[ai][bj][m][0], v1 = acc[ai][bj][m][1];
                        if (pn < 8 || bj == 0) {
                            const int col = (pn - 6) * 256 + bj * 128 + wc * 32 + 8 * fq; u32x4 w;
                            w.x = cvt_pk_bf16(v0[0], v0[1]); w.y = cvt_pk_bf16(v0[2], v0[3]); w.z = cvt_pk_bf16(v1[0], v1[1]); w.w = cvt_pk_bf16(v1[2], v1[3]);
                            *(u32x4*)(CQKV + (size_t)row * 640 + col) = w;
                            float s = (v0[0] * v0[0] + v0[1] * v0[1]) + (v0[2] * v0[2] + v0[3] * v0[3]) + (v1[0] * v1[0] + v1[1] * v1[1]) + (v1[2] * v1[2] + v1[3] * v1[3]);
                            s += __shfl_xor(s, 16); s += __shfl_xor(s, 32);
                            if (fq == 0) SSQ[(size_t)row * 20 + (pn - 6) * 8 + bj * 4 + wc] = s;
                        } else if (wc == 0) {
                            const int pos = row & (SEQ - 1); const int ci = pos * 16 + 8 * (fq & 1);
                            const f32x4 c0 = *(const f32x4*)(CS + ci), c1 = *(const f32x4*)(CS + ci + 4), s0 = *(const f32x4*)(SN + ci), s1 = *(const f32x4*)(SN + ci + 4);
                            f32x4 p0, p1;
#pragma unroll
                            for (int j = 0; j < 4; ++j) { p0[j] = __shfl_xor(v0[j], 32); p1[j] = __shfl_xor(v1[j], 32); }
                            f32x4 o0, o1;
                            if (fq < 2) { o0 = v0 * c0 - p0 * s0; o1 = v1 * c1 - p1 * s1; }
                            else        { o0 = p0 * s0 + v0 * c0; o1 = p1 * s1 + v1 * c1; }
                            u32x4 w; w.x = cvt_pk_bf16(o0[0], o0[1]); w.y = cvt_pk_bf16(o0[2], o0[3]); w.z = cvt_pk_bf16(o1[0], o1[1]); w.w = cvt_pk_bf16(o1[2], o1[3]);
#pragma unroll
                            for (int h = 0; h < 8; ++h) *(u32x4*)(KB + (size_t)row * 768 + h * 96 + 64 + 8 * fq) = w;
                        }
                    } }
        }
    }
};
struct EpiStoreBf16 {
    bf16_t* O; int ldc;
    __device__ __forceinline__ void operator()(const f32x4 (&acc)[2][2][4][2], const pg::Unit& u, int wr, int wc, int fr, int fq, LAS unsigned char* stage, int wid) const {
        const int lane = fr + 16 * fq; bf16_t* const tile = O + (size_t)u.pm * 256 * ldc + u.pn * 256; const int ld = ldc;
#pragma unroll
        for (int ai = 0; ai < 2; ++ai)
#pragma unroll
            for (int m = 0; m < 4; ++m) { u32x4 w[2];
#pragma unroll
                for (int bj = 0; bj < 2; ++bj) { const f32x4 v0 = acc[ai][bj][m][0], v1 = acc[ai][bj][m][1];
                    w[bj].x = cvt_pk_bf16(v0[0], v0[1]); w[bj].y = cvt_pk_bf16(v0[2], v0[3]); w[bj].z = cvt_pk_bf16(v1[0], v1[1]); w[bj].w = cvt_pk_bf16(v1[2], v1[3]); }
                pg::staged_rows(stage, w[0], w[1], ai, m, wid, lane, [tile, ld](int trow, int ch, u32x4 v) { __builtin_nontemporal_store(v, (u32x4*)(tile + (size_t)trow * ld + ch * 8)); }); }
    }
};
struct EpiQUp {
    bf16_t* QB; const float* SSQ; const float* CS; const float* SN;
    __device__ __forceinline__ void operator()(const f32x4 (&acc)[2][2][4][2], const pg::Unit& u, int wr, int wc, int fr, int fq, LAS unsigned char* stage, int wid) const {
        float rstd[2][4];
#pragma unroll
        for (int ai = 0; ai < 2; ++ai)
#pragma unroll
            for (int m = 0; m < 4; ++m) { const int row = u.pm * 256 + ai * 128 + wr * 64 + m * 16 + fr;
                const f32x4 q0 = *(const f32x4*)(SSQ + (size_t)row * 20), q1 = *(const f32x4*)(SSQ + (size_t)row * 20 + 4), q2 = *(const f32x4*)(SSQ + (size_t)row * 20 + 8);
                const float ss = ((q0[0] + q0[1]) + (q0[2] + q0[3])) + ((q1[0] + q1[1]) + (q1[2] + q1[3])) + ((q2[0] + q2[1]) + (q2[2] + q2[3]));
                rstd[ai][m] = 1.0f / sqrtf(ss * (1.f / 384.f) + EPS);
                if (m == 3) asm volatile("" : "+v"(rstd[ai][0]), "+v"(rstd[ai][1]), "+v"(rstd[ai][2]), "+v"(rstd[ai][3]) :: "memory"); }
        const int G0 = u.pn * 8 + wc;
        const int rbj = (G0 % 3 == 2) ? 0 : (((G0 + 4) % 3 == 2) ? 1 : -1);
#pragma unroll
        for (int ai = 0; ai < 2; ++ai)
#pragma unroll
          for (int mh = 0; mh < 2; ++mh) {
            f32x4 c0[2], c1[2], s0[2], s1[2];
#pragma unroll
            for (int m = 0; m < 2; ++m) { c0[m] = f32x4{0.f, 0.f, 0.f, 0.f}; c1[m] = c0[m]; s0[m] = c0[m]; s1[m] = c0[m]; }
            if (rbj >= 0) {
#pragma unroll
                for (int m = 0; m < 2; ++m) { const int row = u.pm * 256 + ai * 128 + wr * 64 + (2 * mh + m) * 16 + fr;
                    const int pos = row & (SEQ - 1); const int ci = pos * 16 + 8 * (fq & 1);
                    c0[m] = *(const f32x4*)(CS + ci); c1[m] = *(const f32x4*)(CS + ci + 4); s0[m] = *(const f32x4*)(SN + ci); s1[m] = *(const f32x4*)(SN + ci + 4); }
            }
#pragma unroll
            for (int mm = 0; mm < 2; ++mm) { const int m = 2 * mh + mm; const int row = u.pm * 256 + ai * 128 + wr * 64 + m * 16 + fr;
#pragma unroll
                for (int bj = 0; bj < 2; ++bj) { const int G = G0 + bj * 4;
                    f32x4 v0 = acc[ai][bj][m][0] * rstd[ai][m], v1 = acc[ai][bj][m][1] * rstd[ai][m];
                    if (bj == rbj) {
                        f32x4 p0, p1;
#pragma unroll
                        for (int j = 0; j < 4; ++j) { p0[j] = __shfl_xor(v0[j], 32); p1[j] = __shfl_xor(v1[j], 32); }
                        if (fq < 2) { v0 = v0 * c0[mm] - p0 * s0[mm]; v1 = v1 * c1[mm] - p1 * s1[mm]; }
                        else        { v0 = p0 * s0[mm] + v0 * c0[mm]; v1 = p1 * s1[mm] + v1 * c1[mm]; }
                    }
                    v0 = v0 * MLA_QSCALE; v1 = v1 * MLA_QSCALE;
                    u32x4 w; w.x = cvt_pk_bf16(v0[0], v0[1]); w.y = cvt_pk_bf16(v0[2], v0[3]); w.z = cvt_pk_bf16(v1[0], v1[1]); w.w = cvt_pk_bf16(v1[2], v1[3]);
                    *(u32x4*)(QB + (size_t)row * 768 + G * 32 + 8 * fq) = w; } }
          }
    }
};
struct EpiKVUp {
    bf16_t *KB, *VB; const float* SSQ;
    __device__ __forceinline__ void operator()(const f32x4 (&acc)[2][2][4][2], const pg::Unit& u, int wr, int wc, int fr, int fq, LAS unsigned char* stage, int wid) const {
        float rstd[2][4];
#pragma unroll
        for (int ai = 0; ai < 2; ++ai)
#pragma unroll
            for (int m = 0; m < 4; ++m) { const int row = u.pm * 256 + ai * 128 + wr * 64 + m * 16 + fr;
                const f32x4 q0 = *(const f32x4*)(SSQ + (size_t)row * 20 + 12), q1 = *(const f32x4*)(SSQ + (size_t)row * 20 + 16);
                const float ss = ((q0[0] + q0[1]) + (q0[2] + q0[3])) + ((q1[0] + q1[1]) + (q1[2] + q1[3]));
                rstd[ai][m] = 1.0f / sqrtf(ss * (1.f / 256.f) + EPS);
                if (m == 3) asm volatile("" : "+v"(rstd[ai][0]), "+v"(rstd[ai][1]), "+v"(rstd[ai][2]), "+v"(rstd[ai][3]) :: "memory"); }
#pragma unroll
        for (int ai = 0; ai < 2; ++ai)
#pragma unroll
            for (int m = 0; m < 4; ++m) { const int row = u.pm * 256 + ai * 128 + wr * 64 + m * 16 + fr;
#pragma unroll
                for (int bj = 0; bj < 2; ++bj) { const int G = u.pn * 8 + bj * 4 + wc;
                    const int h = G >> 2, part = G & 3;
                    const f32x4 v0 = acc[ai][bj][m][0] * rstd[ai][m], v1 = acc[ai][bj][m][1] * rstd[ai][m];
                    u32x4 w; w.x = cvt_pk_bf16(v0[0], v0[1]); w.y = cvt_pk_bf16(v0[2], v0[3]); w.z = cvt_pk_bf16(v1[0], v1[1]); w.w = cvt_pk_bf16(v1[2], v1[3]);
                    if (part < 2) *(u32x4*)(KB + (size_t)row * 768 + h * 96 + part * 32 + 8 * fq) = w;
                    else          *(u32x4*)(VB + (size_t)row * 512 + h * 64 + (part - 2) * 32 + 8 * fq) = w; } }
    }
};

struct PPSched {
    static constexpr bool GATHER = false; static constexpr int KSPLIT = 0;
    const char* A; const char* Bt; int q, nP, first, last;
    __device__ __forceinline__ bool next(int i, pg::Unit& u) const { if (q < 0) return false; const int L = first + i * nP + q; if (L >= last) return false; u.aux = 0; u.pm = L >> 2; u.pn = L & 3; return true; }
    __device__ __forceinline__ int a_ld() const { return 256; }
    __device__ __forceinline__ void addr(const pg::Unit& u, const char*& abase, const char*& bbase) const { abase = A + (size_t)u.pm * pg::BM * 256 * 2; bbase = Bt + (size_t)u.pn * pg::BM * 256 * 2; }
    __device__ __forceinline__ void addr_g(const pg::Unit&, const int (&)[2], const int (&)[2], unsigned (&)[2][2], const char*&) const {}
    __device__ __forceinline__ const char* abase() const { return A; }
};
__device__ __forceinline__ void pp_units(const Frame& F, bool second) {
    unsigned char* ws = F.ws; const int c0 = F.G / 2, nP = F.G - c0, n1 = (2 * nP < 512) ? 2 * nP : 512;
    PPSched S{(const char*)(ws + WS_P16), (const char*)(ws + WS_WPP), (int)blockIdx.x - c0, nP, second ? n1 : 0, second ? 512 : n1};
    EpiStoreBf16 E{(bf16_t*)(ws + WS_PP), 1024};
    pg::gemm_phase(F.lds, S, E, 256, F.wave);
}
__device__ __forceinline__ void p1_inproj(const Frame& F) {
    unsigned char* ws = F.ws;
    { pg::DenseSched S{(const char*)(ws + WS_XN), (const char*)(ws + WS_WIN), 1024, 1024, T / 256, INWP / 256, F.G, (int)blockIdx.x};
      EpiInProj E{(bf16_t*)(ws + WS_QA), (bf16_t*)(ws + WS_CQKV), (bf16_t*)(ws + WS_KB), (float*)(ws + WS_SSQ), (const float*)(ws + WS_ROPE), (const float*)(ws + WS_ROPE) + SEQ * 16};
      pg::gemm_phase(F.lds, S, E, 1024, F.wave); }
    pp_units(F, false);
}
__device__ __forceinline__ void p2_upproj(const Frame& F) {
    unsigned char* ws = F.ws;
    { pg::DenseSched S{(const char*)(ws + WS_CQKV), (const char*)(ws + WS_WUQ), 640, QLORA, T / 256, 3, F.G, (int)blockIdx.x};
      EpiQUp E{(bf16_t*)(ws + WS_QB), (const float*)(ws + WS_SSQ), (const float*)(ws + WS_ROPE), (const float*)(ws + WS_ROPE) + SEQ * 16};
      pg::gemm_phase(F.lds, S, E, QLORA, F.wave); }
    { pg::DenseSched S{(const char*)(ws + WS_CQKV) + 384 * 2, (const char*)(ws + WS_WUKV), 640, KVLORA, T / 256, 4, F.G, (int)blockIdx.x};
      EpiKVUp E{(bf16_t*)(ws + WS_KB), (bf16_t*)(ws + WS_VB), (const float*)(ws + WS_SSQ)};
      pg::gemm_phase(F.lds, S, E, KVLORA, F.wave); }
    pp_units(F, true);
}

namespace mla {
constexpr int QBLK = 32, KVBLK = 64, LDQ = 768, LDKk = 768, LDV = 512, LDO = 512;
constexpr float SCALE = 0.10206207261596577f;
constexpr int SHM_V = KVBLK * 64 * 2  , SHM_K = KVBLK * 256  ;
#define KSWZ(row, colB) ((row) * 256 + ((colB) ^ (((row) & 15) << 4)))
#define SBAR() __builtin_amdgcn_sched_barrier(0)
__device__ __forceinline__ int crow(int r, int hi) { return (r & 3) + 8 * (r >> 2) + 4 * hi; }

__device__ __forceinline__ int v_rd_base(int lane) { return ((lane & 3) << 3) | (((lane >> 2) & 3) << 6) | (((lane >> 4) & 1) << 5) | (((lane >> 5) & 1) << 8); }
constexpr int v_rd_off(int d0, int ks, int half) { return d0 * 512 + ks * 2048 + half * 1024; }
#define MLA_EXP2(x) __builtin_amdgcn_exp2f(x)
constexpr float THR2 = 8.f;
#define MX3(a, b, c) __builtin_fmaxf(__builtin_fmaxf((a), (b)), (c))
__device__ __forceinline__ void soft4(f32x16& p0, f32x16& p1, float& m_reg, float& l_reg, f32x16& negm, f32x16* o, float* al_l, bool first, bf16x8& pa0, bf16x8& pa1, bf16x8& pa2, bf16x8& pa3, int r32, int hi) {
  float ma = MX3(p0[0], p0[1], p0[2]), mb = MX3(p0[3], p0[4], p0[5]), mc = MX3(p0[6], p0[7], p0[8]), md = MX3(p0[9], p0[10], p0[11]);
  ma = MX3(ma, p0[12], p0[13]); mb = MX3(mb, p0[14], p0[15]); mc = MX3(mc, p1[0], p1[1]); md = MX3(md, p1[2], p1[3]);
  ma = MX3(ma, p1[4], p1[5]); mb = MX3(mb, p1[6], p1[7]); mc = MX3(mc, p1[8], p1[9]); md = MX3(md, p1[10], p1[11]);
  ma = MX3(ma, p1[12], p1[13]); mb = MX3(mb, p1[14], p1[15]);
  float pmax = __builtin_fmaxf(MX3(ma, mb, mc), md);
  { auto rr = __builtin_amdgcn_permlane32_swap(__float_as_uint(pmax), __float_as_uint(pmax), false, false);
    pmax = fmaxf(__uint_as_float(rr[0]), __uint_as_float(rr[1])); }
  if (__builtin_expect(first || !__all(pmax <= THR2), 0)) {
    const float dl = first ? pmax : fmaxf(pmax, 0.f);
    m_reg += dl;
#pragma unroll
    for (int r = 0; r < 16; ++r) { p0[r] -= dl; p1[r] -= dl; negm[r] = -m_reg; }
    if (!first) { const float alpha = __builtin_amdgcn_exp2f(-dl); l_reg *= alpha;
      if (hi == 0) al_l[r32] = alpha; asm volatile("s_waitcnt lgkmcnt(0)" ::: "memory");
#pragma unroll
      for (int r = 0; r < 16; ++r) { const float a = al_l[crow(r, hi)]; o[0][r] *= a; o[1][r] *= a; } }
  }
  asm volatile("" : "+v"(negm));
#pragma unroll
  for (int r = 0; r < 16; ++r) { p0[r] = MLA_EXP2(p0[r]); p1[r] = MLA_EXP2(p1[r]); }
  float s0 = p0[0] + p1[0], s1 = p0[1] + p1[1], s2 = p0[2] + p1[2], s3 = p0[3] + p1[3];
#pragma unroll
  for (int r = 4; r < 16; r += 4) { s0 += p0[r] + p1[r]; s1 += p0[r + 1] + p1[r + 1]; s2 += p0[r + 2] + p1[r + 2]; s3 += p0[r + 3] + p1[r + 3]; }
  l_reg += (s0 + s1) + (s2 + s3);
#define PK8(P, BASE, OUT) do { u32x4 w = {cvt_pk_bf16(P[BASE + 0], P[BASE + 1]), cvt_pk_bf16(P[BASE + 2], P[BASE + 3]), cvt_pk_bf16(P[BASE + 4], P[BASE + 5]), cvt_pk_bf16(P[BASE + 6], P[BASE + 7])}; \
    OUT = __builtin_bit_cast(bf16x8, w); } while (0)
  PK8(p0, 0, pa0); PK8(p0, 8, pa1); PK8(p1, 0, pa2); PK8(p1, 8, pa3);
#undef PK8
}
#undef MX3
typedef short v4i16_t __attribute__((ext_vector_type(4)));
typedef __attribute__((address_space(3))) const char* lds_cptr;
__device__ __forceinline__ s16x4 vtr(lds_cptr p) { return __builtin_bit_cast(s16x4, __builtin_amdgcn_ds_read_tr16_b64_v4i16((__attribute__((address_space(3))) v4i16_t*)p)); }
#define VFRAG(L, H) (bf16x8){L[0], L[1], L[2], L[3], H[0], H[1], H[2], H[3]}
__device__ __forceinline__ void mprefetch(bf16x8 (&fk)[12], lds_cptr Ks, int r32, int hi) {
#define KOFF(row, d0) KSWZ(row, ((d0) * 16 + hi * 8) * 2)
#pragma unroll
  for (int d0 = 0; d0 < 6; ++d0) { fk[2 * d0] = *(const __attribute__((address_space(3))) bf16x8*)(Ks + KOFF(r32, d0)); fk[2 * d0 + 1] = *(const __attribute__((address_space(3))) bf16x8*)(Ks + KOFF(32 + r32, d0)); }
#undef KOFF
}
template <bool HAS_PV>
__device__ __forceinline__ void mstage5(f32x16* o, f32x16& p0, f32x16& p1, bf16x8 (&fk)[12], lds_cptr vp, lds_cptr Ks, const bf16x8* qr, const f32x16& negm,
                                        bf16x8 pa0, bf16x8 pa1, bf16x8 pa2, bf16x8 pa3, int r32, int hi) {
  s16x4 vl[8], vh[8];
  if (HAS_PV) {
#pragma unroll
    for (int d0 = 0; d0 < 2; ++d0)
#pragma unroll
      for (int ks = 0; ks < 4; ++ks) { vl[d0 * 4 + ks] = vtr(vp + v_rd_off(d0, ks, 0)); vh[d0 * 4 + ks] = vtr(vp + v_rd_off(d0, ks, 1)); }
    SBAR(); }
  p0 = __builtin_amdgcn_mfma_f32_32x32x16_bf16(fk[0], qr[0], negm, 0, 0, 0); p1 = __builtin_amdgcn_mfma_f32_32x32x16_bf16(fk[1], qr[0], negm, 0, 0, 0);
#pragma unroll
  for (int d0 = 1; d0 < 6; ++d0) { p0 = __builtin_amdgcn_mfma_f32_32x32x16_bf16(fk[2 * d0], qr[d0], p0, 0, 0, 0); p1 = __builtin_amdgcn_mfma_f32_32x32x16_bf16(fk[2 * d0 + 1], qr[d0], p1, 0, 0, 0); }
  if (HAS_PV) {
    SBAR();
#pragma unroll
    for (int d0 = 0; d0 < 2; ++d0) {
      o[d0] = __builtin_amdgcn_mfma_f32_32x32x16_bf16(pa0, VFRAG(vl[d0 * 4 + 0], vh[d0 * 4 + 0]), o[d0], 0, 0, 0); o[d0] = __builtin_amdgcn_mfma_f32_32x32x16_bf16(pa1, VFRAG(vl[d0 * 4 + 1], vh[d0 * 4 + 1]), o[d0], 0, 0, 0);
      o[d0] = __builtin_amdgcn_mfma_f32_32x32x16_bf16(pa2, VFRAG(vl[d0 * 4 + 2], vh[d0 * 4 + 2]), o[d0], 0, 0, 0); o[d0] = __builtin_amdgcn_mfma_f32_32x32x16_bf16(pa3, VFRAG(vl[d0 * 4 + 3], vh[d0 * 4 + 3]), o[d0], 0, 0, 0); }
  }
}
__device__ __forceinline__ void pvlast4(f32x16* o, lds_cptr vp, bf16x8 pa0, bf16x8 pa1, bf16x8 pa2, bf16x8 pa3) {
  s16x4 vl[8], vh[8];
#pragma unroll
  for (int d0 = 0; d0 < 2; ++d0)
#pragma unroll
    for (int ks = 0; ks < 4; ++ks) { vl[d0 * 4 + ks] = vtr(vp + v_rd_off(d0, ks, 0)); vh[d0 * 4 + ks] = vtr(vp + v_rd_off(d0, ks, 1)); }
#pragma unroll
  for (int d0 = 0; d0 < 2; ++d0) {
    o[d0] = __builtin_amdgcn_mfma_f32_32x32x16_bf16(pa0, VFRAG(vl[d0 * 4 + 0], vh[d0 * 4 + 0]), o[d0], 0, 0, 0); o[d0] = __builtin_amdgcn_mfma_f32_32x32x16_bf16(pa1, VFRAG(vl[d0 * 4 + 1], vh[d0 * 4 + 1]), o[d0], 0, 0, 0);
    o[d0] = __builtin_amdgcn_mfma_f32_32x32x16_bf16(pa2, VFRAG(vl[d0 * 4 + 2], vh[d0 * 4 + 2]), o[d0], 0, 0, 0); o[d0] = __builtin_amdgcn_mfma_f32_32x32x16_bf16(pa3, VFRAG(vl[d0 * 4 + 3], vh[d0 * 4 + 3]), o[d0], 0, 0, 0); }
}
constexpr int NSLOT = 4, SLOT_K = SHM_K, SLOT_V = SHM_V;
constexpr int OFF2_K = 0, OFF2_V = NSLOT * SLOT_K, OFF2_WS = OFF2_V + NSLOT * SLOT_V, LDS2_TOTAL = OFF2_WS + NWAVES * 256;
#define MLA_BAR() asm volatile("s_waitcnt lgkmcnt(0)\n\ts_barrier" ::: "memory")

__device__ __forceinline__ void unit(const bf16_t* __restrict__ Qb, const bf16_t* __restrict__ Kh, const bf16_t* __restrict__ Vh, bf16_t* __restrict__ Ob, int seq, char* lds, int wid) {
  const int lane = lane_id(), r32 = lane & 31, hi = lane >> 5;
  const bool hb = wid >= 4;
  char* K_lds = lds + OFF2_K; char* V_lds = lds + OFF2_V;
  float* al_l = (float*)(lds + OFF2_WS) + wid * 64;
  float m_reg = 0.f, l_reg = 0.f; f32x16 o[2] = {}; f32x16 negm = {}; bf16x8 qr[6];
  const bf16_t* Qw = Qb + (long)(wid * QBLK + r32) * LDQ + hi * 8;
#pragma unroll
  for (int d0 = 0; d0 < 6; ++d0) qr[d0] = *reinterpret_cast<const bf16x8*>(Qw + d0 * 16);
  unsigned koA, koB, vo; bool kvA, kvB;
  { const int rA = 8 * wid + (lane >> 4), rB = rA + 4, cp = lane & 15;
    const int cA = cp ^ (rA & 15), cB = cp ^ (rB & 15); kvA = cA < 12; kvB = cB < 12;
    koA = (unsigned)(rA * LDKk * 2 + cA * 16); koB = (unsigned)(rB * LDKk * 2 + cB * 16);
    const int jv = 64 * wid + lane, sub = jv >> 5, within = jv & 31, k = (sub >> 1) * 8 + (within >> 2), c = (sub & 1) * 32 + (within & 3) * 8;
    vo = (unsigned)(k * LDV * 2 + c * 2); }
  const __attribute__((address_space(3))) char* lds3 = (const __attribute__((address_space(3))) char*)(lds_cptr)lds;
#define DMA_TILE(u) do { const char* kt_ = (const char*)(Kh + (long)(u) * KVBLK * LDKk); const char* vt_ = (const char*)(Vh + (long)(u) * KVBLK * LDV); const int sl_ = (u) & 3; \
    if (kvA) __builtin_amdgcn_global_load_lds((const unsigned*)(kt_ + koA), (__attribute__((address_space(3))) unsigned*)(lds3 + OFF2_K + sl_ * SLOT_K + (2 * wid) * 1024), 16, 0, 0); \
    if (kvB) __builtin_amdgcn_global_load_lds((const unsigned*)(kt_ + koB), (__attribute__((address_space(3))) unsigned*)(lds3 + OFF2_K + sl_ * SLOT_K + (2 * wid + 1) * 1024), 16, 0, 0); \
    __builtin_amdgcn_global_load_lds((const unsigned*)(vt_ + vo), (__attribute__((address_space(3))) unsigned*)(lds3 + OFF2_V + sl_ * SLOT_V + wid * 1024), 16, 0, 0); } while (0)
#define DMA_WAIT() asm volatile("s_waitcnt vmcnt(0)" ::: "memory")
  const lds_cptr vp0 = (lds_cptr)V_lds + v_rd_base(lane); const lds_cptr kp0 = (lds_cptr)K_lds;
  f32x16 p0, p1; bf16x8 pa0, pa1, pa2, pa3; const int NT = seq / KVBLK;
  bf16x8 fka[12];
  DMA_WAIT();
  DMA_TILE(0); DMA_TILE(1); DMA_WAIT();
  MLA_BAR();
  if (hb) MLA_BAR();
  DMA_TILE(2);
  mprefetch(fka, kp0, r32, hi);
  mstage5<false>(o, p0, p1, fka, vp0, kp0, qr, negm, pa0, pa1, pa2, pa3, r32, hi);

  MLA_BAR();
  soft4(p0, p1, m_reg, l_reg, negm, o, al_l, true, pa0, pa1, pa2, pa3, r32, hi);
  mprefetch(fka, kp0 + SLOT_K, r32, hi);
  DMA_WAIT();
  MLA_BAR();
#pragma clang loop unroll(disable)
  for (int t = 1; t < NT; ++t) {
    if (t + 2 < NT) DMA_TILE(t + 2);
    SBAR(); mstage5<true>(o, p0, p1, fka, vp0 + ((t - 1) & 3) * SLOT_V, kp0 + (t & 3) * SLOT_K, qr, negm, pa0, pa1, pa2, pa3, r32, hi);

    MLA_BAR();
    soft4(p0, p1, m_reg, l_reg, negm, o, al_l, false, pa0, pa1, pa2, pa3, r32, hi);
    if (t + 1 < NT) mprefetch(fka, kp0 + ((t + 1) & 3) * SLOT_K, r32, hi);
    DMA_WAIT();
    MLA_BAR();
  }
  SBAR(); pvlast4(o, vp0 + ((NT - 1) & 3) * SLOT_V, pa0, pa1, pa2, pa3);
  if (!hb) MLA_BAR();
  MLA_BAR();
  { auto rr = __builtin_amdgcn_permlane32_swap(__float_as_uint(l_reg), __float_as_uint(l_reg), false, false); l_reg = __uint_as_float(rr[0]) + __uint_as_float(rr[1]); }
  if (hi == 0) al_l[r32] = l_reg; asm volatile("s_waitcnt lgkmcnt(0)" ::: "memory");
  float rli[16];
#pragma unroll
  for (int r = 0; r < 16; ++r) rli[r] = __builtin_amdgcn_rcpf(al_l[crow(r, hi)]);
  { bf16_t* stg = (bf16_t*)(lds) + wid * 2048;
#pragma unroll
    for (int r = 0; r < 16; ++r) { const int orow = crow(r, hi);
#pragma unroll
      for (int d0 = 0; d0 < 2; ++d0) stg[orow * 64 + d0 * 32 + r32] = (bf16_t)(cvt_pk_bf16(o[d0][r] * rli[r], 0.f) & 0xffffu); }
    asm volatile("s_waitcnt lgkmcnt(0)" ::: "memory");
    bf16_t* Ow = Ob + (long)(wid * QBLK) * LDO;
#pragma unroll
    for (int i = 0; i < 4; ++i) { const int row = i * 8 + (lane >> 3), ch = lane & 7; const u32x4 v = *(const u32x4*)(stg + row * 64 + ch * 8); *(u32x4*)(Ow + (long)row * LDO + ch * 8) = v; } }
  MLA_BAR();
#undef DMA_TILE
#undef DMA_WAIT
}
#undef KSWZ
#undef SBAR
}

__device__ __forceinline__ void p3_mla(const Frame& F) {
    unsigned char* ws = F.ws;
    const bf16_t* QB = (const bf16_t*)(ws + WS_QB); const bf16_t* KB = (const bf16_t*)(ws + WS_KB); const bf16_t* VB = (const bf16_t*)(ws + WS_VB); bf16_t* OB = (bf16_t*)(ws + WS_OB);
    const int G = F.G;
    if (G == 256) {
        const int x = F.vcu >> 5, c = F.vcu & 31;
        for (int i = 0; i < 4; ++i) {
            const int pair = x * 8 + 2 * i + (c >> 4), qb = c & 15, b = pair >> 3, h = pair & 7;
            const long row0 = (long)b * SEQ;
            mla::unit(QB + (row0 + qb * 256) * 768 + h * 96, KB + row0 * 768 + h * 96, VB + row0 * 512 + h * 64, OB + (row0 + qb * 256) * 512 + h * 64, SEQ, (char*)F.lds, F.wave);
        }
    } else {
        for (int u = F.vcu; u < 1024; u += G) {
            const int pair = u >> 4, qb = u & 15, b = pair >> 3, h = pair & 7; const long row0 = (long)b * SEQ;
            mla::unit(QB + (row0 + qb * 256) * 768 + h * 96, KB + row0 * 768 + h * 96, VB + row0 * 512 + h * 64, OB + (row0 + qb * 256) * 512 + h * 64, SEQ, (char*)F.lds, F.wave);
        }
    }
}

namespace mxa {
#define SBAR() __builtin_amdgcn_sched_barrier(0)
typedef short v4i16_t __attribute__((ext_vector_type(4)));
typedef __attribute__((address_space(3))) const char* lds_cptr;
__device__ __forceinline__ s16x4 vtr(lds_cptr p) { return __builtin_bit_cast(s16x4, __builtin_amdgcn_ds_read_tr16_b64_v4i16((__attribute__((address_space(3))) v4i16_t*)p)); }
__device__ __forceinline__ int crow(int r, int hi) { return (r & 3) + 8 * (r >> 2) + 4 * hi; }
#define KSW2(row, colB) ((row) * 128 + ((colB) ^ ((((row) >> 1) & 7) << 4)))
__device__ __forceinline__ int v_rd_base(int lane) { return ((lane & 3) << 3) | (((lane >> 2) & 3) << 6) | (((lane >> 4) & 1) << 5) | (((lane >> 5) & 1) << 8); }
constexpr int v_rd_off(int d0, int ks, int half) { return d0 * 512 + ks * 2048 + half * 1024; }
constexpr int BUFB = 8192;
#define VFRAG(L, H) (bf16x8){L[0], L[1], L[2], L[3], H[0], H[1], H[2], H[3]}
__device__ __forceinline__ void step(f32x16& o0, f32x16& o1, float& m_reg, float& l_reg, const bf16x8* qr, lds_cptr Kb, lds_cptr Vb, float* al_l, float basef, float sl2, bool first, int r32, int hi) {
  constexpr float THR = 8.f;
  bf16x8 kf[4]; s16x4 vl[4], vh[4];
#pragma unroll
  for (int d0 = 0; d0 < 4; ++d0) kf[d0] = *(const __attribute__((address_space(3))) bf16x8*)(Kb + KSW2(r32, (d0 * 16 + hi * 8) * 2));
#pragma unroll
  for (int d0 = 0; d0 < 2; ++d0)
#pragma unroll
    for (int ks = 0; ks < 2; ++ks) { vl[d0 * 2 + ks] = vtr(Vb + v_rd_off(d0, ks, 0)); vh[d0 * 2 + ks] = vtr(Vb + v_rd_off(d0, ks, 1)); }
  f32x16 p;
  { const float nm = first ? 0.f : -m_reg;
#pragma unroll
    for (int r = 0; r < 16; ++r) p[r] = nm; }
#pragma unroll
  for (int d0 = 0; d0 < 4; ++d0) p = __builtin_amdgcn_mfma_f32_32x32x16_bf16(kf[d0], qr[d0], p, 0, 0, 0);
  const float nsl = -sl2;
  float pmax = -1e30f;
#pragma unroll
  for (int r = 0; r < 16; ++r) {
    const float df = basef - (float)((r & 3) + 8 * (r >> 2)), ad = __builtin_fabsf(df);
    const float sv = fmaf(nsl, ad, p[r]);
    p[r] = (ad <= 64.f) ? sv : -1e30f;
    pmax = fmaxf(pmax, p[r]);
  }
  { auto rr = __builtin_amdgcn_permlane32_swap(__float_as_uint(pmax), __float_as_uint(pmax), false, false);
    pmax = fmaxf(__uint_as_float(rr[0]), __uint_as_float(rr[1])); }
  if (first || !__all(pmax <= THR)) {
    const float dl = first ? pmax : fmaxf(pmax, 0.f);
    m_reg += dl;
#pragma unroll
    for (int r = 0; r < 16; ++r) p[r] -= dl;
    if (!first) { const float alpha = __builtin_amdgcn_exp2f(-dl); l_reg *= alpha;
      if (hi == 0) al_l[r32] = alpha; asm volatile("s_waitcnt lgkmcnt(0)" ::: "memory");
#pragma unroll
      for (int r = 0; r < 16; ++r) { const float a = al_l[crow(r, hi)]; o0[r] *= a; o1[r] *= a; } }
  }
  float ps = 0.f;
#pragma unroll
  for (int r = 0; r < 16; ++r) { p[r] = __builtin_amdgcn_exp2f(p[r]); ps += p[r]; }
  l_reg += ps;
  u32x4 w0 = {cvt_pk_bf16(p[0], p[1]), cvt_pk_bf16(p[2], p[3]), cvt_pk_bf16(p[4], p[5]), cvt_pk_bf16(p[6], p[7])};
  u32x4 w1 = {cvt_pk_bf16(p[8], p[9]), cvt_pk_bf16(p[10], p[11]), cvt_pk_bf16(p[12], p[13]), cvt_pk_bf16(p[14], p[15])};
  const bf16x8 pa0 = __builtin_bit_cast(bf16x8, w0), pa1 = __builtin_bit_cast(bf16x8, w1);
  o0 = __builtin_amdgcn_mfma_f32_32x32x16_bf16(pa0, VFRAG(vl[0], vh[0]), o0, 0, 0, 0); o0 = __builtin_amdgcn_mfma_f32_32x32x16_bf16(pa1, VFRAG(vl[1], vh[1]), o0, 0, 0, 0);
  o1 = __builtin_amdgcn_mfma_f32_32x32x16_bf16(pa0, VFRAG(vl[2], vh[2]), o1, 0, 0, 0); o1 = __builtin_amdgcn_mfma_f32_32x32x16_bf16(pa1, VFRAG(vl[3], vh[3]), o1, 0, 0, 0);
}

__device__ __forceinline__ void task(const bf16_t* __restrict__ QA, const bf16_t* __restrict__ KA, const bf16_t* __restrict__ VA, bf16_t* __restrict__ OP, float* __restrict__ LS,
                                     int b, int h, int n, int rres, int qb, char* wl, float* al) {
  const int lane = lane_id(), r32 = lane & 31, hi = lane >> 5;
  const int dil = (n == 0) ? 1 : (n == 1 ? 4 : 16), L = SEQ / dil, l0 = qb * 64;
  const float sl2 = exp2f(-(float)(h + 1)) * (float)dil * LOG2E;
  const long rowb = (long)b * SEQ;
  const lds_cptr wl3 = (lds_cptr)wl;
  const lds_cptr vrd = wl3 + 4096 + v_rd_base(lane);
  asm volatile("s_waitcnt vmcnt(0)" ::: "memory");
  unsigned ko[4], vo[4];
#pragma unroll
  for (int pc = 0; pc < 4; ++pc) {
    const int kr = 8 * pc + (lane >> 3), c = (lane & 7) ^ ((kr >> 1) & 7);
    ko[pc] = (unsigned)(kr * dil * 1024 + h * 128 + c * 16);
    const int jv = 64 * pc + lane, sub = jv >> 5, within = jv & 31, vk = (sub >> 1) * 8 + (within >> 2), vc = (sub & 1) * 32 + (within & 3) * 8;
    vo[pc] = (unsigned)(vk * dil * 1024 + h * 128 + vc * 2); }
#define MXA_DMA(lk0_, buf_) do { const size_t rb_ = (size_t)(rowb + (long)(lk0_) * dil + rres) * 1024; const char* kb_ = (const char*)KA + rb_; const char* vb_ = (const char*)VA + rb_; \
    _Pragma("unroll") for (int pc = 0; pc < 4; ++pc) { \
      __builtin_amdgcn_global_load_lds((const unsigned*)(kb_ + ko[pc]), (__attribute__((address_space(3))) unsigned*)(wl3 + (buf_) * BUFB + pc * 1024), 16, 0, 0); \
      __builtin_amdgcn_global_load_lds((const unsigned*)(vb_ + vo[pc]), (__attribute__((address_space(3))) unsigned*)(wl3 + (buf_) * BUFB + 4096 + pc * 1024), 16, 0, 0); } } while (0)
  const bool has_behind = (l0 >= 64), has_ahead = (l0 + 64 < L);
  const int nblk = 2 + (has_behind ? 2 : 0) + (has_ahead ? 2 : 0);
  auto blk_at = [&](int i) -> int { if (i < 2) return 2 + i; if (has_behind && has_ahead) return (i == 2) ? 1 : (i == 3 ? 4 : (i == 4 ? 0 : 5)); if (has_behind) return (i == 2) ? 1 : 0; return (i == 2) ? 4 : 5; };
  MXA_DMA(l0, 0);
  bf16x8 q0[4], q1[4];
  { const long ra = rowb + (long)(l0 + r32) * dil + rres, rb2 = rowb + (long)(l0 + 32 + r32) * dil + rres;
#pragma unroll
    for (int d0 = 0; d0 < 4; ++d0) { q0[d0] = *reinterpret_cast<const bf16x8*>(QA + ra * 512 + h * 64 + d0 * 16 + hi * 8); q1[d0] = *reinterpret_cast<const bf16x8*>(QA + rb2 * 512 + h * 64 + d0 * 16 + hi * 8); } }
  asm volatile("s_waitcnt vmcnt(0)" ::: "memory");
  f32x16 oa0 = f32x16{}, oa1 = f32x16{}, ob0 = f32x16{}, ob1 = f32x16{};
  float ma = 0.f, la = 0.f, mb = 0.f, lb = 0.f;
#pragma clang loop unroll(disable)
  for (int i = 0; i < nblk; ++i) {
    const int j = blk_at(i), buf = i & 1;
    if (i + 1 < nblk) { MXA_DMA(l0 - 64 + 32 * blk_at(i + 1), buf ^ 1); }
    if (i > 0) { if (i + 1 < nblk) asm volatile("s_waitcnt vmcnt(8)" ::: "memory"); else asm volatile("s_waitcnt vmcnt(0)" ::: "memory"); }
    const lds_cptr Kb = wl3 + buf * BUFB, Vb = vrd + buf * BUFB;
    const int dk = -64 + 32 * j;
    if (j <= 4) step(oa0, oa1, ma, la, q0, Kb, Vb, al, (float)(r32 - 4 * hi - dk), sl2, i == 0, r32, hi);
    if (j >= 1) step(ob0, ob1, mb, lb, q1, Kb, Vb, al, (float)(32 + r32 - 4 * hi - dk), sl2, i == 0, r32, hi);
    asm volatile("s_waitcnt lgkmcnt(0)" ::: "memory");
  }
#undef MXA_DMA
#pragma unroll
  for (int qs = 0; qs < 2; ++qs) {
    float l_reg = qs ? lb : la; const float m_reg = qs ? mb : ma;
    { auto rr = __builtin_amdgcn_permlane32_swap(__float_as_uint(l_reg), __float_as_uint(l_reg), false, false); l_reg = __uint_as_float(rr[0]) + __uint_as_float(rr[1]); }
    if (hi == 0) { al[r32] = l_reg; const long row = rowb + (long)(l0 + qs * 32 + r32) * dil + rres; LS[row * 8 + h] = m_reg + __builtin_amdgcn_logf(l_reg); }
    asm volatile("s_waitcnt lgkmcnt(0)" ::: "memory");
    bf16_t* stg = (bf16_t*)wl;
#pragma unroll
    for (int r = 0; r < 16; ++r) { const int orow = crow(r, hi); const float rl = __builtin_amdgcn_rcpf(al[orow]);
      stg[orow * 64 + r32] = (bf16_t)(cvt_pk_bf16((qs ? ob0[r] : oa0[r]) * rl, 0.f) & 0xffffu);
      stg[orow * 64 + 32 + r32] = (bf16_t)(cvt_pk_bf16((qs ? ob1[r] : oa1[r]) * rl, 0.f) & 0xffffu); }
    asm volatile("s_waitcnt lgkmcnt(0)" ::: "memory");
#pragma unroll
    for (int i = 0; i < 4; ++i) { const int rw = i * 8 + (lane >> 3), ch = lane & 7; const u32x4 v = *(const u32x4*)(stg + rw * 64 + ch * 8);
      const long row = rowb + (long)(l0 + qs * 32 + rw) * dil + rres; *(u32x4*)(OP + row * 512 + h * 64 + ch * 8) = v; }
    asm volatile("s_waitcnt lgkmcnt(0)" ::: "memory");
  }
}
#undef KSW2
#undef VFRAG
#undef SBAR
}

__device__ __forceinline__ void p3_mixerA(const Frame& F) {
    unsigned char* ws = F.ws;
    const bf16_t* QA = (const bf16_t*)(ws + WS_QA); const bf16_t* KA = (const bf16_t*)(ws + WS_KA); const bf16_t* VA = (const bf16_t*)(ws + WS_VA);
    float* LSE = (float*)(ws + WS_LSE);
    char* wl = (char*)F.lds + F.wave * 16384; float* al = (float*)((char*)F.lds + RING_BYTES + 2048) + F.wave * 64;
    const int x = (F.G == 256) ? (F.vcu >> 5) : 0; const int ngrp = (F.G == 256) ? 8 : 1, per = 64 * 192 / ngrp;
    unsigned* qctr = F.ctl + CW_Q + 64 * x;
    for (;;) {
        unsigned ti = 0; if (lane_id() == 0) ti = atomicAdd(qctr, 1u);
        ti = (unsigned)__builtin_amdgcn_readfirstlane((int)ti);
        if (ti >= (unsigned)per) break;
        const int t = x * per + (int)ti;
        const int pair = t / 192, tt = t % 192, n = tt >> 6, idx = tt & 63;
        const int rres = (n == 0) ? 0 : (n == 1 ? (idx >> 4) : (idx >> 2)), qb = (n == 0) ? idx : (n == 1 ? (idx & 15) : (idx & 3));
        bf16_t* OP = (bf16_t*)(ws + (n == 2 ? WS_OAP2 : WS_OAP0)) + (n == 1 ? (size_t)T * 512 : 0);
        mxa::task(QA, KA, VA, OP, LSE + (size_t)n * ((size_t)T * 8), pair >> 3, pair & 7, n, rres, qb, wl, al);
    }
}
static_assert(WS_OAP1 - WS_OAP0 == (size_t)T * 512 * 2, "OAP0|OAP1 contiguous");

__device__ __forceinline__ void p35_mix(const Frame& F, const Args& a) {
    unsigned char* ws = F.ws; const int lane = lane_id();
    const bf16_t* OB = (const bf16_t*)(ws + WS_OB); const float* LSE = (const float*)(ws + WS_LSE); bf16_t* MIXED = (bf16_t*)(ws + WS_MIXED);
    const bf16_t* OAPn[3] = {(const bf16_t*)(ws + WS_OAP0), (const bf16_t*)(ws + WS_OAP1), (const bf16_t*)(ws + WS_OAP2)};
    const float* g_a = a.in[8]; const float* g_b = a.in[9];
    const int gw = F.vcu * NWAVES + F.wave, NGW = F.G * NWAVES;
    const int h = lane >> 3;
    const f32x4 ga0 = *(const f32x4*)(g_a + lane * 8), ga1 = *(const f32x4*)(g_a + lane * 8 + 4), gb0 = *(const f32x4*)(g_b + lane * 8), gb1 = *(const f32x4*)(g_b + lane * 8 + 4);
    for (int row = gw; row < T; row += NGW) {
        float ls[3]; u32x4 ov[3];
#pragma unroll
        for (int n = 0; n < 3; ++n) { ls[n] = LSE[((size_t)n * T + row) * 8 + h]; ov[n] = *(const u32x4*)(OAPn[n] + (size_t)row * 512 + lane * 8); }
        const u32x4 bv = *(const u32x4*)(OB + (size_t)row * 512 + lane * 8);
        const float mx = fmaxf(ls[0], fmaxf(ls[1], ls[2]));
        float w[3]; float wsum = 0.f;
#pragma unroll
        for (int n = 0; n < 3; ++n) { w[n] = __builtin_amdgcn_exp2f(ls[n] - mx); wsum += w[n]; }
        const float inv = 1.f / wsum;
        float oa[8] = {0.f, 0.f, 0.f, 0.f, 0.f, 0.f, 0.f, 0.f};
#pragma unroll
        for (int n = 0; n < 3; ++n) { const float wn = w[n] * inv;
#pragma unroll
            for (int j = 0; j < 4; ++j) { oa[2 * j] += wn * bf16lo(ov[n][j]); oa[2 * j + 1] += wn * bf16hi(ov[n][j]); } }
        float obv[8];
#pragma unroll
        for (int j = 0; j < 4; ++j) { obv[2 * j] = bf16lo(bv[j]); obv[2 * j + 1] = bf16hi(bv[j]); }
        float sa = 0.f, sb = 0.f;
#pragma unroll
        for (int j = 0; j < 8; ++j) { sa += oa[j] * oa[j]; sb += obv[j] * obv[j]; }
        sa = wsum64(sa); sb = wsum64(sb);
        const float ra = 1.0f / sqrtf(sa * (1.f / 512.f) + EPS), rb = 1.0f / sqrtf(sb * (1.f / 512.f) + EPS);
        u32x4 wa, wb;
        wa.x = cvt_pk_bf16(oa[0] * ra * ga0[0], oa[1] * ra * ga0[1]); wa.y = cvt_pk_bf16(oa[2] * ra * ga0[2], oa[3] * ra * ga0[3]);
        wa.z = cvt_pk_bf16(oa[4] * ra * ga1[0], oa[5] * ra * ga1[1]); wa.w = cvt_pk_bf16(oa[6] * ra * ga1[2], oa[7] * ra * ga1[3]);
        wb.x = cvt_pk_bf16(obv[0] * rb * gb0[0], obv[1] * rb * gb0[1]); wb.y = cvt_pk_bf16(obv[2] * rb * gb0[2], obv[3] * rb * gb0[3]);
        wb.z = cvt_pk_bf16(obv[4] * rb * gb1[0], obv[5] * rb * gb1[1]); wb.w = cvt_pk_bf16(obv[6] * rb * gb1[2], obv[7] * rb * gb1[3]);
        *(u32x4*)(MIXED + (size_t)row * 1024 + lane * 8) = wa;
        *(u32x4*)(MIXED + (size_t)row * 1024 + 512 + lane * 8) = wb;
    }
}

constexpr size_t WS_WRT = 4 * MiB + 512 * 1024;
constexpr size_t WS_RS = 137 * MiB;
constexpr size_t WS_GS = 141 * MiB;
constexpr size_t WS_H2B = 384 * MiB;
constexpr size_t WS_D = 448 * MiB;
constexpr int MOE_TAB = MISC_OFF + 256;
constexpr int NBUCK = 112;
constexpr int CW_BCNT = 32768;
constexpr size_t WS_HID2 = 353 * MiB;
constexpr size_t WS_Y2 = 209 * MiB;
constexpr size_t WS_DST = 280 * MiB;

__device__ __forceinline__ void p0_router_table(const Frame& F, const Args& a) {
    const float* w_r1 = a.in[12]; const float* w_r2 = a.in[14]; const float* g_ffn = a.in[11]; bf16_t* WRH = (bf16_t*)(F.ws + WS_WRT); bf16_t* WRL = WRH + 48 * 1024;
    const int gw = F.vcu * NWAVES + F.wave, NGW = F.G * NWAVES, lane = lane_id();
    for (int idx = gw * 64 + lane; idx < 48 * 1024; idx += NGW * 64) {
        const int o = idx >> 10, k = idx & 1023;
        float w = 0.f;
        if (o < 4) w = w_r1[k * 4 + o]; else if (o < 36) w = w_r2[((size_t)((o - 4) >> 3) * 1024 + k) * 8 + ((o - 4) & 7)];
        w *= g_ffn[k];
        const unsigned hi = cvt_pk_bf16(w, 0.f) & 0xffffu; const float rem = w - __uint_as_float(hi << 16);
        WRH[idx] = (bf16_t)hi; WRL[idx] = (bf16_t)(cvt_pk_bf16(rem, 0.f) & 0xffffu);
    }
}

__device__ __forceinline__ void p4_wo(const Frame& F, const Args& a) {
    unsigned char* ws = F.ws;
    pg::DenseSched S{(const char*)(ws + WS_MIXED), (const char*)(ws + WS_WO), 1024, 1024, T / 256, 4, F.G, (int)blockIdx.x};
    EpiStoreBf16 E{(bf16_t*)(ws + WS_D), 1024};
    pg::gemm_phase(F.lds, S, E, 1024, F.wave);
}

__device__ __forceinline__ void p5_router(const Frame& F, const Args& a) {
    unsigned char* ws = F.ws; const int lane = lane_id(), wid = F.wave;
    const float* X = a.in[0]; const bf16_t* Dm = (const bf16_t*)(ws + WS_D); const float* g_ffn = a.in[11]; const float* b_r1 = a.in[13]; const float* b_r2 = a.in[15];
    const bf16_t* WRH = (const bf16_t*)(ws + WS_WRT); const bf16_t* WRL = WRH + 48 * 1024; bf16_t* MU = (bf16_t*)(ws + WS_M);
    int* LIST = (int*)(ws + WS_LIST); float* RS = (float*)(ws + WS_RS); float* GS = (float*)(ws + WS_GS); int* TOK = (int*)(ws + WS_TOKINFO);
    unsigned* cnt = F.ctl + CW_CNT;
    LAS int* LG = (LAS int*)(F.lds);
    LAS int* SSQ_ = (LAS int*)(F.lds + 26 * 1024);
    LAS unsigned* hist = (LAS unsigned*)(F.lds + 27 * 1024);
    LAS unsigned* gbase = hist + 160;
    int* DST = (int*)(ws + WS_DST); unsigned* bcnt = F.ctl + CW_BCNT;
    const int tr = lane & 15, kg = lane >> 4, tid = wid * 64 + lane;
    const int kw = 128 * wid;
    for (int chunk = F.vcu; chunk < T / 128; chunk += F.G) {
        const int base = chunk * 128;
        for (int i = tid; i < 128 * 49 + 128; i += 512) { if (i < 128 * 49) LG[i] = 0; else SSQ_[i - 128 * 49] = 0; }
        if (tid < 32 + NBUCK) hist[tid] = 0u;
        __syncthreads();
        bf16x8 bh[4][3], bl[4][3];
#pragma unroll
        for (int ks = 0; ks < 4; ++ks)
#pragma unroll
            for (int nb = 0; nb < 3; ++nb) { const size_t wo = (size_t)(nb * 16 + tr) * 1024 + kw + ks * 32 + 8 * kg; bh[ks][nb] = *(const bf16x8*)(WRH + wo); bl[ks][nb] = *(const bf16x8*)(WRL + wo); }
#pragma unroll 2
        for (int mb = 0; mb < 8; ++mb) {
            const size_t ro = (size_t)(base + 16 * mb + tr) * 1024 + kw + 8 * kg;
            f32x4 acc0 = {0.f, 0.f, 0.f, 0.f}, acc1 = acc0, acc2 = acc0; float ss = 0.f;
#pragma unroll
            for (int ks = 0; ks < 4; ++ks) {
                f32x4 v0 = *(const f32x4*)(X + ro + ks * 32), v1 = *(const f32x4*)(X + ro + ks * 32 + 4);
                { const u32x4 dd = *(const u32x4*)(Dm + ro + ks * 32);
                  v0[0] += bf16lo(dd.x); v0[1] += bf16hi(dd.x); v0[2] += bf16lo(dd.y); v0[3] += bf16hi(dd.y); v1[0] += bf16lo(dd.z); v1[1] += bf16hi(dd.z); v1[2] += bf16lo(dd.w); v1[3] += bf16hi(dd.w); }
                ss += (v0[0] * v0[0] + v0[1] * v0[1]) + (v0[2] * v0[2] + v0[3] * v0[3]) + (v1[0] * v1[0] + v1[1] * v1[1]) + (v1[2] * v1[2] + v1[3] * v1[3]);
                u32x4 hi; hi.x = cvt_pk_bf16(v0[0], v0[1]); hi.y = cvt_pk_bf16(v0[2], v0[3]); hi.z = cvt_pk_bf16(v1[0], v1[1]); hi.w = cvt_pk_bf16(v1[2], v1[3]);
                u32x4 lo; lo.x = cvt_pk_bf16(v0[0] - bf16lo(hi.x), v0[1] - bf16hi(hi.x)); lo.y = cvt_pk_bf16(v0[2] - bf16lo(hi.y), v0[3] - bf16hi(hi.y));
                lo.z = cvt_pk_bf16(v1[0] - bf16lo(hi.z), v1[1] - bf16hi(hi.z)); lo.w = cvt_pk_bf16(v1[2] - bf16lo(hi.w), v1[3] - bf16hi(hi.w));
                *(u32x4*)(MU + ro + ks * 32) = hi;
                const bf16x8 ah = __builtin_bit_cast(bf16x8, hi), al = __builtin_bit_cast(bf16x8, lo);
                acc0 = __builtin_amdgcn_mfma_f32_16x16x32_bf16(ah, bh[ks][0], acc0, 0, 0, 0); acc0 = __builtin_amdgcn_mfma_f32_16x16x32_bf16(al, bh[ks][0], acc0, 0, 0, 0); acc0 = __builtin_amdgcn_mfma_f32_16x16x32_bf16(ah, bl[ks][0], acc0, 0, 0, 0);
                acc1 = __builtin_amdgcn_mfma_f32_16x16x32_bf16(ah, bh[ks][1], acc1, 0, 0, 0); acc1 = __builtin_amdgcn_mfma_f32_16x16x32_bf16(al, bh[ks][1], acc1, 0, 0, 0); acc1 = __builtin_amdgcn_mfma_f32_16x16x32_bf16(ah, bl[ks][1], acc1, 0, 0, 0);
                acc2 = __builtin_amdgcn_mfma_f32_16x16x32_bf16(ah, bh[ks][2], acc2, 0, 0, 0); acc2 = __builtin_amdgcn_mfma_f32_16x16x32_bf16(al, bh[ks][2], acc2, 0, 0, 0); acc2 = __builtin_amdgcn_mfma_f32_16x16x32_bf16(ah, bl[ks][2], acc2, 0, 0, 0);
            }
            ss += __shfl_xor(ss, 16); ss += __shfl_xor(ss, 32);
            if (kg == 0) atomicAdd((int*)(SSQ_ + 16 * mb + tr), __float2int_rn(ss * 16384.0f));
#pragma unroll
            for (int r = 0; r < 4; ++r) { const int tk = 16 * mb + 4 * kg + r;
                atomicAdd((int*)(LG + tk * 49 + tr), __float2int_rn(acc0[r] * 1048576.0f)); atomicAdd((int*)(LG + tk * 49 + 16 + tr), __float2int_rn(acc1[r] * 1048576.0f)); if (tr < 4) atomicAdd((int*)(LG + tk * 49 + 32 + tr), __float2int_rn(acc2[r] * 1048576.0f)); }
        }
        __syncthreads();
        int ea = 0, eb = 0, bk = 0, hfa = 0; unsigned la = 0u, lb = 0u, lk = 0u; float w0 = 0.f, w1 = 0.f, rstd = 0.f;
        if (tid < 128) {
            rstd = 1.0f / sqrtf((float)SSQ_[tid] * (1.f / 16384.f) * (1.f / 1024.f) + EPS);
            const LAS int* lg = LG + tid * 49; const float rq = rstd * (1.f / 1048576.f);
            const float l0 = (float)lg[0] * rq + b_r1[0], l1 = (float)lg[1] * rq + b_r1[1], l2 = (float)lg[2] * rq + b_r1[2], l3 = (float)lg[3] * rq + b_r1[3];
            int gi = 0; float gm = l0; if (l1 > gm) { gm = l1; gi = 1; } if (l2 > gm) { gm = l2; gi = 2; } if (l3 > gm) { gm = l3; gi = 3; }
            const float gs = __expf(l0 - gm) + __expf(l1 - gm) + __expf(l2 - gm) + __expf(l3 - gm);
            const float g_val = 1.0f / gs;
            float lv[8];
#pragma unroll
            for (int e = 0; e < 8; ++e) lv[e] = (float)lg[4 + 8 * gi + e] * rq + b_r2[8 * gi + e];
            int e0 = 0; float m0 = lv[0];
#pragma unroll
            for (int e = 1; e < 8; ++e) if (lv[e] > m0) { m0 = lv[e]; e0 = e; }
            int e1 = -1; float m1 = -3.0e38f;
#pragma unroll
            for (int e = 0; e < 8; ++e) if (e != e0 && lv[e] > m1) { m1 = lv[e]; e1 = e; }
            const float x1 = __expf(m1 - m0);
            w0 = g_val / (1.0f + x1); w1 = g_val * x1 / (1.0f + x1);
            ea = gi * 8 + e0; eb = gi * 8 + e1;
            la = atomicAdd((unsigned*)(hist + ea), 1u); lb = atomicAdd((unsigned*)(hist + eb), 1u);
            { const int lo = e0 < e1 ? e0 : e1, hi = e0 < e1 ? e1 : e0; bk = gi * 28 + (lo * 7 - ((lo * (lo - 1)) >> 1) + (hi - lo - 1)); hfa = e0 < e1 ? 0 : 1; }
            lk = atomicAdd((unsigned*)(hist + 32 + bk), 1u);
        }
        __syncthreads();
        if (tid < 32 + NBUCK) { const unsigned c = hist[tid]; gbase[tid] = c ? atomicAdd(tid < 32 ? cnt + 64 * tid : bcnt + 64 * (tid - 32), c) : 0u; }
        __syncthreads();
        if (tid < 128) {
            const int tok = base + tid; const int ra = (int)(gbase[ea] + la), rb = (int)(gbase[eb] + lb);
            LIST[(size_t)ea * T + ra] = tok; RS[(size_t)ea * T + ra] = rstd; GS[(size_t)ea * T + ra] = w0;
            LIST[(size_t)eb * T + rb] = tok; RS[(size_t)eb * T + rb] = rstd; GS[(size_t)eb * T + rb] = w1;
            const int rk2 = (int)(gbase[32 + bk] + lk);
            DST[(size_t)ea * T + ra] = (bk << 17) | (rk2 << 1) | hfa; DST[(size_t)eb * T + rb] = (bk << 17) | (rk2 << 1) | (hfa ^ 1);
            TOK[tok * 2 + 0] = bk; TOK[tok * 2 + 1] = rk2;
        }
        __syncthreads();
    }
}

__device__ __forceinline__ void moe_build_tables(const Frame& F) {
    LAS int* tab = (LAS int*)(F.lds + MOE_TAB);
    const int tid = F.wave * 64 + lane_id();
    if (tid < 32 + NBUCK) tab[512 + tid] = (int)__hip_atomic_load(tid < 32 ? F.ctl + CW_CNT + 64 * tid : F.ctl + CW_BCNT + 64 * (tid - 32), __ATOMIC_RELAXED, __HIP_MEMORY_SCOPE_AGENT);
    __syncthreads();
    if (tid <= 32) { int off = 0, cp = 0;
        for (int j = 0; j < tid; ++j) { const int nch = (tab[512 + j] + 255) >> 8; off += nch * 256; cp += nch; }
        tab[tid] = off; tab[80 + tid] = cp; if (tid < 32) tab[40 + tid] = tab[512 + tid]; }
    else if (tid >= 64 && tid <= 64 + NBUCK) { const int b = tid - 64; int o = 0, p = 0;
        for (int j = 0; j < b; ++j) { const int c = tab[512 + 32 + j]; o += c; p += (c + 255) >> 8; }
        tab[128 + b] = o; tab[384 + b] = p; if (b < NBUCK) tab[256 + b] = tab[512 + 32 + b]; }
    __syncthreads();
}
struct MoeSched1 {
    static constexpr bool GATHER = true; static constexpr int KSPLIT = 0;
    const char* A; const char* Bt; const int* LIST; LAS const int* tab; int G, c;
    __device__ __forceinline__ int a_ld() const { return 1024; }
    __device__ __forceinline__ const char* abase() const { return A; }
    __device__ __forceinline__ bool next(int i, pg::Unit& u) const {
        const int nun = tab[80 + 32] * 2; const long L = (long)i * G + c; if (L >= nun) return false;
        const int ci = (int)L >> 1; u.pn = (int)L & 1;
        int e = 0;
#pragma unroll 1
        for (int k = 1; k < 32; ++k) if (tab[80 + k] <= ci) e = k;
        u.aux = e; u.pm = ci - tab[80 + e]; return true;
    }
    __device__ __forceinline__ void addr(const pg::Unit&, const char*&, const char*&) const {}
    __device__ __forceinline__ void addr_g(const pg::Unit& u, const int (&R)[2], const int (&C)[2], unsigned (&aoff)[2][2], const char*& bbase) const {
        const int e = u.aux, cn = tab[40 + e];
#pragma unroll
        for (int h = 0; h < 2; ++h)
#pragma unroll
            for (int i = 0; i < 2; ++i) { const int rk = u.pm * 256 + h * 128 + R[i]; const int tok = (rk < cn) ? LIST[(size_t)e * T + rk] : 0; aoff[h][i] = (unsigned)((tok * 1024 + C[i]) * 2); }
        bbase = Bt + ((size_t)e * 512 + (size_t)u.pn * 256) * 1024 * 2;
    }
};
struct EpiMoe1 {
    bf16_t* HID2; const float* RS; const float* GS; const int* DST; LAS const int* tab;
    __device__ __forceinline__ void operator()(const f32x4 (&acc)[2][2][4][2], const pg::Unit& u, int wr, int wc, int fr, int fq, LAS unsigned char* stage, int wid) const {
        const int e = u.aux, cn = tab[40 + e];
        float rsv[2][4], gsv[2][4]; int dsv[2][4];
#pragma unroll
        for (int ai = 0; ai < 2; ++ai)
#pragma unroll
            for (int m = 0; m < 4; ++m) { const int rk = u.pm * 256 + ai * 128 + wr * 64 + m * 16 + fr; const bool ok = rk < cn; const size_t o = (size_t)e * T + rk;
                rsv[ai][m] = ok ? RS[o] : 0.f; gsv[ai][m] = ok ? GS[o] : 0.f; dsv[ai][m] = ok ? DST[o] : -1; }
#pragma unroll
        for (int ai = 0; ai < 2; ++ai)
#pragma unroll
            for (int m = 0; m < 4; ++m) { const int d = dsv[ai][m];
                if (d >= 0) { const float rs = rsv[ai][m], gt = gsv[ai][m]; float hv[8];
                    const int row2 = tab[128 + (d >> 17)] + ((d >> 1) & 0xffff), half = d & 1;
#pragma unroll
                    for (int n = 0; n < 2; ++n)
#pragma unroll
                        for (int j = 0; j < 4; ++j) { const float gg = acc[ai][0][m][n][j] * rs, uu = acc[ai][1][m][n][j] * (rs * gt); hv[4 * n + j] = gg / (1.0f + __expf(-gg)) * uu; }
                    u32x4 w; w.x = cvt_pk_bf16(hv[0], hv[1]); w.y = cvt_pk_bf16(hv[2], hv[3]); w.z = cvt_pk_bf16(hv[4], hv[5]); w.w = cvt_pk_bf16(hv[6], hv[7]);
                    *(u32x4*)(HID2 + (size_t)row2 * 512 + half * 256 + u.pn * 128 + wc * 32 + 8 * fq) = w; } }
    }
};
struct MoeSched2 {
    static constexpr bool GATHER = false; static constexpr int KSPLIT = 4;
    const char* A; const char* Bt; LAS const int* tab; int G, c;
    __device__ __forceinline__ int a_ld() const { return 512; }
    __device__ __forceinline__ const char* abase() const { return A; }
    __device__ __forceinline__ bool next(int i, pg::Unit& u) const {
        const int nun = tab[384 + NBUCK] * 4; const long L = (long)i * G + c; if (L >= nun) return false;
        const int ci = (int)L >> 2; u.pn = (int)L & 3;
        const int l = lane_id();
        const unsigned long long m0 = __builtin_amdgcn_ballot_w64(tab[384 + l] <= ci), m1 = __builtin_amdgcn_ballot_w64(l + 64 < NBUCK && tab[384 + 64 + l] <= ci);
        const int b = __builtin_popcountll(m0) + __builtin_popcountll(m1) - 1;
        u.aux = b; u.pm = ci - tab[384 + b]; return true;
    }
    __device__ __forceinline__ void addr(const pg::Unit& u, const char*& abase_, const char*& bbase, const char*& bbase2) const {
        const int b = u.aux, g = b / 28, p = b % 28;
        int lo = 0, rem = p;
#pragma unroll 1
        while (rem >= 7 - lo) { rem -= 7 - lo; ++lo; }
        const int hi = lo + 1 + rem;
        abase_ = A + (size_t)(tab[128 + b] + u.pm * 256) * 512 * 2;
        bbase = Bt + ((size_t)(g * 8 + lo) * 1024 + (size_t)u.pn * 256) * 256 * 2;
        bbase2 = Bt + ((size_t)(g * 8 + hi) * 1024 + (size_t)u.pn * 256) * 256 * 2; }
    __device__ __forceinline__ void addr_g(const pg::Unit&, const int (&)[2], const int (&)[2], unsigned (&)[2][2], const char*&) const {}
};
struct EpiMoe2 {
    bf16_t* Y2; LAS const int* tab;
    __device__ __forceinline__ void operator()(const f32x4 (&acc)[2][2][4][2], const pg::Unit& u, int wr, int wc, int fr, int fq, LAS unsigned char* stage, int wid) const {
        const int b = u.aux, lane = fr + 16 * fq, rk0 = u.pm * 256;
        bf16_t* const tile = Y2 + (size_t)(tab[128 + b] + rk0) * 1024 + u.pn * 256; const int nvalid = tab[256 + b] - rk0;
#pragma unroll
        for (int ai = 0; ai < 2; ++ai)
#pragma unroll
            for (int m = 0; m < 4; ++m) { u32x4 w[2];
#pragma unroll
                for (int bj = 0; bj < 2; ++bj) { const f32x4 v0 = acc[ai][bj][m][0], v1 = acc[ai][bj][m][1];
                    w[bj].x = cvt_pk_bf16(v0[0], v0[1]); w[bj].y = cvt_pk_bf16(v0[2], v0[3]); w[bj].z = cvt_pk_bf16(v1[0], v1[1]); w[bj].w = cvt_pk_bf16(v1[2], v1[3]); }
                pg::staged_rows(stage, w[0], w[1], ai, m, wid, lane, [tile, nvalid](int trow, int ch, u32x4 v) { if (trow < nvalid) __builtin_nontemporal_store(v, (u32x4*)(tile + (size_t)trow * 1024 + ch * 8)); }); }
    }
};
__device__ __forceinline__ void p6a_moe_up(const Frame& F) {
    unsigned char* ws = F.ws; moe_build_tables(F);
    LAS const int* tab = (LAS const int*)(F.lds + MOE_TAB);
    MoeSched1 S{(const char*)(ws + WS_M), (const char*)(ws + WS_WGU), (const int*)(ws + WS_LIST), tab, F.G, F.vcu};
    EpiMoe1 E{(bf16_t*)(ws + WS_HID2), (const float*)(ws + WS_RS), (const float*)(ws + WS_GS), (const int*)(ws + WS_DST), tab};
    pg::gemm_phase(F.lds, S, E, 1024, F.wave);
}
__device__ __forceinline__ void p6b_moe_down(const Frame& F) {
    unsigned char* ws = F.ws; moe_build_tables(F);
    LAS const int* tab = (LAS const int*)(F.lds + MOE_TAB);
    MoeSched2 S{(const char*)(ws + WS_HID2), (const char*)(ws + WS_WD), tab, F.G, F.vcu};
    EpiMoe2 E{(bf16_t*)(ws + WS_Y2), tab};
    pg::gemm_phase(F.lds, S, E, 512, F.wave);
}
__device__ __forceinline__ void p7_combine(const Frame& F, const Args& a) {
    unsigned char* ws = F.ws; const int lane = lane_id();
    bf16_t* H2B = (bf16_t*)(ws + WS_H2B); const bf16_t* MU = (const bf16_t*)(ws + WS_M); const bf16_t* Y2 = (const bf16_t*)(ws + WS_Y2); const int* TOK = (const int*)(ws + WS_TOKINFO); float* RS2 = (float*)(ws + WS_RS2);
    moe_build_tables(F);
    LAS const int* tab = (LAS const int*)(F.lds + MOE_TAB);
    const int gw = F.vcu * NWAVES + F.wave, NGW = F.G * NWAVES;
    for (int row0 = gw * 2; row0 < T; row0 += NGW * 2) {
        f32x4 v[2][4]; float s[2] = {0.f, 0.f};
#pragma unroll
        for (int rr = 0; rr < 2; ++rr) { const int row = row0 + rr;
            const size_t sa = (size_t)(tab[128 + TOK[row * 2]] + TOK[row * 2 + 1]);
#pragma unroll
            for (int j = 0; j < 4; ++j) {
                const u32x2 ya = __builtin_nontemporal_load((const u32x2*)(Y2 + sa * 1024) + lane + 64 * j), hh = ((const u32x2*)(MU + (size_t)row * 1024))[lane + 64 * j];
                v[rr][j].x = bf16lo(hh.x) + bf16lo(ya.x); v[rr][j].y = bf16hi(hh.x) + bf16hi(ya.x); v[rr][j].z = bf16lo(hh.y) + bf16lo(ya.y); v[rr][j].w = bf16hi(hh.y) + bf16hi(ya.y);
                s[rr] += (v[rr][j].x * v[rr][j].x + v[rr][j].y * v[rr][j].y) + (v[rr][j].z * v[rr][j].z + v[rr][j].w * v[rr][j].w); } }
#pragma unroll
        for (int rr = 0; rr < 2; ++rr) { const int row = row0 + rr;
            const float rstd = 1.0f / sqrtf(wsum64(s[rr]) * (1.f / 1024.f) + EPS);
            if (lane == 0) RS2[row] = rstd;
#pragma unroll
            for (int j = 0; j < 4; ++j) { u32x2 hw; hw.x = cvt_pk_bf16(v[rr][j].x, v[rr][j].y); hw.y = cvt_pk_bf16(v[rr][j].z, v[rr][j].w); ((u32x2*)(H2B + (size_t)row * 1024))[lane + 64 * j] = hw; } }
    }
}
struct EpiPle {
    bf16_t* G; const bf16_t* PP; const float* RS2;
    __device__ __forceinline__ void operator()(const f32x4 (&acc)[2][2][4][2], const pg::Unit& u, int wr, int wc, int fr, int fq, LAS unsigned char* stage, int wid) const {
        float rs[2][4];
#pragma unroll
        for (int ai = 0; ai < 2; ++ai)
#pragma unroll
            for (int m = 0; m < 4; ++m) rs[ai][m] = -RS2[u.pm * 256 + ai * 128 + wr * 64 + m * 16 + fr];
#pragma unroll
        for (int ai = 0; ai < 2; ++ai) {
            u32x4 pp[4][2];
#pragma unroll
            for (int m = 0; m < 4; ++m) { const int row = u.pm * 256 + ai * 128 + wr * 64 + m * 16 + fr;
#pragma unroll
                for (int bj = 0; bj < 2; ++bj) pp[m][bj] = *(const u32x4*)(PP + (size_t)row * 1024 + u.pn * 256 + bj * 128 + wc * 32 + 8 * fq); }
#pragma unroll
            for (int m = 0; m < 4; ++m) { const int row = u.pm * 256 + ai * 128 + wr * 64 + m * 16 + fr; const float nr = rs[ai][m];
#pragma unroll
                for (int bj = 0; bj < 2; ++bj) { const size_t off = (size_t)row * 1024 + u.pn * 256 + bj * 128 + wc * 32 + 8 * fq;
                    const u32x4 p4 = pp[m][bj];
                    const f32x4 a0 = acc[ai][bj][m][0] * nr, a1 = acc[ai][bj][m][1] * nr; u32x4 w;
                    w.x = cvt_pk_bf16(bf16lo(p4.x) / (1.0f + __expf(a0[0])), bf16hi(p4.x) / (1.0f + __expf(a0[1])));
                    w.y = cvt_pk_bf16(bf16lo(p4.y) / (1.0f + __expf(a0[2])), bf16hi(p4.y) / (1.0f + __expf(a0[3])));
                    w.z = cvt_pk_bf16(bf16lo(p4.z) / (1.0f + __expf(a1[0])), bf16hi(p4.z) / (1.0f + __expf(a1[1])));
                    w.w = cvt_pk_bf16(bf16lo(p4.w) / (1.0f + __expf(a1[2])), bf16hi(p4.w) / (1.0f + __expf(a1[3])));
                    *(u32x4*)(G + off) = w; } }
            asm volatile("" ::: "memory");
        }
    }
};
__device__ __forceinline__ void p8_ple(const Frame& F, const Args& a) {
    unsigned char* ws = F.ws;
    pg::DenseSched S{(const char*)(ws + WS_H2B), (const char*)(ws + WS_WPG), 1024, 1024, T / 256, 4, F.G, (int)blockIdx.x};
    EpiPle E{(bf16_t*)(ws + WS_D), (const bf16_t*)(ws + WS_PP), (const float*)(ws + WS_RS2)};
    pg::gemm_phase(F.lds, S, E, 1024, F.wave);
}
__device__ __forceinline__ void p9_final(const Frame& F, const Args& a) {
    const int lane = lane_id(); float* H = a.out; const float* gf = a.in[22]; const bf16_t* Gm = (const bf16_t*)(F.ws + WS_D); const bf16_t* H2B = (const bf16_t*)(F.ws + WS_H2B);
    const int gw = F.vcu * NWAVES + F.wave, NGW = F.G * NWAVES;
    f32x4 g[4];
#pragma unroll
    for (int j = 0; j < 4; ++j) g[j] = ((const f32x4*)gf)[lane + 64 * j];
    for (int row = gw; row < T; row += NGW) {
        f32x4 v[4]; float s = 0.f;
#pragma unroll
        for (int j = 0; j < 4; ++j) { const u32x2 hh = ((const u32x2*)(H2B + (size_t)row * 1024))[lane + 64 * j], gg = ((const u32x2*)(Gm + (size_t)row * 1024))[lane + 64 * j];
            v[j].x = bf16lo(hh.x) + bf16lo(gg.x); v[j].y = bf16hi(hh.x) + bf16hi(gg.x); v[j].z = bf16lo(hh.y) + bf16lo(gg.y); v[j].w = bf16hi(hh.y) + bf16hi(gg.y);
            s += (v[j].x * v[j].x + v[j].y * v[j].y) + (v[j].z * v[j].z + v[j].w * v[j].w); }
        const float rstd = 1.0f / sqrtf(wsum64(s) * (1.f / 1024.f) + EPS);
#pragma unroll
        for (int j = 0; j < 4; ++j) ((f32x4*)(H + (size_t)row * 1024))[lane + 64 * j] = v[j] * rstd * g[j];
    }
}

__global__ void __launch_bounds__(512, 2) mega(Args args) {
    extern __shared__ __attribute__((aligned(16))) unsigned char lds_raw[];
    Frame F;
    F.lds = (LAS unsigned char*)lds_raw;
    F.wave = __builtin_amdgcn_readfirstlane(threadIdx.x >> 6);
    F.G = gridDim.x; { const int bx = blockIdx.x; F.vcu = (F.G % 8 == 0) ? (bx % 8) * (F.G / 8) + bx / 8 : bx; }
    F.ws = args.ws; F.ctl = (unsigned*)(args.ws + WS_CTL);
    volatile LAS unsigned* MISC = (volatile LAS unsigned*)(F.lds + MISC_OFF);
    for (int u = threadIdx.x; u < (LDS_BYTES - LDSCTL_OFF) / 4; u += NWAVES * 64) ((LAS unsigned*)(F.lds + LDSCTL_OFF))[u] = 0u;
    __syncthreads();
    XcdBarrier bar = xcd_barrier_post(F.ctl + CW_BAR + args.li * XCD_BAR_WORDS, MISC + 8);
    const int lo = args.ph_lo, hi = args.ph_hi;
#define IN(k) (lo <= (k) && (k) < hi)
#define BOTH(k) (IN(k) && IN((k) + 1))
    if (IN(0)) { p0_prologue(F, args); p0_router_table(F, args); if (BOTH(0)) xcd_barrier(bar); }
    if (IN(1)) { p1_inproj(F); if (BOTH(1)) xcd_barrier(bar); }
    if (IN(2)) { p2_upproj(F); if (BOTH(2)) xcd_barrier(bar); }
    if (IN(3)) { p3_mla(F); p3_mixerA(F); if (BOTH(3)) xcd_barrier(bar); }
    if (IN(4)) { p35_mix(F, args); if (BOTH(4)) xcd_barrier(bar); }
    if (IN(5)) { p4_wo(F, args); if (BOTH(5)) xcd_barrier(bar); }
    if (IN(6)) { p5_router(F, args); if (BOTH(6)) xcd_barrier(bar); }
    if (IN(7)) { p6a_moe_up(F); if (BOTH(7)) xcd_barrier(bar); }
    if (IN(8)) { p6b_moe_down(F); if (BOTH(8)) xcd_barrier(bar); }
    if (IN(9)) { p7_combine(F, args); if (BOTH(9)) xcd_barrier(bar); }
    if (IN(10)) { p8_ple(F, args); if (BOTH(10)) xcd_barrier(bar); }
    if (IN(11)) { p9_final(F, args); }
#undef IN
#undef BOTH
}
constexpr int NPHASES = 12;

extern "C" void kernel_launch(void* const* d_in, const int* in_sizes, int n_in, void* d_out, int out_size, void* d_ws, size_t ws_size, hipStream_t stream) {
    static int grid = 0;
    if (grid == 0) {
        if (n_in != 23 || ws_size < (size_t)512 * MiB || out_size != T * DM) { fprintf(stderr, "kernel_launch: unexpected n_in %d / ws_size %zu / out_size %d\n", n_in, ws_size, out_size); grid = -1; return; }
        int dev = 0, cus = 0;
        if (hipGetDevice(&dev) != hipSuccess || hipDeviceGetAttribute(&cus, hipDeviceAttributeMultiprocessorCount, dev) != hipSuccess) { grid = -1; return; }
        if (hipFuncSetAttribute((const void*)mega, hipFuncAttributeMaxDynamicSharedMemorySize, LDS_BYTES) != hipSuccess) { fprintf(stderr, "kernel_launch: hipFuncSetAttribute failed\n"); grid = -1; return; }
        int per_cu = 0;
        if (hipOccupancyMaxActiveBlocksPerMultiprocessor(&per_cu, (const void*)mega, NWAVES * 64, LDS_BYTES) != hipSuccess || per_cu < 1) { fprintf(stderr, "kernel_launch: occupancy query says %d\n", per_cu); }
        (void)hipGetLastError();
        grid = cus;
    }
    if (grid < 0) return;
    unsigned char* ws = (unsigned char*)d_ws;
    hipMemsetAsync(ws + WS_CTL, 0, CTL_ZERO_BYTES, stream);
    Args a{};
    for (int i = 0; i < 23; ++i) a.in[i] = (const float*)d_in[i];
    a.out = (float*)d_out; a.ws = ws; a.ph_lo = 0; a.ph_hi = NPHASES; a.li = 0; a.pad = 0;
    hipLaunchKernelGGL(mega, dim3(grid), dim3(NWAVES * 64), LDS_BYTES, stream, a);
}
```

```cpp
#include <hip/hip_runtime.h>
#include <cstdint>
#include <cstdio>
#include <cmath>

#define LAS __attribute__((address_space(3)))
#define GAS __attribute__((address_space(1)))
typedef unsigned short bf16_t;
typedef short bf16x8 __attribute__((ext_vector_type(8)));
typedef short s16x4 __attribute__((ext_vector_type(4)));
typedef float f32x2 __attribute__((ext_vector_type(2)));
typedef float f32x4 __attribute__((ext_vector_type(4)));
typedef float f32x16 __attribute__((ext_vector_type(16)));
typedef unsigned u32x2 __attribute__((ext_vector_type(2)));
typedef unsigned u32x4 __attribute__((ext_vector_type(4)));

__device__ __forceinline__ unsigned cvt_pk_bf16(float lo, float hi) { unsigned r; asm volatile("v_cvt_pk_bf16_f32 %0, %1, %2" : "=v"(r) : "v"(lo), "v"(hi)); return r; }
__device__ __forceinline__ float bf16lo(unsigned w) { return __uint_as_float(w << 16); }
__device__ __forceinline__ float bf16hi(unsigned w) { return __uint_as_float(w & 0xffff0000u); }
__device__ __forceinline__ int lane_id() { int r; asm volatile("v_mbcnt_lo_u32_b32 %0, -1, 0\n\tv_mbcnt_hi_u32_b32 %0, -1, %0" : "=v"(r)); return r; }
__device__ __forceinline__ float wsum64(float v) {
#pragma unroll
    for (int o = 1; o < 64; o <<= 1) v += __shfl_xor(v, o);
    return v;
}

namespace pg {
constexpr int BM = 256, BK = 64, HALF = 128, HTB = HALF * BK * 2, STAGE_BYTES = 8 * HTB, NXCD = 8, WGM = 8;
__host__ __device__ __forceinline__ int lds_byte(int r, int c) { const int st = (r >> 4) * 2 + (c >> 5), rr = r & 15, cc = c & 31, ob = rr * 64 + cc * 2; return st * 1024 + (ob ^ (((ob >> 9) & 1) << 5)); }
__host__ __device__ __forceinline__ void stage_rc(int b, int& R, int& C) { const int st = b / 1024, sb = b % 1024, swz = sb ^ (((sb >> 9) & 1) << 5); R = (st >> 1) * 16 + swz / 64; C = (st & 1) * 32 + (swz % 64) / 2; }
__host__ __device__ __forceinline__ int perm32(int rho) { const int n = rho >> 4, i = rho & 15; return 8 * (i >> 2) + 4 * n + (i & 3); }

struct Unit { int pm, pn, aux; };

__device__ __forceinline__ bool static_unit(int nM, int nN, int G, int c, int i, int& pm, int& pn) {
    const int nwg = nM * nN; const long L = (long)i * G + c; if (L >= nwg) return false;
    int wgid = (int)L; { const int q = nwg / NXCD, r = nwg % NXCD, xcd = wgid % NXCD, off = wgid / NXCD; wgid = (xcd < r ? xcd * (q + 1) : r * (q + 1) + (xcd - r) * q) + off; }
    const int nig = WGM * nN, gid = wgid / nig, fm = gid * WGM, gsz = (nM - fm) < WGM ? (nM - fm) : WGM;
    pm = fm + ((wgid % nig) % gsz); pn = (wgid % nig) / gsz; return true;
}

struct DenseSched {
    static constexpr bool GATHER = false; static constexpr int KSPLIT = 0;
    const char* A; const char* Bt; int lda, K, nM, nN, G, c;
    __device__ __forceinline__ bool next(int i, Unit& u) const { u.aux = 0; return static_unit(nM, nN, G, c, i, u.pm, u.pn); }
    __device__ __forceinline__ int a_ld() const { return lda; }
    __device__ __forceinline__ void addr(const Unit& u, const char*& abase, const char*& bbase) const {
        abase = A + (size_t)u.pm * BM * lda * 2; bbase = Bt + (size_t)u.pn * BM * K * 2; }
    __device__ __forceinline__ void addr_g(const Unit&, const int (&)[2], const int (&)[2], unsigned (&)[2][2], const char*&) const {}
    __device__ __forceinline__ const char* abase() const { return A; }
};

constexpr int EPI_STAGE_OFF = 139264, EPI_ROWB = 528;
template <class StoreFn>
__device__ __forceinline__ void staged_rows(LAS unsigned char* stage, u32x4 w0, u32x4 w1, int ai, int m, int wid, int lane, const StoreFn& store) {
    const int wr = wid >> 2, wc = wid & 3, fr = lane & 15, fq = lane >> 4, rr = 16 * wr + fr;
    *(LAS u32x4*)(stage + rr * EPI_ROWB + (32 * wc + 8 * fq) * 2) = w0;
    *(LAS u32x4*)(stage + rr * EPI_ROWB + (128 + 32 * wc + 8 * fq) * 2) = w1;
    asm volatile("s_waitcnt lgkmcnt(0)\n\ts_barrier" ::: "memory");
#pragma unroll
    for (int i = 0; i < 2; ++i) { const int r2 = 4 * wid + 2 * i + (lane >> 5), ch = lane & 31;
        const u32x4 v = *(const LAS u32x4*)(stage + r2 * EPI_ROWB + ch * 16);
        store(128 * ai + 64 * (r2 >> 4) + 16 * m + (r2 & 15), ch, v); }
    asm volatile("s_waitcnt lgkmcnt(0)\n\ts_barrier" ::: "memory");
}

template <class Epi, class Sched>
__device__ __forceinline__ void gemm_phase(LAS unsigned char* lds, const Sched& S, const Epi& E, int K, int wid) {
    const int lane = lane_id(), tid = wid * 64 + lane, wr = wid >> 2, wc = wid & 3, fr = lane & 15, fq = lane >> 4;
    const int nt = K / BK;
    constexpr int KSPLIT = Sched::KSPLIT;
    const int KB = KSPLIT > 0 ? KSPLIT * BK : K;
    int Rr[2], Cc[2]; unsigned voffB[2];
#pragma unroll
    for (int i = 0; i < 2; ++i) { int R, C; stage_rc(tid * 16 + i * 8192, R, C); Rr[i] = R; Cc[i] = C; const int Rb = (R & ~31) + perm32(R & 31); voffB[i] = (unsigned)(Rb * KB + C) * 2u; }
    const size_t kstep = (size_t)(BK * 2);
    const size_t hstepB = (size_t)HALF * KB * 2;
    const unsigned ldsw = (unsigned)wid * 1024u;
    const int aoff = lds_byte(wr * 64 + fr, fq * 8), boff = lds_byte(wc * 32 + fr, fq * 8);
    const char* const Ab = S.abase();
    constexpr bool GATHER = Sched::GATHER;
    unsigned voffA[2];
#pragma unroll
    for (int i = 0; i < 2; ++i) voffA[i] = (unsigned)(Rr[i] * S.a_ld() + Cc[i]) * 2u;
    const size_t hstepA = (size_t)HALF * S.a_ld() * 2;
#define PG_SA(b, h) (((b) * 2 + (h)) * HTB)
#define PG_SB(b, h) ((4 + (b) * 2 + (h)) * HTB)
#define PG_STAGEB(bufoff, gbase) do { _Pragma("unroll") for (int _i = 0; _i < 2; ++_i) \
        __builtin_amdgcn_global_load_lds((const unsigned*)((const char*)(gbase) + voffB[_i]), (LAS unsigned*)(lds + (bufoff) + ldsw + _i * 8192), 16, 0, 0); } while (0)
#define PG_STAGEA(bufoff, uptr, offs, h, kb) do { _Pragma("unroll") for (int _i = 0; _i < 2; ++_i) { \
        const char* _src; if constexpr (GATHER) _src = Ab + (size_t)(offs)[h][_i] + (kb); else _src = (uptr) + (h) * hstepA + (kb) + voffA[_i]; \
        __builtin_amdgcn_global_load_lds((const unsigned*)_src, (LAS unsigned*)(lds + (bufoff) + ldsw + _i * 8192), 16, 0, 0); } } while (0)
#define PG_LDA(dst, b, h) do { _Pragma("unroll") for (int m = 0; m < 4; ++m) _Pragma("unroll") for (int k = 0; k < 2; ++k) dst[m][k] = *(const LAS bf16x8*)(lds + PG_SA(b, h) + aoff + m * 2048 + k * 1024); } while (0)
#define PG_LDB(dst, b, h) do { _Pragma("unroll") for (int n = 0; n < 2; ++n) _Pragma("unroll") for (int k = 0; k < 2; ++k) dst[n][k] = *(const LAS bf16x8*)(lds + PG_SB(b, h) + boff + n * 2048 + k * 1024); } while (0)
#define PG_MMA(ai, bj, At, Bt_) do { __builtin_amdgcn_s_setprio(1); _Pragma("unroll") for (int m = 0; m < 4; ++m) _Pragma("unroll") for (int n = 0; n < 2; ++n) _Pragma("unroll") for (int k = 0; k < 2; ++k) \
        acc[ai][bj][m][n] = __builtin_amdgcn_mfma_f32_16x16x32_bf16(Bt_[n][k], At[m][k], acc[ai][bj][m][n], 0, 0, 0); __builtin_amdgcn_s_setprio(0); } while (0)
#define PG_WAIT_V(n) asm volatile("s_waitcnt vmcnt(" #n ")" ::: "memory")
#define PG_WAIT_L(n) asm volatile("s_waitcnt lgkmcnt(" #n ")" ::: "memory")
#define PG_BAR __builtin_amdgcn_s_barrier()
#define PG_SCHED __builtin_amdgcn_sched_barrier(0)
    Unit cur, nxt; int ui = 0;
    if (!S.next(0, cur)) return;
    f32x4 acc[2][2][4][2];
#pragma unroll
    for (int a = 0; a < 2; ++a)
#pragma unroll
        for (int b = 0; b < 2; ++b)
#pragma unroll
            for (int m = 0; m < 4; ++m)
#pragma unroll
                for (int n = 0; n < 2; ++n) acc[a][b][m][n] = (f32x4){0.f, 0.f, 0.f, 0.f};
    bf16x8 At[4][2], B0[2][2], B1[2][2];
    unsigned cao[2][2], nao[2][2]; const char* cA = nullptr; const char* nA = nullptr; const char* cB; const char* nB; const char* cB2 = nullptr; const char* nB2 = nullptr;
    if constexpr (GATHER) S.addr_g(cur, Rr, Cc, cao, cB); else if constexpr (KSPLIT > 0) S.addr(cur, cA, cB, cB2); else S.addr(cur, cA, cB);
    PG_STAGEB(PG_SB(0, 0), cB); PG_STAGEB(PG_SB(0, 1), cB + hstepB); PG_STAGEA(PG_SA(0, 0), cA, cao, 0, 0); PG_STAGEA(PG_SA(0, 1), cA, cao, 1, 0);
    if (wr == 1) PG_BAR;
    PG_WAIT_V(2); PG_BAR;
    PG_STAGEB(PG_SB(1, 0), cB + kstep); PG_STAGEA(PG_SA(1, 0), cA, cao, 0, kstep); PG_STAGEB(PG_SB(1, 1), cB + hstepB + kstep);
    PG_WAIT_V(6); PG_BAR;
    for (;;) {
        const bool has_next = S.next(ui + 1, nxt);
        if (has_next) { if constexpr (GATHER) S.addr_g(nxt, Rr, Cc, nao, nB); else if constexpr (KSPLIT > 0) S.addr(nxt, nA, nB, nB2); else S.addr(nxt, nA, nB); }
        else { nB = cB; nA = cA; nB2 = cB2;
            if constexpr (GATHER) {
#pragma unroll
                for (int h = 0; h < 2; ++h)
#pragma unroll
                    for (int i = 0; i < 2; ++i) nao[h][i] = cao[h][i]; } }
#pragma clang loop unroll(disable)
        for (int t = 0; t < nt; t += 2) {
            const bool last = (t == nt - 2);
            const size_t k1 = (size_t)(t + 1) * kstep;
            const size_t k2 = last ? 0 : (size_t)(t + 2) * kstep, k3 = k2 + kstep;
            const char* b2;
            if constexpr (KSPLIT > 0) b2 = last ? nB : ((t + 2 >= KSPLIT) ? cB2 + (size_t)(t + 2 - KSPLIT) * kstep : cB + (size_t)(t + 2) * kstep);
            else b2 = last ? nB : cB + (size_t)(t + 2) * kstep;
            const char* b3 = b2 + kstep;
            unsigned a2o[2][2]; const char* a2 = last ? nA : cA;
            if constexpr (GATHER) {
#pragma unroll
                for (int h = 0; h < 2; ++h)
#pragma unroll
                    for (int i = 0; i < 2; ++i) a2o[h][i] = last ? nao[h][i] : cao[h][i]; }
            PG_LDB(B0, 0, 0); PG_LDB(B1, 0, 1); PG_SCHED; PG_LDA(At, 0, 0); PG_STAGEA(PG_SA(1, 1), cA, cao, 1, k1);
            PG_WAIT_V(8); PG_WAIT_L(0); PG_BAR; PG_MMA(0, 0, At, B0); PG_MMA(0, 1, At, B1); PG_BAR; PG_SCHED;
            PG_LDA(At, 0, 1); PG_STAGEB(PG_SB(0, 0), b2); PG_STAGEB(PG_SB(0, 1), b2 + hstepB); PG_STAGEA(PG_SA(0, 0), a2, a2o, 0, k2);
            PG_WAIT_V(8); PG_WAIT_L(0); PG_BAR; PG_MMA(1, 0, At, B0); PG_MMA(1, 1, At, B1); PG_BAR; PG_SCHED;
            PG_LDB(B0, 1, 0); PG_LDB(B1, 1, 1); PG_SCHED; PG_LDA(At, 1, 0); PG_STAGEA(PG_SA(0, 1), a2, a2o, 1, k2);
            PG_WAIT_V(8); PG_WAIT_L(0); PG_BAR; PG_MMA(0, 0, At, B0); PG_MMA(0, 1, At, B1); PG_BAR; PG_SCHED;
            PG_LDA(At, 1, 1); PG_STAGEB(PG_SB(1, 0), b3); PG_STAGEB(PG_SB(1, 1), b3 + hstepB); PG_STAGEA(PG_SA(1, 0), a2, a2o, 0, k3);
            PG_WAIT_V(8); PG_WAIT_L(0); PG_BAR; PG_MMA(1, 0, At, B0); PG_MMA(1, 1, At, B1); PG_BAR; PG_SCHED;
        }
        if (wr == 0) PG_BAR;
        { const int l2 = lane_id();
          E(acc, cur, wr, wc, l2 & 15, l2 >> 4, lds + EPI_STAGE_OFF, wid); }
        if (!has_next) break;
#pragma unroll
        for (int a = 0; a < 2; ++a)
#pragma unroll
            for (int b = 0; b < 2; ++b)
#pragma unroll
                for (int m = 0; m < 4; ++m)
#pragma unroll
                    for (int n = 0; n < 2; ++n) acc[a][b][m][n] = (f32x4){0.f, 0.f, 0.f, 0.f};
        cur = nxt; cB = nB; cA = nA; cB2 = nB2;
        if constexpr (GATHER) {
#pragma unroll
            for (int h = 0; h < 2; ++h)
#pragma unroll
                for (int i = 0; i < 2; ++i) cao[h][i] = nao[h][i]; }
        ++ui;
        if (wr == 1) PG_BAR;
    }
    PG_WAIT_V(0);
    PG_BAR;
#undef PG_SA
#undef PG_SB
#undef PG_STAGEA
#undef PG_STAGEB
#undef PG_LDA
#undef PG_LDB
#undef PG_MMA
#undef PG_WAIT_V
#undef PG_WAIT_L
#undef PG_BAR
#undef PG_SCHED
}
}

#define XB_TMO      128
#define XB_XCNT(j)  (256  + 64 * (j))
#define XB_XSUB(j)  (1280 + 64 * (j))
#define XB_XGEN(j)  (2304 + 64 * (j))
#define XB_TOP      3328
#define XB_TOPGEN   3392
#define XCD_BAR_WORDS 3456
#define XB_SPIN_CAP (1u << 22)
__device__ __forceinline__ unsigned xb_ld(unsigned* p)              { return __hip_atomic_load(p, __ATOMIC_RELAXED, __HIP_MEMORY_SCOPE_AGENT); }
__device__ __forceinline__ unsigned xb_add(unsigned* p, unsigned v) { return __hip_atomic_fetch_add(p, v, __ATOMIC_RELAXED, __HIP_MEMORY_SCOPE_AGENT); }
__device__ __forceinline__ unsigned xb_xcc_id() { return (unsigned)__builtin_amdgcn_s_getreg((3 << 11) | 20) & 0xFu; }
#define XB_SPIN(cond, bar) do { unsigned _sp = 0; while (cond) { __builtin_amdgcn_s_sleep(1); \
    if ((++_sp & 255u) == 0u) { if (xb_ld(&(bar)[XB_TMO])) break; if (_sp > XB_SPIN_CAP) { atomicAdd(&(bar)[XB_TMO], 1u); break; } } } } while (0)
struct XcdBarrier { unsigned* bar; unsigned x; volatile LAS unsigned* st; };
__device__ __forceinline__ XcdBarrier xcd_barrier_post(unsigned* bar, volatile LAS unsigned* st) {
    XcdBarrier b; b.bar = bar; b.x = xb_xcc_id(); b.st = st;
    if (threadIdx.x == 0) (void)xb_add(&bar[XB_XCNT(b.x)], 1u);
    return b;
}
__device__ __forceinline__ void xcd_barrier_complete(unsigned* bar, unsigned x, unsigned& nloc, unsigned& nx) {
    const unsigned G = gridDim.x * gridDim.y * gridDim.z;
    unsigned sum, cnt, mine, sp = 0u;
    for (;;) {
        sum = 0u; cnt = 0u; mine = 0u;
#pragma unroll
        for (unsigned j = 0; j < 16; ++j) { const unsigned c = xb_ld(&bar[XB_XCNT(j)]); sum += c; cnt += (c > 0u) ? 1u : 0u; mine = (j == x) ? c : mine; }
        if (sum == G) break;
        __builtin_amdgcn_s_sleep(1);
        if ((++sp & 255u) == 0u) { if (xb_ld(&bar[XB_TMO])) break; if (sp > XB_SPIN_CAP) { atomicAdd(&bar[XB_TMO], 1u); break; } }
    }
    nloc = mine > 0u ? mine : 1u; nx = cnt > 0u ? cnt : 1u;
}
__device__ __forceinline__ void xcd_barrier(const XcdBarrier& b) {
    asm volatile("s_waitcnt vmcnt(0)" ::: "memory");
    __syncthreads();
    if (threadIdx.x == 0) {
        unsigned* bar = b.bar;
        __builtin_amdgcn_s_waitcnt(0);
        unsigned nloc = b.st[0], nx = b.st[1];
        if (nloc == 0u) { xcd_barrier_complete(bar, b.x, nloc, nx); b.st[0] = nloc; b.st[1] = nx; }
        const unsigned old = xb_add(&bar[XB_XSUB(b.x)], 1u);
        const unsigned gen = old / nloc;
        if (old + 1u == (gen + 1u) * nloc) {
            __builtin_amdgcn_fence(__ATOMIC_RELEASE, "agent");
            asm volatile("s_waitcnt vmcnt(0)" ::: "memory");
            const unsigned og = xb_add(&bar[XB_TOP], 1u);
            const unsigned tg = og / nx;
            if (og + 1u == (tg + 1u) * nx) xb_add(&bar[XB_TOPGEN], 1u);
            else XB_SPIN(xb_ld(&bar[XB_TOPGEN]) == tg, bar);
            __builtin_amdgcn_fence(__ATOMIC_ACQUIRE, "agent");
            xb_add(&bar[XB_XGEN(b.x)], 1u);
            asm volatile("s_waitcnt vmcnt(0)" ::: "memory");
        } else {
            XB_SPIN(xb_ld(&bar[XB_XGEN(b.x)]) == gen, bar);
            __builtin_amdgcn_fence(__ATOMIC_ACQUIRE, "agent");
            asm volatile("s_waitcnt vmcnt(0)" ::: "memory");
        }
    }
    __syncthreads();
}

constexpr int NB = 8, SEQ = 4096, T = NB * SEQ, DM = 1024;
constexpr int INW = 2208, INWP = 2304;
constexpr int QLORA = 384, KVLORA = 256;
constexpr float EPS = 1e-6f;
constexpr float LOG2E = 1.4426950408889634f;
constexpr float QA_SCALE = 0.125f * LOG2E;
constexpr float MLA_QSCALE = 0.10206207261596577f * LOG2E;
constexpr int NWAVES = 8;

constexpr size_t MiB = 1u << 20;
constexpr size_t WS_CTL = 0, CTL_ZERO_BYTES = 1 * MiB;
constexpr size_t WS_ROPE = 1 * MiB;
constexpr size_t WS_SSQ = 2 * MiB;
constexpr size_t WS_WIN = 5 * MiB, WS_WUQ = 10 * MiB, WS_WUKV = 11 * MiB, WS_WO = 12 * MiB, WS_WPG = 14 * MiB, WS_WPP = 16 * MiB, WS_WGU = 17 * MiB, WS_WD = 49 * MiB;
constexpr size_t WS_XN = 65 * MiB;
constexpr size_t WS_P16 = 129 * MiB;
constexpr size_t WS_PP = 145 * MiB;
constexpr size_t WS_QA = 209 * MiB, WS_KA = 241 * MiB, WS_VA = 273 * MiB;
static_assert(WS_KA - WS_QA == (size_t)T * 512 * 2 && WS_VA - WS_KA == (size_t)T * 512 * 2, "QA|KA|VA contiguous");
constexpr size_t WS_CQKV = 305 * MiB;
constexpr size_t WS_QB = 345 * MiB, WS_KB = 393 * MiB;
constexpr size_t WS_VB = 441 * MiB;
constexpr size_t WS_OB = 473 * MiB;
constexpr size_t WS_OAP0 = 65 * MiB, WS_OAP1 = 97 * MiB, WS_OAP2 = 305 * MiB;
constexpr size_t WS_LSE = 129 * MiB;
constexpr size_t WS_MIXED = 209 * MiB;
constexpr size_t WS_M = 65 * MiB;
constexpr size_t WS_Y = 209 * MiB;
constexpr size_t WS_HID = 353 * MiB;
constexpr size_t WS_LIST = 132 * MiB;
constexpr size_t WS_RS2 = 136 * MiB + 896 * 1024;
constexpr size_t WS_TOKINFO = 136 * MiB;
constexpr int CW_BAR = 4096, CW_CNT = 16384, CW_Q = 20480;

constexpr int RING_BYTES = 131072;
constexpr int LDSCTL_OFF = RING_BYTES, MISC_OFF = LDSCTL_OFF + 320;
constexpr int LDS_BYTES = 163840;

struct Args { const float* in[23]; float* out; unsigned char* ws; int ph_lo, ph_hi, li, pad; };
struct Frame {
    LAS unsigned char* lds;
    int wave, vcu, G;
    unsigned char* ws; unsigned* ctl;
};

__device__ __forceinline__ void p0_transpose_item(const float* __restrict__ W, int ldw, int k0, int n0, bf16_t* WT, int ldd, int drow0, const float* __restrict__ gain, LAS float* scr, int lane) {
    const int kq = lane >> 3, n4 = (lane & 7) * 4;
    f32x4 v[8];
#pragma unroll
    for (int i = 0; i < 8; ++i) v[i] = *(const f32x4*)(W + (size_t)(k0 + kq + 8 * i) * ldw + n0 + n4);
#pragma unroll
    for (int i = 0; i < 8; ++i) { const int kk = kq + 8 * i; f32x4 x = v[i]; if (gain) x = x * gain[k0 + kk];
        scr[kk * 33 + n4] = x[0]; scr[kk * 33 + n4 + 1] = x[1]; scr[kk * 33 + n4 + 2] = x[2]; scr[kk * 33 + n4 + 3] = x[3]; }
    asm volatile("s_waitcnt lgkmcnt(0)" ::: "memory");
    const int c = lane & 7;
#pragma unroll
    for (int j = 0; j < 4; ++j) { const int n = (lane >> 3) + 8 * j; const LAS float* s = scr + (8 * c) * 33 + n;
        u32x4 o; o.x = cvt_pk_bf16(s[0 * 33], s[1 * 33]); o.y = cvt_pk_bf16(s[2 * 33], s[3 * 33]); o.z = cvt_pk_bf16(s[4 * 33], s[5 * 33]); o.w = cvt_pk_bf16(s[6 * 33], s[7 * 33]);
        *(u32x4*)(WT + (size_t)(drow0 + n) * ldd + k0 + 8 * c) = o; }
    asm volatile("s_waitcnt lgkmcnt(0)" ::: "memory");
}
__device__ __forceinline__ void rms_row_to_bf16(const float* xrow, const float* __restrict__ g, bf16_t* orow, int lane) {
    const f32x4* xr = (const f32x4*)xrow + lane; const f32x4* gr = (const f32x4*)g + lane;
    f32x4 v[4]; float s = 0.f;
#pragma unroll
    for (int j = 0; j < 4; ++j) { v[j] = xr[64 * j]; s += (v[j].x * v[j].x + v[j].y * v[j].y) + (v[j].z * v[j].z + v[j].w * v[j].w); }
    const float rstd = 1.0f / sqrtf(wsum64(s) * (1.f / 1024.f) + EPS);
    u32x2* o8 = (u32x2*)orow + lane;
#pragma unroll
    for (int j = 0; j < 4; ++j) { const f32x4 gg = gr[64 * j]; u32x2 w; w.x = cvt_pk_bf16(v[j].x * rstd * gg.x, v[j].y * rstd * gg.y); w.y = cvt_pk_bf16(v[j].z * rstd * gg.z, v[j].w * rstd * gg.w); o8[64 * j] = w; }
}

__device__ __forceinline__ void p0_prologue(const Frame& F, const Args& a) {
    LAS float* scr = (LAS float*)(F.lds + F.wave * 16384);
    const int gw = F.vcu * NWAVES + F.wave, NGW = F.G * NWAVES, lane = lane_id();
    unsigned char* ws = F.ws;
    const float* w_in = a.in[3]; const float* g_cq = a.in[4]; const float* w_uq = a.in[5]; const float* g_ckv = a.in[6]; const float* w_ukv = a.in[7];
    const float* w_o = a.in[10]; const float* w_eg = a.in[16]; const float* w_eu = a.in[17]; const float* w_ed = a.in[18]; const float* w_pg = a.in[20]; const float* w_pp = a.in[21];
    constexpr int I_IN = 16 * 69, I_UQ = 6 * 24, I_UKV = 4 * 32, I_O = 16 * 32, I_PG = 16 * 32, I_PP = 4 * 32, I_EG = 32 * 16 * 8, I_EU = I_EG, I_ED = 32 * 4 * 32;
    constexpr int NITEMS = I_IN + I_UQ + I_UKV + I_O + I_PG + I_PP + I_EG + I_EU + I_ED;
    for (int it = gw; it < NITEMS; it += NGW) {
        int r = it;
        if (r < I_IN) { const int kb = r / 69, nb = r % 69; p0_transpose_item(w_in, INW, 64 * kb, 32 * nb, (bf16_t*)(ws + WS_WIN), 1024, 32 * nb, nullptr, scr, lane); continue; } r -= I_IN;
        if (r < I_UQ) { const int kb = r / 24, nb = r % 24; p0_transpose_item(w_uq, 768, 64 * kb, 32 * nb, (bf16_t*)(ws + WS_WUQ), QLORA, 32 * nb, g_cq, scr, lane); continue; } r -= I_UQ;
        if (r < I_UKV) { const int kb = r / 32, nb = r % 32; p0_transpose_item(w_ukv, 1024, 64 * kb, 32 * nb, (bf16_t*)(ws + WS_WUKV), KVLORA, 32 * nb, g_ckv, scr, lane); continue; } r -= I_UKV;
        if (r < I_O) { const int kb = r / 32, nb = r % 32; p0_transpose_item(w_o, 1024, 64 * kb, 32 * nb, (bf16_t*)(ws + WS_WO), 1024, 32 * nb, nullptr, scr, lane); continue; } r -= I_O;
        if (r < I_PG) { const int kb = r / 32, nb = r % 32; p0_transpose_item(w_pg, 1024, 64 * kb, 32 * nb, (bf16_t*)(ws + WS_WPG), 1024, 32 * nb, a.in[19], scr, lane); continue; } r -= I_PG;
        if (r < I_PP) { const int kb = r / 32, nb = r % 32; p0_transpose_item(w_pp, 1024, 64 * kb, 32 * nb, (bf16_t*)(ws + WS_WPP), 256, 32 * nb, nullptr, scr, lane); continue; } r -= I_PP;
        if (r < I_EG + I_EU) {
            const int up = r >= I_EG; if (up) r -= I_EG;
            const int e = r / 128, q = r % 128, kb = q / 8, nb = q % 8, n0 = 32 * nb;
            const int drow = (n0 >> 7) * 256 + (up ? 128 : 0) + (n0 & 127);
            p0_transpose_item((up ? w_eu : w_eg) + (size_t)e * 1024 * 256, 256, 64 * kb, n0, (bf16_t*)(ws + WS_WGU) + (size_t)e * 512 * 1024, 1024, drow, a.in[11], scr, lane); continue; }
        r -= I_EG + I_EU;
        { const int e = r / 128, q = r % 128, kb = q / 32, nb = q % 32;
          p0_transpose_item(w_ed + (size_t)e * 256 * 1024, 1024, 64 * kb, 32 * nb, (bf16_t*)(ws + WS_WD) + (size_t)e * 1024 * 256, 256, 32 * nb, nullptr, scr, lane); }
    }
    for (int i = gw * 64 + lane; i < 96 * 128; i += NGW * 64) ((u32x4*)((bf16_t*)(ws + WS_WIN) + (size_t)INW * 1024))[i] = (u32x4){0u, 0u, 0u, 0u};
    { const float* x = a.in[0]; const float* g_mix = a.in[2]; bf16_t* XN = (bf16_t*)(ws + WS_XN);
      f32x4 gg[4];
#pragma unroll
      for (int j = 0; j < 4; ++j) gg[j] = ((const f32x4*)g_mix)[lane + 64 * j];
      for (int m = gw * 2; m < T; m += NGW * 2) {
          f32x4 v0[4], v1[4]; float s0 = 0.f, s1 = 0.f;
#pragma unroll
          for (int j = 0; j < 4; ++j) { v0[j] = ((const f32x4*)(x + (size_t)m * DM))[lane + 64 * j]; v1[j] = ((const f32x4*)(x + (size_t)(m + 1) * DM))[lane + 64 * j]; }
#pragma unroll
          for (int j = 0; j < 4; ++j) { s0 += (v0[j].x * v0[j].x + v0[j].y * v0[j].y) + (v0[j].z * v0[j].z + v0[j].w * v0[j].w); s1 += (v1[j].x * v1[j].x + v1[j].y * v1[j].y) + (v1[j].z * v1[j].z + v1[j].w * v1[j].w); }
          const float r0 = 1.0f / sqrtf(wsum64(s0) * (1.f / 1024.f) + EPS), r1 = 1.0f / sqrtf(wsum64(s1) * (1.f / 1024.f) + EPS);
#pragma unroll
          for (int j = 0; j < 4; ++j) { u32x2 w0, w1;
              w0.x = cvt_pk_bf16(v0[j].x * r0 * gg[j].x, v0[j].y * r0 * gg[j].y); w0.y = cvt_pk_bf16(v0[j].z * r0 * gg[j].z, v0[j].w * r0 * gg[j].w);
              w1.x = cvt_pk_bf16(v1[j].x * r1 * gg[j].x, v1[j].y * r1 * gg[j].y); w1.y = cvt_pk_bf16(v1[j].z * r1 * gg[j].z, v1[j].w * r1 * gg[j].w);
              ((u32x2*)(XN + (size_t)m * DM))[lane + 64 * j] = w0; ((u32x2*)(XN + (size_t)(m + 1) * DM))[lane + 64 * j] = w1; } } }
    { const float* p = a.in[1]; bf16_t* P16 = (bf16_t*)(ws + WS_P16);
      for (size_t i = (size_t)gw * 64 + lane; i < (size_t)T * 256 / 8; i += (size_t)NGW * 64) {
          const f32x4 v0 = ((const f32x4*)p)[2 * i], v1 = ((const f32x4*)p)[2 * i + 1];
          u32x4 o; o.x = cvt_pk_bf16(v0.x, v0.y); o.y = cvt_pk_bf16(v0.z, v0.w); o.z = cvt_pk_bf16(v1.x, v1.y); o.w = cvt_pk_bf16(v1.z, v1.w);
          ((u32x4*)P16)[i] = o; } }
    { float* cs = (float*)(ws + WS_ROPE); float* sn = cs + SEQ * 16;
      for (int idx = gw * 64 + lane; idx < SEQ * 16; idx += NGW * 64) {
          const int pos = idx >> 4, i = idx & 15;
          const float inv = 1.0f / powf(10000.0f, (float)(2 * i) / 32.0f);
          const float ang = (float)pos * inv;
          cs[idx] = (float)cos((double)ang); sn[idx] = (float)sin((double)ang); } }
}

struct EpiInProj {
    bf16_t *QA, *CQKV, *KB; float* SSQ; const float* CS; const float* SN;
    __device__ __forceinline__ void operator()(const f32x4 (&acc)[2][2][4][2], const pg::Unit& u, int wr, int wc, int fr, int fq, LAS unsigned char* stage, int wid) const {
        const int pn = u.pn;
        if (pn < 6) {
            bf16_t* const tile = QA + (size_t)(pn >> 1) * ((size_t)T * 512) + (size_t)u.pm * 256 * 512 + (pn & 1) * 256; const float sc = (pn < 2) ? QA_SCALE : 1.f;
            const int lane = fr + 16 * fq;
#pragma unroll
            for (int ai = 0; ai < 2; ++ai)
#pragma unroll
                for (int m = 0; m < 4; ++m) { u32x4 w[2];
#pragma unroll
                    for (int bj = 0; bj < 2; ++bj) { const f32x4 v0 = acc[ai][bj][m][0] * sc, v1 = acc[ai][bj][m][1] * sc;
                        w[bj].x = cvt_pk_bf16(v0[0], v0[1]); w[bj].y = cvt_pk_bf16(v0[2], v0[3]); w[bj].z = cvt_pk_bf16(v1[0], v1[1]); w[bj].w = cvt_pk_bf16(v1[2], v1[3]); }
                    pg::staged_rows(stage, w[0], w[1], ai, m, wid, lane, [tile](int trow, int ch, u32x4 v) { __builtin_nontemporal_store(v, (u32x4*)(tile + (size_t)trow * 512 + ch * 8)); }); }
        } else {
#pragma unroll
            for (int ai = 0; ai < 2; ++ai)
#pragma unroll
                for (int m = 0; m < 4; ++m) { const int row = u.pm * 256 + ai * 128 + wr * 64 + m * 16 + fr;
#pragma unroll
                    for (int bj = 0; bj < 2; ++bj) {
                        const f32x4 v0 = acc[ai][bj][m][0], v1 = acc[ai][bj][m][1];
                        if (pn < 8 || bj == 0) {
                            const int col = (pn - 6) * 256 + bj * 128 + wc * 32 + 8 * fq; u32x4 w;
                            w.x = cvt_pk_bf16(v0[0], v0[1]); w.y = cvt_pk_bf16(v0[2], v0[3]); w.z = cvt_pk_bf16(v1[0], v1[1]); w.w = cvt_pk_bf16(v1[2], v1[3]);
                            *(u32x4*)(CQKV + (size_t)row * 640 + col) = w;
                            float s = (v0[0] * v0[0] + v0[1] * v0[1]) + (v0[2] * v0[2] + v0[3] * v0[3]) + (v1[0] * v1[0] + v1[1] * v1[1]) + (v1[2] * v1[2] + v1[3] * v1[3]);
                            s += __shfl_xor(s, 16); s += __shfl_xor(s, 32);
                            if (fq == 0) SSQ[(size_t)row * 20 + (pn - 6) * 8 + bj * 4 + wc] = s;
                        } else if (wc == 0) {
                            const int pos = row & (SEQ - 1); const int ci = pos * 16 + 8 * (fq & 1);
                            const f32x4 c0 = *(const f32x4*)(CS + ci), c1 = *(const f32x4*)(CS + ci + 4), s0 = *(const f32x4*)(SN + ci), s1 = *(const f32x4*)(SN + ci + 4);
                            f32x4 p0, p1;
#pragma unroll
                            for (int j = 0; j < 4; ++j) { p0[j] = __shfl_xor(v0[j], 32); p1[j] = __shfl_xor(v1[j], 32); }
                            f32x4 o0, o1;
                            if (fq < 2) { o0 = v0 * c0 - p0 * s0; o1 = v1 * c1 - p1 * s1; }
                            else        { o0 = p0 * s0 + v0 * c0; o1 = p1 * s1 + v1 * c1; }
                            u32x4 w; w.x = cvt_pk_bf16(o0[0], o0[1]); w.y = cvt_pk_bf16(o0[2], o0[3]); w.z = cvt_pk_bf16(o1[0], o1[1]); w.w = cvt_pk_bf16(o1[2], o1[3]);
#pragma unroll
                            for (int h = 0; h < 8; ++h) *(u32x4*)(KB + (size_t)row * 768 + h * 96 + 64 + 8 * fq) = w;
                        }
                    } }
        }
    }
};
struct EpiStoreBf16 {
    bf16_t* O; int ldc;
    __device__ __forceinline__ void operator()(const f32x4 (&acc)[2][2][4][2], const pg::Unit& u, int wr, int wc, int fr, int fq, LAS unsigned char* stage, int wid) const {
        const int lane = fr + 16 * fq; bf16_t* const tile = O + (size_t)u.pm * 256 * ldc + u.pn * 256; const int ld = ldc;
#pragma unroll
        for (int ai = 0; ai < 2; ++ai)
#pragma unroll
            for (int m = 0; m < 4; ++m) { u32x4 w[2];
#pragma unroll
                for (int bj = 0; bj < 2; ++bj) { const f32x4 v0 = acc[ai][bj][m][0], v1 = acc[ai][bj][m][1];
                    w[bj].x = cvt_pk_bf16(v0[0], v0[1]); w[bj].y = cvt_pk_bf16(v0[2], v0[3]); w[bj].z = cvt_pk_bf16(v1[0], v1[1]); w[bj].w = cvt_pk_bf16(v1[2], v1[3]); }
                pg::staged_rows(stage, w[0], w[1], ai, m, wid, lane, [tile, ld](int trow, int ch, u32x4 v) { __builtin_nontemporal_store(v, (u32x4*)(tile + (size_t)trow * ld + ch * 8)); }); }
    }
};
struct EpiQUp {
    bf16_t* QB; const float* SSQ; const float* CS; const float* SN;
    __device__ __forceinline__ void operator()(const f32x4 (&acc)[2][2][4][2], const pg::Unit& u, int wr, int wc, int fr, int fq, LAS unsigned char* stage, int wid) const {
        float rstd[2][4];
#pragma unroll
        for (int ai = 0; ai < 2; ++ai)
#pragma unroll
            for (int m = 0; m < 4; ++m) { const int row = u.pm * 256 + ai * 128 + wr * 64 + m * 16 + fr;
                const f32x4 q0 = *(const f32x4*)(SSQ + (size_t)row * 20), q1 = *(const f32x4*)(SSQ + (size_t)row * 20 + 4), q2 = *(const f32x4*)(SSQ + (size_t)row * 20 + 8);
                const float ss = ((q0[0] + q0[1]) + (q0[2] + q0[3])) + ((q1[0] + q1[1]) + (q1[2] + q1[3])) + ((q2[0] + q2[1]) + (q2[2] + q2[3]));
                rstd[ai][m] = 1.0f / sqrtf(ss * (1.f / 384.f) + EPS);
                if (m == 3) asm volatile("" : "+v"(rstd[ai][0]), "+v"(rstd[ai][1]), "+v"(rstd[ai][2]), "+v"(rstd[ai][3]) :: "memory"); }
        const int G0 = u.pn * 8 + wc;
        const int rbj = (G0 % 3 == 2) ? 0 : (((G0 + 4) % 3 == 2) ? 1 : -1);
#pragma unroll
        for (int ai = 0; ai < 2; ++ai)
#pragma unroll
          for (int mh = 0; mh < 2; ++mh) {
            f32x4 c0[2], c1[2], s0[2], s1[2];
#pragma unroll
            for (int m = 0; m < 2; ++m) { c0[m] = f32x4{0.f, 0.f, 0.f, 0.f}; c1[m] = c0[m]; s0[m] = c0[m]; s1[m] = c0[m]; }
            if (rbj >= 0) {
#pragma unroll
                for (int m = 0; m < 2; ++m) { const int row = u.pm * 256 + ai * 128 + wr * 64 + (2 * mh + m) * 16 + fr;
                    const int pos = row & (SEQ - 1); const int ci = pos * 16 + 8 * (fq & 1);
                    c0[m] = *(const f32x4*)(CS + ci); c1[m] = *(const f32x4*)(CS + ci + 4); s0[m] = *(const f32x4*)(SN + ci); s1[m] = *(const f32x4*)(SN + ci + 4); }
            }
#pragma unroll
            for (int mm = 0; mm < 2; ++mm) { const int m = 2 * mh + mm; const int row = u.pm * 256 + ai * 128 + wr * 64 + m * 16 + fr;
#pragma unroll
                for (int bj = 0; bj < 2; ++bj) { const int G = G0 + bj * 4;
                    f32x4 v0 = acc[ai][bj][m][0] * rstd[ai][m], v1 = acc[ai][bj][m][1] * rstd[ai][m];
                    if (bj == rbj) {
                        f32x4 p0, p1;
#pragma unroll
                        for (int j = 0; j < 4; ++j) { p0[j] = __shfl_xor(v0[j], 32); p1[j] = __shfl_xor(v1[j], 32); }
                        if (fq < 2) { v0 = v0 * c0[mm] - p0 * s0[mm]; v1 = v1 * c1[mm] - p1 * s1[mm]; }
                        else        { v0 = p0 * s0[mm] + v0 * c0[mm]; v1 = p1 * s1[mm] + v1 * c1[mm]; }
                    }
                    v0 = v0 * MLA_QSCALE; v1 = v1 * MLA_QSCALE;
                    u32x4 w; w.x = cvt_pk_bf16(v0[0], v0[1]); w.y = cvt_pk_bf16(v0[2], v0[3]); w.z = cvt_pk_bf16(v1[0], v1[1]); w.w = cvt_pk_bf16(v1[2], v1[3]);
                    *(u32x4*)(QB + (size_t)row * 768 + G * 32 + 8 * fq) = w; } }
          }
    }
};
struct EpiKVUp {
    bf16_t *KB, *VB; const float* SSQ;
    __device__ __forceinline__ void operator()(const f32x4 (&acc)[2][2][4][2], const pg::Unit& u, int wr, int wc, int fr, int fq, LAS unsigned char* stage, int wid) const {
        float rstd[2][4];
#pragma unroll
        for (int ai = 0; ai < 2; ++ai)
#pragma unroll
            for (int m = 0; m < 4; ++m) { const int row = u.pm * 256 + ai * 128 + wr * 64 + m * 16 + fr;
                const f32x4 q0 = *(const f32x4*)(SSQ + (size_t)row * 20 + 12), q1 = *(const f32x4*)(SSQ + (size_t)row * 20 + 16);
                const float ss = ((q0[0] + q0[1]) + (q0[2] + q0[3])) + ((q1[0] + q1[1]) + (q1[2] + q1[3]));
                rstd[ai][m] = 1.0f / sqrtf(ss * (1.f / 256.f) + EPS);
                if (m == 3) asm volatile("" : "+v"(rstd[ai][0]), "+v"(rstd[ai][1]), "+v"(rstd[ai][2]), "+v"(rstd[ai][3]) :: "memory"); }
#pragma unroll
        for (int ai = 0; ai < 2; ++ai)
#pragma unroll
            for (int m = 0; m < 4; ++m) { const int row = u.pm * 256 + ai * 128 + wr * 64 + m * 16 + fr;
#pragma unroll
                for (int bj = 0; bj < 2; ++bj) { const int G = u.pn * 8 + bj * 4 + wc;
                    const int h = G >> 2, part = G & 3;
                    const f32x4 v0 = acc[ai][bj][m][0] * rstd[ai][m], v1 = acc[ai][bj][m][1] * rstd[ai][m];
                    u32x4 w; w.x = cvt_pk_bf16(v0[0], v0[1]); w.y = cvt_pk_bf16(v0[2], v0[3]); w.z = cvt_pk_bf16(v1[0], v1[1]); w.w = cvt_pk_bf16(v1[2], v1[3]);
                    if (part < 2) *(u32x4*)(KB + (size_t)row * 768 + h * 96 + part * 32 + 8 * fq) = w;
                    else          *(u32x4*)(VB + (size_t)row * 512 + h * 64 + (part - 2) * 32 + 8 * fq) = w; } }
    }
};

struct PPSched {
    static constexpr bool GATHER = false; static constexpr int KSPLIT = 0;
    const char* A; const char* Bt; int q, nP, first, last;
    __device__ __forceinline__ bool next(int i, pg::Unit& u) const { if (q < 0) return false; const int L = first + i * nP + q; if (L >= last) return false; u.aux = 0; u.pm = L >> 2; u.pn = L & 3; return true; }
    __device__ __forceinline__ int a_ld() const { return 256; }
    __device__ __forceinline__ void addr(const pg::Unit& u, const char*& abase, const char*& bbase) const { abase = A + (size_t)u.pm * pg::BM * 256 * 2; bbase = Bt + (size_t)u.pn * pg::BM * 256 * 2; }
    __device__ __forceinline__ void addr_g(const pg::Unit&, const int (&)[2], const int (&)[2], unsigned (&)[2][2], const char*&) const {}
    __device__ __forceinline__ const char* abase() const { return A; }
};
__device__ __forceinline__ void pp_units(const Frame& F, bool second) {
    unsigned char* ws = F.ws; const int c0 = F.G / 2, nP = F.G - c0, n1 = (2 * nP < 512) ? 2 * nP : 512;
    PPSched S{(const char*)(ws + WS_P16), (const char*)(ws + WS_WPP), (int)blockIdx.x - c0, nP, second ? n1 : 0, second ? 512 : n1};
    EpiStoreBf16 E{(bf16_t*)(ws + WS_PP), 1024};
    pg::gemm_phase(F.lds, S, E, 256, F.wave);
}
__device__ __forceinline__ void p1_inproj(const Frame& F) {
    unsigned char* ws = F.ws;
    { pg::DenseSched S{(const char*)(ws + WS_XN), (const char*)(ws + WS_WIN), 1024, 1024, T / 256, INWP / 256, F.G, (int)blockIdx.x};
      EpiInProj E{(bf16_t*)(ws + WS_QA), (bf16_t*)(ws + WS_CQKV), (bf16_t*)(ws + WS_KB), (float*)(ws + WS_SSQ), (const float*)(ws + WS_ROPE), (const float*)(ws + WS_ROPE) + SEQ * 16};
      pg::gemm_phase(F.lds, S, E, 1024, F.wave); }
    pp_units(F, false);
}
__device__ __forceinline__ void p2_upproj(const Frame& F) {
    unsigned char* ws = F.ws;
    { pg::DenseSched S{(const char*)(ws + WS_CQKV), (const char*)(ws + WS_WUQ), 640, QLORA, T / 256, 3, F.G, (int)blockIdx.x};
      EpiQUp E{(bf16_t*)(ws + WS_QB), (const float*)(ws + WS_SSQ), (const float*)(ws + WS_ROPE), (const float*)(ws + WS_ROPE) + SEQ * 16};
      pg::gemm_phase(F.lds, S, E, QLORA, F.wave); }
    { pg::DenseSched S{(const char*)(ws + WS_CQKV) + 384 * 2, (const char*)(ws + WS_WUKV), 640, KVLORA, T / 256, 4, F.G, (int)blockIdx.x};
      EpiKVUp E{(bf16_t*)(ws + WS_KB), (bf16_t*)(ws + WS_VB), (const float*)(ws + WS_SSQ)};
      pg::gemm_phase(F.lds, S, E, KVLORA, F.wave); }
    pp_units(F, true);
}

namespace mla {
constexpr int QBLK = 32, KVBLK = 64, LDQ = 768, LDKk = 768, LDV = 512, LDO = 512;
constexpr float SCALE = 0.10206207261596577f;
constexpr int SHM_V = KVBLK * 64 * 2  , SHM_K = KVBLK * 256  ;
#define KSWZ(row, colB) ((row) * 256 + ((colB) ^ (((row) & 15) << 4)))
#define SBAR() __builtin_amdgcn_sched_barrier(0)
__device__ __forceinline__ int crow(int r, int hi) { return (r & 3) + 8 * (r >> 2) + 4 * hi; }

__device__ __forceinline__ int v_rd_base(int lane) { return ((lane & 3) << 3) | (((lane >> 2) & 3) << 6) | (((lane >> 4) & 1) << 5) | (((lane >> 5) & 1) << 8); }
constexpr int v_rd_off(int d0, int ks, int half) { return d0 * 512 + ks * 2048 + half * 1024; }
#define MLA_EXP2(x) __builtin_amdgcn_exp2f(x)
constexpr float THR2 = 8.f;
#define MX3(a, b, c) __builtin_fmaxf(__builtin_fmaxf((a), (b)), (c))
__device__ __forceinline__ void soft4(f32x16& p0, f32x16& p1, float& m_reg, float& l_reg, f32x16& negm, f32x16* o, float* al_l, bool first, bf16x8& pa0, bf16x8& pa1, bf16x8& pa2, bf16x8& pa3, int r32, int hi) {
  float ma = MX3(p0[0], p0[1], p0[2]), mb = MX3(p0[3], p0[4], p0[5]), mc = MX3(p0[6], p0[7], p0[8]), md = MX3(p0[9], p0[10], p0[11]);
  ma = MX3(ma, p0[12], p0[13]); mb = MX3(mb, p0[14], p0[15]); mc = MX3(mc, p1[0], p1[1]); md = MX3(md, p1[2], p1[3]);
  ma = MX3(ma, p1[4], p1[5]); mb = MX3(mb, p1[6], p1[7]); mc = MX3(mc, p1[8], p1[9]); md = MX3(md, p1[10], p1[11]);
  ma = MX3(ma, p1[12], p1[13]); mb = MX3(mb, p1[14], p1[15]);
  float pmax = __builtin_fmaxf(MX3(ma, mb, mc), md);
  { auto rr = __builtin_amdgcn_permlane32_swap(__float_as_uint(pmax), __float_as_uint(pmax), false, false);
    pmax = fmaxf(__uint_as_float(rr[0]), __uint_as_float(rr[1])); }
  if (__builtin_expect(first || !__all(pmax <= THR2), 0)) {
    const float dl = first ? pmax : fmaxf(pmax, 0.f);
    m_reg += dl;
#pragma unroll
    for (int r = 0; r < 16; ++r) { p0[r] -= dl; p1[r] -= dl; negm[r] = -m_reg; }
    if (!first) { const float alpha = __builtin_amdgcn_exp2f(-dl); l_reg *= alpha;
      if (hi == 0) al_l[r32] = alpha; asm volatile("s_waitcnt lgkmcnt(0)" ::: "memory");
#pragma unroll
      for (int r = 0; r < 16; ++r) { const float a = al_l[crow(r, hi)]; o[0][r] *= a; o[1][r] *= a; } }
  }
  asm volatile("" : "+v"(negm));
#pragma unroll
  for (int r = 0; r < 16; ++r) { p0[r] = MLA_EXP2(p0[r]); p1[r] = MLA_EXP2(p1[r]); }
  float s0 = p0[0] + p1[0], s1 = p0[1] + p1[1], s2 = p0[2] + p1[2], s3 = p0[3] + p1[3];
#pragma unroll
  for (int r = 4; r < 16; r += 4) { s0 += p0[r] + p1[r]; s1 += p0[r + 1] + p1[r + 1]; s2 += p0[r + 2] + p1[r + 2]; s3 += p0[r + 3] + p1[r + 3]; }
  l_reg += (s0 + s1) + (s2 + s3);
#define PK8(P, BASE, OUT) do { u32x4 w = {cvt_pk_bf16(P[BASE + 0], P[BASE + 1]), cvt_pk_bf16(P[BASE + 2], P[BASE + 3]), cvt_pk_bf16(P[BASE + 4], P[BASE + 5]), cvt_pk_bf16(P[BASE + 6], P[BASE + 7])}; \
    OUT = __builtin_bit_cast(bf16x8, w); } while (0)
  PK8(p0, 0, pa0); PK8(p0, 8, pa1); PK8(p1, 0, pa2); PK8(p1, 8, pa3);
#undef PK8
}
#undef MX3
typedef short v4i16_t __attribute__((ext_vector_type(4)));
typedef __attribute__((address_space(3))) const char* lds_cptr;
__device__ __forceinline__ s16x4 vtr(lds_cptr p) { return __builtin_bit_cast(s16x4, __builtin_amdgcn_ds_read_tr16_b64_v4i16((__attribute__((address_space(3))) v4i16_t*)p)); }
#define VFRAG(L, H) (bf16x8){L[0], L[1], L[2], L[3], H[0], H[1], H[2], H[3]}
__device__ __forceinline__ void mprefetch(bf16x8 (&fk)[12], lds_cptr Ks, int r32, int hi) {
#define KOFF(row, d0) KSWZ(row, ((d0) * 16 + hi * 8) * 2)
#pragma unroll
  for (int d0 = 0; d0 < 6; ++d0) { fk[2 * d0] = *(const __attribute__((address_space(3))) bf16x8*)(Ks + KOFF(r32, d0)); fk[2 * d0 + 1] = *(const __attribute__((address_space(3))) bf16x8*)(Ks + KOFF(32 + r32, d0)); }
#undef KOFF
}
template <bool HAS_PV>
__device__ __forceinline__ void mstage5(f32x16* o, f32x16& p0, f32x16& p1, bf16x8 (&fk)[12], lds_cptr vp, lds_cptr Ks, const bf16x8* qr, const f32x16& negm,
                                        bf16x8 pa0, bf16x8 pa1, bf16x8 pa2, bf16x8 pa3, int r32, int hi) {
  s16x4 vl[8], vh[8];
  if (HAS_PV) {
#pragma unroll
    for (int d0 = 0; d0 < 2; ++d0)
#pragma unroll
      for (int ks = 0; ks < 4; ++ks) { vl[d0 * 4 + ks] = vtr(vp + v_rd_off(d0, ks, 0)); vh[d0 * 4 + ks] = vtr(vp + v_rd_off(d0, ks, 1)); }
    SBAR(); }
  p0 = __builtin_amdgcn_mfma_f32_32x32x16_bf16(fk[0], qr[0], negm, 0, 0, 0); p1 = __builtin_amdgcn_mfma_f32_32x32x16_bf16(fk[1], qr[0], negm, 0, 0, 0);
#pragma unroll
  for (int d0 = 1; d0 < 6; ++d0) { p0 = __builtin_amdgcn_mfma_f32_32x32x16_bf16(fk[2 * d0], qr[d0], p0, 0, 0, 0); p1 = __builtin_amdgcn_mfma_f32_32x32x16_bf16(fk[2 * d0 + 1], qr[d0], p1, 0, 0, 0); }
  if (HAS_PV) {
    SBAR();
#pragma unroll
    for (int d0 = 0; d0 < 2; ++d0) {
      o[d0] = __builtin_amdgcn_mfma_f32_32x32x16_bf16(pa0, VFRAG(vl[d0 * 4 + 0], vh[d0 * 4 + 0]), o[d0], 0, 0, 0); o[d0] = __builtin_amdgcn_mfma_f32_32x32x16_bf16(pa1, VFRAG(vl[d0 * 4 + 1], vh[d0 * 4 + 1]), o[d0], 0, 0, 0);
      o[d0] = __builtin_amdgcn_mfma_f32_32x32x16_bf16(pa2, VFRAG(vl[d0 * 4 + 2], vh[d0 * 4 + 2]), o[d0], 0, 0, 0); o[d0] = __builtin_amdgcn_mfma_f32_32x32x16_bf16(pa3, VFRAG(vl[d0 * 4 + 3], vh[d0 * 4 + 3]), o[d0], 0, 0, 0); }
  }
}
__device__ __forceinline__ void pvlast4(f32x16* o, lds_cptr vp, bf16x8 pa0, bf16x8 pa1, bf16x8 pa2, bf16x8 pa3) {
  s16x4 vl[8], vh[8];
#pragma unroll
  for (int d0 = 0; d0 < 2; ++d0)
#pragma unroll
    for (int ks = 0; ks < 4; ++ks) { vl[d0 * 4 + ks] = vtr(vp + v_rd_off(d0, ks, 0)); vh[d0 * 4 + ks] = vtr(vp + v_rd_off(d0, ks, 1)); }
#pragma unroll
  for (int d0 = 0; d0 < 2; ++d0) {
    o[d0] = __builtin_amdgcn_mfma_f32_32x32x16_bf16(pa0, VFRAG(vl[d0 * 4 + 0], vh[d0 * 4 + 0]), o[d0], 0, 0, 0); o[d0] = __builtin_amdgcn_mfma_f32_32x32x16_bf16(pa1, VFRAG(vl[d0 * 4 + 1], vh[d0 * 4 + 1]), o[d0], 0, 0, 0);
    o[d0] = __builtin_amdgcn_mfma_f32_32x32x16_bf16(pa2, VFRAG(vl[d0 * 4 + 2], vh[d0 * 4 + 2]), o[d0], 0, 0, 0); o[d0] = __builtin_amdgcn_mfma_f32_32x32x16_bf16(pa3, VFRAG(vl[d0 * 4 + 3], vh[d0 * 4 + 3]), o[d0], 0, 0, 0); }
}
constexpr int NSLOT = 4, SLOT_K = SHM_K, SLOT_V = SHM_V;
constexpr int OFF2_K = 0, OFF2_V = NSLOT * SLOT_K, OFF2_WS = OFF2_V + NSLOT * SLOT_V, LDS2_TOTAL = OFF2_WS + NWAVES * 256;
#define MLA_BAR() asm volatile("s_waitcnt lgkmcnt(0)\n\ts_barrier" ::: "memory")

__device__ __forceinline__ void unit(const bf16_t* __restrict__ Qb, const bf16_t* __restrict__ Kh, const bf16_t* __restrict__ Vh, bf16_t* __restrict__ Ob, int seq, char* lds, int wid) {
  const int lane = lane_id(), r32 = lane & 31, hi = lane >> 5;
  const bool hb = wid >= 4;
  char* K_lds = lds + OFF2_K; char* V_lds = lds + OFF2_V;
  float* al_l = (float*)(lds + OFF2_WS) + wid * 64;
  float m_reg = 0.f, l_reg = 0.f; f32x16 o[2] = {}; f32x16 negm = {}; bf16x8 qr[6];
  const bf16_t* Qw = Qb + (long)(wid * QBLK + r32) * LDQ + hi * 8;
#pragma unroll
  for (int d0 = 0; d0 < 6; ++d0) qr[d0] = *reinterpret_cast<const bf16x8*>(Qw + d0 * 16);
  unsigned koA, koB, vo; bool kvA, kvB;
  { const int rA = 8 * wid + (lane >> 4), rB = rA + 4, cp = lane & 15;
    const int cA = cp ^ (rA & 15), cB = cp ^ (rB & 15); kvA = cA < 12; kvB = cB < 12;
    koA = (unsigned)(rA * LDKk * 2 + cA * 16); koB = (unsigned)(rB * LDKk * 2 + cB * 16);
    const int jv = 64 * wid + lane, sub = jv >> 5, within = jv & 31, k = (sub >> 1) * 8 + (within >> 2), c = (sub & 1) * 32 + (within & 3) * 8;
    vo = (unsigned)(k * LDV * 2 + c * 2); }
  const __attribute__((address_space(3))) char* lds3 = (const __attribute__((address_space(3))) char*)(lds_cptr)lds;
#define DMA_TILE(u) do { const char* kt_ = (const char*)(Kh + (long)(u) * KVBLK * LDKk); const char* vt_ = (const char*)(Vh + (long)(u) * KVBLK * LDV); const int sl_ = (u) & 3; \
    if (kvA) __builtin_amdgcn_global_load_lds((const unsigned*)(kt_ + koA), (__attribute__((address_space(3))) unsigned*)(lds3 + OFF2_K + sl_ * SLOT_K + (2 * wid) * 1024), 16, 0, 0); \
    if (kvB) __builtin_amdgcn_global_load_lds((const unsigned*)(kt_ + koB), (__attribute__((address_space(3))) unsigned*)(lds3 + OFF2_K + sl_ * SLOT_K + (2 * wid + 1) * 1024), 16, 0, 0); \
    __builtin_amdgcn_global_load_lds((const unsigned*)(vt_ + vo), (__attribute__((address_space(3))) unsigned*)(lds3 + OFF2_V + sl_ * SLOT_V + wid * 1024), 16, 0, 0); } while (0)
#define DMA_WAIT() asm volatile("s_waitcnt vmcnt(0)" ::: "memory")
  const lds_cptr vp0 = (lds_cptr)V_lds + v_rd_base(lane); const lds_cptr kp0 = (lds_cptr)K_lds;
  f32x16 p0, p1; bf16x8 pa0, pa1, pa2, pa3; const int NT = seq / KVBLK;
  bf16x8 fka[12];
  DMA_WAIT();
  DMA_TILE(0); DMA_TILE(1); DMA_WAIT();
  MLA_BAR();
  if (hb) MLA_BAR();
  DMA_TILE(2);
  mprefetch(fka, kp0, r32, hi);
  mstage5<false>(o, p0, p1, fka, vp0, kp0, qr, negm, pa0, pa1, pa2, pa3, r32, hi);

  MLA_BAR();
  soft4(p0, p1, m_reg, l_reg, negm, o, al_l, true, pa0, pa1, pa2, pa3, r32, hi);
  mprefetch(fka, kp0 + SLOT_K, r32, hi);
  DMA_WAIT();
  MLA_BAR();
#pragma clang loop unroll(disable)
  for (int t = 1; t < NT; ++t) {
    if (t + 2 < NT) DMA_TILE(t + 2);
    SBAR(); mstage5<true>(o, p0, p1, fka, vp0 + ((t - 1) & 3) * SLOT_V, kp0 + (t & 3) * SLOT_K, qr, negm, pa0, pa1, pa2, pa3, r32, hi);

    MLA_BAR();
    soft4(p0, p1, m_reg, l_reg, negm, o, al_l, false, pa0, pa1, pa2, pa3, r32, hi);
    if (t + 1 < NT) mprefetch(fka, kp0 + ((t + 1) & 3) * SLOT_K, r32, hi);
    DMA_WAIT();
    MLA_BAR();
  }
  SBAR(); pvlast4(o, vp0 + ((NT - 1) & 3) * SLOT_V, pa0, pa1, pa2, pa3);
  if (!hb) MLA_BAR();
  MLA_BAR();
  { auto rr = __builtin_amdgcn_permlane32_swap(__float_as_uint(l_reg), __float_as_uint(l_reg), false, false); l_reg = __uint_as_float(rr[0]) + __uint_as_float(rr[1]); }
  if (hi == 0) al_l[r32] = l_reg; asm volatile("s_waitcnt lgkmcnt(0)" ::: "memory");
  float rli[16];
#pragma unroll
  for (int r = 0; r < 16; ++r) rli[r] = __builtin_amdgcn_rcpf(al_l[crow(r, hi)]);
  { bf16_t* stg = (bf16_t*)(lds) + wid * 2048;
#pragma unroll
    for (int r = 0; r < 16; ++r) { const int orow = crow(r, hi);
#pragma unroll
      for (int d0 = 0; d0 < 2; ++d0) stg[orow * 64 + d0 * 32 + r32] = (bf16_t)(cvt_pk_bf16(o[d0][r] * rli[r], 0.f) & 0xffffu); }
    asm volatile("s_waitcnt lgkmcnt(0)" ::: "memory");
    bf16_t* Ow = Ob + (long)(wid * QBLK) * LDO;
#pragma unroll
    for (int i = 0; i < 4; ++i) { const int row = i * 8 + (lane >> 3), ch = lane & 7; const u32x4 v = *(const u32x4*)(stg + row * 64 + ch * 8); *(u32x4*)(Ow + (long)row * LDO + ch * 8) = v; } }
  MLA_BAR();
#undef DMA_TILE
#undef DMA_WAIT
}
#undef KSWZ
#undef SBAR
}

__device__ __forceinline__ void p3_mla(const Frame& F) {
    unsigned char* ws = F.ws;
    const bf16_t* QB = (const bf16_t*)(ws + WS_QB); const bf16_t* KB = (const bf16_t*)(ws + WS_KB); const bf16_t* VB = (const bf16_t*)(ws + WS_VB); bf16_t* OB = (bf16_t*)(ws + WS_OB);
    const int G = F.G;
    if (G == 256) {
        const int x = F.vcu >> 5, c = F.vcu & 31;
        for (int i = 0; i < 4; ++i) {
            const int pair = x * 8 + 2 * i + (c >> 4), qb = c & 15, b = pair >> 3, h = pair & 7;
            const long row0 = (long)b * SEQ;
            mla::unit(QB + (row0 + qb * 256) * 768 + h * 96, KB + row0 * 768 + h * 96, VB + row0 * 512 + h * 64, OB + (row0 + qb * 256) * 512 + h * 64, SEQ, (char*)F.lds, F.wave);
        }
    } else {
        for (int u = F.vcu; u < 1024; u += G) {
            const int pair = u >> 4, qb = u & 15, b = pair >> 3, h = pair & 7; const long row0 = (long)b * SEQ;
            mla::unit(QB + (row0 + qb * 256) * 768 + h * 96, KB + row0 * 768 + h * 96, VB + row0 * 512 + h * 64, OB + (row0 + qb * 256) * 512 + h * 64, SEQ, (char*)F.lds, F.wave);
        }
    }
}

namespace mxa {
#define SBAR() __builtin_amdgcn_sched_barrier(0)
typedef short v4i16_t __attribute__((ext_vector_type(4)));
typedef __attribute__((address_space(3))) const char* lds_cptr;
__device__ __forceinline__ s16x4 vtr(lds_cptr p) { return __builtin_bit_cast(s16x4, __builtin_amdgcn_ds_read_tr16_b64_v4i16((__attribute__((address_space(3))) v4i16_t*)p)); }
__device__ __forceinline__ int crow(int r, int hi) { return (r & 3) + 8 * (r >> 2) + 4 * hi; }
#define KSW2(row, colB) ((row) * 128 + ((colB) ^ ((((row) >> 1) & 7) << 4)))
__device__ __forceinline__ int v_rd_base(int lane) { return ((lane & 3) << 3) | (((lane >> 2) & 3) << 6) | (((lane >> 4) & 1) << 5) | (((lane >> 5) & 1) << 8); }
constexpr int v_rd_off(int d0, int ks, int half) { return d0 * 512 + ks * 2048 + half * 1024; }
constexpr int BUFB = 8192;
#define VFRAG(L, H) (bf16x8){L[0], L[1], L[2], L[3], H[0], H[1], H[2], H[3]}
__device__ __forceinline__ void step(f32x16& o0, f32x16& o1, float& m_reg, float& l_reg, const bf16x8* qr, lds_cptr Kb, lds_cptr Vb, float* al_l, float basef, float sl2, bool first, int r32, int hi) {
  constexpr float THR = 8.f;
  bf16x8 kf[4]; s16x4 vl[4], vh[4];
#pragma unroll
  for (int d0 = 0; d0 < 4; ++d0) kf[d0] = *(const __attribute__((address_space(3))) bf16x8*)(Kb + KSW2(r32, (d0 * 16 + hi * 8) * 2));
#pragma unroll
  for (int d0 = 0; d0 < 2; ++d0)
#pragma unroll
    for (int ks = 0; ks < 2; ++ks) { vl[d0 * 2 + ks] = vtr(Vb + v_rd_off(d0, ks, 0)); vh[d0 * 2 + ks] = vtr(Vb + v_rd_off(d0, ks, 1)); }
  f32x16 p;
  { const float nm = first ? 0.f : -m_reg;
#pragma unroll
    for (int r = 0; r < 16; ++r) p[r] = nm; }
#pragma unroll
  for (int d0 = 0; d0 < 4; ++d0) p = __builtin_amdgcn_mfma_f32_32x32x16_bf16(kf[d0], qr[d0], p, 0, 0, 0);
  const float nsl = -sl2;
  float pmax = -1e30f;
#pragma unroll
  for (int r = 0; r < 16; ++r) {
    const float df = basef - (float)((r & 3) + 8 * (r >> 2)), ad = __builtin_fabsf(df);
    const float sv = fmaf(nsl, ad, p[r]);
    p[r] = (ad <= 64.f) ? sv : -1e30f;
    pmax = fmaxf(pmax, p[r]);
  }
  { auto rr = __builtin_amdgcn_permlane32_swap(__float_as_uint(pmax), __float_as_uint(pmax), false, false);
    pmax = fmaxf(__uint_as_float(rr[0]), __uint_as_float(rr[1])); }
  if (first || !__all(pmax <= THR)) {
    const float dl = first ? pmax : fmaxf(pmax, 0.f);
    m_reg += dl;
#pragma unroll
    for (int r = 0; r < 16; ++r) p[r] -= dl;
    if (!first) { const float alpha = __builtin_amdgcn_exp2f(-dl); l_reg *= alpha;
      if (hi == 0) al_l[r32] = alpha; asm volatile("s_waitcnt lgkmcnt(0)" ::: "memory");
#pragma unroll
      for (int r = 0; r < 16; ++r) { const float a = al_l[crow(r, hi)]; o0[r] *= a; o1[r] *= a; } }
  }
  float ps = 0.f;
#pragma unroll
  for (int r = 0; r < 16; ++r) { p[r] = __builtin_amdgcn_exp2f(p[r]); ps += p[r]; }
  l_reg += ps;
  u32x4 w0 = {cvt_pk_bf16(p[0], p[1]), cvt_pk_bf16(p[2], p[3]), cvt_pk_bf16(p[4], p[5]), cvt_pk_bf16(p[6], p[7])};
  u32x4 w1 = {cvt_pk_bf16(p[8], p[9]), cvt_pk_bf16(p[10], p[11]), cvt_pk_bf16(p[12], p[13]), cvt_pk_bf16(p[14], p[15])};
  const bf16x8 pa0 = __builtin_bit_cast(bf16x8, w0), pa1 = __builtin_bit_cast(bf16x8, w1);
  o0 = __builtin_amdgcn_mfma_f32_32x32x16_bf16(pa0, VFRAG(vl[0], vh[0]), o0, 0, 0, 0); o0 = __builtin_amdgcn_mfma_f32_32x32x16_bf16(pa1, VFRAG(vl[1], vh[1]), o0, 0, 0, 0);
  o1 = __builtin_amdgcn_mfma_f32_32x32x16_bf16(pa0, VFRAG(vl[2], vh[2]), o1, 0, 0, 0); o1 = __builtin_amdgcn_mfma_f32_32x32x16_bf16(pa1, VFRAG(vl[3], vh[3]), o1, 0, 0, 0);
}

__device__ __forceinline__ void task(const bf16_t* __restrict__ QA, const bf16_t* __restrict__ KA, const bf16_t* __restrict__ VA, bf16_t* __restrict__ OP, float* __restrict__ LS,
                                     int b, int h, int n, int rres, int qb, char* wl, float* al) {
  const int lane = lane_id(), r32 = lane & 31, hi = lane >> 5;
  const int dil = (n == 0) ? 1 : (n == 1 ? 4 : 16), L = SEQ / dil, l0 = qb * 64;
  const float sl2 = exp2f(-(float)(h + 1)) * (float)dil * LOG2E;
  const long rowb = (long)b * SEQ;
  const lds_cptr wl3 = (lds_cptr)wl;
  const lds_cptr vrd = wl3 + 4096 + v_rd_base(lane);
  asm volatile("s_waitcnt vmcnt(0)" ::: "memory");
  unsigned ko[4], vo[4];
#pragma unroll
  for (int pc = 0; pc < 4; ++pc) {
    const int kr = 8 * pc + (lane >> 3), c = (lane & 7) ^ ((kr >> 1) & 7);
    ko[pc] = (unsigned)(kr * dil * 1024 + h * 128 + c * 16);
    const int jv = 64 * pc + lane, sub = jv >> 5, within = jv & 31, vk = (sub >> 1) * 8 + (within >> 2), vc = (sub & 1) * 32 + (within & 3) * 8;
    vo[pc] = (unsigned)(vk * dil * 1024 + h * 128 + vc * 2); }
#define MXA_DMA(lk0_, buf_) do { const size_t rb_ = (size_t)(rowb + (long)(lk0_) * dil + rres) * 1024; const char* kb_ = (const char*)KA + rb_; const char* vb_ = (const char*)VA + rb_; \
    _Pragma("unroll") for (int pc = 0; pc < 4; ++pc) { \
      __builtin_amdgcn_global_load_lds((const unsigned*)(kb_ + ko[pc]), (__attribute__((address_space(3))) unsigned*)(wl3 + (buf_) * BUFB + pc * 1024), 16, 0, 0); \
      __builtin_amdgcn_global_load_lds((const unsigned*)(vb_ + vo[pc]), (__attribute__((address_space(3))) unsigned*)(wl3 + (buf_) * BUFB + 4096 + pc * 1024), 16, 0, 0); } } while (0)
  const bool has_behind = (l0 >= 64), has_ahead = (l0 + 64 < L);
  const int nblk = 2 + (has_behind ? 2 : 0) + (has_ahead ? 2 : 0);
  auto blk_at = [&](int i) -> int { if (i < 2) return 2 + i; if (has_behind && has_ahead) return (i == 2) ? 1 : (i == 3 ? 4 : (i == 4 ? 0 : 5)); if (has_behind) return (i == 2) ? 1 : 0; return (i == 2) ? 4 : 5; };
  MXA_DMA(l0, 0);
  bf16x8 q0[4], q1[4];
  { const long ra = rowb + (long)(l0 + r32) * dil + rres, rb2 = rowb + (long)(l0 + 32 + r32) * dil + rres;
#pragma unroll
    for (int d0 = 0; d0 < 4; ++d0) { q0[d0] = *reinterpret_cast<const bf16x8*>(QA + ra * 512 + h * 64 + d0 * 16 + hi * 8); q1[d0] = *reinterpret_cast<const bf16x8*>(QA + rb2 * 512 + h * 64 + d0 * 16 + hi * 8); } }
  asm volatile("s_waitcnt vmcnt(0)" ::: "memory");
  f32x16 oa0 = f32x16{}, oa1 = f32x16{}, ob0 = f32x16{}, ob1 = f32x16{};
  float ma = 0.f, la = 0.f, mb = 0.f, lb = 0.f;
#pragma clang loop unroll(disable)
  for (int i = 0; i < nblk; ++i) {
    const int j = blk_at(i), buf = i & 1;
    if (i + 1 < nblk) { MXA_DMA(l0 - 64 + 32 * blk_at(i + 1), buf ^ 1); }
    if (i > 0) { if (i + 1 < nblk) asm volatile("s_waitcnt vmcnt(8)" ::: "memory"); else asm volatile("s_waitcnt vmcnt(0)" ::: "memory"); }
    const lds_cptr Kb = wl3 + buf * BUFB, Vb = vrd + buf * BUFB;
    const int dk = -64 + 32 * j;
    if (j <= 4) step(oa0, oa1, ma, la, q0, Kb, Vb, al, (float)(r32 - 4 * hi - dk), sl2, i == 0, r32, hi);
    if (j >= 1) step(ob0, ob1, mb, lb, q1, Kb, Vb, al, (float)(32 + r32 - 4 * hi - dk), sl2, i == 0, r32, hi);
    asm volatile("s_waitcnt lgkmcnt(0)" ::: "memory");
  }
#undef MXA_DMA
#pragma unroll
  for (int qs = 0; qs < 2; ++qs) {
    float l_reg = qs ? lb : la; const float m_reg = qs ? mb : ma;
    { auto rr = __builtin_amdgcn_permlane32_swap(__float_as_uint(l_reg), __float_as_uint(l_reg), false, false); l_reg = __uint_as_float(rr[0]) + __uint_as_float(rr[1]); }
    if (hi == 0) { al[r32] = l_reg; const long row = rowb + (long)(l0 + qs * 32 + r32) * dil + rres; LS[row * 8 + h] = m_reg + __builtin_amdgcn_logf(l_reg); }
    asm volatile("s_waitcnt lgkmcnt(0)" ::: "memory");
    bf16_t* stg = (bf16_t*)wl;
#pragma unroll
    for (int r = 0; r < 16; ++r) { const int orow = crow(r, hi); const float rl = __builtin_amdgcn_rcpf(al[orow]);
      stg[orow * 64 + r32] = (bf16_t)(cvt_pk_bf16((qs ? ob0[r] : oa0[r]) * rl, 0.f) & 0xffffu);
      stg[orow * 64 + 32 + r32] = (bf16_t)(cvt_pk_bf16((qs ? ob1[r] : oa1[r]) * rl, 0.f) & 0xffffu); }
    asm volatile("s_waitcnt lgkmcnt(0)" ::: "memory");
#pragma unroll
    for (int i = 0; i < 4; ++i) { const int rw = i * 8 + (lane >> 3), ch = lane & 7; const u32x4 v = *(const u32x4*)(stg + rw * 64 + ch * 8);
      const long row = rowb + (long)(l0 + qs * 32 + rw) * dil + rres; *(u32x4*)(OP + row * 512 + h * 64 + ch * 8) = v; }
    asm volatile("s_waitcnt lgkmcnt(0)" ::: "memory");
  }
}
#undef KSW2
#undef VFRAG
#undef SBAR
}

__device__ __forceinline__ void p3_mixerA(const Frame& F) {
    unsigned char* ws = F.ws;
    const bf16_t* QA = (const bf16_t*)(ws + WS_QA); const bf16_t* KA = (const bf16_t*)(ws + WS_KA); const bf16_t* VA = (const bf16_t*)(ws + WS_VA);
    float* LSE = (float*)(ws + WS_LSE);
    char* wl = (char*)F.lds + F.wave * 16384; float* al = (float*)((char*)F.lds + RING_BYTES + 2048) + F.wave * 64;
    const int x = (F.G == 256) ? (F.vcu >> 5) : 0; const int ngrp = (F.G == 256) ? 8 : 1, per = 64 * 192 / ngrp;
    unsigned* qctr = F.ctl + CW_Q + 64 * x;
    for (;;) {
        unsigned ti = 0; if (lane_id() == 0) ti = atomicAdd(qctr, 1u);
        ti = (unsigned)__builtin_amdgcn_readfirstlane((int)ti);
        if (ti >= (unsigned)per) break;
        const int t = x * per + (int)ti;
        const int pair = t / 192, tt = t % 192, n = tt >> 6, idx = tt & 63;
        const int rres = (n == 0) ? 0 : (n == 1 ? (idx >> 4) : (idx >> 2)), qb = (n == 0) ? idx : (n == 1 ? (idx & 15) : (idx & 3));
        bf16_t* OP = (bf16_t*)(ws + (n == 2 ? WS_OAP2 : WS_OAP0)) + (n == 1 ? (size_t)T * 512 : 0);
        mxa::task(QA, KA, VA, OP, LSE + (size_t)n * ((size_t)T * 8), pair >> 3, pair & 7, n, rres, qb, wl, al);
    }
}
static_assert(WS_OAP1 - WS_OAP0 == (size_t)T * 512 * 2, "OAP0|OAP1 contiguous");

__device__ __forceinline__ void p35_mix(const Frame& F, const Args& a) {
    unsigned char* ws = F.ws; const int lane = lane_id();
    const bf16_t* OB = (const bf16_t*)(ws + WS_OB); const float* LSE = (const float*)(ws + WS_LSE); bf16_t* MIXED = (bf16_t*)(ws + WS_MIXED);
    const bf16_t* OAPn[3] = {(const bf16_t*)(ws + WS_OAP0), (const bf16_t*)(ws + WS_OAP1), (const bf16_t*)(ws + WS_OAP2)};
    const float* g_a = a.in[8]; const float* g_b = a.in[9];
    const int gw = F.vcu * NWAVES + F.wave, NGW = F.G * NWAVES;
    const int h = lane >> 3;
    const f32x4 ga0 = *(const f32x4*)(g_a + lane * 8), ga1 = *(const f32x4*)(g_a + lane * 8 + 4), gb0 = *(const f32x4*)(g_b + lane * 8), gb1 = *(const f32x4*)(g_b + lane * 8 + 4);
    for (int row = gw; row < T; row += NGW) {
        float ls[3]; u32x4 ov[3];
#pragma unroll
        for (int n = 0; n < 3; ++n) { ls[n] = LSE[((size_t)n * T + row) * 8 + h]; ov[n] = *(const u32x4*)(OAPn[n] + (size_t)row * 512 + lane * 8); }
        const u32x4 bv = *(const u32x4*)(OB + (size_t)row * 512 + lane * 8);
        const float mx = fmaxf(ls[0], fmaxf(ls[1], ls[2]));
        float w[3]; float wsum = 0.f;
#pragma unroll
        for (int n = 0; n < 3; ++n) { w[n] = __builtin_amdgcn_exp2f(ls[n] - mx); wsum += w[n]; }
        const float inv = 1.f / wsum;
        float oa[8] = {0.f, 0.f, 0.f, 0.f, 0.f, 0.f, 0.f, 0.f};
#pragma unroll
        for (int n = 0; n < 3; ++n) { const float wn = w[n] * inv;
#pragma unroll
            for (int j = 0; j < 4; ++j) { oa[2 * j] += wn * bf16lo(ov[n][j]); oa[2 * j + 1] += wn * bf16hi(ov[n][j]); } }
        float obv[8];
#pragma unroll
        for (int j = 0; j < 4; ++j) { obv[2 * j] = bf16lo(bv[j]); obv[2 * j + 1] = bf16hi(bv[j]); }
        float sa = 0.f, sb = 0.f;
#pragma unroll
        for (int j = 0; j < 8; ++j) { sa += oa[j] * oa[j]; sb += obv[j] * obv[j]; }
        sa = wsum64(sa); sb = wsum64(sb);
        const float ra = 1.0f / sqrtf(sa * (1.f / 512.f) + EPS), rb = 1.0f / sqrtf(sb * (1.f / 512.f) + EPS);
        u32x4 wa, wb;
        wa.x = cvt_pk_bf16(oa[0] * ra * ga0[0], oa[1] * ra * ga0[1]); wa.y = cvt_pk_bf16(oa[2] * ra * ga0[2], oa[3] * ra * ga0[3]);
        wa.z = cvt_pk_bf16(oa[4] * ra * ga1[0], oa[5] * ra * ga1[1]); wa.w = cvt_pk_bf16(oa[6] * ra * ga1[2], oa[7] * ra * ga1[3]);
        wb.x = cvt_pk_bf16(obv[0] * rb * gb0[0], obv[1] * rb * gb0[1]); wb.y = cvt_pk_bf16(obv[2] * rb * gb0[2], obv[3] * rb * gb0[3]);
        wb.z = cvt_pk_bf16(obv[4] * rb * gb1[0], obv[5] * rb * gb1[1]); wb.w = cvt_pk_bf16(obv[6] * rb * gb1[2], obv[7] * rb * gb1[3]);
        *(u32x4*)(MIXED + (size_t)row * 1024 + lane * 8) = wa;
        *(u32x4*)(MIXED + (size_t)row * 1024 + 512 + lane * 8) = wb;
    }
}

constexpr size_t WS_WRT = 4 * MiB + 512 * 1024;
constexpr size_t WS_RS = 137 * MiB;
constexpr size_t WS_GS = 141 * MiB;
constexpr size_t WS_H2B = 384 * MiB;
constexpr size_t WS_D = 448 * MiB;
constexpr int MOE_TAB = MISC_OFF + 256;
constexpr int NBUCK = 112;
constexpr int CW_BCNT = 32768;
constexpr size_t WS_HID2 = 209 * MiB;
constexpr size_t WS_BLIST = 288 * MiB;
constexpr size_t WS_SSQ2 = 136 * MiB + 256 * 1024;
constexpr int MOE_TOKL = MOE_TAB + 4096;
constexpr size_t WS_DST = 280 * MiB;

__device__ __forceinline__ void p0_router_table(const Frame& F, const Args& a) {
    const float* w_r1 = a.in[12]; const float* w_r2 = a.in[14]; const float* g_ffn = a.in[11]; bf16_t* WRH = (bf16_t*)(F.ws + WS_WRT); bf16_t* WRL = WRH + 48 * 1024;
    const int gw = F.vcu * NWAVES + F.wave, NGW = F.G * NWAVES, lane = lane_id();
    for (int idx = gw * 64 + lane; idx < 48 * 1024; idx += NGW * 64) {
        const int o = idx >> 10, k = idx & 1023;
        float w = 0.f;
        if (o < 4) w = w_r1[k * 4 + o]; else if (o < 36) w = w_r2[((size_t)((o - 4) >> 3) * 1024 + k) * 8 + ((o - 4) & 7)];
        w *= g_ffn[k];
        const unsigned hi = cvt_pk_bf16(w, 0.f) & 0xffffu; const float rem = w - __uint_as_float(hi << 16);
        WRH[idx] = (bf16_t)hi; WRL[idx] = (bf16_t)(cvt_pk_bf16(rem, 0.f) & 0xffffu);
    }
}

__device__ __forceinline__ void p4_wo(const Frame& F, const Args& a) {
    unsigned char* ws = F.ws;
    pg::DenseSched S{(const char*)(ws + WS_MIXED), (const char*)(ws + WS_WO), 1024, 1024, T / 256, 4, F.G, (int)blockIdx.x};
    EpiStoreBf16 E{(bf16_t*)(ws + WS_D), 1024};
    pg::gemm_phase(F.lds, S, E, 1024, F.wave);
}

__device__ __forceinline__ void p5_router(const Frame& F, const Args& a) {
    unsigned char* ws = F.ws; const int lane = lane_id(), wid = F.wave;
    const float* X = a.in[0]; const bf16_t* Dm = (const bf16_t*)(ws + WS_D); const float* g_ffn = a.in[11]; const float* b_r1 = a.in[13]; const float* b_r2 = a.in[15];
    const bf16_t* WRH = (const bf16_t*)(ws + WS_WRT); const bf16_t* WRL = WRH + 48 * 1024; bf16_t* MU = (bf16_t*)(ws + WS_M);
    int* LIST = (int*)(ws + WS_LIST); float* RS = (float*)(ws + WS_RS); float* GS = (float*)(ws + WS_GS);
    unsigned* cnt = F.ctl + CW_CNT;
    LAS int* LG = (LAS int*)(F.lds);
    LAS int* SSQ_ = (LAS int*)(F.lds + 26 * 1024);
    LAS unsigned* hist = (LAS unsigned*)(F.lds + 27 * 1024);
    LAS unsigned* gbase = hist + 160;
    int* DST = (int*)(ws + WS_DST); int* BLIST = (int*)(ws + WS_BLIST); unsigned* bcnt = F.ctl + CW_BCNT;
    const int tr = lane & 15, kg = lane >> 4, tid = wid * 64 + lane;
    const int kw = 128 * wid;
    for (int chunk = F.vcu; chunk < T / 128; chunk += F.G) {
        const int base = chunk * 128;
        for (int i = tid; i < 128 * 49 + 128; i += 512) { if (i < 128 * 49) LG[i] = 0; else SSQ_[i - 128 * 49] = 0; }
        if (tid < 32 + NBUCK) hist[tid] = 0u;
        __syncthreads();
        bf16x8 bh[4][3], bl[4][3];
#pragma unroll
        for (int ks = 0; ks < 4; ++ks)
#pragma unroll
            for (int nb = 0; nb < 3; ++nb) { const size_t wo = (size_t)(nb * 16 + tr) * 1024 + kw + ks * 32 + 8 * kg; bh[ks][nb] = *(const bf16x8*)(WRH + wo); bl[ks][nb] = *(const bf16x8*)(WRL + wo); }
#pragma unroll 2
        for (int mb = 0; mb < 8; ++mb) {
            const size_t ro = (size_t)(base + 16 * mb + tr) * 1024 + kw + 8 * kg;
            f32x4 acc0 = {0.f, 0.f, 0.f, 0.f}, acc1 = acc0, acc2 = acc0; float ss = 0.f;
#pragma unroll
            for (int ks = 0; ks < 4; ++ks) {
                f32x4 v0 = *(const f32x4*)(X + ro + ks * 32), v1 = *(const f32x4*)(X + ro + ks * 32 + 4);
                { const u32x4 dd = *(const u32x4*)(Dm + ro + ks * 32);
                  v0[0] += bf16lo(dd.x); v0[1] += bf16hi(dd.x); v0[2] += bf16lo(dd.y); v0[3] += bf16hi(dd.y); v1[0] += bf16lo(dd.z); v1[1] += bf16hi(dd.z); v1[2] += bf16lo(dd.w); v1[3] += bf16hi(dd.w); }
                ss += (v0[0] * v0[0] + v0[1] * v0[1]) + (v0[2] * v0[2] + v0[3] * v0[3]) + (v1[0] * v1[0] + v1[1] * v1[1]) + (v1[2] * v1[2] + v1[3] * v1[3]);
                u32x4 hi; hi.x = cvt_pk_bf16(v0[0], v0[1]); hi.y = cvt_pk_bf16(v0[2], v0[3]); hi.z = cvt_pk_bf16(v1[0], v1[1]); hi.w = cvt_pk_bf16(v1[2], v1[3]);
                u32x4 lo; lo.x = cvt_pk_bf16(v0[0] - bf16lo(hi.x), v0[1] - bf16hi(hi.x)); lo.y = cvt_pk_bf16(v0[2] - bf16lo(hi.y), v0[3] - bf16hi(hi.y));
                lo.z = cvt_pk_bf16(v1[0] - bf16lo(hi.z), v1[1] - bf16hi(hi.z)); lo.w = cvt_pk_bf16(v1[2] - bf16lo(hi.w), v1[3] - bf16hi(hi.w));
                *(u32x4*)(MU + ro + ks * 32) = hi;
                const bf16x8 ah = __builtin_bit_cast(bf16x8, hi), al = __builtin_bit_cast(bf16x8, lo);
                acc0 = __builtin_amdgcn_mfma_f32_16x16x32_bf16(ah, bh[ks][0], acc0, 0, 0, 0); acc0 = __builtin_amdgcn_mfma_f32_16x16x32_bf16(al, bh[ks][0], acc0, 0, 0, 0); acc0 = __builtin_amdgcn_mfma_f32_16x16x32_bf16(ah, bl[ks][0], acc0, 0, 0, 0);
                acc1 = __builtin_amdgcn_mfma_f32_16x16x32_bf16(ah, bh[ks][1], acc1, 0, 0, 0); acc1 = __builtin_amdgcn_mfma_f32_16x16x32_bf16(al, bh[ks][1], acc1, 0, 0, 0); acc1 = __builtin_amdgcn_mfma_f32_16x16x32_bf16(ah, bl[ks][1], acc1, 0, 0, 0);
                acc2 = __builtin_amdgcn_mfma_f32_16x16x32_bf16(ah, bh[ks][2], acc2, 0, 0, 0); acc2 = __builtin_amdgcn_mfma_f32_16x16x32_bf16(al, bh[ks][2], acc2, 0, 0, 0); acc2 = __builtin_amdgcn_mfma_f32_16x16x32_bf16(ah, bl[ks][2], acc2, 0, 0, 0);
            }
            ss += __shfl_xor(ss, 16); ss += __shfl_xor(ss, 32);
            if (kg == 0) atomicAdd((int*)(SSQ_ + 16 * mb + tr), __float2int_rn(ss * 16384.0f));
#pragma unroll
            for (int r = 0; r < 4; ++r) { const int tk = 16 * mb + 4 * kg + r;
                atomicAdd((int*)(LG + tk * 49 + tr), __float2int_rn(acc0[r] * 1048576.0f)); atomicAdd((int*)(LG + tk * 49 + 16 + tr), __float2int_rn(acc1[r] * 1048576.0f)); if (tr < 4) atomicAdd((int*)(LG + tk * 49 + 32 + tr), __float2int_rn(acc2[r] * 1048576.0f)); }
        }
        __syncthreads();
        int ea = 0, eb = 0, bk = 0, hfa = 0; unsigned la = 0u, lb = 0u, lk = 0u; float w0 = 0.f, w1 = 0.f, rstd = 0.f;
        if (tid < 128) {
            rstd = 1.0f / sqrtf((float)SSQ_[tid] * (1.f / 16384.f) * (1.f / 1024.f) + EPS);
            const LAS int* lg = LG + tid * 49; const float rq = rstd * (1.f / 1048576.f);
            const float l0 = (float)lg[0] * rq + b_r1[0], l1 = (float)lg[1] * rq + b_r1[1], l2 = (float)lg[2] * rq + b_r1[2], l3 = (float)lg[3] * rq + b_r1[3];
            int gi = 0; float gm = l0; if (l1 > gm) { gm = l1; gi = 1; } if (l2 > gm) { gm = l2; gi = 2; } if (l3 > gm) { gm = l3; gi = 3; }
            const float gs = __expf(l0 - gm) + __expf(l1 - gm) + __expf(l2 - gm) + __expf(l3 - gm);
            const float g_val = 1.0f / gs;
            float lv[8];
#pragma unroll
            for (int e = 0; e < 8; ++e) lv[e] = (float)lg[4 + 8 * gi + e] * rq + b_r2[8 * gi + e];
            int e0 = 0; float m0 = lv[0];
#pragma unroll
            for (int e = 1; e < 8; ++e) if (lv[e] > m0) { m0 = lv[e]; e0 = e; }
            int e1 = -1; float m1 = -3.0e38f;
#pragma unroll
            for (int e = 0; e < 8; ++e) if (e != e0 && lv[e] > m1) { m1 = lv[e]; e1 = e; }
            const float x1 = __expf(m1 - m0);
            w0 = g_val / (1.0f + x1); w1 = g_val * x1 / (1.0f + x1);
            ea = gi * 8 + e0; eb = gi * 8 + e1;
            la = atomicAdd((unsigned*)(hist + ea), 1u); lb = atomicAdd((unsigned*)(hist + eb), 1u);
            { const int lo = e0 < e1 ? e0 : e1, hi = e0 < e1 ? e1 : e0; bk = gi * 28 + (lo * 7 - ((lo * (lo - 1)) >> 1) + (hi - lo - 1)); hfa = e0 < e1 ? 0 : 1; }
            lk = atomicAdd((unsigned*)(hist + 32 + bk), 1u);
        }
        __syncthreads();
        if (tid < 32 + NBUCK) { const unsigned c = hist[tid]; gbase[tid] = c ? atomicAdd(tid < 32 ? cnt + 64 * tid : bcnt + 64 * (tid - 32), c) : 0u; }
        __syncthreads();
        if (tid < 128) {
            const int tok = base + tid; const int ra = (int)(gbase[ea] + la), rb = (int)(gbase[eb] + lb);
            LIST[(size_t)ea * T + ra] = tok; RS[(size_t)ea * T + ra] = rstd; GS[(size_t)ea * T + ra] = w0;
            LIST[(size_t)eb * T + rb] = tok; RS[(size_t)eb * T + rb] = rstd; GS[(size_t)eb * T + rb] = w1;
            const int rk2 = (int)(gbase[32 + bk] + lk);
            DST[(size_t)ea * T + ra] = (bk << 17) | (rk2 << 1) | hfa; DST[(size_t)eb * T + rb] = (bk << 17) | (rk2 << 1) | (hfa ^ 1);
            BLIST[(size_t)bk * T + rk2] = tok;
        }
        __syncthreads();
    }
}

__device__ __forceinline__ void moe_build_tables(const Frame& F) {
    LAS int* tab = (LAS int*)(F.lds + MOE_TAB);
    const int tid = F.wave * 64 + lane_id();
    if (tid < 32 + NBUCK) tab[512 + tid] = (int)__hip_atomic_load(tid < 32 ? F.ctl + CW_CNT + 64 * tid : F.ctl + CW_BCNT + 64 * (tid - 32), __ATOMIC_RELAXED, __HIP_MEMORY_SCOPE_AGENT);
    __syncthreads();
    if (tid <= 32) { int off = 0, cp = 0;
        for (int j = 0; j < tid; ++j) { const int nch = (tab[512 + j] + 255) >> 8; off += nch * 256; cp += nch; }
        tab[tid] = off; tab[80 + tid] = cp; if (tid < 32) tab[40 + tid] = tab[512 + tid]; }
    else if (tid >= 64 && tid <= 64 + NBUCK) { const int b = tid - 64; int o = 0, p = 0;
        for (int j = 0; j < b; ++j) { const int c = tab[512 + 32 + j]; o += c; p += (c + 255) >> 8; }
        tab[128 + b] = o; tab[384 + b] = p; if (b < NBUCK) tab[256 + b] = tab[512 + 32 + b]; }
    __syncthreads();
}
struct MoeSched1 {
    static constexpr bool GATHER = true; static constexpr int KSPLIT = 0;
    const char* A; const char* Bt; const int* LIST; LAS const int* tab; int G, c;
    __device__ __forceinline__ int a_ld() const { return 1024; }
    __device__ __forceinline__ const char* abase() const { return A; }
    __device__ __forceinline__ bool next(int i, pg::Unit& u) const {
        const int nun = tab[80 + 32] * 2; const long L = (long)i * G + c; if (L >= nun) return false;
        const int ci = (int)L >> 1; u.pn = (int)L & 1;
        int e = 0;
#pragma unroll 1
        for (int k = 1; k < 32; ++k) if (tab[80 + k] <= ci) e = k;
        u.aux = e; u.pm = ci - tab[80 + e]; return true;
    }
    __device__ __forceinline__ void addr(const pg::Unit&, const char*&, const char*&) const {}
    __device__ __forceinline__ void addr_g(const pg::Unit& u, const int (&R)[2], const int (&C)[2], unsigned (&aoff)[2][2], const char*& bbase) const {
        const int e = u.aux, cn = tab[40 + e];
#pragma unroll
        for (int h = 0; h < 2; ++h)
#pragma unroll
            for (int i = 0; i < 2; ++i) { const int rk = u.pm * 256 + h * 128 + R[i]; const int tok = (rk < cn) ? LIST[(size_t)e * T + rk] : 0; aoff[h][i] = (unsigned)((tok * 1024 + C[i]) * 2); }
        bbase = Bt + ((size_t)e * 512 + (size_t)u.pn * 256) * 1024 * 2;
    }
};
struct EpiMoe1 {
    bf16_t* HID2; const float* RS; const float* GS; const int* DST; LAS const int* tab;
    __device__ __forceinline__ void operator()(const f32x4 (&acc)[2][2][4][2], const pg::Unit& u, int wr, int wc, int fr, int fq, LAS unsigned char* stage, int wid) const {
        const int e = u.aux, cn = tab[40 + e];
        float rsv[2][4], gsv[2][4]; int dsv[2][4];
#pragma unroll
        for (int ai = 0; ai < 2; ++ai)
#pragma unroll
            for (int m = 0; m < 4; ++m) { const int rk = u.pm * 256 + ai * 128 + wr * 64 + m * 16 + fr; const bool ok = rk < cn; const size_t o = (size_t)e * T + rk;
                rsv[ai][m] = ok ? RS[o] : 0.f; gsv[ai][m] = ok ? GS[o] : 0.f; dsv[ai][m] = ok ? DST[o] : -1; }
#pragma unroll
        for (int ai = 0; ai < 2; ++ai)
#pragma unroll
            for (int m = 0; m < 4; ++m) { const int d = dsv[ai][m];
                if (d >= 0) { const float rs = rsv[ai][m], gt = gsv[ai][m]; float hv[8];
                    const int row2 = tab[128 + (d >> 17)] + ((d >> 1) & 0xffff), half = d & 1;
#pragma unroll
                    for (int n = 0; n < 2; ++n)
#pragma unroll
                        for (int j = 0; j < 4; ++j) { const float gg = acc[ai][0][m][n][j] * rs, uu = acc[ai][1][m][n][j] * (rs * gt); hv[4 * n + j] = gg / (1.0f + __expf(-gg)) * uu; }
                    u32x4 w; w.x = cvt_pk_bf16(hv[0], hv[1]); w.y = cvt_pk_bf16(hv[2], hv[3]); w.z = cvt_pk_bf16(hv[4], hv[5]); w.w = cvt_pk_bf16(hv[6], hv[7]);
                    *(u32x4*)(HID2 + (size_t)row2 * 512 + half * 256 + u.pn * 128 + wc * 32 + 8 * fq) = w; } }
    }
};
struct MoeSched2 {
    static constexpr bool GATHER = false; static constexpr int KSPLIT = 4;
    const char* A; const char* Bt; LAS const int* tab; int G, c;
    __device__ __forceinline__ int a_ld() const { return 512; }
    __device__ __forceinline__ const char* abase() const { return A; }
    __device__ __forceinline__ bool next(int i, pg::Unit& u) const {
        const int nun = tab[384 + NBUCK] * 4; const long L = (long)i * G + c; if (L >= nun) return false;
        const int ci = (int)L >> 2; u.pn = (int)L & 3;
        const int l = lane_id();
        const unsigned long long m0 = __builtin_amdgcn_ballot_w64(tab[384 + l] <= ci), m1 = __builtin_amdgcn_ballot_w64(l + 64 < NBUCK && tab[384 + 64 + l] <= ci);
        const int b = __builtin_popcountll(m0) + __builtin_popcountll(m1) - 1;
        u.aux = b; u.pm = ci - tab[384 + b]; return true;
    }
    __device__ __forceinline__ void addr(const pg::Unit& u, const char*& abase_, const char*& bbase, const char*& bbase2) const {
        const int b = u.aux, g = b / 28, p = b % 28;
        int lo = 0, rem = p;
#pragma unroll 1
        while (rem >= 7 - lo) { rem -= 7 - lo; ++lo; }
        const int hi = lo + 1 + rem;
        abase_ = A + (size_t)(tab[128 + b] + u.pm * 256) * 512 * 2;
        bbase = Bt + ((size_t)(g * 8 + lo) * 1024 + (size_t)u.pn * 256) * 256 * 2;
        bbase2 = Bt + ((size_t)(g * 8 + hi) * 1024 + (size_t)u.pn * 256) * 256 * 2; }
    __device__ __forceinline__ void addr_g(const pg::Unit&, const int (&)[2], const int (&)[2], unsigned (&)[2][2], const char*&) const {}
};
__device__ __forceinline__ void moe2_fetch(LAS const int* tokl, const bf16_t* MU, size_t colo, int wid, int rsub, int ai, int m, int (&tk)[2], u32x4 (&mv)[2]) {
#pragma unroll
    for (int i = 0; i < 2; ++i) { const int r2 = 4 * wid + 2 * i + rsub, trow = 128 * ai + 64 * (r2 >> 4) + 16 * m + (r2 & 15);
        tk[i] = tokl[trow]; mv[i] = (u32x4){0u, 0u, 0u, 0u};
        if (tk[i] >= 0) mv[i] = *(const u32x4*)(MU + (size_t)tk[i] * 1024 + colo); }
}
struct EpiMoe2 {
    bf16_t* H2B; const bf16_t* MU; const int* BLIST; float* SSQ2; LAS const int* tab; LAS int* tokl;
    __device__ __forceinline__ void operator()(const f32x4 (&acc)[2][2][4][2], const pg::Unit& u, int wr, int wc, int fr, int fq, LAS unsigned char* stage, int wid) const {
        const int b = u.aux, lane = fr + 16 * fq, rk0 = u.pm * 256, nvalid = tab[256 + b] - rk0, tid = wid * 64 + lane;
        if (tid < 256) tokl[tid] = (tid < nvalid) ? BLIST[(size_t)b * T + rk0 + tid] : -1;
        asm volatile("s_waitcnt lgkmcnt(0)\n\ts_barrier" ::: "memory");
        const int ch = lane & 31, rsub = lane >> 5, rr = 16 * wr + fr; const size_t colo = (size_t)u.pn * 256 + ch * 8;
        int tk[2]; u32x4 mv[2];
        moe2_fetch(tokl, MU, colo, wid, rsub, 0, 0, tk, mv);
#pragma unroll
        for (int it = 0; it < 8; ++it) { const int ai = it >> 2, m = it & 3;
            u32x4 w[2];
#pragma unroll
            for (int bj = 0; bj < 2; ++bj) { const f32x4 v0 = acc[ai][bj][m][0], v1 = acc[ai][bj][m][1];
                w[bj].x = cvt_pk_bf16(v0[0], v0[1]); w[bj].y = cvt_pk_bf16(v0[2], v0[3]); w[bj].z = cvt_pk_bf16(v1[0], v1[1]); w[bj].w = cvt_pk_bf16(v1[2], v1[3]); }
            *(LAS u32x4*)(stage + rr * pg::EPI_ROWB + (32 * wc + 8 * fq) * 2) = w[0];
            *(LAS u32x4*)(stage + rr * pg::EPI_ROWB + (128 + 32 * wc + 8 * fq) * 2) = w[1];
            asm volatile("s_waitcnt lgkmcnt(0)\n\ts_barrier" ::: "memory");
            int tkn[2] = {-1, -1}; u32x4 mvn[2] = {(u32x4){0u, 0u, 0u, 0u}, (u32x4){0u, 0u, 0u, 0u}};
            if (it < 7) moe2_fetch(tokl, MU, colo, wid, rsub, (it + 1) >> 2, (it + 1) & 3, tkn, mvn);
#pragma unroll
            for (int i = 0; i < 2; ++i) { const int r2 = 4 * wid + 2 * i + rsub;
                const u32x4 v = *(const LAS u32x4*)(stage + r2 * pg::EPI_ROWB + ch * 16); const u32x4 hh = mv[i];
                float h[8]; h[0] = bf16lo(v.x) + bf16lo(hh.x); h[1] = bf16hi(v.x) + bf16hi(hh.x); h[2] = bf16lo(v.y) + bf16lo(hh.y); h[3] = bf16hi(v.y) + bf16hi(hh.y);
                h[4] = bf16lo(v.z) + bf16lo(hh.z); h[5] = bf16hi(v.z) + bf16hi(hh.z); h[6] = bf16lo(v.w) + bf16lo(hh.w); h[7] = bf16hi(v.w) + bf16hi(hh.w);
                float ss = ((h[0] * h[0] + h[1] * h[1]) + (h[2] * h[2] + h[3] * h[3])) + ((h[4] * h[4] + h[5] * h[5]) + (h[6] * h[6] + h[7] * h[7]));
                if (tk[i] < 0) ss = 0.f;
                ss += __shfl_xor(ss, 16); ss += __shfl_xor(ss, 8); ss += __shfl_xor(ss, 4); ss += __shfl_xor(ss, 2); ss += __shfl_xor(ss, 1);
                if (tk[i] >= 0) { u32x4 o; o.x = cvt_pk_bf16(h[0], h[1]); o.y = cvt_pk_bf16(h[2], h[3]); o.z = cvt_pk_bf16(h[4], h[5]); o.w = cvt_pk_bf16(h[6], h[7]);
                    *(u32x4*)(H2B + (size_t)tk[i] * 1024 + colo) = o;
                    if (ch == 0) SSQ2[(size_t)tk[i] * 4 + u.pn] = ss; } }
            asm volatile("s_waitcnt lgkmcnt(0)\n\ts_barrier" ::: "memory");
#pragma unroll
            for (int i = 0; i < 2; ++i) { tk[i] = tkn[i]; mv[i] = mvn[i]; }
        }
    }
};
__device__ __forceinline__ void p6a_moe_up(const Frame& F) {
    unsigned char* ws = F.ws; moe_build_tables(F);
    LAS const int* tab = (LAS const int*)(F.lds + MOE_TAB);
    MoeSched1 S{(const char*)(ws + WS_M), (const char*)(ws + WS_WGU), (const int*)(ws + WS_LIST), tab, F.G, F.vcu};
    EpiMoe1 E{(bf16_t*)(ws + WS_HID2), (const float*)(ws + WS_RS), (const float*)(ws + WS_GS), (const int*)(ws + WS_DST), tab};
    pg::gemm_phase(F.lds, S, E, 1024, F.wave);
}
__device__ __forceinline__ void p6b_moe_down(const Frame& F) {
    unsigned char* ws = F.ws; moe_build_tables(F);
    LAS const int* tab = (LAS const int*)(F.lds + MOE_TAB);
    MoeSched2 S{(const char*)(ws + WS_HID2), (const char*)(ws + WS_WD), tab, F.G, F.vcu};
    EpiMoe2 E{(bf16_t*)(ws + WS_H2B), (const bf16_t*)(ws + WS_M), (const int*)(ws + WS_BLIST), (float*)(ws + WS_SSQ2), tab, (LAS int*)(F.lds + MOE_TOKL)};
    pg::gemm_phase(F.lds, S, E, 512, F.wave);
}
struct EpiPle {
    bf16_t* G; const bf16_t* PP; const float* RS2;
    __device__ __forceinline__ void operator()(const f32x4 (&acc)[2][2][4][2], const pg::Unit& u, int wr, int wc, int fr, int fq, LAS unsigned char* stage, int wid) const {
        float rs[2][4];
#pragma unroll
        for (int ai = 0; ai < 2; ++ai)
#pragma unroll
            for (int m = 0; m < 4; ++m) { const f32x4 q = *(const f32x4*)(RS2 + (size_t)(u.pm * 256 + ai * 128 + wr * 64 + m * 16 + fr) * 4);
                rs[ai][m] = -1.0f / sqrtf(((q[0] + q[1]) + (q[2] + q[3])) * (1.f / 1024.f) + EPS);
                if (m == 3) asm volatile("" : "+v"(rs[ai][0]), "+v"(rs[ai][1]), "+v"(rs[ai][2]), "+v"(rs[ai][3]) :: "memory"); }
#pragma unroll
        for (int ai = 0; ai < 2; ++ai) {
            u32x4 pp[4][2];
#pragma unroll
            for (int m = 0; m < 4; ++m) { const int row = u.pm * 256 + ai * 128 + wr * 64 + m * 16 + fr;
#pragma unroll
                for (int bj = 0; bj < 2; ++bj) pp[m][bj] = *(const u32x4*)(PP + (size_t)row * 1024 + u.pn * 256 + bj * 128 + wc * 32 + 8 * fq); }
#pragma unroll
            for (int m = 0; m < 4; ++m) { const int row = u.pm * 256 + ai * 128 + wr * 64 + m * 16 + fr; const float nr = rs[ai][m];
#pragma unroll
                for (int bj = 0; bj < 2; ++bj) { const size_t off = (size_t)row * 1024 + u.pn * 256 + bj * 128 + wc * 32 + 8 * fq;
                    const u32x4 p4 = pp[m][bj];
                    const f32x4 a0 = acc[ai][bj][m][0] * nr, a1 = acc[ai][bj][m][1] * nr; u32x4 w;
                    w.x = cvt_pk_bf16(bf16lo(p4.x) / (1.0f + __expf(a0[0])), bf16hi(p4.x) / (1.0f + __expf(a0[1])));
                    w.y = cvt_pk_bf16(bf16lo(p4.y) / (1.0f + __expf(a0[2])), bf16hi(p4.y) / (1.0f + __expf(a0[3])));
                    w.z = cvt_pk_bf16(bf16lo(p4.z) / (1.0f + __expf(a1[0])), bf16hi(p4.z) / (1.0f + __expf(a1[1])));
                    w.w = cvt_pk_bf16(bf16lo(p4.w) / (1.0f + __expf(a1[2])), bf16hi(p4.w) / (1.0f + __expf(a1[3])));
                    *(u32x4*)(G + off) = w; } }
            asm volatile("" ::: "memory");
        }
    }
};
__device__ __forceinline__ void p8_ple(const Frame& F, const Args& a) {
    unsigned char* ws = F.ws;
    pg::DenseSched S{(const char*)(ws + WS_H2B), (const char*)(ws + WS_WPG), 1024, 1024, T / 256, 4, F.G, (int)blockIdx.x};
    EpiPle E{(bf16_t*)(ws + WS_D), (const bf16_t*)(ws + WS_PP), (const float*)(ws + WS_SSQ2)};
    pg::gemm_phase(F.lds, S, E, 1024, F.wave);
}
__device__ __forceinline__ void p9_final(const Frame& F, const Args& a) {
    const int lane = lane_id(); float* H = a.out; const float* gf = a.in[22]; const bf16_t* Gm = (const bf16_t*)(F.ws + WS_D); const bf16_t* H2B = (const bf16_t*)(F.ws + WS_H2B);
    const int gw = F.vcu * NWAVES + F.wave, NGW = F.G * NWAVES;
    f32x4 g[4];
#pragma unroll
    for (int j = 0; j < 4; ++j) g[j] = ((const f32x4*)gf)[lane + 64 * j];
    for (int row = gw; row < T; row += NGW) {
        f32x4 v[4]; float s = 0.f;
#pragma unroll
        for (int j = 0; j < 4; ++j) { const u32x2 hh = ((const u32x2*)(H2B + (size_t)row * 1024))[lane + 64 * j], gg = ((const u32x2*)(Gm + (size_t)row * 1024))[lane + 64 * j];
            v[j].x = bf16lo(hh.x) + bf16lo(gg.x); v[j].y = bf16hi(hh.x) + bf16hi(gg.x); v[j].z = bf16lo(hh.y) + bf16lo(gg.y); v[j].w = bf16hi(hh.y) + bf16hi(gg.y);
            s += (v[j].x * v[j].x + v[j].y * v[j].y) + (v[j].z * v[j].z + v[j].w * v[j].w); }
        const float rstd = 1.0f / sqrtf(wsum64(s) * (1.f / 1024.f) + EPS);
#pragma unroll
        for (int j = 0; j < 4; ++j) ((f32x4*)(H + (size_t)row * 1024))[lane + 64 * j] = v[j] * rstd * g[j];
    }
}

__global__ void __launch_bounds__(512, 2) mega(Args args) {
    extern __shared__ __attribute__((aligned(16))) unsigned char lds_raw[];
    Frame F;
    F.lds = (LAS unsigned char*)lds_raw;
    F.wave = __builtin_amdgcn_readfirstlane(threadIdx.x >> 6);
    F.G = gridDim.x; { const int bx = blockIdx.x; F.vcu = (F.G % 8 == 0) ? (bx % 8) * (F.G / 8) + bx / 8 : bx; }
    F.ws = args.ws; F.ctl = (unsigned*)(args.ws + WS_CTL);
    volatile LAS unsigned* MISC = (volatile LAS unsigned*)(F.lds + MISC_OFF);
    for (int u = threadIdx.x; u < (LDS_BYTES - LDSCTL_OFF) / 4; u += NWAVES * 64) ((LAS unsigned*)(F.lds + LDSCTL_OFF))[u] = 0u;
    __syncthreads();
    XcdBarrier bar = xcd_barrier_post(F.ctl + CW_BAR + args.li * XCD_BAR_WORDS, MISC + 8);
    const int lo = args.ph_lo, hi = args.ph_hi;
#define IN(k) (lo <= (k) && (k) < hi)
#define BOTH(k) (IN(k) && IN((k) + 1))
    if (IN(0)) { p0_prologue(F, args); p0_router_table(F, args); if (BOTH(0)) xcd_barrier(bar); }
    if (IN(1)) { p1_inproj(F); if (BOTH(1)) xcd_barrier(bar); }
    if (IN(2)) { p2_upproj(F); if (BOTH(2)) xcd_barrier(bar); }
    if (IN(3)) { p3_mla(F); p3_mixerA(F); if (BOTH(3)) xcd_barrier(bar); }
    if (IN(4)) { p35_mix(F, args); if (BOTH(4)) xcd_barrier(bar); }
    if (IN(5)) { p4_wo(F, args); if (BOTH(5)) xcd_barrier(bar); }
    if (IN(6)) { p5_router(F, args); if (BOTH(6)) xcd_barrier(bar); }
    if (IN(7)) { p6a_moe_up(F); if (BOTH(7)) xcd_barrier(bar); }
    if (IN(8)) { p6b_moe_down(F); if (BOTH(8)) xcd_barrier(bar); }
    if (IN(9)) { p8_ple(F, args); if (BOTH(9)) xcd_barrier(bar); }
    if (IN(10)) { p9_final(F, args); }
#undef IN
#undef BOTH
}
constexpr int NPHASES = 11;

extern "C" void kernel_launch(void* const* d_in, const int* in_sizes, int n_in, void* d_out, int out_size, void* d_ws, size_t ws_size, hipStream_t stream) {
    static int grid = 0;
    if (grid == 0) {
        if (n_in != 23 || ws_size < (size_t)512 * MiB || out_size != T * DM) { fprintf(stderr, "kernel_launch: unexpected n_in %d / ws_size %zu / out_size %d\n", n_in, ws_size, out_size); grid = -1; return; }
        int dev = 0, cus = 0;
        if (hipGetDevice(&dev) != hipSuccess || hipDeviceGetAttribute(&cus, hipDeviceAttributeMultiprocessorCount, dev) != hipSuccess) { grid = -1; return; }
        if (hipFuncSetAttribute((const void*)mega, hipFuncAttributeMaxDynamicSharedMemorySize, LDS_BYTES) != hipSuccess) { fprintf(stderr, "kernel_launch: hipFuncSetAttribute failed\n"); grid = -1; return; }
        int per_cu = 0;
        if (hipOccupancyMaxActiveBlocksPerMultiprocessor(&per_cu, (const void*)mega, NWAVES * 64, LDS_BYTES) != hipSuccess || per_cu < 1) { fprintf(stderr, "kernel_launch: occupancy query says %d\n", per_cu); }
        (void)hipGetLastError();
        grid = cus;
    }
    if (grid < 0) return;
    unsigned char* ws = (unsigned char*)d_ws;
    hipMemsetAsync(ws + WS_CTL, 0, CTL_ZERO_BYTES, stream);
    Args a{};
    for (int i = 0; i < 23; ++i) a.in[i] = (const float*)d_in[i];
    a.out = (float*)d_out; a.ws = ws; a.ph_lo = 0; a.ph_hi = NPHASES; a.li = 0; a.pad = 0;
    hipLaunchKernelGGL(mega, dim3(grid), dim3(NWAVES * 64), LDS_BYTES, stream, a);
}
```

```cpp
#include <hip/hip_runtime.h>
#include <cstdint>
#include <cstdio>
#include <cmath>

#define LAS __attribute__((address_space(3)))
#define GAS __attribute__((address_space(1)))
typedef unsigned short bf16_t;
typedef short bf16x8 __attribute__((ext_vector_type(8)));
typedef short s16x4 __attribute__((ext_vector_type(4)));
typedef float f32x2 __attribute__((ext_vector_type(2)));
typedef float f32x4 __attribute__((ext_vector_type(4)));
typedef float f32x16 __attribute__((ext_vector_type(16)));
typedef unsigned u32x2 __attribute__((ext_vector_type(2)));
typedef unsigned u32x4 __attribute__((ext_vector_type(4)));

__device__ __forceinline__ unsigned cvt_pk_bf16(float lo, float hi) { unsigned r; asm volatile("v_cvt_pk_bf16_f32 %0, %1, %2" : "=v"(r) : "v"(lo), "v"(hi)); return r; }
__device__ __forceinline__ float bf16lo(unsigned w) { return __uint_as_float(w << 16); }
__device__ __forceinline__ float bf16hi(unsigned w) { return __uint_as_float(w & 0xffff0000u); }
__device__ __forceinline__ int lane_id() { int r; asm volatile("v_mbcnt_lo_u32_b32 %0, -1, 0\n\tv_mbcnt_hi_u32_b32 %0, -1, %0" : "=v"(r)); return r; }
__device__ __forceinline__ float wsum64(float v) {
#pragma unroll
    for (int o = 1; o < 64; o <<= 1) v += __shfl_xor(v, o);
    return v;
}

namespace pg {
constexpr int BM = 256, BK = 64, HALF = 128, HTB = HALF * BK * 2, STAGE_BYTES = 8 * HTB, NXCD = 8, WGM = 8;
__host__ __device__ __forceinline__ int lds_byte(int r, int c) { const int st = (r >> 4) * 2 + (c >> 5), rr = r & 15, cc = c & 31, ob = rr * 64 + cc * 2; return st * 1024 + (ob ^ (((ob >> 9) & 1) << 5)); }
__host__ __device__ __forceinline__ void stage_rc(int b, int& R, int& C) { const int st = b / 1024, sb = b % 1024, swz = sb ^ (((sb >> 9) & 1) << 5); R = (st >> 1) * 16 + swz / 64; C = (st & 1) * 32 + (swz % 64) / 2; }
__host__ __device__ __forceinline__ int perm32(int rho) { const int n = rho >> 4, i = rho & 15; return 8 * (i >> 2) + 4 * n + (i & 3); }

struct Unit { int pm, pn, aux; };

__device__ __forceinline__ bool static_unit(int nM, int nN, int G, int c, int i, int& pm, int& pn) {
    const int nwg = nM * nN; const long L = (long)i * G + c; if (L >= nwg) return false;
    int wgid = (int)L; { const int q = nwg / NXCD, r = nwg % NXCD, xcd = wgid % NXCD, off = wgid / NXCD; wgid = (xcd < r ? xcd * (q + 1) : r * (q + 1) + (xcd - r) * q) + off; }
    const int nig = WGM * nN, gid = wgid / nig, fm = gid * WGM, gsz = (nM - fm) < WGM ? (nM - fm) : WGM;
    pm = fm + ((wgid % nig) % gsz); pn = (wgid % nig) / gsz; return true;
}

struct DenseSched {
    static constexpr bool GATHER = false; static constexpr int KSPLIT = 0;
    const char* A; const char* Bt; int lda, K, nM, nN, G, c;
    __device__ __forceinline__ bool next(int i, Unit& u) const { u.aux = 0; return static_unit(nM, nN, G, c, i, u.pm, u.pn); }
    __device__ __forceinline__ int a_ld() const { return lda; }
    __device__ __forceinline__ void addr(const Unit& u, const char*& abase, const char*& bbase) const {
        abase = A + (size_t)u.pm * BM * lda * 2; bbase = Bt + (size_t)u.pn * BM * K * 2; }
    __device__ __forceinline__ void addr_g(const Unit&, const int (&)[2], const int (&)[2], unsigned (&)[2][2], const char*&) const {}
    __device__ __forceinline__ const char* abase() const { return A; }
};

constexpr int EPI_STAGE_OFF = 139264, EPI_ROWB = 528;
template <class StoreFn>
__device__ __forceinline__ void staged_rows(LAS unsigned char* stage, u32x4 w0, u32x4 w1, int ai, int m, int wid, int lane, const StoreFn& store) {
    const int wr = wid >> 2, wc = wid & 3, fr = lane & 15, fq = lane >> 4, rr = 16 * wr + fr;
    *(LAS u32x4*)(stage + rr * EPI_ROWB + (32 * wc + 8 * fq) * 2) = w0;
    *(LAS u32x4*)(stage + rr * EPI_ROWB + (128 + 32 * wc + 8 * fq) * 2) = w1;
    asm volatile("s_waitcnt lgkmcnt(0)\n\ts_barrier" ::: "memory");
#pragma unroll
    for (int i = 0; i < 2; ++i) { const int r2 = 4 * wid + 2 * i + (lane >> 5), ch = lane & 31;
        const u32x4 v = *(const LAS u32x4*)(stage + r2 * EPI_ROWB + ch * 16);
        store(128 * ai + 64 * (r2 >> 4) + 16 * m + (r2 & 15), ch, v); }
    asm volatile("s_waitcnt lgkmcnt(0)\n\ts_barrier" ::: "memory");
}

template <class Epi, class Sched>
__device__ __forceinline__ void gemm_phase(LAS unsigned char* lds, const Sched& S, const Epi& E, int K, int wid) {
    const int lane = lane_id(), tid = wid * 64 + lane, wr = wid >> 2, wc = wid & 3, fr = lane & 15, fq = lane >> 4;
    const int nt = K / BK;
    constexpr int KSPLIT = Sched::KSPLIT;
    const int KB = KSPLIT > 0 ? KSPLIT * BK : K;
    int Rr[2], Cc[2]; unsigned voffB[2];
#pragma unroll
    for (int i = 0; i < 2; ++i) { int R, C; stage_rc(tid * 16 + i * 8192, R, C); Rr[i] = R; Cc[i] = C; const int Rb = (R & ~31) + perm32(R & 31); voffB[i] = (unsigned)(Rb * KB + C) * 2u; }
    const size_t kstep = (size_t)(BK * 2);
    const size_t hstepB = (size_t)HALF * KB * 2;
    const unsigned ldsw = (unsigned)wid * 1024u;
    const int aoff = lds_byte(wr * 64 + fr, fq * 8), boff = lds_byte(wc * 32 + fr, fq * 8);
    const char* const Ab = S.abase();
    constexpr bool GATHER = Sched::GATHER;
    unsigned voffA[2];
#pragma unroll
    for (int i = 0; i < 2; ++i) voffA[i] = (unsigned)(Rr[i] * S.a_ld() + Cc[i]) * 2u;
    const size_t hstepA = (size_t)HALF * S.a_ld() * 2;
#define PG_SA(b, h) (((b) * 2 + (h)) * HTB)
#define PG_SB(b, h) ((4 + (b) * 2 + (h)) * HTB)
#define PG_STAGEB(bufoff, gbase) do { _Pragma("unroll") for (int _i = 0; _i < 2; ++_i) \
        __builtin_amdgcn_global_load_lds((const unsigned*)((const char*)(gbase) + voffB[_i]), (LAS unsigned*)(lds + (bufoff) + ldsw + _i * 8192), 16, 0, 0); } while (0)
#define PG_STAGEA(bufoff, uptr, offs, h, kb) do { _Pragma("unroll") for (int _i = 0; _i < 2; ++_i) { \
        const char* _src; if constexpr (GATHER) _src = Ab + (size_t)(offs)[h][_i] + (kb); else _src = (uptr) + (h) * hstepA + (kb) + voffA[_i]; \
        __builtin_amdgcn_global_load_lds((const unsigned*)_src, (LAS unsigned*)(lds + (bufoff) + ldsw + _i * 8192), 16, 0, 0); } } while (0)
#define PG_LDA(dst, b, h) do { _Pragma("unroll") for (int m = 0; m < 4; ++m) _Pragma("unroll") for (int k = 0; k < 2; ++k) dst[m][k] = *(const LAS bf16x8*)(lds + PG_SA(b, h) + aoff + m * 2048 + k * 1024); } while (0)
#define PG_LDB(dst, b, h) do { _Pragma("unroll") for (int n = 0; n < 2; ++n) _Pragma("unroll") for (int k = 0; k < 2; ++k) dst[n][k] = *(const LAS bf16x8*)(lds + PG_SB(b, h) + boff + n * 2048 + k * 1024); } while (0)
#define PG_MMA(ai, bj, At, Bt_) do { __builtin_amdgcn_s_setprio(1); _Pragma("unroll") for (int m = 0; m < 4; ++m) _Pragma("unroll") for (int n = 0; n < 2; ++n) _Pragma("unroll") for (int k = 0; k < 2; ++k) \
        acc[ai][bj][m][n] = __builtin_amdgcn_mfma_f32_16x16x32_bf16(Bt_[n][k], At[m][k], acc[ai][bj][m][n], 0, 0, 0); __builtin_amdgcn_s_setprio(0); } while (0)
#define PG_WAIT_V(n) asm volatile("s_waitcnt vmcnt(" #n ")" ::: "memory")
#define PG_WAIT_L(n) asm volatile("s_waitcnt lgkmcnt(" #n ")" ::: "memory")
#define PG_BAR __builtin_amdgcn_s_barrier()
#define PG_SCHED __builtin_amdgcn_sched_barrier(0)
    Unit cur, nxt; int ui = 0;
    if (!S.next(0, cur)) return;
    f32x4 acc[2][2][4][2];
#pragma unroll
    for (int a = 0; a < 2; ++a)
#pragma unroll
        for (int b = 0; b < 2; ++b)
#pragma unroll
            for (int m = 0; m < 4; ++m)
#pragma unroll
                for (int n = 0; n < 2; ++n) acc[a][b][m][n] = (f32x4){0.f, 0.f, 0.f, 0.f};
    bf16x8 At[4][2], B0[2][2], B1[2][2];
    unsigned cao[2][2], nao[2][2]; const char* cA = nullptr; const char* nA = nullptr; const char* cB; const char* nB; const char* cB2 = nullptr; const char* nB2 = nullptr;
    if constexpr (GATHER) S.addr_g(cur, Rr, Cc, cao, cB); else if constexpr (KSPLIT > 0) S.addr(cur, cA, cB, cB2); else S.addr(cur, cA, cB);
    PG_STAGEB(PG_SB(0, 0), cB); PG_STAGEB(PG_SB(0, 1), cB + hstepB); PG_STAGEA(PG_SA(0, 0), cA, cao, 0, 0); PG_STAGEA(PG_SA(0, 1), cA, cao, 1, 0);
    if (wr == 1) PG_BAR;
    PG_WAIT_V(2); PG_BAR;
    PG_STAGEB(PG_SB(1, 0), cB + kstep); PG_STAGEA(PG_SA(1, 0), cA, cao, 0, kstep); PG_STAGEB(PG_SB(1, 1), cB + hstepB + kstep);
    PG_WAIT_V(6); PG_BAR;
    for (;;) {
        const bool has_next = S.next(ui + 1, nxt);
        if (has_next) { if constexpr (GATHER) S.addr_g(nxt, Rr, Cc, nao, nB); else if constexpr (KSPLIT > 0) S.addr(nxt, nA, nB, nB2); else S.addr(nxt, nA, nB); }
        else { nB = cB; nA = cA; nB2 = cB2;
            if constexpr (GATHER) {
#pragma unroll
                for (int h = 0; h < 2; ++h)
#pragma unroll
                    for (int i = 0; i < 2; ++i) nao[h][i] = cao[h][i]; } }
#pragma clang loop unroll(disable)
        for (int t = 0; t < nt; t += 2) {
            const bool last = (t == nt - 2);
            const size_t k1 = (size_t)(t + 1) * kstep;
            const size_t k2 = last ? 0 : (size_t)(t + 2) * kstep, k3 = k2 + kstep;
            const char* b2;
            if constexpr (KSPLIT > 0) b2 = last ? nB : ((t + 2 >= KSPLIT) ? cB2 + (size_t)(t + 2 - KSPLIT) * kstep : cB + (size_t)(t + 2) * kstep);
            else b2 = last ? nB : cB + (size_t)(t + 2) * kstep;
            const char* b3 = b2 + kstep;
            unsigned a2o[2][2]; const char* a2 = last ? nA : cA;
            if constexpr (GATHER) {
#pragma unroll
                for (int h = 0; h < 2; ++h)
#pragma unroll
                    for (int i = 0; i < 2; ++i) a2o[h][i] = last ? nao[h][i] : cao[h][i]; }
            PG_LDB(B0, 0, 0); PG_LDB(B1, 0, 1); PG_SCHED; PG_LDA(At, 0, 0); PG_STAGEA(PG_SA(1, 1), cA, cao, 1, k1);
            PG_WAIT_V(8); PG_WAIT_L(0); PG_BAR; PG_MMA(0, 0, At, B0); PG_MMA(0, 1, At, B1); PG_BAR; PG_SCHED;
            PG_LDA(At, 0, 1); PG_STAGEB(PG_SB(0, 0), b2); PG_STAGEB(PG_SB(0, 1), b2 + hstepB); PG_STAGEA(PG_SA(0, 0), a2, a2o, 0, k2);
            PG_WAIT_V(8); PG_WAIT_L(0); PG_BAR; PG_MMA(1, 0, At, B0); PG_MMA(1, 1, At, B1); PG_BAR; PG_SCHED;
            PG_LDB(B0, 1, 0); PG_LDB(B1, 1, 1); PG_SCHED; PG_LDA(At, 1, 0); PG_STAGEA(PG_SA(0, 1), a2, a2o, 1, k2);
            PG_WAIT_V(8); PG_WAIT_L(0); PG_BAR; PG_MMA(0, 0, At, B0); PG_MMA(0, 1, At, B1); PG_BAR; PG_SCHED;
            PG_LDA(At, 1, 1); PG_STAGEB(PG_SB(1, 0), b3); PG_STAGEB(PG_SB(1, 1), b3 + hstepB); PG_STAGEA(PG_SA(1, 0), a2, a2o, 0, k3);
            PG_WAIT_V(8); PG_WAIT_L(0); PG_BAR; PG_MMA(1, 0, At, B0); PG_MMA(1, 1, At, B1); PG_BAR; PG_SCHED;
        }
        if (wr == 0) PG_BAR;
        { const int l2 = lane_id();
          E(acc, cur, wr, wc, l2 & 15, l2 >> 4, lds + EPI_STAGE_OFF, wid); }
        if (!has_next) break;
#pragma unroll
        for (int a = 0; a < 2; ++a)
#pragma unroll
            for (int b = 0; b < 2; ++b)
#pragma unroll
                for (int m = 0; m < 4; ++m)
#pragma unroll
                    for (int n = 0; n < 2; ++n) acc[a][b][m][n] = (f32x4){0.f, 0.f, 0.f, 0.f};
        cur = nxt; cB = nB; cA = nA; cB2 = nB2;
        if constexpr (GATHER) {
#pragma unroll
            for (int h = 0; h < 2; ++h)
#pragma unroll
                for (int i = 0; i < 2; ++i) cao[h][i] = nao[h][i]; }
        ++ui;
        if (wr == 1) PG_BAR;
    }
    PG_WAIT_V(0);
    PG_BAR;
#undef PG_SA
#undef PG_SB
#undef PG_STAGEA
#undef PG_STAGEB
#undef PG_LDA
#undef PG_LDB
#undef PG_MMA
#undef PG_WAIT_V
#undef PG_WAIT_L
#undef PG_BAR
#undef PG_SCHED
}
}

#define XB_TMO      128
#define XB_XCNT(j)  (256  + 64 * (j))
#define XB_XSUB(j)  (1280 + 64 * (j))
#define XB_XGEN(j)  (2304 + 64 * (j))
#define XB_TOP      3328
#define XB_TOPGEN   3392
#define XCD_BAR_WORDS 3456
#define XB_SPIN_CAP (1u << 22)
__device__ __forceinline__ unsigned xb_ld(unsigned* p)              { return __hip_atomic_load(p, __ATOMIC_RELAXED, __HIP_MEMORY_SCOPE_AGENT); }
__device__ __forceinline__ unsigned xb_add(unsigned* p, unsigned v) { return __hip_atomic_fetch_add(p, v, __ATOMIC_RELAXED, __HIP_MEMORY_SCOPE_AGENT); }
__device__ __forceinline__ unsigned xb_xcc_id() { return (unsigned)__builtin_amdgcn_s_getreg((3 << 11) | 20) & 0xFu; }
#define XB_SPIN(cond, bar) do { unsigned _sp = 0; while (cond) { __builtin_amdgcn_s_sleep(1); \
    if ((++_sp & 255u) == 0u) { if (xb_ld(&(bar)[XB_TMO])) break; if (_sp > XB_SPIN_CAP) { atomicAdd(&(bar)[XB_TMO], 1u); break; } } } } while (0)
struct XcdBarrier { unsigned* bar; unsigned x; volatile LAS unsigned* st; };
__device__ __forceinline__ XcdBarrier xcd_barrier_post(unsigned* bar, volatile LAS unsigned* st) {
    XcdBarrier b; b.bar = bar; b.x = xb_xcc_id(); b.st = st;
    if (threadIdx.x == 0) (void)xb_add(&bar[XB_XCNT(b.x)], 1u);
    return b;
}
__device__ __forceinline__ void xcd_barrier_complete(unsigned* bar, unsigned x, unsigned& nloc, unsigned& nx) {
    const unsigned G = gridDim.x * gridDim.y * gridDim.z;
    unsigned sum, cnt, mine, sp = 0u;
    for (;;) {
        sum = 0u; cnt = 0u; mine = 0u;
#pragma unroll
        for (unsigned j = 0; j < 16; ++j) { const unsigned c = xb_ld(&bar[XB_XCNT(j)]); sum += c; cnt += (c > 0u) ? 1u : 0u; mine = (j == x) ? c : mine; }
        if (sum == G) break;
        __builtin_amdgcn_s_sleep(1);
        if ((++sp & 255u) == 0u) { if (xb_ld(&bar[XB_TMO])) break; if (sp > XB_SPIN_CAP) { atomicAdd(&bar[XB_TMO], 1u); break; } }
    }
    nloc = mine > 0u ? mine : 1u; nx = cnt > 0u ? cnt : 1u;
}
__device__ __forceinline__ void xcd_barrier(const XcdBarrier& b) {
    asm volatile("s_waitcnt vmcnt(0)" ::: "memory");
    __syncthreads();
    if (threadIdx.x == 0) {
        unsigned* bar = b.bar;
        __builtin_amdgcn_s_waitcnt(0);
        unsigned nloc = b.st[0], nx = b.st[1];
        if (nloc == 0u) { xcd_barrier_complete(bar, b.x, nloc, nx); b.st[0] = nloc; b.st[1] = nx; }
        const unsigned old = xb_add(&bar[XB_XSUB(b.x)], 1u);
        const unsigned gen = old / nloc;
        if (old + 1u == (gen + 1u) * nloc) {
            __builtin_amdgcn_fence(__ATOMIC_RELEASE, "agent");
            asm volatile("s_waitcnt vmcnt(0)" ::: "memory");
            const unsigned og = xb_add(&bar[XB_TOP], 1u);
            const unsigned tg = og / nx;
            if (og + 1u == (tg + 1u) * nx) xb_add(&bar[XB_TOPGEN], 1u);
            else XB_SPIN(xb_ld(&bar[XB_TOPGEN]) == tg, bar);
            __builtin_amdgcn_fence(__ATOMIC_ACQUIRE, "agent");
            xb_add(&bar[XB_XGEN(b.x)], 1u);
            asm volatile("s_waitcnt vmcnt(0)" ::: "memory");
        } else {
            XB_SPIN(xb_ld(&bar[XB_XGEN(b.x)]) == gen, bar);
            __builtin_amdgcn_fence(__ATOMIC_ACQUIRE, "agent");
            asm volatile("s_waitcnt vmcnt(0)" ::: "memory");
        }
    }
    __syncthreads();
}

constexpr int NB = 8, SEQ = 4096, T = NB * SEQ, DM = 1024;
constexpr int INW = 2208, INWP = 2304;
constexpr int QLORA = 384, KVLORA = 256;
constexpr float EPS = 1e-6f;
constexpr float LOG2E = 1.4426950408889634f;
constexpr float QA_SCALE = 0.125f * LOG2E;
constexpr float MLA_QSCALE = 0.10206207261596577f * LOG2E;
constexpr int NWAVES = 8;

constexpr size_t MiB = 1u << 20;
constexpr size_t WS_CTL = 0, CTL_ZERO_BYTES = 1 * MiB;
constexpr size_t WS_ROPE = 1 * MiB;
constexpr size_t WS_SSQ = 2 * MiB;
constexpr size_t WS_WIN = 5 * MiB, WS_WUQ = 10 * MiB, WS_WUKV = 11 * MiB, WS_WO = 12 * MiB, WS_WPG = 14 * MiB, WS_WPP = 16 * MiB, WS_WGU = 17 * MiB, WS_WD = 49 * MiB;
constexpr size_t WS_XN = 65 * MiB;
constexpr size_t WS_P16 = 305 * MiB;
constexpr size_t WS_PP = 145 * MiB;
constexpr size_t WS_QA = 209 * MiB, WS_KA = 241 * MiB, WS_VA = 273 * MiB;
static_assert(WS_KA - WS_QA == (size_t)T * 512 * 2 && WS_VA - WS_KA == (size_t)T * 512 * 2, "QA|KA|VA contiguous");
constexpr size_t WS_CQKV = 305 * MiB;
constexpr size_t WS_QB = 345 * MiB, WS_KB = 393 * MiB;
constexpr size_t WS_VB = 441 * MiB;
constexpr size_t WS_OB = 473 * MiB;
constexpr size_t WS_OAP0 = 65 * MiB, WS_OAP1 = 97 * MiB, WS_OAP2 = 305 * MiB;
constexpr size_t WS_LSE = 129 * MiB;
constexpr size_t WS_MIXED = 209 * MiB;
constexpr size_t WS_M = 65 * MiB;
constexpr size_t WS_Y = 209 * MiB;
constexpr size_t WS_HID = 353 * MiB;
constexpr size_t WS_LIST = 132 * MiB;
constexpr size_t WS_RS2 = 136 * MiB + 896 * 1024;
constexpr size_t WS_TOKINFO = 136 * MiB;
constexpr int CW_BAR = 4096, CW_CNT = 16384, CW_Q = 20480;

constexpr int RING_BYTES = 131072;
constexpr int LDSCTL_OFF = RING_BYTES, MISC_OFF = LDSCTL_OFF + 320;
constexpr int LDS_BYTES = 163840;

struct Args { const float* in[23]; float* out; unsigned char* ws; int ph_lo, ph_hi, li, pad; };
struct Frame {
    LAS unsigned char* lds;
    int wave, vcu, G;
    unsigned char* ws; unsigned* ctl;
};

__device__ __forceinline__ void p0_transpose_item(const float* __restrict__ W, int ldw, int k0, int n0, bf16_t* WT, int ldd, int drow0, const float* __restrict__ gain, LAS float* scr, int lane) {
    const int kq = lane >> 3, n4 = (lane & 7) * 4;
    f32x4 v[8];
#pragma unroll
    for (int i = 0; i < 8; ++i) v[i] = *(const f32x4*)(W + (size_t)(k0 + kq + 8 * i) * ldw + n0 + n4);
#pragma unroll
    for (int i = 0; i < 8; ++i) { const int kk = kq + 8 * i; f32x4 x = v[i]; if (gain) x = x * gain[k0 + kk];
        scr[kk * 33 + n4] = x[0]; scr[kk * 33 + n4 + 1] = x[1]; scr[kk * 33 + n4 + 2] = x[2]; scr[kk * 33 + n4 + 3] = x[3]; }
    asm volatile("s_waitcnt lgkmcnt(0)" ::: "memory");
    const int c = lane & 7;
#pragma unroll
    for (int j = 0; j < 4; ++j) { const int n = (lane >> 3) + 8 * j; const LAS float* s = scr + (8 * c) * 33 + n;
        u32x4 o; o.x = cvt_pk_bf16(s[0 * 33], s[1 * 33]); o.y = cvt_pk_bf16(s[2 * 33], s[3 * 33]); o.z = cvt_pk_bf16(s[4 * 33], s[5 * 33]); o.w = cvt_pk_bf16(s[6 * 33], s[7 * 33]);
        *(u32x4*)(WT + (size_t)(drow0 + n) * ldd + k0 + 8 * c) = o; }
    asm volatile("s_waitcnt lgkmcnt(0)" ::: "memory");
}
__device__ __forceinline__ void rms_row_to_bf16(const float* xrow, const float* __restrict__ g, bf16_t* orow, int lane) {
    const f32x4* xr = (const f32x4*)xrow + lane; const f32x4* gr = (const f32x4*)g + lane;
    f32x4 v[4]; float s = 0.f;
#pragma unroll
    for (int j = 0; j < 4; ++j) { v[j] = xr[64 * j]; s += (v[j].x * v[j].x + v[j].y * v[j].y) + (v[j].z * v[j].z + v[j].w * v[j].w); }
    const float rstd = 1.0f / sqrtf(wsum64(s) * (1.f / 1024.f) + EPS);
    u32x2* o8 = (u32x2*)orow + lane;
#pragma unroll
    for (int j = 0; j < 4; ++j) { const f32x4 gg = gr[64 * j]; u32x2 w; w.x = cvt_pk_bf16(v[j].x * rstd * gg.x, v[j].y * rstd * gg.y); w.y = cvt_pk_bf16(v[j].z * rstd * gg.z, v[j].w * rstd * gg.w); o8[64 * j] = w; }
}

__device__ __forceinline__ void p0_prologue(const Frame& F, const Args& a) {
    LAS float* scr = (LAS float*)(F.lds + F.wave * 16384);
    const int gw = F.vcu * NWAVES + F.wave, NGW = F.G * NWAVES, lane = lane_id();
    unsigned char* ws = F.ws;
    const float* w_in = a.in[3]; const float* g_cq = a.in[4]; const float* w_uq = a.in[5]; const float* g_ckv = a.in[6]; const float* w_ukv = a.in[7];
    const float* w_o = a.in[10]; const float* w_eg = a.in[16]; const float* w_eu = a.in[17]; const float* w_ed = a.in[18]; const float* w_pg = a.in[20]; const float* w_pp = a.in[21];
    constexpr int I_IN = 16 * 69, I_UQ = 6 * 24, I_UKV = 4 * 32, I_O = 16 * 32, I_PG = 16 * 32, I_PP = 4 * 32, I_EG = 32 * 16 * 8, I_EU = I_EG, I_ED = 32 * 4 * 32;
    constexpr int NITEMS = I_IN + I_UQ + I_UKV + I_O + I_PG + I_PP + I_EG + I_EU + I_ED;
    for (int it = gw; it < NITEMS; it += NGW) {
        int r = it;
        if (r < I_IN) { const int kb = r / 69, nb = r % 69; p0_transpose_item(w_in, INW, 64 * kb, 32 * nb, (bf16_t*)(ws + WS_WIN), 1024, 32 * nb, nullptr, scr, lane); continue; } r -= I_IN;
        if (r < I_UQ) { const int kb = r / 24, nb = r % 24; p0_transpose_item(w_uq, 768, 64 * kb, 32 * nb, (bf16_t*)(ws + WS_WUQ), QLORA, 32 * nb, g_cq, scr, lane); continue; } r -= I_UQ;
        if (r < I_UKV) { const int kb = r / 32, nb = r % 32; p0_transpose_item(w_ukv, 1024, 64 * kb, 32 * nb, (bf16_t*)(ws + WS_WUKV), KVLORA, 32 * nb, g_ckv, scr, lane); continue; } r -= I_UKV;
        if (r < I_O) { const int kb = r / 32, nb = r % 32; p0_transpose_item(w_o, 1024, 64 * kb, 32 * nb, (bf16_t*)(ws + WS_WO), 1024, 32 * nb, nullptr, scr, lane); continue; } r -= I_O;
        if (r < I_PG) { const int kb = r / 32, nb = r % 32; p0_transpose_item(w_pg, 1024, 64 * kb, 32 * nb, (bf16_t*)(ws + WS_WPG), 1024, 32 * nb, a.in[19], scr, lane); continue; } r -= I_PG;
        if (r < I_PP) { const int kb = r / 32, nb = r % 32; p0_transpose_item(w_pp, 1024, 64 * kb, 32 * nb, (bf16_t*)(ws + WS_WPP), 256, 32 * nb, nullptr, scr, lane); continue; } r -= I_PP;
        if (r < I_EG + I_EU) {
            const int up = r >= I_EG; if (up) r -= I_EG;
            const int e = r / 128, q = r % 128, kb = q / 8, nb = q % 8, n0 = 32 * nb;
            const int drow = (n0 >> 7) * 256 + (up ? 128 : 0) + (n0 & 127);
            p0_transpose_item((up ? w_eu : w_eg) + (size_t)e * 1024 * 256, 256, 64 * kb, n0, (bf16_t*)(ws + WS_WGU) + (size_t)e * 512 * 1024, 1024, drow, a.in[11], scr, lane); continue; }
        r -= I_EG + I_EU;
        { const int e = r / 128, q = r % 128, kb = q / 32, nb = q % 32;
          p0_transpose_item(w_ed + (size_t)e * 256 * 1024, 1024, 64 * kb, 32 * nb, (bf16_t*)(ws + WS_WD) + (size_t)e * 1024 * 256, 256, 32 * nb, nullptr, scr, lane); }
    }
    for (int i = gw * 64 + lane; i < 96 * 128; i += NGW * 64) ((u32x4*)((bf16_t*)(ws + WS_WIN) + (size_t)INW * 1024))[i] = (u32x4){0u, 0u, 0u, 0u};
    { const float* x = a.in[0]; const float* g_mix = a.in[2]; bf16_t* XN = (bf16_t*)(ws + WS_XN);
      f32x4 gg[4];
#pragma unroll
      for (int j = 0; j < 4; ++j) gg[j] = ((const f32x4*)g_mix)[lane + 64 * j];
      for (int m = gw * 2; m < T; m += NGW * 2) {
          f32x4 v0[4], v1[4]; float s0 = 0.f, s1 = 0.f;
#pragma unroll
          for (int j = 0; j < 4; ++j) { v0[j] = ((const f32x4*)(x + (size_t)m * DM))[lane + 64 * j]; v1[j] = ((const f32x4*)(x + (size_t)(m + 1) * DM))[lane + 64 * j]; }
#pragma unroll
          for (int j = 0; j < 4; ++j) { s0 += (v0[j].x * v0[j].x + v0[j].y * v0[j].y) + (v0[j].z * v0[j].z + v0[j].w * v0[j].w); s1 += (v1[j].x * v1[j].x + v1[j].y * v1[j].y) + (v1[j].z * v1[j].z + v1[j].w * v1[j].w); }
          const float r0 = 1.0f / sqrtf(wsum64(s0) * (1.f / 1024.f) + EPS), r1 = 1.0f / sqrtf(wsum64(s1) * (1.f / 1024.f) + EPS);
#pragma unroll
          for (int j = 0; j < 4; ++j) { u32x2 w0, w1;
              w0.x = cvt_pk_bf16(v0[j].x * r0 * gg[j].x, v0[j].y * r0 * gg[j].y); w0.y = cvt_pk_bf16(v0[j].z * r0 * gg[j].z, v0[j].w * r0 * gg[j].w);
              w1.x = cvt_pk_bf16(v1[j].x * r1 * gg[j].x, v1[j].y * r1 * gg[j].y); w1.y = cvt_pk_bf16(v1[j].z * r1 * gg[j].z, v1[j].w * r1 * gg[j].w);
              ((u32x2*)(XN + (size_t)m * DM))[lane + 64 * j] = w0; ((u32x2*)(XN + (size_t)(m + 1) * DM))[lane + 64 * j] = w1; } } }
    { float* cs = (float*)(ws + WS_ROPE); float* sn = cs + SEQ * 16;
      for (int idx = gw * 64 + lane; idx < SEQ * 16; idx += NGW * 64) {
          const int pos = idx >> 4, i = idx & 15;
          const float inv = 1.0f / powf(10000.0f, (float)(2 * i) / 32.0f);
          const float ang = (float)pos * inv;
          cs[idx] = (float)cos((double)ang); sn[idx] = (float)sin((double)ang); } }
}

struct EpiInProj {
    bf16_t *QA, *CQKV, *KB; float* SSQ; const float* CS; const float* SN;
    __device__ __forceinline__ void operator()(const f32x4 (&acc)[2][2][4][2], const pg::Unit& u, int wr, int wc, int fr, int fq, LAS unsigned char* stage, int wid) const {
        const int pn = u.pn;
        if (pn < 6) {
            bf16_t* const tile = QA + (size_t)(pn >> 1) * ((size_t)T * 512) + (size_t)u.pm * 256 * 512 + (pn & 1) * 256; const float sc = (pn < 2) ? QA_SCALE : 1.f;
            const int lane = fr + 16 * fq;
#pragma unroll
            for (int ai = 0; ai < 2; ++ai)
#pragma unroll
                for (int m = 0; m < 4; ++m) { u32x4 w[2];
#pragma unroll
                    for (int bj = 0; bj < 2; ++bj) { const f32x4 v0 = acc[ai][bj][m][0] * sc, v1 = acc[ai][bj][m][1] * sc;
                        w[bj].x = cvt_pk_bf16(v0[0], v0[1]); w[bj].y = cvt_pk_bf16(v0[2], v0[3]); w[bj].z = cvt_pk_bf16(v1[0], v1[1]); w[bj].w = cvt_pk_bf16(v1[2], v1[3]); }
                    pg::staged_rows(stage, w[0], w[1], ai, m, wid, lane, [tile](int trow, int ch, u32x4 v) { __builtin_nontemporal_store(v, (u32x4*)(tile + (size_t)trow * 512 + ch * 8)); }); }
        } else {
#pragma unroll
            for (int ai = 0; ai < 2; ++ai)
#pragma unroll
                for (int m = 0; m < 4; ++m) { const int row = u.pm * 256 + ai * 128 + wr * 64 + m * 16 + fr;
#pragma unroll
                    for (int bj = 0; bj < 2; ++bj) {
                        const f32x4 v0 = acc[ai][bj][m][0], v1 = acc[ai][bj][m][1];
                        if (pn < 8 || bj == 0) {
                            const int col = (pn - 6) * 256 + bj * 128 + wc * 32 + 8 * fq; u32x4 w;
                            w.x = cvt_pk_bf16(v0[0], v0[1]); w.y = cvt_pk_bf16(v0[2], v0[3]); w.z = cvt_pk_bf16(v1[0], v1[1]); w.w = cvt_pk_bf16(v1[2], v1[3]);
                            *(u32x4*)(CQKV + (size_t)row * 640 + col) = w;
                            float s = (v0[0] * v0[0] + v0[1] * v0[1]) + (v0[2] * v0[2] + v0[3] * v0[3]) + (v1[0] * v1[0] + v1[1] * v1[1]) + (v1[2] * v1[2] + v1[3] * v1[3]);
                            s += __shfl_xor(s, 16); s += __shfl_xor(s, 32);
                            if (fq == 0) SSQ[(size_t)row * 20 + (pn - 6) * 8 + bj * 4 + wc] = s;
                        } else if (wc == 0) {
                            const int pos = row & (SEQ - 1); const int ci = pos * 16 + 8 * (fq & 1);
                            const f32x4 c0 = *(const f32x4*)(CS + ci), c1 = *(const f32x4*)(CS + ci + 4), s0 = *(const f32x4*)(SN + ci), s1 = *(const f32x4*)(SN + ci + 4);
                            f32x4 p0, p1;
#pragma unroll
                            for (int j = 0; j < 4; ++j) { p0[j] = __shfl_xor(v0[j], 32); p1[j] = __shfl_xor(v1[j], 32); }
                            f32x4 o0, o1;
                            if (fq < 2) { o0 = v0 * c0 - p0 * s0; o1 = v1 * c1 - p1 * s1; }
                            else        { o0 = p0 * s0 + v0 * c0; o1 = p1 * s1 + v1 * c1; }
                            u32x4 w; w.x = cvt_pk_bf16(o0[0], o0[1]); w.y = cvt_pk_bf16(o0[2], o0[3]); w.z = cvt_pk_bf16(o1[0], o1[1]); w.w = cvt_pk_bf16(o1[2], o1[3]);
#pragma unroll
                            for (int h = 0; h < 8; ++h) *(u32x4*)(KB + (size_t)row * 768 + h * 96 + 64 + 8 * fq) = w;
                        }
                    } }
        }
    }
};
struct EpiStoreBf16 {
    bf16_t* O; int ldc;
    __device__ __forceinline__ void operator()(const f32x4 (&acc)[2][2][4][2], const pg::Unit& u, int wr, int wc, int fr, int fq, LAS unsigned char* stage, int wid) const {
        const int lane = fr + 16 * fq; bf16_t* const tile = O + (size_t)u.pm * 256 * ldc + u.pn * 256; const int ld = ldc;
#pragma unroll
        for (int ai = 0; ai < 2; ++ai)
#pragma unroll
            for (int m = 0; m < 4; ++m) { u32x4 w[2];
#pragma unroll
                for (int bj = 0; bj < 2; ++bj) { const f32x4 v0 = acc[ai][bj][m][0], v1 = acc[ai][bj][m][1];
                    w[bj].x = cvt_pk_bf16(v0[0], v0[1]); w[bj].y = cvt_pk_bf16(v0[2], v0[3]); w[bj].z = cvt_pk_bf16(v1[0], v1[1]); w[bj].w = cvt_pk_bf16(v1[2], v1[3]); }
                pg::staged_rows(stage, w[0], w[1], ai, m, wid, lane, [tile, ld](int trow, int ch, u32x4 v) { __builtin_nontemporal_store(v, (u32x4*)(tile + (size_t)trow * ld + ch * 8)); }); }
    }
};
struct EpiQUp {
    bf16_t* QB; const float* SSQ; const float* CS; const float* SN;
    __device__ __forceinline__ void operator()(const f32x4 (&acc)[2][2][4][2], const pg::Unit& u, int wr, int wc, int fr, int fq, LAS unsigned char* stage, int wid) const {
        float rstd[2][4];
#pragma unroll
        for (int ai = 0; ai < 2; ++ai)
#pragma unroll
            for (int m = 0; m < 4; ++m) { const int row = u.pm * 256 + ai * 128 + wr * 64 + m * 16 + fr;
                const f32x4 q0 = *(const f32x4*)(SSQ + (size_t)row * 20), q1 = *(const f32x4*)(SSQ + (size_t)row * 20 + 4), q2 = *(const f32x4*)(SSQ + (size_t)row * 20 + 8);
                const float ss = ((q0[0] + q0[1]) + (q0[2] + q0[3])) + ((q1[0] + q1[1]) + (q1[2] + q1[3])) + ((q2[0] + q2[1]) + (q2[2] + q2[3]));
                rstd[ai][m] = 1.0f / sqrtf(ss * (1.f / 384.f) + EPS);
                if (m == 3) asm volatile("" : "+v"(rstd[ai][0]), "+v"(rstd[ai][1]), "+v"(rstd[ai][2]), "+v"(rstd[ai][3]) :: "memory"); }
        const int G0 = u.pn * 8 + wc;
        const int rbj = (G0 % 3 == 2) ? 0 : (((G0 + 4) % 3 == 2) ? 1 : -1);
#pragma unroll
        for (int ai = 0; ai < 2; ++ai)
#pragma unroll
          for (int mh = 0; mh < 2; ++mh) {
            f32x4 c0[2], c1[2], s0[2], s1[2];
#pragma unroll
            for (int m = 0; m < 2; ++m) { c0[m] = f32x4{0.f, 0.f, 0.f, 0.f}; c1[m] = c0[m]; s0[m] = c0[m]; s1[m] = c0[m]; }
            if (rbj >= 0) {
#pragma unroll
                for (int m = 0; m < 2; ++m) { const int row = u.pm * 256 + ai * 128 + wr * 64 + (2 * mh + m) * 16 + fr;
                    const int pos = row & (SEQ - 1); const int ci = pos * 16 + 8 * (fq & 1);
                    c0[m] = *(const f32x4*)(CS + ci); c1[m] = *(const f32x4*)(CS + ci + 4); s0[m] = *(const f32x4*)(SN + ci); s1[m] = *(const f32x4*)(SN + ci + 4); }
            }
#pragma unroll
            for (int mm = 0; mm < 2; ++mm) { const int m = 2 * mh + mm; const int row = u.pm * 256 + ai * 128 + wr * 64 + m * 16 + fr;
#pragma unroll
                for (int bj = 0; bj < 2; ++bj) { const int G = G0 + bj * 4;
                    f32x4 v0 = acc[ai][bj][m][0] * rstd[ai][m], v1 = acc[ai][bj][m][1] * rstd[ai][m];
                    if (bj == rbj) {
                        f32x4 p0, p1;
#pragma unroll
                        for (int j = 0; j < 4; ++j) { p0[j] = __shfl_xor(v0[j], 32); p1[j] = __shfl_xor(v1[j], 32); }
                        if (fq < 2) { v0 = v0 * c0[mm] - p0 * s0[mm]; v1 = v1 * c1[mm] - p1 * s1[mm]; }
                        else        { v0 = p0 * s0[mm] + v0 * c0[mm]; v1 = p1 * s1[mm] + v1 * c1[mm]; }
                    }
                    v0 = v0 * MLA_QSCALE; v1 = v1 * MLA_QSCALE;
                    u32x4 w; w.x = cvt_pk_bf16(v0[0], v0[1]); w.y = cvt_pk_bf16(v0[2], v0[3]); w.z = cvt_pk_bf16(v1[0], v1[1]); w.w = cvt_pk_bf16(v1[2], v1[3]);
                    *(u32x4*)(QB + (size_t)row * 768 + G * 32 + 8 * fq) = w; } }
          }
    }
};
struct EpiKVUp {
    bf16_t *KB, *VB; const float* SSQ;
    __device__ __forceinline__ void operator()(const f32x4 (&acc)[2][2][4][2], const pg::Unit& u, int wr, int wc, int fr, int fq, LAS unsigned char* stage, int wid) const {
        float rstd[2][4];
#pragma unroll
        for (int ai = 0; ai < 2; ++ai)
#pragma unroll
            for (int m = 0; m < 4; ++m) { const int row = u.pm * 256 + ai * 128 + wr * 64 + m * 16 + fr;
                const f32x4 q0 = *(const f32x4*)(SSQ + (size_t)row * 20 + 12), q1 = *(const f32x4*)(SSQ + (size_t)row * 20 + 16);
                const float ss = ((q0[0] + q0[1]) + (q0[2] + q0[3])) + ((q1[0] + q1[1]) + (q1[2] + q1[3]));
                rstd[ai][m] = 1.0f / sqrtf(ss * (1.f / 256.f) + EPS);
                if (m == 3) asm volatile("" : "+v"(rstd[ai][0]), "+v"(rstd[ai][1]), "+v"(rstd[ai][2]), "+v"(rstd[ai][3]) :: "memory"); }
#pragma unroll
        for (int ai = 0; ai < 2; ++ai)
#pragma unroll
            for (int m = 0; m < 4; ++m) { const int row = u.pm * 256 + ai * 128 + wr * 64 + m * 16 + fr;
#pragma unroll
                for (int bj = 0; bj < 2; ++bj) { const int G = u.pn * 8 + bj * 4 + wc;
                    const int h = G >> 2, part = G & 3;
                    const f32x4 v0 = acc[ai][bj][m][0] * rstd[ai][m], v1 = acc[ai][bj][m][1] * rstd[ai][m];
                    u32x4 w; w.x = cvt_pk_bf16(v0[0], v0[1]); w.y = cvt_pk_bf16(v0[2], v0[3]); w.z = cvt_pk_bf16(v1[0], v1[1]); w.w = cvt_pk_bf16(v1[2], v1[3]);
                    if (part < 2) *(u32x4*)(KB + (size_t)row * 768 + h * 96 + part * 32 + 8 * fq) = w;
                    else          *(u32x4*)(VB + (size_t)row * 512 + h * 64 + (part - 2) * 32 + 8 * fq) = w; } }
    }
};

struct PPSched {
    static constexpr bool GATHER = false; static constexpr int KSPLIT = 0;
    const char* A; const char* Bt; int q, nP;
    __device__ __forceinline__ bool next(int i, pg::Unit& u) const { if (q < 0) return false; const int L = i * nP + q; if (L >= 512) return false; u.aux = 0; u.pm = L >> 2; u.pn = L & 3; return true; }
    __device__ __forceinline__ int a_ld() const { return 256; }
    __device__ __forceinline__ void addr(const pg::Unit& u, const char*& abase, const char*& bbase) const { abase = A + (size_t)u.pm * pg::BM * 256 * 2; bbase = Bt + (size_t)u.pn * pg::BM * 256 * 2; }
    __device__ __forceinline__ void addr_g(const pg::Unit&, const int (&)[2], const int (&)[2], unsigned (&)[2][2], const char*&) const {}
    __device__ __forceinline__ const char* abase() const { return A; }
};
__device__ __forceinline__ void pp_units(const Frame& F, int c, int nun) {
    unsigned char* ws = F.ws; const int r = nun % F.G, nP = F.G - r;
    PPSched S{(const char*)(ws + WS_P16), (const char*)(ws + WS_WPP), c - r, nP};
    EpiStoreBf16 E{(bf16_t*)(ws + WS_PP), 1024};
    pg::gemm_phase(F.lds, S, E, 256, F.wave);
}
__device__ __forceinline__ void p1_inproj(const Frame& F) {
    unsigned char* ws = F.ws;
    { pg::DenseSched S{(const char*)(ws + WS_XN), (const char*)(ws + WS_WIN), 1024, 1024, T / 256, INWP / 256, F.G, (int)blockIdx.x};
      EpiInProj E{(bf16_t*)(ws + WS_QA), (bf16_t*)(ws + WS_CQKV), (bf16_t*)(ws + WS_KB), (float*)(ws + WS_SSQ), (const float*)(ws + WS_ROPE), (const float*)(ws + WS_ROPE) + SEQ * 16};
      pg::gemm_phase(F.lds, S, E, 1024, F.wave); }
}
__device__ __forceinline__ void p2_upproj(const Frame& F) {
    unsigned char* ws = F.ws;
    { pg::DenseSched S{(const char*)(ws + WS_CQKV), (const char*)(ws + WS_WUQ), 640, QLORA, T / 256, 3, F.G, (int)blockIdx.x};
      EpiQUp E{(bf16_t*)(ws + WS_QB), (const float*)(ws + WS_SSQ), (const float*)(ws + WS_ROPE), (const float*)(ws + WS_ROPE) + SEQ * 16};
      pg::gemm_phase(F.lds, S, E, QLORA, F.wave); }
    { pg::DenseSched S{(const char*)(ws + WS_CQKV) + 384 * 2, (const char*)(ws + WS_WUKV), 640, KVLORA, T / 256, 4, F.G, (int)blockIdx.x};
      EpiKVUp E{(bf16_t*)(ws + WS_KB), (bf16_t*)(ws + WS_VB), (const float*)(ws + WS_SSQ)};
      pg::gemm_phase(F.lds, S, E, KVLORA, F.wave); }
}

namespace mla {
constexpr int QBLK = 32, KVBLK = 64, LDQ = 768, LDKk = 768, LDV = 512, LDO = 512;
constexpr float SCALE = 0.10206207261596577f;
constexpr int SHM_V = KVBLK * 64 * 2  , SHM_K = KVBLK * 256  ;
#define KSWZ(row, colB) ((row) * 256 + ((colB) ^ (((row) & 15) << 4)))
#define SBAR() __builtin_amdgcn_sched_barrier(0)
__device__ __forceinline__ int crow(int r, int hi) { return (r & 3) + 8 * (r >> 2) + 4 * hi; }

__device__ __forceinline__ int v_rd_base(int lane) { return ((lane & 3) << 3) | (((lane >> 2) & 3) << 6) | (((lane >> 4) & 1) << 5) | (((lane >> 5) & 1) << 8); }
constexpr int v_rd_off(int d0, int ks, int half) { return d0 * 512 + ks * 2048 + half * 1024; }
#define MLA_EXP2(x) __builtin_amdgcn_exp2f(x)
constexpr float THR2 = 8.f;
#define MX3(a, b, c) __builtin_fmaxf(__builtin_fmaxf((a), (b)), (c))
__device__ __forceinline__ void soft4(f32x16& p0, f32x16& p1, float& m_reg, float& l_reg, f32x16& negm, f32x16* o, float* al_l, bool first, bf16x8& pa0, bf16x8& pa1, bf16x8& pa2, bf16x8& pa3, int r32, int hi) {
  float ma = MX3(p0[0], p0[1], p0[2]), mb = MX3(p0[3], p0[4], p0[5]), mc = MX3(p0[6], p0[7], p0[8]), md = MX3(p0[9], p0[10], p0[11]);
  ma = MX3(ma, p0[12], p0[13]); mb = MX3(mb, p0[14], p0[15]); mc = MX3(mc, p1[0], p1[1]); md = MX3(md, p1[2], p1[3]);
  ma = MX3(ma, p1[4], p1[5]); mb = MX3(mb, p1[6], p1[7]); mc = MX3(mc, p1[8], p1[9]); md = MX3(md, p1[10], p1[11]);
  ma = MX3(ma, p1[12], p1[13]); mb = MX3(mb, p1[14], p1[15]);
  float pmax = __builtin_fmaxf(MX3(ma, mb, mc), md);
  { auto rr = __builtin_amdgcn_permlane32_swap(__float_as_uint(pmax), __float_as_uint(pmax), false, false);
    pmax = fmaxf(__uint_as_float(rr[0]), __uint_as_float(rr[1])); }
  if (__builtin_expect(first || !__all(pmax <= THR2), 0)) {
    const float dl = first ? pmax : fmaxf(pmax, 0.f);
    m_reg += dl;
#pragma unroll
    for (int r = 0; r < 16; ++r) { p0[r] -= dl; p1[r] -= dl; negm[r] = -m_reg; }
    if (!first) { const float alpha = __builtin_amdgcn_exp2f(-dl); l_reg *= alpha;
      if (hi == 0) al_l[r32] = alpha; asm volatile("s_waitcnt lgkmcnt(0)" ::: "memory");
#pragma unroll
      for (int r = 0; r < 16; ++r) { const float a = al_l[crow(r, hi)]; o[0][r] *= a; o[1][r] *= a; } }
  }
  asm volatile("" : "+v"(negm));
#pragma unroll
  for (int r = 0; r < 16; ++r) { p0[r] = MLA_EXP2(p0[r]); p1[r] = MLA_EXP2(p1[r]); }
  float s0 = p0[0] + p1[0], s1 = p0[1] + p1[1], s2 = p0[2] + p1[2], s3 = p0[3] + p1[3];
#pragma unroll
  for (int r = 4; r < 16; r += 4) { s0 += p0[r] + p1[r]; s1 += p0[r + 1] + p1[r + 1]; s2 += p0[r + 2] + p1[r + 2]; s3 += p0[r + 3] + p1[r + 3]; }
  l_reg += (s0 + s1) + (s2 + s3);
#define PK8(P, BASE, OUT) do { u32x4 w = {cvt_pk_bf16(P[BASE + 0], P[BASE + 1]), cvt_pk_bf16(P[BASE + 2], P[BASE + 3]), cvt_pk_bf16(P[BASE + 4], P[BASE + 5]), cvt_pk_bf16(P[BASE + 6], P[BASE + 7])}; \
    OUT = __builtin_bit_cast(bf16x8, w); } while (0)
  PK8(p0, 0, pa0); PK8(p0, 8, pa1); PK8(p1, 0, pa2); PK8(p1, 8, pa3);
#undef PK8
}
#undef MX3
typedef short v4i16_t __attribute__((ext_vector_type(4)));
typedef __attribute__((address_space(3))) const char* lds_cptr;
__device__ __forceinline__ s16x4 vtr(lds_cptr p) { return __builtin_bit_cast(s16x4, __builtin_amdgcn_ds_read_tr16_b64_v4i16((__attribute__((address_space(3))) v4i16_t*)p)); }
#define VFRAG(L, H) (bf16x8){L[0], L[1], L[2], L[3], H[0], H[1], H[2], H[3]}
__device__ __forceinline__ void mprefetch(bf16x8 (&fk)[12], lds_cptr Ks, int r32, int hi) {
#define KOFF(row, d0) KSWZ(row, ((d0) * 16 + hi * 8) * 2)
#pragma unroll
  for (int d0 = 0; d0 < 6; ++d0) { fk[2 * d0] = *(const __attribute__((address_space(3))) bf16x8*)(Ks + KOFF(r32, d0)); fk[2 * d0 + 1] = *(const __attribute__((address_space(3))) bf16x8*)(Ks + KOFF(32 + r32, d0)); }
#undef KOFF
}
template <bool HAS_PV>
__device__ __forceinline__ void mstage5(f32x16* o, f32x16& p0, f32x16& p1, bf16x8 (&fk)[12], lds_cptr vp, lds_cptr Ks, const bf16x8* qr, const f32x16& negm,
                                        bf16x8 pa0, bf16x8 pa1, bf16x8 pa2, bf16x8 pa3, int r32, int hi) {
  s16x4 vl[8], vh[8];
  if (HAS_PV) {
#pragma unroll
    for (int d0 = 0; d0 < 2; ++d0)
#pragma unroll
      for (int ks = 0; ks < 4; ++ks) { vl[d0 * 4 + ks] = vtr(vp + v_rd_off(d0, ks, 0)); vh[d0 * 4 + ks] = vtr(vp + v_rd_off(d0, ks, 1)); }
    SBAR(); }
  p0 = __builtin_amdgcn_mfma_f32_32x32x16_bf16(fk[0], qr[0], negm, 0, 0, 0); p1 = __builtin_amdgcn_mfma_f32_32x32x16_bf16(fk[1], qr[0], negm, 0, 0, 0);
#pragma unroll
  for (int d0 = 1; d0 < 6; ++d0) { p0 = __builtin_amdgcn_mfma_f32_32x32x16_bf16(fk[2 * d0], qr[d0], p0, 0, 0, 0); p1 = __builtin_amdgcn_mfma_f32_32x32x16_bf16(fk[2 * d0 + 1], qr[d0], p1, 0, 0, 0); }
  if (HAS_PV) {
    SBAR();
#pragma unroll
    for (int d0 = 0; d0 < 2; ++d0) {
      o[d0] = __builtin_amdgcn_mfma_f32_32x32x16_bf16(pa0, VFRAG(vl[d0 * 4 + 0], vh[d0 * 4 + 0]), o[d0], 0, 0, 0); o[d0] = __builtin_amdgcn_mfma_f32_32x32x16_bf16(pa1, VFRAG(vl[d0 * 4 + 1], vh[d0 * 4 + 1]), o[d0], 0, 0, 0);
      o[d0] = __builtin_amdgcn_mfma_f32_32x32x16_bf16(pa2, VFRAG(vl[d0 * 4 + 2], vh[d0 * 4 + 2]), o[d0], 0, 0, 0); o[d0] = __builtin_amdgcn_mfma_f32_32x32x16_bf16(pa3, VFRAG(vl[d0 * 4 + 3], vh[d0 * 4 + 3]), o[d0], 0, 0, 0); }
  }
}
__device__ __forceinline__ void pvlast4(f32x16* o, lds_cptr vp, bf16x8 pa0, bf16x8 pa1, bf16x8 pa2, bf16x8 pa3) {
  s16x4 vl[8], vh[8];
#pragma unroll
  for (int d0 = 0; d0 < 2; ++d0)
#pragma unroll
    for (int ks = 0; ks < 4; ++ks) { vl[d0 * 4 + ks] = vtr(vp + v_rd_off(d0, ks, 0)); vh[d0 * 4 + ks] = vtr(vp + v_rd_off(d0, ks, 1)); }
#pragma unroll
  for (int d0 = 0; d0 < 2; ++d0) {
    o[d0] = __builtin_amdgcn_mfma_f32_32x32x16_bf16(pa0, VFRAG(vl[d0 * 4 + 0], vh[d0 * 4 + 0]), o[d0], 0, 0, 0); o[d0] = __builtin_amdgcn_mfma_f32_32x32x16_bf16(pa1, VFRAG(vl[d0 * 4 + 1], vh[d0 * 4 + 1]), o[d0], 0, 0, 0);
    o[d0] = __builtin_amdgcn_mfma_f32_32x32x16_bf16(pa2, VFRAG(vl[d0 * 4 + 2], vh[d0 * 4 + 2]), o[d0], 0, 0, 0); o[d0] = __builtin_amdgcn_mfma_f32_32x32x16_bf16(pa3, VFRAG(vl[d0 * 4 + 3], vh[d0 * 4 + 3]), o[d0], 0, 0, 0); }
}
constexpr int NSLOT = 4, SLOT_K = SHM_K, SLOT_V = SHM_V;
constexpr int OFF2_K = 0, OFF2_V = NSLOT * SLOT_K, OFF2_WS = OFF2_V + NSLOT * SLOT_V, LDS2_TOTAL = OFF2_WS + NWAVES * 256;
#define MLA_BAR() asm volatile("s_waitcnt lgkmcnt(0)\n\ts_barrier" ::: "memory")

__device__ __forceinline__ void unit(const bf16_t* __restrict__ Qb, const bf16_t* __restrict__ Kh, const bf16_t* __restrict__ Vh, bf16_t* __restrict__ Ob, int seq, char* lds, int wid) {
  const int lane = lane_id(), r32 = lane & 31, hi = lane >> 5;
  const bool hb = wid >= 4;
  char* K_lds = lds + OFF2_K; char* V_lds = lds + OFF2_V;
  float* al_l = (float*)(lds + OFF2_WS) + wid * 64;
  float m_reg = 0.f, l_reg = 0.f; f32x16 o[2] = {}; f32x16 negm = {}; bf16x8 qr[6];
  const bf16_t* Qw = Qb + (long)(wid * QBLK + r32) * LDQ + hi * 8;
#pragma unroll
  for (int d0 = 0; d0 < 6; ++d0) qr[d0] = *reinterpret_cast<const bf16x8*>(Qw + d0 * 16);
  unsigned koA, koB, vo; bool kvA, kvB;
  { const int rA = 8 * wid + (lane >> 4), rB = rA + 4, cp = lane & 15;
    const int cA = cp ^ (rA & 15), cB = cp ^ (rB & 15); kvA = cA < 12; kvB = cB < 12;
    koA = (unsigned)(rA * LDKk * 2 + cA * 16); koB = (unsigned)(rB * LDKk * 2 + cB * 16);
    const int jv = 64 * wid + lane, sub = jv >> 5, within = jv & 31, k = (sub >> 1) * 8 + (within >> 2), c = (sub & 1) * 32 + (within & 3) * 8;
    vo = (unsigned)(k * LDV * 2 + c * 2); }
  const __attribute__((address_space(3))) char* lds3 = (const __attribute__((address_space(3))) char*)(lds_cptr)lds;
#define DMA_TILE(u) do { const char* kt_ = (const char*)(Kh + (long)(u) * KVBLK * LDKk); const char* vt_ = (const char*)(Vh + (long)(u) * KVBLK * LDV); const int sl_ = (u) & 3; \
    if (kvA) __builtin_amdgcn_global_load_lds((const unsigned*)(kt_ + koA), (__attribute__((address_space(3))) unsigned*)(lds3 + OFF2_K + sl_ * SLOT_K + (2 * wid) * 1024), 16, 0, 0); \
    if (kvB) __builtin_amdgcn_global_load_lds((const unsigned*)(kt_ + koB), (__attribute__((address_space(3))) unsigned*)(lds3 + OFF2_K + sl_ * SLOT_K + (2 * wid + 1) * 1024), 16, 0, 0); \
    __builtin_amdgcn_global_load_lds((const unsigned*)(vt_ + vo), (__attribute__((address_space(3))) unsigned*)(lds3 + OFF2_V + sl_ * SLOT_V + wid * 1024), 16, 0, 0); } while (0)
#define DMA_WAIT() asm volatile("s_waitcnt vmcnt(0)" ::: "memory")
  const lds_cptr vp0 = (lds_cptr)V_lds + v_rd_base(lane); const lds_cptr kp0 = (lds_cptr)K_lds;
  f32x16 p0, p1; bf16x8 pa0, pa1, pa2, pa3; const int NT = seq / KVBLK;
  bf16x8 fka[12];
  DMA_WAIT();
  DMA_TILE(0); DMA_TILE(1); DMA_WAIT();
  MLA_BAR();
  if (hb) MLA_BAR();
  DMA_TILE(2);
  mprefetch(fka, kp0, r32, hi);
  mstage5<false>(o, p0, p1, fka, vp0, kp0, qr, negm, pa0, pa1, pa2, pa3, r32, hi);

  MLA_BAR();
  soft4(p0, p1, m_reg, l_reg, negm, o, al_l, true, pa0, pa1, pa2, pa3, r32, hi);
  mprefetch(fka, kp0 + SLOT_K, r32, hi);
  DMA_WAIT();
  MLA_BAR();
#pragma clang loop unroll(disable)
  for (int t = 1; t < NT; ++t) {
    if (t + 2 < NT) DMA_TILE(t + 2);
    SBAR(); mstage5<true>(o, p0, p1, fka, vp0 + ((t - 1) & 3) * SLOT_V, kp0 + (t & 3) * SLOT_K, qr, negm, pa0, pa1, pa2, pa3, r32, hi);

    MLA_BAR();
    soft4(p0, p1, m_reg, l_reg, negm, o, al_l, false, pa0, pa1, pa2, pa3, r32, hi);
    if (t + 1 < NT) mprefetch(fka, kp0 + ((t + 1) & 3) * SLOT_K, r32, hi);
    DMA_WAIT();
    MLA_BAR();
  }
  SBAR(); pvlast4(o, vp0 + ((NT - 1) & 3) * SLOT_V, pa0, pa1, pa2, pa3);
  if (!hb) MLA_BAR();
  MLA_BAR();
  { auto rr = __builtin_amdgcn_permlane32_swap(__float_as_uint(l_reg), __float_as_uint(l_reg), false, false); l_reg = __uint_as_float(rr[0]) + __uint_as_float(rr[1]); }
  if (hi == 0) al_l[r32] = l_reg; asm volatile("s_waitcnt lgkmcnt(0)" ::: "memory");
  float rli[16];
#pragma unroll
  for (int r = 0; r < 16; ++r) rli[r] = __builtin_amdgcn_rcpf(al_l[crow(r, hi)]);
  { bf16_t* stg = (bf16_t*)(lds) + wid * 2048;
#pragma unroll
    for (int r = 0; r < 16; ++r) { const int orow = crow(r, hi);
#pragma unroll
      for (int d0 = 0; d0 < 2; ++d0) stg[orow * 64 + d0 * 32 + r32] = (bf16_t)(cvt_pk_bf16(o[d0][r] * rli[r], 0.f) & 0xffffu); }
    asm volatile("s_waitcnt lgkmcnt(0)" ::: "memory");
    bf16_t* Ow = Ob + (long)(wid * QBLK) * LDO;
#pragma unroll
    for (int i = 0; i < 4; ++i) { const int row = i * 8 + (lane >> 3), ch = lane & 7; const u32x4 v = *(const u32x4*)(stg + row * 64 + ch * 8); *(u32x4*)(Ow + (long)row * LDO + ch * 8) = v; } }
  MLA_BAR();
#undef DMA_TILE
#undef DMA_WAIT
}
#undef KSWZ
#undef SBAR
}

__device__ __forceinline__ void p3_mla(const Frame& F) {
    unsigned char* ws = F.ws;
    const bf16_t* QB = (const bf16_t*)(ws + WS_QB); const bf16_t* KB = (const bf16_t*)(ws + WS_KB); const bf16_t* VB = (const bf16_t*)(ws + WS_VB); bf16_t* OB = (bf16_t*)(ws + WS_OB);
    const int G = F.G;
    if (G == 256) {
        const int x = F.vcu >> 5, c = F.vcu & 31;
        for (int i = 0; i < 4; ++i) {
            const int pair = x * 8 + 2 * i + (c >> 4), qb = c & 15, b = pair >> 3, h = pair & 7;
            const long row0 = (long)b * SEQ;
            mla::unit(QB + (row0 + qb * 256) * 768 + h * 96, KB + row0 * 768 + h * 96, VB + row0 * 512 + h * 64, OB + (row0 + qb * 256) * 512 + h * 64, SEQ, (char*)F.lds, F.wave);
        }
    } else {
        for (int u = F.vcu; u < 1024; u += G) {
            const int pair = u >> 4, qb = u & 15, b = pair >> 3, h = pair & 7; const long row0 = (long)b * SEQ;
            mla::unit(QB + (row0 + qb * 256) * 768 + h * 96, KB + row0 * 768 + h * 96, VB + row0 * 512 + h * 64, OB + (row0 + qb * 256) * 512 + h * 64, SEQ, (char*)F.lds, F.wave);
        }
    }
}

namespace mxa {
#define SBAR() __builtin_amdgcn_sched_barrier(0)
typedef short v4i16_t __attribute__((ext_vector_type(4)));
typedef __attribute__((address_space(3))) const char* lds_cptr;
__device__ __forceinline__ s16x4 vtr(lds_cptr p) { return __builtin_bit_cast(s16x4, __builtin_amdgcn_ds_read_tr16_b64_v4i16((__attribute__((address_space(3))) v4i16_t*)p)); }
__device__ __forceinline__ int crow(int r, int hi) { return (r & 3) + 8 * (r >> 2) + 4 * hi; }
#define KSW2(row, colB) ((row) * 128 + ((colB) ^ ((((row) >> 1) & 7) << 4)))
__device__ __forceinline__ int v_rd_base(int lane) { return ((lane & 3) << 3) | (((lane >> 2) & 3) << 6) | (((lane >> 4) & 1) << 5) | (((lane >> 5) & 1) << 8); }
constexpr int v_rd_off(int d0, int ks, int half) { return d0 * 512 + ks * 2048 + half * 1024; }
constexpr int BUFB = 8192;
#define VFRAG(L, H) (bf16x8){L[0], L[1], L[2], L[3], H[0], H[1], H[2], H[3]}
__device__ __forceinline__ void step(f32x16& o0, f32x16& o1, float& m_reg, float& l_reg, const bf16x8* qr, lds_cptr Kb, lds_cptr Vb, float* al_l, float basef, float sl2, bool first, int r32, int hi) {
  constexpr float THR = 8.f;
  bf16x8 kf[4]; s16x4 vl[4], vh[4];
#pragma unroll
  for (int d0 = 0; d0 < 4; ++d0) kf[d0] = *(const __attribute__((address_space(3))) bf16x8*)(Kb + KSW2(r32, (d0 * 16 + hi * 8) * 2));
#pragma unroll
  for (int d0 = 0; d0 < 2; ++d0)
#pragma unroll
    for (int ks = 0; ks < 2; ++ks) { vl[d0 * 2 + ks] = vtr(Vb + v_rd_off(d0, ks, 0)); vh[d0 * 2 + ks] = vtr(Vb + v_rd_off(d0, ks, 1)); }
  f32x16 p;
  { const float nm = first ? 0.f : -m_reg;
#pragma unroll
    for (int r = 0; r < 16; ++r) p[r] = nm; }
#pragma unroll
  for (int d0 = 0; d0 < 4; ++d0) p = __builtin_amdgcn_mfma_f32_32x32x16_bf16(kf[d0], qr[d0], p, 0, 0, 0);
  const float nsl = -sl2;
  float pmax = -1e30f;
#pragma unroll
  for (int r = 0; r < 16; ++r) {
    const float df = basef - (float)((r & 3) + 8 * (r >> 2)), ad = __builtin_fabsf(df);
    const float sv = fmaf(nsl, ad, p[r]);
    p[r] = (ad <= 64.f) ? sv : -1e30f;
    pmax = fmaxf(pmax, p[r]);
  }
  { auto rr = __builtin_amdgcn_permlane32_swap(__float_as_uint(pmax), __float_as_uint(pmax), false, false);
    pmax = fmaxf(__uint_as_float(rr[0]), __uint_as_float(rr[1])); }
  if (first || !__all(pmax <= THR)) {
    const float dl = first ? pmax : fmaxf(pmax, 0.f);
    m_reg += dl;
#pragma unroll
    for (int r = 0; r < 16; ++r) p[r] -= dl;
    if (!first) { const float alpha = __builtin_amdgcn_exp2f(-dl); l_reg *= alpha;
      if (hi == 0) al_l[r32] = alpha; asm volatile("s_waitcnt lgkmcnt(0)" ::: "memory");
#pragma unroll
      for (int r = 0; r < 16; ++r) { const float a = al_l[crow(r, hi)]; o0[r] *= a; o1[r] *= a; } }
  }
  float ps = 0.f;
#pragma unroll
  for (int r = 0; r < 16; ++r) { p[r] = __builtin_amdgcn_exp2f(p[r]); ps += p[r]; }
  l_reg += ps;
  u32x4 w0 = {cvt_pk_bf16(p[0], p[1]), cvt_pk_bf16(p[2], p[3]), cvt_pk_bf16(p[4], p[5]), cvt_pk_bf16(p[6], p[7])};
  u32x4 w1 = {cvt_pk_bf16(p[8], p[9]), cvt_pk_bf16(p[10], p[11]), cvt_pk_bf16(p[12], p[13]), cvt_pk_bf16(p[14], p[15])};
  const bf16x8 pa0 = __builtin_bit_cast(bf16x8, w0), pa1 = __builtin_bit_cast(bf16x8, w1);
  o0 = __builtin_amdgcn_mfma_f32_32x32x16_bf16(pa0, VFRAG(vl[0], vh[0]), o0, 0, 0, 0); o0 = __builtin_amdgcn_mfma_f32_32x32x16_bf16(pa1, VFRAG(vl[1], vh[1]), o0, 0, 0, 0);
  o1 = __builtin_amdgcn_mfma_f32_32x32x16_bf16(pa0, VFRAG(vl[2], vh[2]), o1, 0, 0, 0); o1 = __builtin_amdgcn_mfma_f32_32x32x16_bf16(pa1, VFRAG(vl[3], vh[3]), o1, 0, 0, 0);
}

__device__ __forceinline__ void task(const bf16_t* __restrict__ QA, const bf16_t* __restrict__ KA, const bf16_t* __restrict__ VA, bf16_t* __restrict__ OP, float* __restrict__ LS,
                                     int b, int h, int n, int rres, int qb, char* wl, float* al) {
  const int lane = lane_id(), r32 = lane & 31, hi = lane >> 5;
  const int dil = (n == 0) ? 1 : (n == 1 ? 4 : 16), L = SEQ / dil, l0 = qb * 64;
  const float sl2 = exp2f(-(float)(h + 1)) * (float)dil * LOG2E;
  const long rowb = (long)b * SEQ;
  const lds_cptr wl3 = (lds_cptr)wl;
  const lds_cptr vrd = wl3 + 4096 + v_rd_base(lane);
  asm volatile("s_waitcnt vmcnt(0)" ::: "memory");
  unsigned ko[4], vo[4];
#pragma unroll
  for (int pc = 0; pc < 4; ++pc) {
    const int kr = 8 * pc + (lane >> 3), c = (lane & 7) ^ ((kr >> 1) & 7);
    ko[pc] = (unsigned)(kr * dil * 1024 + h * 128 + c * 16);
    const int jv = 64 * pc + lane, sub = jv >> 5, within = jv & 31, vk = (sub >> 1) * 8 + (within >> 2), vc = (sub & 1) * 32 + (within & 3) * 8;
    vo[pc] = (unsigned)(vk * dil * 1024 + h * 128 + vc * 2); }
#define MXA_DMA(lk0_, buf_) do { const size_t rb_ = (size_t)(rowb + (long)(lk0_) * dil + rres) * 1024; const char* kb_ = (const char*)KA + rb_; const char* vb_ = (const char*)VA + rb_; \
    _Pragma("unroll") for (int pc = 0; pc < 4; ++pc) { \
      __builtin_amdgcn_global_load_lds((const unsigned*)(kb_ + ko[pc]), (__attribute__((address_space(3))) unsigned*)(wl3 + (buf_) * BUFB + pc * 1024), 16, 0, 0); \
      __builtin_amdgcn_global_load_lds((const unsigned*)(vb_ + vo[pc]), (__attribute__((address_space(3))) unsigned*)(wl3 + (buf_) * BUFB + 4096 + pc * 1024), 16, 0, 0); } } while (0)
  const bool has_behind = (l0 >= 64), has_ahead = (l0 + 64 < L);
  const int nblk = 2 + (has_behind ? 2 : 0) + (has_ahead ? 2 : 0);
  auto blk_at = [&](int i) -> int { if (i < 2) return 2 + i; if (has_behind && has_ahead) return (i == 2) ? 1 : (i == 3 ? 4 : (i == 4 ? 0 : 5)); if (has_behind) return (i == 2) ? 1 : 0; return (i == 2) ? 4 : 5; };
  MXA_DMA(l0, 0);
  bf16x8 q0[4], q1[4];
  { const long ra = rowb + (long)(l0 + r32) * dil + rres, rb2 = rowb + (long)(l0 + 32 + r32) * dil + rres;
#pragma unroll
    for (int d0 = 0; d0 < 4; ++d0) { q0[d0] = *reinterpret_cast<const bf16x8*>(QA + ra * 512 + h * 64 + d0 * 16 + hi * 8); q1[d0] = *reinterpret_cast<const bf16x8*>(QA + rb2 * 512 + h * 64 + d0 * 16 + hi * 8); } }
  asm volatile("s_waitcnt vmcnt(0)" ::: "memory");
  f32x16 oa0 = f32x16{}, oa1 = f32x16{}, ob0 = f32x16{}, ob1 = f32x16{};
  float ma = 0.f, la = 0.f, mb = 0.f, lb = 0.f;
#pragma clang loop unroll(disable)
  for (int i = 0; i < nblk; ++i) {
    const int j = blk_at(i), buf = i & 1;
    if (i + 1 < nblk) { MXA_DMA(l0 - 64 + 32 * blk_at(i + 1), buf ^ 1); }
    if (i > 0) { if (i + 1 < nblk) asm volatile("s_waitcnt vmcnt(8)" ::: "memory"); else asm volatile("s_waitcnt vmcnt(0)" ::: "memory"); }
    const lds_cptr Kb = wl3 + buf * BUFB, Vb = vrd + buf * BUFB;
    const int dk = -64 + 32 * j;
    if (j <= 4) step(oa0, oa1, ma, la, q0, Kb, Vb, al, (float)(r32 - 4 * hi - dk), sl2, i == 0, r32, hi);
    if (j >= 1) step(ob0, ob1, mb, lb, q1, Kb, Vb, al, (float)(32 + r32 - 4 * hi - dk), sl2, i == 0, r32, hi);
    asm volatile("s_waitcnt lgkmcnt(0)" ::: "memory");
  }
#undef MXA_DMA
#pragma unroll
  for (int qs = 0; qs < 2; ++qs) {
    float l_reg = qs ? lb : la; const float m_reg = qs ? mb : ma;
    { auto rr = __builtin_amdgcn_permlane32_swap(__float_as_uint(l_reg), __float_as_uint(l_reg), false, false); l_reg = __uint_as_float(rr[0]) + __uint_as_float(rr[1]); }
    if (hi == 0) { al[r32] = l_reg; const long row = rowb + (long)(l0 + qs * 32 + r32) * dil + rres; LS[row * 8 + h] = m_reg + __builtin_amdgcn_logf(l_reg); }
    asm volatile("s_waitcnt lgkmcnt(0)" ::: "memory");
    bf16_t* stg = (bf16_t*)wl;
#pragma unroll
    for (int r = 0; r < 16; ++r) { const int orow = crow(r, hi); const float rl = __builtin_amdgcn_rcpf(al[orow]);
      stg[orow * 64 + r32] = (bf16_t)(cvt_pk_bf16((qs ? ob0[r] : oa0[r]) * rl, 0.f) & 0xffffu);
      stg[orow * 64 + 32 + r32] = (bf16_t)(cvt_pk_bf16((qs ? ob1[r] : oa1[r]) * rl, 0.f) & 0xffffu); }
    asm volatile("s_waitcnt lgkmcnt(0)" ::: "memory");
#pragma unroll
    for (int i = 0; i < 4; ++i) { const int rw = i * 8 + (lane >> 3), ch = lane & 7; const u32x4 v = *(const u32x4*)(stg + rw * 64 + ch * 8);
      const long row = rowb + (long)(l0 + qs * 32 + rw) * dil + rres; *(u32x4*)(OP + row * 512 + h * 64 + ch * 8) = v; }
    asm volatile("s_waitcnt lgkmcnt(0)" ::: "memory");
  }
}
#undef KSW2
#undef VFRAG
#undef SBAR
}

__device__ __forceinline__ void p3_mixerA(const Frame& F) {
    unsigned char* ws = F.ws;
    const bf16_t* QA = (const bf16_t*)(ws + WS_QA); const bf16_t* KA = (const bf16_t*)(ws + WS_KA); const bf16_t* VA = (const bf16_t*)(ws + WS_VA);
    float* LSE = (float*)(ws + WS_LSE);
    char* wl = (char*)F.lds + F.wave * 16384; float* al = (float*)((char*)F.lds + RING_BYTES + 2048) + F.wave * 64;
    const int x = (F.G == 256) ? (F.vcu >> 5) : 0; const int ngrp = (F.G == 256) ? 8 : 1, per = 64 * 192 / ngrp;
    unsigned* qctr = F.ctl + CW_Q + 64 * x;
    for (;;) {
        unsigned ti = 0; if (lane_id() == 0) ti = atomicAdd(qctr, 1u);
        ti = (unsigned)__builtin_amdgcn_readfirstlane((int)ti);
        if (ti >= (unsigned)per) break;
        const int t = x * per + (int)ti;
        const int pair = t / 192, tt = t % 192, n = tt >> 6, idx = tt & 63;
        const int rres = (n == 0) ? 0 : (n == 1 ? (idx >> 4) : (idx >> 2)), qb = (n == 0) ? idx : (n == 1 ? (idx & 15) : (idx & 3));
        bf16_t* OP = (bf16_t*)(ws + (n == 2 ? WS_OAP2 : WS_OAP0)) + (n == 1 ? (size_t)T * 512 : 0);
        mxa::task(QA, KA, VA, OP, LSE + (size_t)n * ((size_t)T * 8), pair >> 3, pair & 7, n, rres, qb, wl, al);
    }
}
static_assert(WS_OAP1 - WS_OAP0 == (size_t)T * 512 * 2, "OAP0|OAP1 contiguous");

__device__ __forceinline__ void p35_mix(const Frame& F, const Args& a) {
    unsigned char* ws = F.ws; const int lane = lane_id();
    const bf16_t* OB = (const bf16_t*)(ws + WS_OB); const float* LSE = (const float*)(ws + WS_LSE); bf16_t* MIXED = (bf16_t*)(ws + WS_MIXED);
    const bf16_t* OAPn[3] = {(const bf16_t*)(ws + WS_OAP0), (const bf16_t*)(ws + WS_OAP1), (const bf16_t*)(ws + WS_OAP2)};
    const float* g_a = a.in[8]; const float* g_b = a.in[9];
    const int gw = F.vcu * NWAVES + F.wave, NGW = F.G * NWAVES;
    const int h = lane >> 3;
    const f32x4 ga0 = *(const f32x4*)(g_a + lane * 8), ga1 = *(const f32x4*)(g_a + lane * 8 + 4), gb0 = *(const f32x4*)(g_b + lane * 8), gb1 = *(const f32x4*)(g_b + lane * 8 + 4);
    for (int row = gw; row < T; row += NGW) {
        float ls[3]; u32x4 ov[3];
#pragma unroll
        for (int n = 0; n < 3; ++n) { ls[n] = LSE[((size_t)n * T + row) * 8 + h]; ov[n] = *(const u32x4*)(OAPn[n] + (size_t)row * 512 + lane * 8); }
        const u32x4 bv = *(const u32x4*)(OB + (size_t)row * 512 + lane * 8);
        const float mx = fmaxf(ls[0], fmaxf(ls[1], ls[2]));
        float w[3]; float wsum = 0.f;
#pragma unroll
        for (int n = 0; n < 3; ++n) { w[n] = __builtin_amdgcn_exp2f(ls[n] - mx); wsum += w[n]; }
        const float inv = 1.f / wsum;
        float oa[8] = {0.f, 0.f, 0.f, 0.f, 0.f, 0.f, 0.f, 0.f};
#pragma unroll
        for (int n = 0; n < 3; ++n) { const float wn = w[n] * inv;
#pragma unroll
            for (int j = 0; j < 4; ++j) { oa[2 * j] += wn * bf16lo(ov[n][j]); oa[2 * j + 1] += wn * bf16hi(ov[n][j]); } }
        float obv[8];
#pragma unroll
        for (int j = 0; j < 4; ++j) { obv[2 * j] = bf16lo(bv[j]); obv[2 * j + 1] = bf16hi(bv[j]); }
        float sa = 0.f, sb = 0.f;
#pragma unroll
        for (int j = 0; j < 8; ++j) { sa += oa[j] * oa[j]; sb += obv[j] * obv[j]; }
        sa = wsum64(sa); sb = wsum64(sb);
        const float ra = 1.0f / sqrtf(sa * (1.f / 512.f) + EPS), rb = 1.0f / sqrtf(sb * (1.f / 512.f) + EPS);
        u32x4 wa, wb;
        wa.x = cvt_pk_bf16(oa[0] * ra * ga0[0], oa[1] * ra * ga0[1]); wa.y = cvt_pk_bf16(oa[2] * ra * ga0[2], oa[3] * ra * ga0[3]);
        wa.z = cvt_pk_bf16(oa[4] * ra * ga1[0], oa[5] * ra * ga1[1]); wa.w = cvt_pk_bf16(oa[6] * ra * ga1[2], oa[7] * ra * ga1[3]);
        wb.x = cvt_pk_bf16(obv[0] * rb * gb0[0], obv[1] * rb * gb0[1]); wb.y = cvt_pk_bf16(obv[2] * rb * gb0[2], obv[3] * rb * gb0[3]);
        wb.z = cvt_pk_bf16(obv[4] * rb * gb1[0], obv[5] * rb * gb1[1]); wb.w = cvt_pk_bf16(obv[6] * rb * gb1[2], obv[7] * rb * gb1[3]);
        *(u32x4*)(MIXED + (size_t)row * 1024 + lane * 8) = wa;
        *(u32x4*)(MIXED + (size_t)row * 1024 + 512 + lane * 8) = wb;
    }
}

constexpr size_t WS_WRT = 4 * MiB + 512 * 1024;
constexpr size_t WS_RS = 137 * MiB;
constexpr size_t WS_GS = 141 * MiB;
constexpr size_t WS_H2B = 384 * MiB;
constexpr size_t WS_D = 448 * MiB;
constexpr int MOE_TAB = MISC_OFF + 256;
constexpr int NBUCK = 112;
constexpr int CW_BCNT = 32768;
constexpr size_t WS_HID2 = 209 * MiB;
constexpr size_t WS_BLIST = 288 * MiB;
constexpr size_t WS_SSQ2 = 136 * MiB + 256 * 1024;
constexpr int MOE_TOKL = MOE_TAB + 4096;
constexpr size_t WS_DST = 280 * MiB;

__device__ __forceinline__ void p0_router_table(const Frame& F, const Args& a) {
    const float* w_r1 = a.in[12]; const float* w_r2 = a.in[14]; const float* g_ffn = a.in[11]; bf16_t* WRH = (bf16_t*)(F.ws + WS_WRT); bf16_t* WRL = WRH + 48 * 1024;
    const int gw = F.vcu * NWAVES + F.wave, NGW = F.G * NWAVES, lane = lane_id();
    for (int idx = gw * 64 + lane; idx < 48 * 1024; idx += NGW * 64) {
        const int o = idx >> 10, k = idx & 1023;
        float w = 0.f;
        if (o < 4) w = w_r1[k * 4 + o]; else if (o < 36) w = w_r2[((size_t)((o - 4) >> 3) * 1024 + k) * 8 + ((o - 4) & 7)];
        w *= g_ffn[k];
        const unsigned hi = cvt_pk_bf16(w, 0.f) & 0xffffu; const float rem = w - __uint_as_float(hi << 16);
        WRH[idx] = (bf16_t)hi; WRL[idx] = (bf16_t)(cvt_pk_bf16(rem, 0.f) & 0xffffu);
    }
}

__device__ __forceinline__ void p4_wo(const Frame& F, const Args& a) {
    unsigned char* ws = F.ws;
    { const float* p = a.in[1]; bf16_t* P16 = (bf16_t*)(ws + WS_P16); const int gw = F.vcu * NWAVES + F.wave, NGW = F.G * NWAVES, lane = lane_id();
      for (size_t i = (size_t)gw * 64 + lane; i < (size_t)T * 256 / 8; i += (size_t)NGW * 64) {
          const f32x4 v0 = ((const f32x4*)p)[2 * i], v1 = ((const f32x4*)p)[2 * i + 1];
          u32x4 o; o.x = cvt_pk_bf16(v0.x, v0.y); o.y = cvt_pk_bf16(v0.z, v0.w); o.z = cvt_pk_bf16(v1.x, v1.y); o.w = cvt_pk_bf16(v1.z, v1.w);
          ((u32x4*)P16)[i] = o; } }
    pg::DenseSched S{(const char*)(ws + WS_MIXED), (const char*)(ws + WS_WO), 1024, 1024, T / 256, 4, F.G, (int)blockIdx.x};
    EpiStoreBf16 E{(bf16_t*)(ws + WS_D), 1024};
    pg::gemm_phase(F.lds, S, E, 1024, F.wave);
}

__device__ __forceinline__ void p5_router(const Frame& F, const Args& a) {
    unsigned char* ws = F.ws; const int lane = lane_id(), wid = F.wave;
    const float* X = a.in[0]; const bf16_t* Dm = (const bf16_t*)(ws + WS_D); const float* g_ffn = a.in[11]; const float* b_r1 = a.in[13]; const float* b_r2 = a.in[15];
    const bf16_t* WRH = (const bf16_t*)(ws + WS_WRT); const bf16_t* WRL = WRH + 48 * 1024; bf16_t* MU = (bf16_t*)(ws + WS_M);
    int* LIST = (int*)(ws + WS_LIST); float* RS = (float*)(ws + WS_RS); float* GS = (float*)(ws + WS_GS);
    unsigned* cnt = F.ctl + CW_CNT;
    LAS int* LG = (LAS int*)(F.lds);
    LAS int* SSQ_ = (LAS int*)(F.lds + 26 * 1024);
    LAS unsigned* hist = (LAS unsigned*)(F.lds + 27 * 1024);
    LAS unsigned* gbase = hist + 160;
    int* DST = (int*)(ws + WS_DST); int* BLIST = (int*)(ws + WS_BLIST); unsigned* bcnt = F.ctl + CW_BCNT;
    const int tr = lane & 15, kg = lane >> 4, tid = wid * 64 + lane;
    const int kw = 128 * wid;
    for (int chunk = F.vcu; chunk < T / 128; chunk += F.G) {
        const int base = chunk * 128;
        for (int i = tid; i < 128 * 49 + 128; i += 512) { if (i < 128 * 49) LG[i] = 0; else SSQ_[i - 128 * 49] = 0; }
        if (tid < 32 + NBUCK) hist[tid] = 0u;
        __syncthreads();
        bf16x8 bh[4][3], bl[4][3];
#pragma unroll
        for (int ks = 0; ks < 4; ++ks)
#pragma unroll
            for (int nb = 0; nb < 3; ++nb) { const size_t wo = (size_t)(nb * 16 + tr) * 1024 + kw + ks * 32 + 8 * kg; bh[ks][nb] = *(const bf16x8*)(WRH + wo); bl[ks][nb] = *(const bf16x8*)(WRL + wo); }
#pragma unroll 2
        for (int mb = 0; mb < 8; ++mb) {
            const size_t ro = (size_t)(base + 16 * mb + tr) * 1024 + kw + 8 * kg;
            f32x4 acc0 = {0.f, 0.f, 0.f, 0.f}, acc1 = acc0, acc2 = acc0; float ss = 0.f;
#pragma unroll
            for (int ks = 0; ks < 4; ++ks) {
                f32x4 v0 = *(const f32x4*)(X + ro + ks * 32), v1 = *(const f32x4*)(X + ro + ks * 32 + 4);
                { const u32x4 dd = *(const u32x4*)(Dm + ro + ks * 32);
                  v0[0] += bf16lo(dd.x); v0[1] += bf16hi(dd.x); v0[2] += bf16lo(dd.y); v0[3] += bf16hi(dd.y); v1[0] += bf16lo(dd.z); v1[1] += bf16hi(dd.z); v1[2] += bf16lo(dd.w); v1[3] += bf16hi(dd.w); }
                ss += (v0[0] * v0[0] + v0[1] * v0[1]) + (v0[2] * v0[2] + v0[3] * v0[3]) + (v1[0] * v1[0] + v1[1] * v1[1]) + (v1[2] * v1[2] + v1[3] * v1[3]);
                u32x4 hi; hi.x = cvt_pk_bf16(v0[0], v0[1]); hi.y = cvt_pk_bf16(v0[2], v0[3]); hi.z = cvt_pk_bf16(v1[0], v1[1]); hi.w = cvt_pk_bf16(v1[2], v1[3]);
                u32x4 lo; lo.x = cvt_pk_bf16(v0[0] - bf16lo(hi.x), v0[1] - bf16hi(hi.x)); lo.y = cvt_pk_bf16(v0[2] - bf16lo(hi.y), v0[3] - bf16hi(hi.y));
                lo.z = cvt_pk_bf16(v1[0] - bf16lo(hi.z), v1[1] - bf16hi(hi.z)); lo.w = cvt_pk_bf16(v1[2] - bf16lo(hi.w), v1[3] - bf16hi(hi.w));
                *(u32x4*)(MU + ro + ks * 32) = hi;
                const bf16x8 ah = __builtin_bit_cast(bf16x8, hi), al = __builtin_bit_cast(bf16x8, lo);
                acc0 = __builtin_amdgcn_mfma_f32_16x16x32_bf16(ah, bh[ks][0], acc0, 0, 0, 0); acc0 = __builtin_amdgcn_mfma_f32_16x16x32_bf16(al, bh[ks][0], acc0, 0, 0, 0); acc0 = __builtin_amdgcn_mfma_f32_16x16x32_bf16(ah, bl[ks][0], acc0, 0, 0, 0);
                acc1 = __builtin_amdgcn_mfma_f32_16x16x32_bf16(ah, bh[ks][1], acc1, 0, 0, 0); acc1 = __builtin_amdgcn_mfma_f32_16x16x32_bf16(al, bh[ks][1], acc1, 0, 0, 0); acc1 = __builtin_amdgcn_mfma_f32_16x16x32_bf16(ah, bl[ks][1], acc1, 0, 0, 0);
                acc2 = __builtin_amdgcn_mfma_f32_16x16x32_bf16(ah, bh[ks][2], acc2, 0, 0, 0); acc2 = __builtin_amdgcn_mfma_f32_16x16x32_bf16(al, bh[ks][2], acc2, 0, 0, 0); acc2 = __builtin_amdgcn_mfma_f32_16x16x32_bf16(ah, bl[ks][2], acc2, 0, 0, 0);
            }
            ss += __shfl_xor(ss, 16); ss += __shfl_xor(ss, 32);
            if (kg == 0) atomicAdd((int*)(SSQ_ + 16 * mb + tr), __float2int_rn(ss * 16384.0f));
#pragma unroll
            for (int r = 0; r < 4; ++r) { const int tk = 16 * mb + 4 * kg + r;
                atomicAdd((int*)(LG + tk * 49 + tr), __float2int_rn(acc0[r] * 1048576.0f)); atomicAdd((int*)(LG + tk * 49 + 16 + tr), __float2int_rn(acc1[r] * 1048576.0f)); if (tr < 4) atomicAdd((int*)(LG + tk * 49 + 32 + tr), __float2int_rn(acc2[r] * 1048576.0f)); }
        }
        __syncthreads();
        int ea = 0, eb = 0, bk = 0, hfa = 0; unsigned la = 0u, lb = 0u, lk = 0u; float w0 = 0.f, w1 = 0.f, rstd = 0.f;
        if (tid < 128) {
            rstd = 1.0f / sqrtf((float)SSQ_[tid] * (1.f / 16384.f) * (1.f / 1024.f) + EPS);
            const LAS int* lg = LG + tid * 49; const float rq = rstd * (1.f / 1048576.f);
            const float l0 = (float)lg[0] * rq + b_r1[0], l1 = (float)lg[1] * rq + b_r1[1], l2 = (float)lg[2] * rq + b_r1[2], l3 = (float)lg[3] * rq + b_r1[3];
            int gi = 0; float gm = l0; if (l1 > gm) { gm = l1; gi = 1; } if (l2 > gm) { gm = l2; gi = 2; } if (l3 > gm) { gm = l3; gi = 3; }
            const float gs = __expf(l0 - gm) + __expf(l1 - gm) + __expf(l2 - gm) + __expf(l3 - gm);
            const float g_val = 1.0f / gs;
            float lv[8];
#pragma unroll
            for (int e = 0; e < 8; ++e) lv[e] = (float)lg[4 + 8 * gi + e] * rq + b_r2[8 * gi + e];
            int e0 = 0; float m0 = lv[0];
#pragma unroll
            for (int e = 1; e < 8; ++e) if (lv[e] > m0) { m0 = lv[e]; e0 = e; }
            int e1 = -1; float m1 = -3.0e38f;
#pragma unroll
            for (int e = 0; e < 8; ++e) if (e != e0 && lv[e] > m1) { m1 = lv[e]; e1 = e; }
            const float x1 = __expf(m1 - m0);
            w0 = g_val / (1.0f + x1); w1 = g_val * x1 / (1.0f + x1);
            ea = gi * 8 + e0; eb = gi * 8 + e1;
            la = atomicAdd((unsigned*)(hist + ea), 1u); lb = atomicAdd((unsigned*)(hist + eb), 1u);
            { const int lo = e0 < e1 ? e0 : e1, hi = e0 < e1 ? e1 : e0; bk = gi * 28 + (lo * 7 - ((lo * (lo - 1)) >> 1) + (hi - lo - 1)); hfa = e0 < e1 ? 0 : 1; }
            lk = atomicAdd((unsigned*)(hist + 32 + bk), 1u);
        }
        __syncthreads();
        if (tid < 32 + NBUCK) { const unsigned c = hist[tid]; gbase[tid] = c ? atomicAdd(tid < 32 ? cnt + 64 * tid : bcnt + 64 * (tid - 32), c) : 0u; }
        __syncthreads();
        if (tid < 128) {
            const int tok = base + tid; const int ra = (int)(gbase[ea] + la), rb = (int)(gbase[eb] + lb);
            LIST[(size_t)ea * T + ra] = tok; RS[(size_t)ea * T + ra] = rstd; GS[(size_t)ea * T + ra] = w0;
            LIST[(size_t)eb * T + rb] = tok; RS[(size_t)eb * T + rb] = rstd; GS[(size_t)eb * T + rb] = w1;
            const int rk2 = (int)(gbase[32 + bk] + lk);
            DST[(size_t)ea * T + ra] = (bk << 17) | (rk2 << 1) | hfa; DST[(size_t)eb * T + rb] = (bk << 17) | (rk2 << 1) | (hfa ^ 1);
            BLIST[(size_t)bk * T + rk2] = tok;
        }
        __syncthreads();
    }
}

__device__ __forceinline__ void moe_build_tables(const Frame& F) {
    LAS int* tab = (LAS int*)(F.lds + MOE_TAB);
    const int tid = F.wave * 64 + lane_id();
    if (tid < 32 + NBUCK) tab[512 + tid] = (int)__hip_atomic_load(tid < 32 ? F.ctl + CW_CNT + 64 * tid : F.ctl + CW_BCNT + 64 * (tid - 32), __ATOMIC_RELAXED, __HIP_MEMORY_SCOPE_AGENT);
    __syncthreads();
    if (tid <= 32) { int off = 0, cp = 0;
        for (int j = 0; j < tid; ++j) { const int nch = (tab[512 + j] + 255) >> 8; off += nch * 256; cp += nch; }
        tab[tid] = off; tab[80 + tid] = cp; if (tid < 32) tab[40 + tid] = tab[512 + tid]; }
    else if (tid >= 64 && tid <= 64 + NBUCK) { const int b = tid - 64; int o = 0, p = 0;
        for (int j = 0; j < b; ++j) { const int c = tab[512 + 32 + j]; o += c; p += (c + 255) >> 8; }
        tab[128 + b] = o; tab[384 + b] = p; if (b < NBUCK) tab[256 + b] = tab[512 + 32 + b]; }
    __syncthreads();
}
struct MoeSched1 {
    static constexpr bool GATHER = true; static constexpr int KSPLIT = 0;
    const char* A; const char* Bt; const int* LIST; LAS const int* tab; int G, c;
    __device__ __forceinline__ int a_ld() const { return 1024; }
    __device__ __forceinline__ const char* abase() const { return A; }
    __device__ __forceinline__ bool next(int i, pg::Unit& u) const {
        const int nun = tab[80 + 32] * 2; const long L = (long)i * G + c; if (L >= nun) return false;
        const int ci = (int)L >> 1; u.pn = (int)L & 1;
        int e = 0;
#pragma unroll 1
        for (int k = 1; k < 32; ++k) if (tab[80 + k] <= ci) e = k;
        u.aux = e; u.pm = ci - tab[80 + e]; return true;
    }
    __device__ __forceinline__ void addr(const pg::Unit&, const char*&, const char*&) const {}
    __device__ __forceinline__ void addr_g(const pg::Unit& u, const int (&R)[2], const int (&C)[2], unsigned (&aoff)[2][2], const char*& bbase) const {
        const int e = u.aux, cn = tab[40 + e];
#pragma unroll
        for (int h = 0; h < 2; ++h)
#pragma unroll
            for (int i = 0; i < 2; ++i) { const int rk = u.pm * 256 + h * 128 + R[i]; const int tok = (rk < cn) ? LIST[(size_t)e * T + rk] : 0; aoff[h][i] = (unsigned)((tok * 1024 + C[i]) * 2); }
        bbase = Bt + ((size_t)e * 512 + (size_t)u.pn * 256) * 1024 * 2;
    }
};
struct EpiMoe1 {
    bf16_t* HID2; const float* RS; const float* GS; const int* DST; LAS const int* tab;
    __device__ __forceinline__ void operator()(const f32x4 (&acc)[2][2][4][2], const pg::Unit& u, int wr, int wc, int fr, int fq, LAS unsigned char* stage, int wid) const {
        const int e = u.aux, cn = tab[40 + e];
        float rsv[2][4], gsv[2][4]; int dsv[2][4];
#pragma unroll
        for (int ai = 0; ai < 2; ++ai)
#pragma unroll
            for (int m = 0; m < 4; ++m) { const int rk = u.pm * 256 + ai * 128 + wr * 64 + m * 16 + fr; const bool ok = rk < cn; const size_t o = (size_t)e * T + rk;
                rsv[ai][m] = ok ? RS[o] : 0.f; gsv[ai][m] = ok ? GS[o] : 0.f; dsv[ai][m] = ok ? DST[o] : -1; }
#pragma unroll
        for (int ai = 0; ai < 2; ++ai)
#pragma unroll
            for (int m = 0; m < 4; ++m) { const int d = dsv[ai][m];
                if (d >= 0) { const float rs = rsv[ai][m], gt = gsv[ai][m]; float hv[8];
                    const int row2 = tab[128 + (d >> 17)] + ((d >> 1) & 0xffff), half = d & 1;
#pragma unroll
                    for (int n = 0; n < 2; ++n)
#pragma unroll
                        for (int j = 0; j < 4; ++j) { const float gg = acc[ai][0][m][n][j] * rs, uu = acc[ai][1][m][n][j] * (rs * gt); hv[4 * n + j] = gg / (1.0f + __expf(-gg)) * uu; }
                    u32x4 w; w.x = cvt_pk_bf16(hv[0], hv[1]); w.y = cvt_pk_bf16(hv[2], hv[3]); w.z = cvt_pk_bf16(hv[4], hv[5]); w.w = cvt_pk_bf16(hv[6], hv[7]);
                    *(u32x4*)(HID2 + (size_t)row2 * 512 + half * 256 + u.pn * 128 + wc * 32 + 8 * fq) = w; } }
    }
};
struct MoeSched2 {
    static constexpr bool GATHER = false; static constexpr int KSPLIT = 4;
    const char* A; const char* Bt; LAS const int* tab; int G, c;
    __device__ __forceinline__ int a_ld() const { return 512; }
    __device__ __forceinline__ const char* abase() const { return A; }
    __device__ __forceinline__ bool next(int i, pg::Unit& u) const {
        const int nun = tab[384 + NBUCK] * 4; const long L = (long)i * G + c; if (L >= nun) return false;
        const int ci = (int)L >> 2; u.pn = (int)L & 3;
        const int l = lane_id();
        const unsigned long long m0 = __builtin_amdgcn_ballot_w64(tab[384 + l] <= ci), m1 = __builtin_amdgcn_ballot_w64(l + 64 < NBUCK && tab[384 + 64 + l] <= ci);
        const int b = __builtin_popcountll(m0) + __builtin_popcountll(m1) - 1;
        u.aux = b; u.pm = ci - tab[384 + b]; return true;
    }
    __device__ __forceinline__ void addr(const pg::Unit& u, const char*& abase_, const char*& bbase, const char*& bbase2) const {
        const int b = u.aux, g = b / 28, p = b % 28;
        int lo = 0, rem = p;
#pragma unroll 1
        while (rem >= 7 - lo) { rem -= 7 - lo; ++lo; }
        const int hi = lo + 1 + rem;
        abase_ = A + (size_t)(tab[128 + b] + u.pm * 256) * 512 * 2;
        bbase = Bt + ((size_t)(g * 8 + lo) * 1024 + (size_t)u.pn * 256) * 256 * 2;
        bbase2 = Bt + ((size_t)(g * 8 + hi) * 1024 + (size_t)u.pn * 256) * 256 * 2; }
    __device__ __forceinline__ void addr_g(const pg::Unit&, const int (&)[2], const int (&)[2], unsigned (&)[2][2], const char*&) const {}
};
__device__ __forceinline__ void moe2_fetch(LAS const int* tokl, const bf16_t* MU, size_t colo, int wid, int rsub, int ai, int m, int (&tk)[2], u32x4 (&mv)[2]) {
#pragma unroll
    for (int i = 0; i < 2; ++i) { const int r2 = 4 * wid + 2 * i + rsub, trow = 128 * ai + 64 * (r2 >> 4) + 16 * m + (r2 & 15);
        tk[i] = tokl[trow]; mv[i] = (u32x4){0u, 0u, 0u, 0u};
        if (tk[i] >= 0) mv[i] = *(const u32x4*)(MU + (size_t)tk[i] * 1024 + colo); }
}
struct EpiMoe2 {
    bf16_t* H2B; const bf16_t* MU; const int* BLIST; float* SSQ2; LAS const int* tab; LAS int* tokl;
    __device__ __forceinline__ void operator()(const f32x4 (&acc)[2][2][4][2], const pg::Unit& u, int wr, int wc, int fr, int fq, LAS unsigned char* stage, int wid) const {
        const int b = u.aux, lane = fr + 16 * fq, rk0 = u.pm * 256, nvalid = tab[256 + b] - rk0, tid = wid * 64 + lane;
        if (tid < 256) tokl[tid] = (tid < nvalid) ? BLIST[(size_t)b * T + rk0 + tid] : -1;
        asm volatile("s_waitcnt lgkmcnt(0)\n\ts_barrier" ::: "memory");
        const int ch = lane & 31, rsub = lane >> 5, rr = 16 * wr + fr; const size_t colo = (size_t)u.pn * 256 + ch * 8;
        int tk[2]; u32x4 mv[2];
        moe2_fetch(tokl, MU, colo, wid, rsub, 0, 0, tk, mv);
#pragma unroll
        for (int it = 0; it < 8; ++it) { const int ai = it >> 2, m = it & 3;
            u32x4 w[2];
#pragma unroll
            for (int bj = 0; bj < 2; ++bj) { const f32x4 v0 = acc[ai][bj][m][0], v1 = acc[ai][bj][m][1];
                w[bj].x = cvt_pk_bf16(v0[0], v0[1]); w[bj].y = cvt_pk_bf16(v0[2], v0[3]); w[bj].z = cvt_pk_bf16(v1[0], v1[1]); w[bj].w = cvt_pk_bf16(v1[2], v1[3]); }
            *(LAS u32x4*)(stage + rr * pg::EPI_ROWB + (32 * wc + 8 * fq) * 2) = w[0];
            *(LAS u32x4*)(stage + rr * pg::EPI_ROWB + (128 + 32 * wc + 8 * fq) * 2) = w[1];
            asm volatile("s_waitcnt lgkmcnt(0)\n\ts_barrier" ::: "memory");
            int tkn[2] = {-1, -1}; u32x4 mvn[2] = {(u32x4){0u, 0u, 0u, 0u}, (u32x4){0u, 0u, 0u, 0u}};
            if (it < 7) moe2_fetch(tokl, MU, colo, wid, rsub, (it + 1) >> 2, (it + 1) & 3, tkn, mvn);
#pragma unroll
            for (int i = 0; i < 2; ++i) { const int r2 = 4 * wid + 2 * i + rsub;
                const u32x4 v = *(const LAS u32x4*)(stage + r2 * pg::EPI_ROWB + ch * 16); const u32x4 hh = mv[i];
                float h[8]; h[0] = bf16lo(v.x) + bf16lo(hh.x); h[1] = bf16hi(v.x) + bf16hi(hh.x); h[2] = bf16lo(v.y) + bf16lo(hh.y); h[3] = bf16hi(v.y) + bf16hi(hh.y);
                h[4] = bf16lo(v.z) + bf16lo(hh.z); h[5] = bf16hi(v.z) + bf16hi(hh.z); h[6] = bf16lo(v.w) + bf16lo(hh.w); h[7] = bf16hi(v.w) + bf16hi(hh.w);
                float ss = ((h[0] * h[0] + h[1] * h[1]) + (h[2] * h[2] + h[3] * h[3])) + ((h[4] * h[4] + h[5] * h[5]) + (h[6] * h[6] + h[7] * h[7]));
                if (tk[i] < 0) ss = 0.f;
                ss += __shfl_xor(ss, 16); ss += __shfl_xor(ss, 8); ss += __shfl_xor(ss, 4); ss += __shfl_xor(ss, 2); ss += __shfl_xor(ss, 1);
                if (tk[i] >= 0) { u32x4 o; o.x = cvt_pk_bf16(h[0], h[1]); o.y = cvt_pk_bf16(h[2], h[3]); o.z = cvt_pk_bf16(h[4], h[5]); o.w = cvt_pk_bf16(h[6], h[7]);
                    *(u32x4*)(H2B + (size_t)tk[i] * 1024 + colo) = o;
                    if (ch == 0) SSQ2[(size_t)tk[i] * 4 + u.pn] = ss; } }
            asm volatile("s_waitcnt lgkmcnt(0)\n\ts_barrier" ::: "memory");
#pragma unroll
            for (int i = 0; i < 2; ++i) { tk[i] = tkn[i]; mv[i] = mvn[i]; }
        }
    }
};
__device__ __forceinline__ void p6a_moe_up(const Frame& F) {
    unsigned char* ws = F.ws; moe_build_tables(F);
    LAS const int* tab = (LAS const int*)(F.lds + MOE_TAB);
    MoeSched1 S{(const char*)(ws + WS_M), (const char*)(ws + WS_WGU), (const int*)(ws + WS_LIST), tab, F.G, F.vcu};
    EpiMoe1 E{(bf16_t*)(ws + WS_HID2), (const float*)(ws + WS_RS), (const float*)(ws + WS_GS), (const int*)(ws + WS_DST), tab};
    pg::gemm_phase(F.lds, S, E, 1024, F.wave);
    pp_units(F, F.vcu, tab[80 + 32] * 2);
}
__device__ __forceinline__ void p6b_moe_down(const Frame& F) {
    unsigned char* ws = F.ws; moe_build_tables(F);
    LAS const int* tab = (LAS const int*)(F.lds + MOE_TAB);
    MoeSched2 S{(const char*)(ws + WS_HID2), (const char*)(ws + WS_WD), tab, F.G, F.vcu};
    EpiMoe2 E{(bf16_t*)(ws + WS_H2B), (const bf16_t*)(ws + WS_M), (const int*)(ws + WS_BLIST), (float*)(ws + WS_SSQ2), tab, (LAS int*)(F.lds + MOE_TOKL)};
    pg::gemm_phase(F.lds, S, E, 512, F.wave);
}
struct EpiPle {
    bf16_t* G; const bf16_t* PP; const float* RS2;
    __device__ __forceinline__ void operator()(const f32x4 (&acc)[2][2][4][2], const pg::Unit& u, int wr, int wc, int fr, int fq, LAS unsigned char* stage, int wid) const {
        float rs[2][4];
#pragma unroll
        for (int ai = 0; ai < 2; ++ai)
#pragma unroll
            for (int m = 0; m < 4; ++m) { const f32x4 q = *(const f32x4*)(RS2 + (size_t)(u.pm * 256 + ai * 128 + wr * 64 + m * 16 + fr) * 4);
                rs[ai][m] = -1.0f / sqrtf(((q[0] + q[1]) + (q[2] + q[3])) * (1.f / 1024.f) + EPS);
                if (m == 3) asm volatile("" : "+v"(rs[ai][0]), "+v"(rs[ai][1]), "+v"(rs[ai][2]), "+v"(rs[ai][3]) :: "memory"); }
#pragma unroll
        for (int ai = 0; ai < 2; ++ai) {
            u32x4 pp[4][2];
#pragma unroll
            for (int m = 0; m < 4; ++m) { const int row = u.pm * 256 + ai * 128 + wr * 64 + m * 16 + fr;
#pragma unroll
                for (int bj = 0; bj < 2; ++bj) pp[m][bj] = *(const u32x4*)(PP + (size_t)row * 1024 + u.pn * 256 + bj * 128 + wc * 32 + 8 * fq); }
#pragma unroll
            for (int m = 0; m < 4; ++m) { const int row = u.pm * 256 + ai * 128 + wr * 64 + m * 16 + fr; const float nr = rs[ai][m];
#pragma unroll
                for (int bj = 0; bj < 2; ++bj) { const size_t off = (size_t)row * 1024 + u.pn * 256 + bj * 128 + wc * 32 + 8 * fq;
                    const u32x4 p4 = pp[m][bj];
                    const f32x4 a0 = acc[ai][bj][m][0] * nr, a1 = acc[ai][bj][m][1] * nr; u32x4 w;
                    w.x = cvt_pk_bf16(bf16lo(p4.x) / (1.0f + __expf(a0[0])), bf16hi(p4.x) / (1.0f + __expf(a0[1])));
                    w.y = cvt_pk_bf16(bf16lo(p4.y) / (1.0f + __expf(a0[2])), bf16hi(p4.y) / (1.0f + __expf(a0[3])));
                    w.z = cvt_pk_bf16(bf16lo(p4.z) / (1.0f + __expf(a1[0])), bf16hi(p4.z) / (1.0f + __expf(a1[1])));
                    w.w = cvt_pk_bf16(bf16lo(p4.w) / (1.0f + __expf(a1[2])), bf16hi(p4.w) / (1.0f + __expf(a1[3])));
                    *(u32x4*)(G + off) = w; } }
            asm volatile("" ::: "memory");
        }
    }
};
__device__ __forceinline__ void p8_ple(const Frame& F, const Args& a) {
    unsigned char* ws = F.ws;
    pg::DenseSched S{(const char*)(ws + WS_H2B), (const char*)(ws + WS_WPG), 1024, 1024, T / 256, 4, F.G, (int)blockIdx.x};
    EpiPle E{(bf16_t*)(ws + WS_D), (const bf16_t*)(ws + WS_PP), (const float*)(ws + WS_SSQ2)};
    pg::gemm_phase(F.lds, S, E, 1024, F.wave);
}
__device__ __forceinline__ void p9_final(const Frame& F, const Args& a) {
    const int lane = lane_id(); float* H = a.out; const float* gf = a.in[22]; const bf16_t* Gm = (const bf16_t*)(F.ws + WS_D); const bf16_t* H2B = (const bf16_t*)(F.ws + WS_H2B);
    const int gw = F.vcu * NWAVES + F.wave, NGW = F.G * NWAVES;
    f32x4 g[4];
#pragma unroll
    for (int j = 0; j < 4; ++j) g[j] = ((const f32x4*)gf)[lane + 64 * j];
    for (int row = gw; row < T; row += NGW) {
        f32x4 v[4]; float s = 0.f;
#pragma unroll
        for (int j = 0; j < 4; ++j) { const u32x2 hh = ((const u32x2*)(H2B + (size_t)row * 1024))[lane + 64 * j], gg = ((const u32x2*)(Gm + (size_t)row * 1024))[lane + 64 * j];
            v[j].x = bf16lo(hh.x) + bf16lo(gg.x); v[j].y = bf16hi(hh.x) + bf16hi(gg.x); v[j].z = bf16lo(hh.y) + bf16lo(gg.y); v[j].w = bf16hi(hh.y) + bf16hi(gg.y);
            s += (v[j].x * v[j].x + v[j].y * v[j].y) + (v[j].z * v[j].z + v[j].w * v[j].w); }
        const float rstd = 1.0f / sqrtf(wsum64(s) * (1.f / 1024.f) + EPS);
#pragma unroll
        for (int j = 0; j < 4; ++j) ((f32x4*)(H + (size_t)row * 1024))[lane + 64 * j] = v[j] * rstd * g[j];
    }
}

__global__ void __launch_bounds__(512, 2) mega(Args args) {
    extern __shared__ __attribute__((aligned(16))) unsigned char lds_raw[];
    Frame F;
    F.lds = (LAS unsigned char*)lds_raw;
    F.wave = __builtin_amdgcn_readfirstlane(threadIdx.x >> 6);
    F.G = gridDim.x; { const int bx = blockIdx.x; F.vcu = (F.G % 8 == 0) ? (bx % 8) * (F.G / 8) + bx / 8 : bx; }
    F.ws = args.ws; F.ctl = (unsigned*)(args.ws + WS_CTL);
    volatile LAS unsigned* MISC = (volatile LAS unsigned*)(F.lds + MISC_OFF);
    for (int u = threadIdx.x; u < (LDS_BYTES - LDSCTL_OFF) / 4; u += NWAVES * 64) ((LAS unsigned*)(F.lds + LDSCTL_OFF))[u] = 0u;
    __syncthreads();
    XcdBarrier bar = xcd_barrier_post(F.ctl + CW_BAR + args.li * XCD_BAR_WORDS, MISC + 8);
    const int lo = args.ph_lo, hi = args.ph_hi;
#define IN(k) (lo <= (k) && (k) < hi)
#define BOTH(k) (IN(k) && IN((k) + 1))
    if (IN(0)) { p0_prologue(F, args); p0_router_table(F, args); if (BOTH(0)) xcd_barrier(bar); }
    if (IN(1)) { p1_inproj(F); if (BOTH(1)) xcd_barrier(bar); }
    if (IN(2)) { p2_upproj(F); if (BOTH(2)) xcd_barrier(bar); }
    if (IN(3)) { p3_mla(F); p3_mixerA(F); if (BOTH(3)) xcd_barrier(bar); }
    if (IN(4)) { p35_mix(F, args); if (BOTH(4)) xcd_barrier(bar); }
    if (IN(5)) { p4_wo(F, args); if (BOTH(5)) xcd_barrier(bar); }
    if (IN(6)) { p5_router(F, args); if (BOTH(6)) xcd_barrier(bar); }
    if (IN(7)) { p6a_moe_up(F); if (BOTH(7)) xcd_barrier(bar); }
    if (IN(8)) { p6b_moe_down(F); if (BOTH(8)) xcd_barrier(bar); }
    if (IN(9)) { p8_ple(F, args); if (BOTH(9)) xcd_barrier(bar); }
    if (IN(10)) { p9_final(F, args); }
#undef IN
#undef BOTH
}
constexpr int NPHASES = 11;

extern "C" void kernel_launch(void* const* d_in, const int* in_sizes, int n_in, void* d_out, int out_size, void* d_ws, size_t ws_size, hipStream_t stream) {
    static int grid = 0;
    if (grid == 0) {
        if (n_in != 23 || ws_size < (size_t)512 * MiB || out_size != T * DM) { fprintf(stderr, "kernel_launch: unexpected n_in %d / ws_size %zu / out_size %d\n", n_in, ws_size, out_size); grid = -1; return; }
        int dev = 0, cus = 0;
        if (hipGetDevice(&dev) != hipSuccess || hipDeviceGetAttribute(&cus, hipDeviceAttributeMultiprocessorCount, dev) != hipSuccess) { grid = -1; return; }
        if (hipFuncSetAttribute((const void*)mega, hipFuncAttributeMaxDynamicSharedMemorySize, LDS_BYTES) != hipSuccess) { fprintf(stderr, "kernel_launch: hipFuncSetAttribute failed\n"); grid = -1; return; }
        int per_cu = 0;
        if (hipOccupancyMaxActiveBlocksPerMultiprocessor(&per_cu, (const void*)mega, NWAVES * 64, LDS_BYTES) != hipSuccess || per_cu < 1) { fprintf(stderr, "kernel_launch: occupancy query says %d\n", per_cu); }
        (void)hipGetLastError();
        grid = cus;
    }
    if (grid < 0) return;
    unsigned char* ws = (unsigned char*)d_ws;
    hipMemsetAsync(ws + WS_CTL, 0, CTL_ZERO_BYTES, stream);
    Args a{};
    for (int i = 0; i < 23; ++i) a.in[i] = (const float*)d_in[i];
    a.out = (float*)d_out; a.ws = ws; a.ph_lo = 0; a.ph_hi = NPHASES; a.li = 0; a.pad = 0;
    hipLaunchKernelGGL(mega, dim3(grid), dim3(NWAVES * 64), LDS_BYTES, stream, a);
}
```

```cpp
#include <hip/hip_runtime.h>
#include <cstdint>
#include <cstdio>
#include <cmath>

#define LAS __attribute__((address_space(3)))
#define GAS __attribute__((address_space(1)))
typedef unsigned short bf16_t;
typedef short bf16x8 __attribute__((ext_vector_type(8)));
typedef short s16x4 __attribute__((ext_vector_type(4)));
typedef float f32x2 __attribute__((ext_vector_type(2)));
typedef float f32x4 __attribute__((ext_vector_type(4)));
typedef float f32x16 __attribute__((ext_vector_type(16)));
typedef unsigned u32x2 __attribute__((ext_vector_type(2)));
typedef unsigned u32x4 __attribute__((ext_vector_type(4)));

__device__ __forceinline__ unsigned cvt_pk_bf16(float lo, float hi) { unsigned r; asm volatile("v_cvt_pk_bf16_f32 %0, %1, %2" : "=v"(r) : "v"(lo), "v"(hi)); return r; }
__device__ __forceinline__ float bf16lo(unsigned w) { return __uint_as_float(w << 16); }
__device__ __forceinline__ float bf16hi(unsigned w) { return __uint_as_float(w & 0xffff0000u); }
__device__ __forceinline__ int lane_id() { int r; asm volatile("v_mbcnt_lo_u32_b32 %0, -1, 0\n\tv_mbcnt_hi_u32_b32 %0, -1, %0" : "=v"(r)); return r; }
__device__ __forceinline__ float wsum64(float v) {
#pragma unroll
    for (int o = 1; o < 64; o <<= 1) v += __shfl_xor(v, o);
    return v;
}

namespace pg {
constexpr int BM = 256, BK = 64, HALF = 128, HTB = HALF * BK * 2, STAGE_BYTES = 8 * HTB, NXCD = 8, WGM = 8;
__host__ __device__ __forceinline__ int lds_byte(int r, int c) { const int st = (r >> 4) * 2 + (c >> 5), rr = r & 15, cc = c & 31, ob = rr * 64 + cc * 2; return st * 1024 + (ob ^ (((ob >> 9) & 1) << 5)); }
__host__ __device__ __forceinline__ void stage_rc(int b, int& R, int& C) { const int st = b / 1024, sb = b % 1024, swz = sb ^ (((sb >> 9) & 1) << 5); R = (st >> 1) * 16 + swz / 64; C = (st & 1) * 32 + (swz % 64) / 2; }
__host__ __device__ __forceinline__ int perm32(int rho) { const int n = rho >> 4, i = rho & 15; return 8 * (i >> 2) + 4 * n + (i & 3); }

struct Unit { int pm, pn, aux; };

__device__ __forceinline__ bool static_unit(int nM, int nN, int G, int c, int i, int& pm, int& pn) {
    const int nwg = nM * nN; const long L = (long)i * G + c; if (L >= nwg) return false;
    int wgid = (int)L; { const int q = nwg / NXCD, r = nwg % NXCD, xcd = wgid % NXCD, off = wgid / NXCD; wgid = (xcd < r ? xcd * (q + 1) : r * (q + 1) + (xcd - r) * q) + off; }
    const int nig = WGM * nN, gid = wgid / nig, fm = gid * WGM, gsz = (nM - fm) < WGM ? (nM - fm) : WGM;
    pm = fm + ((wgid % nig) % gsz); pn = (wgid % nig) / gsz; return true;
}

struct DenseSched {
    static constexpr bool GATHER = false; static constexpr int KSPLIT = 0;
    const char* A; const char* Bt; int lda, K, nM, nN, G, c;
    __device__ __forceinline__ bool next(int i, Unit& u) const { u.aux = 0; return static_unit(nM, nN, G, c, i, u.pm, u.pn); }
    __device__ __forceinline__ int a_ld() const { return lda; }
    __device__ __forceinline__ void addr(const Unit& u, const char*& abase, const char*& bbase) const {
        abase = A + (size_t)u.pm * BM * lda * 2; bbase = Bt + (size_t)u.pn * BM * K * 2; }
    __device__ __forceinline__ void addr_g(const Unit&, const int (&)[2], const int (&)[2], unsigned (&)[2][2], const char*&) const {}
    __device__ __forceinline__ const char* abase() const { return A; }
};

constexpr int EPI_STAGE_OFF = 139264, EPI_ROWB = 528;
template <class StoreFn>
__device__ __forceinline__ void staged_rows(LAS unsigned char* stage, u32x4 w0, u32x4 w1, int ai, int m, int wid, int lane, const StoreFn& store) {
    const int wr = wid >> 2, wc = wid & 3, fr = lane & 15, fq = lane >> 4, rr = 16 * wr + fr;
    *(LAS u32x4*)(stage + rr * EPI_ROWB + (32 * wc + 8 * fq) * 2) = w0;
    *(LAS u32x4*)(stage + rr * EPI_ROWB + (128 + 32 * wc + 8 * fq) * 2) = w1;
    asm volatile("s_waitcnt lgkmcnt(0)\n\ts_barrier" ::: "memory");
#pragma unroll
    for (int i = 0; i < 2; ++i) { const int r2 = 4 * wid + 2 * i + (lane >> 5), ch = lane & 31;
        const u32x4 v = *(const LAS u32x4*)(stage + r2 * EPI_ROWB + ch * 16);
        store(128 * ai + 64 * (r2 >> 4) + 16 * m + (r2 & 15), ch, v); }
    asm volatile("s_waitcnt lgkmcnt(0)\n\ts_barrier" ::: "memory");
}

template <class Epi, class Sched>
__device__ __forceinline__ void gemm_phase(LAS unsigned char* lds, const Sched& S, const Epi& E, int K, int wid) {
    const int lane = lane_id(), tid = wid * 64 + lane, wr = wid >> 2, wc = wid & 3, fr = lane & 15, fq = lane >> 4;
    const int nt = K / BK;
    constexpr int KSPLIT = Sched::KSPLIT;
    const int KB = KSPLIT > 0 ? KSPLIT * BK : K;
    int Rr[2], Cc[2]; unsigned voffB[2];
#pragma unroll
    for (int i = 0; i < 2; ++i) { int R, C; stage_rc(tid * 16 + i * 8192, R, C); Rr[i] = R; Cc[i] = C; const int Rb = (R & ~31) + perm32(R & 31); voffB[i] = (unsigned)(Rb * KB + C) * 2u; }
    const size_t kstep = (size_t)(BK * 2);
    const size_t hstepB = (size_t)HALF * KB * 2;
    const unsigned ldsw = (unsigned)wid * 1024u;
    const int aoff = lds_byte(wr * 64 + fr, fq * 8), boff = lds_byte(wc * 32 + fr, fq * 8);
    const char* const Ab = S.abase();
    constexpr bool GATHER = Sched::GATHER;
    unsigned voffA[2];
#pragma unroll
    for (int i = 0; i < 2; ++i) voffA[i] = (unsigned)(Rr[i] * S.a_ld() + Cc[i]) * 2u;
    const size_t hstepA = (size_t)HALF * S.a_ld() * 2;
#define PG_SA(b, h) (((b) * 2 + (h)) * HTB)
#define PG_SB(b, h) ((4 + (b) * 2 + (h)) * HTB)
#define PG_STAGEB(bufoff, gbase) do { _Pragma("unroll") for (int _i = 0; _i < 2; ++_i) \
        __builtin_amdgcn_global_load_lds((const unsigned*)((const char*)(gbase) + voffB[_i]), (LAS unsigned*)(lds + (bufoff) + ldsw + _i * 8192), 16, 0, 0); } while (0)
#define PG_STAGEA(bufoff, uptr, offs, h, kb) do { _Pragma("unroll") for (int _i = 0; _i < 2; ++_i) { \
        const char* _src; if constexpr (GATHER) _src = Ab + (size_t)(offs)[h][_i] + (kb); else _src = (uptr) + (h) * hstepA + (kb) + voffA[_i]; \
        __builtin_amdgcn_global_load_lds((const unsigned*)_src, (LAS unsigned*)(lds + (bufoff) + ldsw + _i * 8192), 16, 0, 0); } } while (0)
#define PG_LDA(dst, b, h) do { _Pragma("unroll") for (int m = 0; m < 4; ++m) _Pragma("unroll") for (int k = 0; k < 2; ++k) dst[m][k] = *(const LAS bf16x8*)(lds + PG_SA(b, h) + aoff + m * 2048 + k * 1024); } while (0)
#define PG_LDB(dst, b, h) do { _Pragma("unroll") for (int n = 0; n < 2; ++n) _Pragma("unroll") for (int k = 0; k < 2; ++k) dst[n][k] = *(const LAS bf16x8*)(lds + PG_SB(b, h) + boff + n * 2048 + k * 1024); } while (0)
#define PG_MMA(ai, bj, At, Bt_) do { __builtin_amdgcn_s_setprio(1); _Pragma("unroll") for (int m = 0; m < 4; ++m) _Pragma("unroll") for (int n = 0; n < 2; ++n) _Pragma("unroll") for (int k = 0; k < 2; ++k) \
        acc[ai][bj][m][n] = __builtin_amdgcn_mfma_f32_16x16x32_bf16(Bt_[n][k], At[m][k], acc[ai][bj][m][n], 0, 0, 0); __builtin_amdgcn_s_setprio(0); } while (0)
#define PG_WAIT_V(n) asm volatile("s_waitcnt vmcnt(" #n ")" ::: "memory")
#define PG_WAIT_L(n) asm volatile("s_waitcnt lgkmcnt(" #n ")" ::: "memory")
#define PG_BAR __builtin_amdgcn_s_barrier()
#define PG_SCHED __builtin_amdgcn_sched_barrier(0)
    Unit cur, nxt; int ui = 0;
    if (!S.next(0, cur)) return;
    f32x4 acc[2][2][4][2];
#pragma unroll
    for (int a = 0; a < 2; ++a)
#pragma unroll
        for (int b = 0; b < 2; ++b)
#pragma unroll
            for (int m = 0; m < 4; ++m)
#pragma unroll
                for (int n = 0; n < 2; ++n) acc[a][b][m][n] = (f32x4){0.f, 0.f, 0.f, 0.f};
    bf16x8 At[4][2], B0[2][2], B1[2][2];
    unsigned cao[2][2], nao[2][2]; const char* cA = nullptr; const char* nA = nullptr; const char* cB; const char* nB; const char* cB2 = nullptr; const char* nB2 = nullptr;
    if constexpr (GATHER) S.addr_g(cur, Rr, Cc, cao, cB); else if constexpr (KSPLIT > 0) S.addr(cur, cA, cB, cB2); else S.addr(cur, cA, cB);
    PG_STAGEB(PG_SB(0, 0), cB); PG_STAGEB(PG_SB(0, 1), cB + hstepB); PG_STAGEA(PG_SA(0, 0), cA, cao, 0, 0); PG_STAGEA(PG_SA(0, 1), cA, cao, 1, 0);
    if (wr == 1) PG_BAR;
    PG_WAIT_V(2); PG_BAR;
    PG_STAGEB(PG_SB(1, 0), cB + kstep); PG_STAGEA(PG_SA(1, 0), cA, cao, 0, kstep); PG_STAGEB(PG_SB(1, 1), cB + hstepB + kstep);
    PG_WAIT_V(6); PG_BAR;
    for (;;) {
        const bool has_next = S.next(ui + 1, nxt);
        if (has_next) { if constexpr (GATHER) S.addr_g(nxt, Rr, Cc, nao, nB); else if constexpr (KSPLIT > 0) S.addr(nxt, nA, nB, nB2); else S.addr(nxt, nA, nB); }
        else { nB = cB; nA = cA; nB2 = cB2;
            if constexpr (GATHER) {
#pragma unroll
                for (int h = 0; h < 2; ++h)
#pragma unroll
                    for (int i = 0; i < 2; ++i) nao[h][i] = cao[h][i]; } }
#pragma clang loop unroll(disable)
        for (int t = 0; t < nt; t += 2) {
            const bool last = (t == nt - 2);
            const size_t k1 = (size_t)(t + 1) * kstep;
            const size_t k2 = last ? 0 : (size_t)(t + 2) * kstep, k3 = k2 + kstep;
            const char* b2;
            if constexpr (KSPLIT > 0) b2 = last ? nB : ((t + 2 >= KSPLIT) ? cB2 + (size_t)(t + 2 - KSPLIT) * kstep : cB + (size_t)(t + 2) * kstep);
            else b2 = last ? nB : cB + (size_t)(t + 2) * kstep;
            const char* b3 = b2 + kstep;
            unsigned a2o[2][2]; const char* a2 = last ? nA : cA;
            if constexpr (GATHER) {
#pragma unroll
                for (int h = 0; h < 2; ++h)
#pragma unroll
                    for (int i = 0; i < 2; ++i) a2o[h][i] = last ? nao[h][i] : cao[h][i]; }
            PG_LDB(B0, 0, 0); PG_LDB(B1, 0, 1); PG_SCHED; PG_LDA(At, 0, 0); PG_STAGEA(PG_SA(1, 1), cA, cao, 1, k1);
            PG_WAIT_V(8); PG_WAIT_L(0); PG_BAR; PG_MMA(0, 0, At, B0); PG_MMA(0, 1, At, B1); PG_BAR; PG_SCHED;
            PG_LDA(At, 0, 1); PG_STAGEB(PG_SB(0, 0), b2); PG_STAGEB(PG_SB(0, 1), b2 + hstepB); PG_STAGEA(PG_SA(0, 0), a2, a2o, 0, k2);
            PG_WAIT_V(8); PG_WAIT_L(0); PG_BAR; PG_MMA(1, 0, At, B0); PG_MMA(1, 1, At, B1); PG_BAR; PG_SCHED;
            PG_LDB(B0, 1, 0); PG_LDB(B1, 1, 1); PG_SCHED; PG_LDA(At, 1, 0); PG_STAGEA(PG_SA(0, 1), a2, a2o, 1, k2);
            PG_WAIT_V(8); PG_WAIT_L(0); PG_BAR; PG_MMA(0, 0, At, B0); PG_MMA(0, 1, At, B1); PG_BAR; PG_SCHED;
            PG_LDA(At, 1, 1); PG_STAGEB(PG_SB(1, 0), b3); PG_STAGEB(PG_SB(1, 1), b3 + hstepB); PG_STAGEA(PG_SA(1, 0), a2, a2o, 0, k3);
            PG_WAIT_V(8); PG_WAIT_L(0); PG_BAR; PG_MMA(1, 0, At, B0); PG_MMA(1, 1, At, B1); PG_BAR; PG_SCHED;
        }
        if (wr == 0) PG_BAR;
        { const int l2 = lane_id();
          E(acc, cur, wr, wc, l2 & 15, l2 >> 4, lds + EPI_STAGE_OFF, wid); }
        if (!has_next) break;
#pragma unroll
        for (int a = 0; a < 2; ++a)
#pragma unroll
            for (int b = 0; b < 2; ++b)
#pragma unroll
                for (int m = 0; m < 4; ++m)
#pragma unroll
                    for (int n = 0; n < 2; ++n) acc[a][b][m][n] = (f32x4){0.f, 0.f, 0.f, 0.f};
        cur = nxt; cB = nB; cA = nA; cB2 = nB2;
        if constexpr (GATHER) {
#pragma unroll
            for (int h = 0; h < 2; ++h)
#pragma unroll
                for (int i = 0; i < 2; ++i) cao[h][i] = nao[h][i]; }
        ++ui;
        if (wr == 1) PG_BAR;
    }
    PG_WAIT_V(0);
    PG_BAR;
#undef PG_SA
#undef PG_SB
#undef PG_STAGEA
#undef PG_STAGEB
#undef PG_LDA
#undef PG_LDB
#undef PG_MMA
#undef PG_WAIT_V
#undef PG_WAIT_L
#undef PG_BAR
#undef PG_SCHED
}
}

#define XB_TMO      128
#define XB_XCNT(j)  (256  + 64 * (j))
#define XB_XSUB(j)  (1280 + 64 * (j))
#define XB_XGEN(j)  (2304 + 64 * (j))
#define XB_TOP      3328
#define XB_TOPGEN   3392
#define XCD_BAR_WORDS 3456
#define XB_SPIN_CAP (1u << 22)
__device__ __forceinline__ unsigned xb_ld(unsigned* p)              { return __hip_atomic_load(p, __ATOMIC_RELAXED, __HIP_MEMORY_SCOPE_AGENT); }
__device__ __forceinline__ unsigned xb_add(unsigned* p, unsigned v) { return __hip_atomic_fetch_add(p, v, __ATOMIC_RELAXED, __HIP_MEMORY_SCOPE_AGENT); }
__device__ __forceinline__ unsigned xb_xcc_id() { return (unsigned)__builtin_amdgcn_s_getreg((3 << 11) | 20) & 0xFu; }
#define XB_SPIN(cond, bar) do { unsigned _sp = 0; while (cond) { __builtin_amdgcn_s_sleep(1); \
    if ((++_sp & 255u) == 0u) { if (xb_ld(&(bar)[XB_TMO])) break; if (_sp > XB_SPIN_CAP) { atomicAdd(&(bar)[XB_TMO], 1u); break; } } } } while (0)
struct XcdBarrier { unsigned* bar; unsigned x; volatile LAS unsigned* st; };
__device__ __forceinline__ XcdBarrier xcd_barrier_post(unsigned* bar, volatile LAS unsigned* st) {
    XcdBarrier b; b.bar = bar; b.x = xb_xcc_id(); b.st = st;
    if (threadIdx.x == 0) (void)xb_add(&bar[XB_XCNT(b.x)], 1u);
    return b;
}
__device__ __forceinline__ void xcd_barrier_complete(unsigned* bar, unsigned x, unsigned& nloc, unsigned& nx) {
    const unsigned G = gridDim.x * gridDim.y * gridDim.z;
    unsigned sum, cnt, mine, sp = 0u;
    for (;;) {
        sum = 0u; cnt = 0u; mine = 0u;
#pragma unroll
        for (unsigned j = 0; j < 16; ++j) { const unsigned c = xb_ld(&bar[XB_XCNT(j)]); sum += c; cnt += (c > 0u) ? 1u : 0u; mine = (j == x) ? c : mine; }
        if (sum == G) break;
        __builtin_amdgcn_s_sleep(1);
        if ((++sp & 255u) == 0u) { if (xb_ld(&bar[XB_TMO])) break; if (sp > XB_SPIN_CAP) { atomicAdd(&bar[XB_TMO], 1u); break; } }
    }
    nloc = mine > 0u ? mine : 1u; nx = cnt > 0u ? cnt : 1u;
}
__device__ __forceinline__ void xcd_barrier(const XcdBarrier& b) {
    asm volatile("s_waitcnt vmcnt(0)" ::: "memory");
    __syncthreads();
    if (threadIdx.x == 0) {
        unsigned* bar = b.bar;
        __builtin_amdgcn_s_waitcnt(0);
        unsigned nloc = b.st[0], nx = b.st[1];
        if (nloc == 0u) { xcd_barrier_complete(bar, b.x, nloc, nx); b.st[0] = nloc; b.st[1] = nx; }
        const unsigned old = xb_add(&bar[XB_XSUB(b.x)], 1u);
        const unsigned gen = old / nloc;
        if (old + 1u == (gen + 1u) * nloc) {
            __builtin_amdgcn_fence(__ATOMIC_RELEASE, "agent");
            asm volatile("s_waitcnt vmcnt(0)" ::: "memory");
            const unsigned og = xb_add(&bar[XB_TOP], 1u);
            const unsigned tg = og / nx;
            if (og + 1u == (tg + 1u) * nx) xb_add(&bar[XB_TOPGEN], 1u);
            else XB_SPIN(xb_ld(&bar[XB_TOPGEN]) == tg, bar);
            __builtin_amdgcn_fence(__ATOMIC_ACQUIRE, "agent");
            xb_add(&bar[XB_XGEN(b.x)], 1u);
            asm volatile("s_waitcnt vmcnt(0)" ::: "memory");
        } else {
            XB_SPIN(xb_ld(&bar[XB_XGEN(b.x)]) == gen, bar);
            __builtin_amdgcn_fence(__ATOMIC_ACQUIRE, "agent");
            asm volatile("s_waitcnt vmcnt(0)" ::: "memory");
        }
    }
    __syncthreads();
}

constexpr int NB = 8, SEQ = 4096, T = NB * SEQ, DM = 1024;
constexpr int INW = 2208, INWP = 2304;
constexpr int QLORA = 384, KVLORA = 256;
constexpr float EPS = 1e-6f;
constexpr float LOG2E = 1.4426950408889634f;
constexpr float QA_SCALE = 0.125f * LOG2E;
constexpr float MLA_QSCALE = 0.10206207261596577f * LOG2E;
constexpr int NWAVES = 8;

constexpr size_t MiB = 1u << 20;
constexpr size_t WS_CTL = 0, CTL_ZERO_BYTES = 1 * MiB;
constexpr size_t WS_ROPE = 1 * MiB;
constexpr size_t WS_SSQ = 2 * MiB;
constexpr size_t WS_WIN = 5 * MiB, WS_WUQ = 10 * MiB, WS_WUKV = 11 * MiB, WS_WO = 12 * MiB, WS_WPG = 14 * MiB, WS_WPP = 16 * MiB, WS_WGU = 17 * MiB, WS_WD = 49 * MiB;
constexpr size_t WS_XN = 65 * MiB;
constexpr size_t WS_P16 = 305 * MiB;
constexpr size_t WS_PP = 145 * MiB;
constexpr size_t WS_QA = 209 * MiB, WS_KA = 241 * MiB, WS_VA = 273 * MiB;
static_assert(WS_KA - WS_QA == (size_t)T * 512 * 2 && WS_VA - WS_KA == (size_t)T * 512 * 2, "QA|KA|VA contiguous");
constexpr size_t WS_CQKV = 305 * MiB;
constexpr size_t WS_QB = 345 * MiB, WS_KB = 393 * MiB;
constexpr size_t WS_VB = 441 * MiB;
constexpr size_t WS_OB = 473 * MiB;
constexpr size_t WS_OAP0 = 65 * MiB, WS_OAP1 = 97 * MiB, WS_OAP2 = 305 * MiB;
constexpr size_t WS_LSE = 129 * MiB;
constexpr size_t WS_MIXED = 209 * MiB;
constexpr size_t WS_M = 65 * MiB;
constexpr size_t WS_Y = 209 * MiB;
constexpr size_t WS_HID = 353 * MiB;
constexpr size_t WS_LIST = 132 * MiB;
constexpr size_t WS_RS2 = 136 * MiB + 896 * 1024;
constexpr size_t WS_TOKINFO = 136 * MiB;
constexpr int CW_BAR = 4096, CW_CNT = 16384, CW_Q = 20480;

constexpr int RING_BYTES = 131072;
constexpr int LDSCTL_OFF = RING_BYTES, MISC_OFF = LDSCTL_OFF + 320;
constexpr int LDS_BYTES = 163840;

struct Args { const float* in[23]; float* out; unsigned char* ws; int ph_lo, ph_hi, li, pad; };
struct Frame {
    LAS unsigned char* lds;
    int wave, vcu, G;
    unsigned char* ws; unsigned* ctl;
};

__device__ __forceinline__ void p0_transpose_item(const float* __restrict__ W, int ldw, int k0, int n0, bf16_t* WT, int ldd, int drow0, const float* __restrict__ gain, LAS float* scr, int lane) {
    const int kq = lane >> 3, n4 = (lane & 7) * 4;
    f32x4 v[8];
#pragma unroll
    for (int i = 0; i < 8; ++i) v[i] = *(const f32x4*)(W + (size_t)(k0 + kq + 8 * i) * ldw + n0 + n4);
#pragma unroll
    for (int i = 0; i < 8; ++i) { const int kk = kq + 8 * i; f32x4 x = v[i]; if (gain) x = x * gain[k0 + kk];
        scr[kk * 33 + n4] = x[0]; scr[kk * 33 + n4 + 1] = x[1]; scr[kk * 33 + n4 + 2] = x[2]; scr[kk * 33 + n4 + 3] = x[3]; }
    asm volatile("s_waitcnt lgkmcnt(0)" ::: "memory");
    const int c = lane & 7;
#pragma unroll
    for (int j = 0; j < 4; ++j) { const int n = (lane >> 3) + 8 * j; const LAS float* s = scr + (8 * c) * 33 + n;
        u32x4 o; o.x = cvt_pk_bf16(s[0 * 33], s[1 * 33]); o.y = cvt_pk_bf16(s[2 * 33], s[3 * 33]); o.z = cvt_pk_bf16(s[4 * 33], s[5 * 33]); o.w = cvt_pk_bf16(s[6 * 33], s[7 * 33]);
        *(u32x4*)(WT + (size_t)(drow0 + n) * ldd + k0 + 8 * c) = o; }
    asm volatile("s_waitcnt lgkmcnt(0)" ::: "memory");
}
__device__ __forceinline__ void rms_row_to_bf16(const float* xrow, const float* __restrict__ g, bf16_t* orow, int lane) {
    const f32x4* xr = (const f32x4*)xrow + lane; const f32x4* gr = (const f32x4*)g + lane;
    f32x4 v[4]; float s = 0.f;
#pragma unroll
    for (int j = 0; j < 4; ++j) { v[j] = xr[64 * j]; s += (v[j].x * v[j].x + v[j].y * v[j].y) + (v[j].z * v[j].z + v[j].w * v[j].w); }
    const float rstd = 1.0f / sqrtf(wsum64(s) * (1.f / 1024.f) + EPS);
    u32x2* o8 = (u32x2*)orow + lane;
#pragma unroll
    for (int j = 0; j < 4; ++j) { const f32x4 gg = gr[64 * j]; u32x2 w; w.x = cvt_pk_bf16(v[j].x * rstd * gg.x, v[j].y * rstd * gg.y); w.y = cvt_pk_bf16(v[j].z * rstd * gg.z, v[j].w * rstd * gg.w); o8[64 * j] = w; }
}

__device__ __forceinline__ void p0_prologue(const Frame& F, const Args& a) {
    LAS float* scr = (LAS float*)(F.lds + F.wave * 16384);
    const int gw = F.vcu * NWAVES + F.wave, NGW = F.G * NWAVES, lane = lane_id();
    unsigned char* ws = F.ws;
    const float* w_in = a.in[3]; const float* g_cq = a.in[4]; const float* w_uq = a.in[5]; const float* g_ckv = a.in[6]; const float* w_ukv = a.in[7];
    const float* w_o = a.in[10]; const float* w_eg = a.in[16]; const float* w_eu = a.in[17]; const float* w_ed = a.in[18]; const float* w_pg = a.in[20]; const float* w_pp = a.in[21];
    constexpr int I_IN = 16 * 69, I_UQ = 6 * 24, I_UKV = 4 * 32, I_O = 16 * 32, I_PG = 16 * 32, I_PP = 4 * 32, I_EG = 32 * 16 * 8, I_EU = I_EG, I_ED = 32 * 4 * 32;
    constexpr int NITEMS = I_IN + I_UQ + I_UKV + I_O + I_PG + I_PP + I_EG + I_EU + I_ED;
    for (int it = gw; it < NITEMS; it += NGW) {
        int r = it;
        if (r < I_IN) { const int kb = r / 69, nb = r % 69; p0_transpose_item(w_in, INW, 64 * kb, 32 * nb, (bf16_t*)(ws + WS_WIN), 1024, 32 * nb, nullptr, scr, lane); continue; } r -= I_IN;
        if (r < I_UQ) { const int kb = r / 24, nb = r % 24; p0_transpose_item(w_uq, 768, 64 * kb, 32 * nb, (bf16_t*)(ws + WS_WUQ), QLORA, 32 * nb, g_cq, scr, lane); continue; } r -= I_UQ;
        if (r < I_UKV) { const int kb = r / 32, nb = r % 32; p0_transpose_item(w_ukv, 1024, 64 * kb, 32 * nb, (bf16_t*)(ws + WS_WUKV), KVLORA, 32 * nb, g_ckv, scr, lane); continue; } r -= I_UKV;
        if (r < I_O) { const int kb = r / 32, nb = r % 32; p0_transpose_item(w_o, 1024, 64 * kb, 32 * nb, (bf16_t*)(ws + WS_WO), 1024, 32 * nb, nullptr, scr, lane); continue; } r -= I_O;
        if (r < I_PG) { const int kb = r / 32, nb = r % 32; p0_transpose_item(w_pg, 1024, 64 * kb, 32 * nb, (bf16_t*)(ws + WS_WPG), 1024, 32 * nb, a.in[19], scr, lane); continue; } r -= I_PG;
        if (r < I_PP) { const int kb = r / 32, nb = r % 32; p0_transpose_item(w_pp, 1024, 64 * kb, 32 * nb, (bf16_t*)(ws + WS_WPP), 256, 32 * nb, nullptr, scr, lane); continue; } r -= I_PP;
        if (r < I_EG + I_EU) {
            const int up = r >= I_EG; if (up) r -= I_EG;
            const int e = r / 128, q = r % 128, kb = q / 8, nb = q % 8, n0 = 32 * nb;
            const int drow = (n0 >> 7) * 256 + (up ? 128 : 0) + (n0 & 127);
            p0_transpose_item((up ? w_eu : w_eg) + (size_t)e * 1024 * 256, 256, 64 * kb, n0, (bf16_t*)(ws + WS_WGU) + (size_t)e * 512 * 1024, 1024, drow, a.in[11], scr, lane); continue; }
        r -= I_EG + I_EU;
        { const int e = r / 128, q = r % 128, kb = q / 32, nb = q % 32;
          p0_transpose_item(w_ed + (size_t)e * 256 * 1024, 1024, 64 * kb, 32 * nb, (bf16_t*)(ws + WS_WD) + (size_t)e * 1024 * 256, 256, 32 * nb, nullptr, scr, lane); }
    }
    for (int i = gw * 64 + lane; i < 96 * 128; i += NGW * 64) ((u32x4*)((bf16_t*)(ws + WS_WIN) + (size_t)INW * 1024))[i] = (u32x4){0u, 0u, 0u, 0u};
    { const float* x = a.in[0]; const float* g_mix = a.in[2]; bf16_t* XN = (bf16_t*)(ws + WS_XN);
      f32x4 gg[4];
#pragma unroll
      for (int j = 0; j < 4; ++j) gg[j] = ((const f32x4*)g_mix)[lane + 64 * j];
      for (int m = gw * 2; m < T; m += NGW * 2) {
          f32x4 v0[4], v1[4]; float s0 = 0.f, s1 = 0.f;
#pragma unroll
          for (int j = 0; j < 4; ++j) { v0[j] = ((const f32x4*)(x + (size_t)m * DM))[lane + 64 * j]; v1[j] = ((const f32x4*)(x + (size_t)(m + 1) * DM))[lane + 64 * j]; }
#pragma unroll
          for (int j = 0; j < 4; ++j) { s0 += (v0[j].x * v0[j].x + v0[j].y * v0[j].y) + (v0[j].z * v0[j].z + v0[j].w * v0[j].w); s1 += (v1[j].x * v1[j].x + v1[j].y * v1[j].y) + (v1[j].z * v1[j].z + v1[j].w * v1[j].w); }
          const float r0 = 1.0f / sqrtf(wsum64(s0) * (1.f / 1024.f) + EPS), r1 = 1.0f / sqrtf(wsum64(s1) * (1.f / 1024.f) + EPS);
#pragma unroll
          for (int j = 0; j < 4; ++j) { u32x2 w0, w1;
              w0.x = cvt_pk_bf16(v0[j].x * r0 * gg[j].x, v0[j].y * r0 * gg[j].y); w0.y = cvt_pk_bf16(v0[j].z * r0 * gg[j].z, v0[j].w * r0 * gg[j].w);
              w1.x = cvt_pk_bf16(v1[j].x * r1 * gg[j].x, v1[j].y * r1 * gg[j].y); w1.y = cvt_pk_bf16(v1[j].z * r1 * gg[j].z, v1[j].w * r1 * gg[j].w);
              ((u32x2*)(XN + (size_t)m * DM))[lane + 64 * j] = w0; ((u32x2*)(XN + (size_t)(m + 1) * DM))[lane + 64 * j] = w1; } } }
    { float* cs = (float*)(ws + WS_ROPE); float* sn = cs + SEQ * 16;
      for (int idx = gw * 64 + lane; idx < SEQ * 16; idx += NGW * 64) {
          const int pos = idx >> 4, i = idx & 15;
          const float inv = 1.0f / powf(10000.0f, (float)(2 * i) / 32.0f);
          const float ang = (float)pos * inv;
          cs[idx] = (float)cos((double)ang); sn[idx] = (float)sin((double)ang); } }
}

struct EpiInProj {
    bf16_t *QA, *CQKV, *KB; float* SSQ; const float* CS; const float* SN;
    __device__ __forceinline__ void operator()(const f32x4 (&acc)[2][2][4][2], const pg::Unit& u, int wr, int wc, int fr, int fq, LAS unsigned char* stage, int wid) const {
        const int pn = u.pn;
        if (pn < 6) {
            bf16_t* const tile = QA + (size_t)(pn >> 1) * ((size_t)T * 512) + (size_t)u.pm * 256 * 512 + (pn & 1) * 256; const float sc = (pn < 2) ? QA_SCALE : 1.f;
            const int lane = fr + 16 * fq;
#pragma unroll
            for (int ai = 0; ai < 2; ++ai)
#pragma unroll
                for (int m = 0; m < 4; ++m) { u32x4 w[2];
#pragma unroll
                    for (int bj = 0; bj < 2; ++bj) { const f32x4 v0 = acc[ai][bj][m][0] * sc, v1 = acc[ai][bj][m][1] * sc;
                        w[bj].x = cvt_pk_bf16(v0[0], v0[1]); w[bj].y = cvt_pk_bf16(v0[2], v0[3]); w[bj].z = cvt_pk_bf16(v1[0], v1[1]); w[bj].w = cvt_pk_bf16(v1[2], v1[3]); }
                    pg::staged_rows(stage, w[0], w[1], ai, m, wid, lane, [tile](int trow, int ch, u32x4 v) { __builtin_nontemporal_store(v, (u32x4*)(tile + (size_t)trow * 512 + ch * 8)); }); }
        } else {
#pragma unroll
            for (int ai = 0; ai < 2; ++ai)
#pragma unroll
                for (int m = 0; m < 4; ++m) { const int row = u.pm * 256 + ai * 128 + wr * 64 + m * 16 + fr;
#pragma unroll
                    for (int bj = 0; bj < 2; ++bj) {
                        const f32x4 v0 = acc[ai][bj][m][0], v1 = acc[ai][bj][m][1];
                        if (pn < 8 || bj == 0) {
                            const int col = (pn - 6) * 256 + bj * 128 + wc * 32 + 8 * fq; u32x4 w;
                            w.x = cvt_pk_bf16(v0[0], v0[1]); w.y = cvt_pk_bf16(v0[2], v0[3]); w.z = cvt_pk_bf16(v1[0], v1[1]); w.w = cvt_pk_bf16(v1[2], v1[3]);
                            *(u32x4*)(CQKV + (size_t)row * 640 + col) = w;
                            float s = (v0[0] * v0[0] + v0[1] * v0[1]) + (v0[2] * v0[2] + v0[3] * v0[3]) + (v1[0] * v1[0] + v1[1] * v1[1]) + (v1[2] * v1[2] + v1[3] * v1[3]);
                            s += __shfl_xor(s, 16); s += __shfl_xor(s, 32);
                            if (fq == 0) SSQ[(size_t)row * 20 + (pn - 6) * 8 + bj * 4 + wc] = s;
                        } else if (wc == 0) {
                            const int pos = row & (SEQ - 1); const int ci = pos * 16 + 8 * (fq & 1);
                            const f32x4 c0 = *(const f32x4*)(CS + ci), c1 = *(const f32x4*)(CS + ci + 4), s0 = *(const f32x4*)(SN + ci), s1 = *(const f32x4*)(SN + ci + 4);
                            f32x4 p0, p1;
#pragma unroll
                            for (int j = 0; j < 4; ++j) { p0[j] = __shfl_xor(v0[j], 32); p1[j] = __shfl_xor(v1[j], 32); }
                            f32x4 o0, o1;
                            if (fq < 2) { o0 = v0 * c0 - p0 * s0; o1 = v1 * c1 - p1 * s1; }
                            else        { o0 = p0 * s0 + v0 * c0; o1 = p1 * s1 + v1 * c1; }
                            u32x4 w; w.x = cvt_pk_bf16(o0[0], o0[1]); w.y = cvt_pk_bf16(o0[2], o0[3]); w.z = cvt_pk_bf16(o1[0], o1[1]); w.w = cvt_pk_bf16(o1[2], o1[3]);
#pragma unroll
                            for (int h = 0; h < 8; ++h) *(u32x4*)(KB + (size_t)row * 768 + h * 96 + 64 + 8 * fq) = w;
                        }
                    } }
        }
    }
};
struct EpiStoreBf16 {
    bf16_t* O; int ldc;
    __device__ __forceinline__ void operator()(const f32x4 (&acc)[2][2][4][2], const pg::Unit& u, int wr, int wc, int fr, int fq, LAS unsigned char* stage, int wid) const {
        const int lane = fr + 16 * fq; bf16_t* const tile = O + (size_t)u.pm * 256 * ldc + u.pn * 256; const int ld = ldc;
#pragma unroll
        for (int ai = 0; ai < 2; ++ai)
#pragma unroll
            for (int m = 0; m < 4; ++m) { u32x4 w[2];
#pragma unroll
                for (int bj = 0; bj < 2; ++bj) { const f32x4 v0 = acc[ai][bj][m][0], v1 = acc[ai][bj][m][1];
                    w[bj].x = cvt_pk_bf16(v0[0], v0[1]); w[bj].y = cvt_pk_bf16(v0[2], v0[3]); w[bj].z = cvt_pk_bf16(v1[0], v1[1]); w[bj].w = cvt_pk_bf16(v1[2], v1[3]); }
                pg::staged_rows(stage, w[0], w[1], ai, m, wid, lane, [tile, ld](int trow, int ch, u32x4 v) { __builtin_nontemporal_store(v, (u32x4*)(tile + (size_t)trow * ld + ch * 8)); }); }
    }
};
struct EpiQUp {
    bf16_t* QB; const float* SSQ; const float* CS; const float* SN;
    __device__ __forceinline__ void operator()(const f32x4 (&acc)[2][2][4][2], const pg::Unit& u, int wr, int wc, int fr, int fq, LAS unsigned char* stage, int wid) const {
        float rstd[2][4];
#pragma unroll
        for (int ai = 0; ai < 2; ++ai)
#pragma unroll
            for (int m = 0; m < 4; ++m) { const int row = u.pm * 256 + ai * 128 + wr * 64 + m * 16 + fr;
                const f32x4 q0 = *(const f32x4*)(SSQ + (size_t)row * 20), q1 = *(const f32x4*)(SSQ + (size_t)row * 20 + 4), q2 = *(const f32x4*)(SSQ + (size_t)row * 20 + 8);
                const float ss = ((q0[0] + q0[1]) + (q0[2] + q0[3])) + ((q1[0] + q1[1]) + (q1[2] + q1[3])) + ((q2[0] + q2[1]) + (q2[2] + q2[3]));
                rstd[ai][m] = 1.0f / sqrtf(ss * (1.f / 384.f) + EPS);
                if (m == 3) asm volatile("" : "+v"(rstd[ai][0]), "+v"(rstd[ai][1]), "+v"(rstd[ai][2]), "+v"(rstd[ai][3]) :: "memory"); }
        const int G0 = u.pn * 8 + wc;
        const int rbj = (G0 % 3 == 2) ? 0 : (((G0 + 4) % 3 == 2) ? 1 : -1);
#pragma unroll
        for (int ai = 0; ai < 2; ++ai)
#pragma unroll
          for (int mh = 0; mh < 2; ++mh) {
            f32x4 c0[2], c1[2], s0[2], s1[2];
#pragma unroll
            for (int m = 0; m < 2; ++m) { c0[m] = f32x4{0.f, 0.f, 0.f, 0.f}; c1[m] = c0[m]; s0[m] = c0[m]; s1[m] = c0[m]; }
            if (rbj >= 0) {
#pragma unroll
                for (int m = 0; m < 2; ++m) { const int row = u.pm * 256 + ai * 128 + wr * 64 + (2 * mh + m) * 16 + fr;
                    const int pos = row & (SEQ - 1); const int ci = pos * 16 + 8 * (fq & 1);
                    c0[m] = *(const f32x4*)(CS + ci); c1[m] = *(const f32x4*)(CS + ci + 4); s0[m] = *(const f32x4*)(SN + ci); s1[m] = *(const f32x4*)(SN + ci + 4); }
            }
#pragma unroll
            for (int mm = 0; mm < 2; ++mm) { const int m = 2 * mh + mm; const int row = u.pm * 256 + ai * 128 + wr * 64 + m * 16 + fr;
#pragma unroll
                for (int bj = 0; bj < 2; ++bj) { const int G = G0 + bj * 4;
                    f32x4 v0 = acc[ai][bj][m][0] * rstd[ai][m], v1 = acc[ai][bj][m][1] * rstd[ai][m];
                    if (bj == rbj) {
                        f32x4 p0, p1;
#pragma unroll
                        for (int j = 0; j < 4; ++j) { p0[j] = __shfl_xor(v0[j], 32); p1[j] = __shfl_xor(v1[j], 32); }
                        if (fq < 2) { v0 = v0 * c0[mm] - p0 * s0[mm]; v1 = v1 * c1[mm] - p1 * s1[mm]; }
                        else        { v0 = p0 * s0[mm] + v0 * c0[mm]; v1 = p1 * s1[mm] + v1 * c1[mm]; }
                    }
                    v0 = v0 * MLA_QSCALE; v1 = v1 * MLA_QSCALE;
                    u32x4 w; w.x = cvt_pk_bf16(v0[0], v0[1]); w.y = cvt_pk_bf16(v0[2], v0[3]); w.z = cvt_pk_bf16(v1[0], v1[1]); w.w = cvt_pk_bf16(v1[2], v1[3]);
                    *(u32x4*)(QB + (size_t)row * 768 + G * 32 + 8 * fq) = w; } }
          }
    }
};
struct EpiKVUp {
    bf16_t *KB, *VB; const float* SSQ;
    __device__ __forceinline__ void operator()(const f32x4 (&acc)[2][2][4][2], const pg::Unit& u, int wr, int wc, int fr, int fq, LAS unsigned char* stage, int wid) const {
        float rstd[2][4];
#pragma unroll
        for (int ai = 0; ai < 2; ++ai)
#pragma unroll
            for (int m = 0; m < 4; ++m) { const int row = u.pm * 256 + ai * 128 + wr * 64 + m * 16 + fr;
                const f32x4 q0 = *(const f32x4*)(SSQ + (size_t)row * 20 + 12), q1 = *(const f32x4*)(SSQ + (size_t)row * 20 + 16);
                const float ss = ((q0[0] + q0[1]) + (q0[2] + q0[3])) + ((q1[0] + q1[1]) + (q1[2] + q1[3]));
                rstd[ai][m] = 1.0f / sqrtf(ss * (1.f / 256.f) + EPS);
                if (m == 3) asm volatile("" : "+v"(rstd[ai][0]), "+v"(rstd[ai][1]), "+v"(rstd[ai][2]), "+v"(rstd[ai][3]) :: "memory"); }
#pragma unroll
        for (int ai = 0; ai < 2; ++ai)
#pragma unroll
            for (int m = 0; m < 4; ++m) { const int row = u.pm * 256 + ai * 128 + wr * 64 + m * 16 + fr;
#pragma unroll
                for (int bj = 0; bj < 2; ++bj) { const int G = u.pn * 8 + bj * 4 + wc;
                    const int h = G >> 2, part = G & 3;
                    const f32x4 v0 = acc[ai][bj][m][0] * rstd[ai][m], v1 = acc[ai][bj][m][1] * rstd[ai][m];
                    u32x4 w; w.x = cvt_pk_bf16(v0[0], v0[1]); w.y = cvt_pk_bf16(v0[2], v0[3]); w.z = cvt_pk_bf16(v1[0], v1[1]); w.w = cvt_pk_bf16(v1[2], v1[3]);
                    if (part < 2) *(u32x4*)(KB + (size_t)row * 768 + h * 96 + part * 32 + 8 * fq) = w;
                    else          *(u32x4*)(VB + (size_t)row * 512 + h * 64 + (part - 2) * 32 + 8 * fq) = w; } }
    }
};

struct PPSched {
    static constexpr bool GATHER = false; static constexpr int KSPLIT = 0;
    const char* A; const char* Bt; int q, nP;
    __device__ __forceinline__ bool next(int i, pg::Unit& u) const { if (q < 0) return false; const int L = i * nP + q; if (L >= 512) return false; u.aux = 0; u.pm = L >> 2; u.pn = L & 3; return true; }
    __device__ __forceinline__ int a_ld() const { return 256; }
    __device__ __forceinline__ void addr(const pg::Unit& u, const char*& abase, const char*& bbase) const { abase = A + (size_t)u.pm * pg::BM * 256 * 2; bbase = Bt + (size_t)u.pn * pg::BM * 256 * 2; }
    __device__ __forceinline__ void addr_g(const pg::Unit&, const int (&)[2], const int (&)[2], unsigned (&)[2][2], const char*&) const {}
    __device__ __forceinline__ const char* abase() const { return A; }
};
__device__ __forceinline__ void pp_units(const Frame& F, int c, int nun) {
    unsigned char* ws = F.ws; const int r = nun % F.G, nP = F.G - r;
    PPSched S{(const char*)(ws + WS_P16), (const char*)(ws + WS_WPP), c - r, nP};
    EpiStoreBf16 E{(bf16_t*)(ws + WS_PP), 1024};
    pg::gemm_phase(F.lds, S, E, 256, F.wave);
}
__device__ __forceinline__ void p1_inproj(const Frame& F) {
    unsigned char* ws = F.ws;
    { pg::DenseSched S{(const char*)(ws + WS_XN), (const char*)(ws + WS_WIN), 1024, 1024, T / 256, INWP / 256, F.G, (int)blockIdx.x};
      EpiInProj E{(bf16_t*)(ws + WS_QA), (bf16_t*)(ws + WS_CQKV), (bf16_t*)(ws + WS_KB), (float*)(ws + WS_SSQ), (const float*)(ws + WS_ROPE), (const float*)(ws + WS_ROPE) + SEQ * 16};
      pg::gemm_phase(F.lds, S, E, 1024, F.wave); }
}
__device__ __forceinline__ void p2_upproj(const Frame& F) {
    unsigned char* ws = F.ws;
    { pg::DenseSched S{(const char*)(ws + WS_CQKV), (const char*)(ws + WS_WUQ), 640, QLORA, T / 256, 3, F.G, (int)blockIdx.x};
      EpiQUp E{(bf16_t*)(ws + WS_QB), (const float*)(ws + WS_SSQ), (const float*)(ws + WS_ROPE), (const float*)(ws + WS_ROPE) + SEQ * 16};
      pg::gemm_phase(F.lds, S, E, QLORA, F.wave); }
    { pg::DenseSched S{(const char*)(ws + WS_CQKV) + 384 * 2, (const char*)(ws + WS_WUKV), 640, KVLORA, T / 256, 4, F.G, (int)blockIdx.x};
      EpiKVUp E{(bf16_t*)(ws + WS_KB), (bf16_t*)(ws + WS_VB), (const float*)(ws + WS_SSQ)};
      pg::gemm_phase(F.lds, S, E, KVLORA, F.wave); }
}

namespace mla {
constexpr int QBLK = 32, KVBLK = 64, LDQ = 768, LDKk = 768, LDV = 512, LDO = 512;
constexpr float SCALE = 0.10206207261596577f;
constexpr int SHM_V = KVBLK * 64 * 2  , SHM_K = KVBLK * 256  ;
#define KSWZ(row, colB) ((row) * 256 + ((colB) ^ (((row) & 15) << 4)))
#define SBAR() __builtin_amdgcn_sched_barrier(0)
__device__ __forceinline__ int crow(int r, int hi) { return (r & 3) + 8 * (r >> 2) + 4 * hi; }

__device__ __forceinline__ int v_rd_base(int lane) { return ((lane & 3) << 3) | (((lane >> 2) & 3) << 6) | (((lane >> 4) & 1) << 5) | (((lane >> 5) & 1) << 8); }
constexpr int v_rd_off(int d0, int ks, int half) { return d0 * 512 + ks * 2048 + half * 1024; }
#define MLA_EXP2(x) __builtin_amdgcn_exp2f(x)
constexpr float THR2 = 8.f;
#define MX3(a, b, c) __builtin_fmaxf(__builtin_fmaxf((a), (b)), (c))
__device__ __forceinline__ void soft4(f32x16& p0, f32x16& p1, float& m_reg, float& l_reg, f32x16& negm, f32x16* o, float* al_l, bool first, bf16x8& pa0, bf16x8& pa1, bf16x8& pa2, bf16x8& pa3, int r32, int hi) {
  float ma = MX3(p0[0], p0[1], p0[2]), mb = MX3(p0[3], p0[4], p0[5]), mc = MX3(p0[6], p0[7], p0[8]), md = MX3(p0[9], p0[10], p0[11]);
  ma = MX3(ma, p0[12], p0[13]); mb = MX3(mb, p0[14], p0[15]); mc = MX3(mc, p1[0], p1[1]); md = MX3(md, p1[2], p1[3]);
  ma = MX3(ma, p1[4], p1[5]); mb = MX3(mb, p1[6], p1[7]); mc = MX3(mc, p1[8], p1[9]); md = MX3(md, p1[10], p1[11]);
  ma = MX3(ma, p1[12], p1[13]); mb = MX3(mb, p1[14], p1[15]);
  float pmax = __builtin_fmaxf(MX3(ma, mb, mc), md);
  { auto rr = __builtin_amdgcn_permlane32_swap(__float_as_uint(pmax), __float_as_uint(pmax), false, false);
    pmax = fmaxf(__uint_as_float(rr[0]), __uint_as_float(rr[1])); }
  if (__builtin_expect(first || !__all(pmax <= THR2), 0)) {
    const float dl = first ? pmax : fmaxf(pmax, 0.f);
    m_reg += dl;
#pragma unroll
    for (int r = 0; r < 16; ++r) { p0[r] -= dl; p1[r] -= dl; negm[r] = -m_reg; }
    if (!first) { const float alpha = __builtin_amdgcn_exp2f(-dl); l_reg *= alpha;
      if (hi == 0) al_l[r32] = alpha; asm volatile("s_waitcnt lgkmcnt(0)" ::: "memory");
#pragma unroll
      for (int r = 0; r < 16; ++r) { const float a = al_l[crow(r, hi)]; o[0][r] *= a; o[1][r] *= a; } }
  }
  asm volatile("" : "+v"(negm));
#pragma unroll
  for (int r = 0; r < 16; ++r) { p0[r] = MLA_EXP2(p0[r]); p1[r] = MLA_EXP2(p1[r]); }
  float s0 = p0[0] + p1[0], s1 = p0[1] + p1[1], s2 = p0[2] + p1[2], s3 = p0[3] + p1[3];
#pragma unroll
  for (int r = 4; r < 16; r += 4) { s0 += p0[r] + p1[r]; s1 += p0[r + 1] + p1[r + 1]; s2 += p0[r + 2] + p1[r + 2]; s3 += p0[r + 3] + p1[r + 3]; }
  l_reg += (s0 + s1) + (s2 + s3);
#define PK8(P, BASE, OUT) do { u32x4 w = {cvt_pk_bf16(P[BASE + 0], P[BASE + 1]), cvt_pk_bf16(P[BASE + 2], P[BASE + 3]), cvt_pk_bf16(P[BASE + 4], P[BASE + 5]), cvt_pk_bf16(P[BASE + 6], P[BASE + 7])}; \
    OUT = __builtin_bit_cast(bf16x8, w); } while (0)
  PK8(p0, 0, pa0); PK8(p0, 8, pa1); PK8(p1, 0, pa2); PK8(p1, 8, pa3);
#undef PK8
}
#undef MX3
typedef short v4i16_t __attribute__((ext_vector_type(4)));
typedef __attribute__((address_space(3))) const char* lds_cptr;
__device__ __forceinline__ s16x4 vtr(lds_cptr p) { return __builtin_bit_cast(s16x4, __builtin_amdgcn_ds_read_tr16_b64_v4i16((__attribute__((address_space(3))) v4i16_t*)p)); }
#define VFRAG(L, H) (bf16x8){L[0], L[1], L[2], L[3], H[0], H[1], H[2], H[3]}
__device__ __forceinline__ void mprefetch(bf16x8 (&fk)[12], lds_cptr Ks, int r32, int hi) {
#define KOFF(row, d0) KSWZ(row, ((d0) * 16 + hi * 8) * 2)
#pragma unroll
  for (int d0 = 0; d0 < 6; ++d0) { fk[2 * d0] = *(const __attribute__((address_space(3))) bf16x8*)(Ks + KOFF(r32, d0)); fk[2 * d0 + 1] = *(const __attribute__((address_space(3))) bf16x8*)(Ks + KOFF(32 + r32, d0)); }
#undef KOFF
}
template <bool HAS_PV>
__device__ __forceinline__ void mstage5(f32x16* o, f32x16& p0, f32x16& p1, bf16x8 (&fk)[12], lds_cptr vp, lds_cptr Ks, const bf16x8* qr, const f32x16& negm,
                                        bf16x8 pa0, bf16x8 pa1, bf16x8 pa2, bf16x8 pa3, int r32, int hi) {
  s16x4 vl[8], vh[8];
  if (HAS_PV) {
#pragma unroll
    for (int d0 = 0; d0 < 2; ++d0)
#pragma unroll
      for (int ks = 0; ks < 4; ++ks) { vl[d0 * 4 + ks] = vtr(vp + v_rd_off(d0, ks, 0)); vh[d0 * 4 + ks] = vtr(vp + v_rd_off(d0, ks, 1)); }
    SBAR(); }
  p0 = __builtin_amdgcn_mfma_f32_32x32x16_bf16(fk[0], qr[0], negm, 0, 0, 0); p1 = __builtin_amdgcn_mfma_f32_32x32x16_bf16(fk[1], qr[0], negm, 0, 0, 0);
#pragma unroll
  for (int d0 = 1; d0 < 6; ++d0) { p0 = __builtin_amdgcn_mfma_f32_32x32x16_bf16(fk[2 * d0], qr[d0], p0, 0, 0, 0); p1 = __builtin_amdgcn_mfma_f32_32x32x16_bf16(fk[2 * d0 + 1], qr[d0], p1, 0, 0, 0); }
  if (HAS_PV) {
    SBAR();
#pragma unroll
    for (int d0 = 0; d0 < 2; ++d0) {
      o[d0] = __builtin_amdgcn_mfma_f32_32x32x16_bf16(pa0, VFRAG(vl[d0 * 4 + 0], vh[d0 * 4 + 0]), o[d0], 0, 0, 0); o[d0] = __builtin_amdgcn_mfma_f32_32x32x16_bf16(pa1, VFRAG(vl[d0 * 4 + 1], vh[d0 * 4 + 1]), o[d0], 0, 0, 0);
      o[d0] = __builtin_amdgcn_mfma_f32_32x32x16_bf16(pa2, VFRAG(vl[d0 * 4 + 2], vh[d0 * 4 + 2]), o[d0], 0, 0, 0); o[d0] = __builtin_amdgcn_mfma_f32_32x32x16_bf16(pa3, VFRAG(vl[d0 * 4 + 3], vh[d0 * 4 + 3]), o[d0], 0, 0, 0); }
  }
}
__device__ __forceinline__ void pvlast4(f32x16* o, lds_cptr vp, bf16x8 pa0, bf16x8 pa1, bf16x8 pa2, bf16x8 pa3) {
  s16x4 vl[8], vh[8];
#pragma unroll
  for (int d0 = 0; d0 < 2; ++d0)
#pragma unroll
    for (int ks = 0; ks < 4; ++ks) { vl[d0 * 4 + ks] = vtr(vp + v_rd_off(d0, ks, 0)); vh[d0 * 4 + ks] = vtr(vp + v_rd_off(d0, ks, 1)); }
#pragma unroll
  for (int d0 = 0; d0 < 2; ++d0) {
    o[d0] = __builtin_amdgcn_mfma_f32_32x32x16_bf16(pa0, VFRAG(vl[d0 * 4 + 0], vh[d0 * 4 + 0]), o[d0], 0, 0, 0); o[d0] = __builtin_amdgcn_mfma_f32_32x32x16_bf16(pa1, VFRAG(vl[d0 * 4 + 1], vh[d0 * 4 + 1]), o[d0], 0, 0, 0);
    o[d0] = __builtin_amdgcn_mfma_f32_32x32x16_bf16(pa2, VFRAG(vl[d0 * 4 + 2], vh[d0 * 4 + 2]), o[d0], 0, 0, 0); o[d0] = __builtin_amdgcn_mfma_f32_32x32x16_bf16(pa3, VFRAG(vl[d0 * 4 + 3], vh[d0 * 4 + 3]), o[d0], 0, 0, 0); }
}
constexpr int NSLOT = 4, SLOT_K = SHM_K, SLOT_V = SHM_V;
constexpr int OFF2_K = 0, OFF2_V = NSLOT * SLOT_K, OFF2_WS = OFF2_V + NSLOT * SLOT_V, LDS2_TOTAL = OFF2_WS + NWAVES * 256;
#define MLA_BAR() asm volatile("s_waitcnt lgkmcnt(0)\n\ts_barrier" ::: "memory")

__device__ __forceinline__ void unit(const bf16_t* __restrict__ Qb, const bf16_t* __restrict__ Kh, const bf16_t* __restrict__ Vh, bf16_t* __restrict__ Ob, int seq, char* lds, int wid) {
  const int lane = lane_id(), r32 = lane & 31, hi = lane >> 5;
  const bool hb = wid >= 4;
  char* K_lds = lds + OFF2_K; char* V_lds = lds + OFF2_V;
  float* al_l = (float*)(lds + OFF2_WS) + wid * 64;
  float m_reg = 0.f, l_reg = 0.f; f32x16 o[2] = {}; f32x16 negm = {}; bf16x8 qr[6];
  const bf16_t* Qw = Qb + (long)(wid * QBLK + r32) * LDQ + hi * 8;
#pragma unroll
  for (int d0 = 0; d0 < 6; ++d0) qr[d0] = *reinterpret_cast<const bf16x8*>(Qw + d0 * 16);
  unsigned koA, koB, vo; bool kvA, kvB;
  { const int rA = 8 * wid + (lane >> 4), rB = rA + 4, cp = lane & 15;
    const int cA = cp ^ (rA & 15), cB = cp ^ (rB & 15); kvA = cA < 12; kvB = cB < 12;
    koA = (unsigned)(rA * LDKk * 2 + cA * 16); koB = (unsigned)(rB * LDKk * 2 + cB * 16);
    const int jv = 64 * wid + lane, sub = jv >> 5, within = jv & 31, k = (sub >> 1) * 8 + (within >> 2), c = (sub & 1) * 32 + (within & 3) * 8;
    vo = (unsigned)(k * LDV * 2 + c * 2); }
  const __attribute__((address_space(3))) char* lds3 = (const __attribute__((address_space(3))) char*)(lds_cptr)lds;
#define DMA_TILE(u) do { const char* kt_ = (const char*)(Kh + (long)(u) * KVBLK * LDKk); const char* vt_ = (const char*)(Vh + (long)(u) * KVBLK * LDV); const int sl_ = (u) & 3; \
    if (kvA) __builtin_amdgcn_global_load_lds((const unsigned*)(kt_ + koA), (__attribute__((address_space(3))) unsigned*)(lds3 + OFF2_K + sl_ * SLOT_K + (2 * wid) * 1024), 16, 0, 0); \
    if (kvB) __builtin_amdgcn_global_load_lds((const unsigned*)(kt_ + koB), (__attribute__((address_space(3))) unsigned*)(lds3 + OFF2_K + sl_ * SLOT_K + (2 * wid + 1) * 1024), 16, 0, 0); \
    __builtin_amdgcn_global_load_lds((const unsigned*)(vt_ + vo), (__attribute__((address_space(3))) unsigned*)(lds3 + OFF2_V + sl_ * SLOT_V + wid * 1024), 16, 0, 0); } while (0)
#define DMA_WAIT() asm volatile("s_waitcnt vmcnt(0)" ::: "memory")
  const lds_cptr vp0 = (lds_cptr)V_lds + v_rd_base(lane); const lds_cptr kp0 = (lds_cptr)K_lds;
  f32x16 p0, p1; bf16x8 pa0, pa1, pa2, pa3; const int NT = seq / KVBLK;
  bf16x8 fka[12];
  DMA_WAIT();
  DMA_TILE(0); DMA_TILE(1); DMA_WAIT();
  MLA_BAR();
  if (hb) MLA_BAR();
  DMA_TILE(2);
  mprefetch(fka, kp0, r32, hi);
  mstage5<false>(o, p0, p1, fka, vp0, kp0, qr, negm, pa0, pa1, pa2, pa3, r32, hi);

  MLA_BAR();
  soft4(p0, p1, m_reg, l_reg, negm, o, al_l, true, pa0, pa1, pa2, pa3, r32, hi);
  mprefetch(fka, kp0 + SLOT_K, r32, hi);
  DMA_WAIT();
  MLA_BAR();
#pragma clang loop unroll(disable)
  for (int t = 1; t < NT; ++t) {
    if (t + 2 < NT) DMA_TILE(t + 2);
    SBAR(); mstage5<true>(o, p0, p1, fka, vp0 + ((t - 1) & 3) * SLOT_V, kp0 + (t & 3) * SLOT_K, qr, negm, pa0, pa1, pa2, pa3, r32, hi);

    MLA_BAR();
    soft4(p0, p1, m_reg, l_reg, negm, o, al_l, false, pa0, pa1, pa2, pa3, r32, hi);
    if (t + 1 < NT) mprefetch(fka, kp0 + ((t + 1) & 3) * SLOT_K, r32, hi);
    DMA_WAIT();
    MLA_BAR();
  }
  SBAR(); pvlast4(o, vp0 + ((NT - 1) & 3) * SLOT_V, pa0, pa1, pa2, pa3);
  if (!hb) MLA_BAR();
  MLA_BAR();
  { auto rr = __builtin_amdgcn_permlane32_swap(__float_as_uint(l_reg), __float_as_uint(l_reg), false, false); l_reg = __uint_as_float(rr[0]) + __uint_as_float(rr[1]); }
  if (hi == 0) al_l[r32] = l_reg; asm volatile("s_waitcnt lgkmcnt(0)" ::: "memory");
  float rli[16];
#pragma unroll
  for (int r = 0; r < 16; ++r) rli[r] = __builtin_amdgcn_rcpf(al_l[crow(r, hi)]);
  { bf16_t* stg = (bf16_t*)(lds) + wid * 2048;
#pragma unroll
    for (int r = 0; r < 16; ++r) { const int orow = crow(r, hi);
#pragma unroll
      for (int d0 = 0; d0 < 2; ++d0) stg[orow * 64 + d0 * 32 + r32] = (bf16_t)(cvt_pk_bf16(o[d0][r] * rli[r], 0.f) & 0xffffu); }
    asm volatile("s_waitcnt lgkmcnt(0)" ::: "memory");
    bf16_t* Ow = Ob + (long)(wid * QBLK) * LDO;
#pragma unroll
    for (int i = 0; i < 4; ++i) { const int row = i * 8 + (lane >> 3), ch = lane & 7; const u32x4 v = *(const u32x4*)(stg + row * 64 + ch * 8); *(u32x4*)(Ow + (long)row * LDO + ch * 8) = v; } }
  MLA_BAR();
#undef DMA_TILE
#undef DMA_WAIT
}
#undef KSWZ
#undef SBAR
}

__device__ __forceinline__ void p3_mla(const Frame& F) {
    unsigned char* ws = F.ws;
    const bf16_t* QB = (const bf16_t*)(ws + WS_QB); const bf16_t* KB = (const bf16_t*)(ws + WS_KB); const bf16_t* VB = (const bf16_t*)(ws + WS_VB); bf16_t* OB = (bf16_t*)(ws + WS_OB);
    const int G = F.G;
    if (G == 256) {
        const int x = F.vcu >> 5, c = F.vcu & 31;
        for (int i = 0; i < 4; ++i) {
            const int pair = x * 8 + 2 * i + (c >> 4), qb = c & 15, b = pair >> 3, h = pair & 7;
            const long row0 = (long)b * SEQ;
            mla::unit(QB + (row0 + qb * 256) * 768 + h * 96, KB + row0 * 768 + h * 96, VB + row0 * 512 + h * 64, OB + (row0 + qb * 256) * 512 + h * 64, SEQ, (char*)F.lds, F.wave);
        }
    } else {
        for (int u = F.vcu; u < 1024; u += G) {
            const int pair = u >> 4, qb = u & 15, b = pair >> 3, h = pair & 7; const long row0 = (long)b * SEQ;
            mla::unit(QB + (row0 + qb * 256) * 768 + h * 96, KB + row0 * 768 + h * 96, VB + row0 * 512 + h * 64, OB + (row0 + qb * 256) * 512 + h * 64, SEQ, (char*)F.lds, F.wave);
        }
    }
}

namespace mxa {
#define SBAR() __builtin_amdgcn_sched_barrier(0)
typedef short v4i16_t __attribute__((ext_vector_type(4)));
typedef __attribute__((address_space(3))) const char* lds_cptr;
__device__ __forceinline__ s16x4 vtr(lds_cptr p) { return __builtin_bit_cast(s16x4, __builtin_amdgcn_ds_read_tr16_b64_v4i16((__attribute__((address_space(3))) v4i16_t*)p)); }
__device__ __forceinline__ int crow(int r, int hi) { return (r & 3) + 8 * (r >> 2) + 4 * hi; }
#define KSW2(row, colB) ((row) * 128 + ((colB) ^ ((((row) >> 1) & 7) << 4)))
__device__ __forceinline__ int v_rd_base(int lane) { return ((lane & 3) << 3) | (((lane >> 2) & 3) << 6) | (((lane >> 4) & 1) << 5) | (((lane >> 5) & 1) << 8); }
constexpr int v_rd_off(int d0, int ks, int half) { return d0 * 512 + ks * 2048 + half * 1024; }
constexpr int BUFB = 8192;
#define VFRAG(L, H) (bf16x8){L[0], L[1], L[2], L[3], H[0], H[1], H[2], H[3]}
__device__ __forceinline__ void step(f32x16& o0, f32x16& o1, float& m_reg, float& l_reg, const bf16x8* qr, lds_cptr Kb, lds_cptr Vb, float* al_l, float basef, float sl2, bool first, int r32, int hi) {
  constexpr float THR = 8.f;
  bf16x8 kf[4]; s16x4 vl[4], vh[4];
#pragma unroll
  for (int d0 = 0; d0 < 4; ++d0) kf[d0] = *(const __attribute__((address_space(3))) bf16x8*)(Kb + KSW2(r32, (d0 * 16 + hi * 8) * 2));
#pragma unroll
  for (int d0 = 0; d0 < 2; ++d0)
#pragma unroll
    for (int ks = 0; ks < 2; ++ks) { vl[d0 * 2 + ks] = vtr(Vb + v_rd_off(d0, ks, 0)); vh[d0 * 2 + ks] = vtr(Vb + v_rd_off(d0, ks, 1)); }
  f32x16 p;
  { const float nm = first ? 0.f : -m_reg;
#pragma unroll
    for (int r = 0; r < 16; ++r) p[r] = nm; }
#pragma unroll
  for (int d0 = 0; d0 < 4; ++d0) p = __builtin_amdgcn_mfma_f32_32x32x16_bf16(kf[d0], qr[d0], p, 0, 0, 0);
  const float nsl = -sl2;
  float pmax = -1e30f;
#pragma unroll
  for (int r = 0; r < 16; ++r) {
    const float df = basef - (float)((r & 3) + 8 * (r >> 2)), ad = __builtin_fabsf(df);
    const float sv = fmaf(nsl, ad, p[r]);
    p[r] = (ad <= 64.f) ? sv : -1e30f;
    pmax = fmaxf(pmax, p[r]);
  }
  { auto rr = __builtin_amdgcn_permlane32_swap(__float_as_uint(pmax), __float_as_uint(pmax), false, false);
    pmax = fmaxf(__uint_as_float(rr[0]), __uint_as_float(rr[1])); }
  if (first || !__all(pmax <= THR)) {
    const float dl = first ? pmax : fmaxf(pmax, 0.f);
    m_reg += dl;
#pragma unroll
    for (int r = 0; r < 16; ++r) p[r] -= dl;
    if (!first) { const float alpha = __builtin_amdgcn_exp2f(-dl); l_reg *= alpha;
      if (hi == 0) al_l[r32] = alpha; asm volatile("s_waitcnt lgkmcnt(0)" ::: "memory");
#pragma unroll
      for (int r = 0; r < 16; ++r) { const float a = al_l[crow(r, hi)]; o0[r] *= a; o1[r] *= a; } }
  }
  float ps = 0.f;
#pragma unroll
  for (int r = 0; r < 16; ++r) { p[r] = __builtin_amdgcn_exp2f(p[r]); ps += p[r]; }
  l_reg += ps;
  u32x4 w0 = {cvt_pk_bf16(p[0], p[1]), cvt_pk_bf16(p[2], p[3]), cvt_pk_bf16(p[4], p[5]), cvt_pk_bf16(p[6], p[7])};
  u32x4 w1 = {cvt_pk_bf16(p[8], p[9]), cvt_pk_bf16(p[10], p[11]), cvt_pk_bf16(p[12], p[13]), cvt_pk_bf16(p[14], p[15])};
  const bf16x8 pa0 = __builtin_bit_cast(bf16x8, w0), pa1 = __builtin_bit_cast(bf16x8, w1);
  o0 = __builtin_amdgcn_mfma_f32_32x32x16_bf16(pa0, VFRAG(vl[0], vh[0]), o0, 0, 0, 0); o0 = __builtin_amdgcn_mfma_f32_32x32x16_bf16(pa1, VFRAG(vl[1], vh[1]), o0, 0, 0, 0);
  o1 = __builtin_amdgcn_mfma_f32_32x32x16_bf16(pa0, VFRAG(vl[2], vh[2]), o1, 0, 0, 0); o1 = __builtin_amdgcn_mfma_f32_32x32x16_bf16(pa1, VFRAG(vl[3], vh[3]), o1, 0, 0, 0);
}

__device__ __forceinline__ void task(const bf16_t* __restrict__ QA, const bf16_t* __restrict__ KA, const bf16_t* __restrict__ VA, bf16_t* __restrict__ OP, float* __restrict__ LS,
                                     int b, int h, int n, int rres, int qb, char* wl, float* al) {
  const int lane = lane_id(), r32 = lane & 31, hi = lane >> 5;
  const int dil = (n == 0) ? 1 : (n == 1 ? 4 : 16), L = SEQ / dil, l0 = qb * 64;
  const float sl2 = exp2f(-(float)(h + 1)) * (float)dil * LOG2E;
  const long rowb = (long)b * SEQ;
  const lds_cptr wl3 = (lds_cptr)wl;
  const lds_cptr vrd = wl3 + 4096 + v_rd_base(lane);
  asm volatile("s_waitcnt vmcnt(0)" ::: "memory");
  unsigned ko[4], vo[4];
#pragma unroll
  for (int pc = 0; pc < 4; ++pc) {
    const int kr = 8 * pc + (lane >> 3), c = (lane & 7) ^ ((kr >> 1) & 7);
    ko[pc] = (unsigned)(kr * dil * 1024 + h * 128 + c * 16);
    const int jv = 64 * pc + lane, sub = jv >> 5, within = jv & 31, vk = (sub >> 1) * 8 + (within >> 2), vc = (sub & 1) * 32 + (within & 3) * 8;
    vo[pc] = (unsigned)(vk * dil * 1024 + h * 128 + vc * 2); }
#define MXA_DMA(lk0_, buf_) do { const size_t rb_ = (size_t)(rowb + (long)(lk0_) * dil + rres) * 1024; const char* kb_ = (const char*)KA + rb_; const char* vb_ = (const char*)VA + rb_; \
    _Pragma("unroll") for (int pc = 0; pc < 4; ++pc) { \
      __builtin_amdgcn_global_load_lds((const unsigned*)(kb_ + ko[pc]), (__attribute__((address_space(3))) unsigned*)(wl3 + (buf_) * BUFB + pc * 1024), 16, 0, 0); \
      __builtin_amdgcn_global_load_lds((const unsigned*)(vb_ + vo[pc]), (__attribute__((address_space(3))) unsigned*)(wl3 + (buf_) * BUFB + 4096 + pc * 1024), 16, 0, 0); } } while (0)
  const bool has_behind = (l0 >= 64), has_ahead = (l0 + 64 < L);
  const int nblk = 2 + (has_behind ? 2 : 0) + (has_ahead ? 2 : 0);
  auto blk_at = [&](int i) -> int { if (i < 2) return 2 + i; if (has_behind && has_ahead) return (i == 2) ? 1 : (i == 3 ? 4 : (i == 4 ? 0 : 5)); if (has_behind) return (i == 2) ? 1 : 0; return (i == 2) ? 4 : 5; };
  MXA_DMA(l0, 0);
  bf16x8 q0[4], q1[4];
  { const long ra = rowb + (long)(l0 + r32) * dil + rres, rb2 = rowb + (long)(l0 + 32 + r32) * dil + rres;
#pragma unroll
    for (int d0 = 0; d0 < 4; ++d0) { q0[d0] = *reinterpret_cast<const bf16x8*>(QA + ra * 512 + h * 64 + d0 * 16 + hi * 8); q1[d0] = *reinterpret_cast<const bf16x8*>(QA + rb2 * 512 + h * 64 + d0 * 16 + hi * 8); } }
  asm volatile("s_waitcnt vmcnt(0)" ::: "memory");
  f32x16 oa0 = f32x16{}, oa1 = f32x16{}, ob0 = f32x16{}, ob1 = f32x16{};
  float ma = 0.f, la = 0.f, mb = 0.f, lb = 0.f;
#pragma clang loop unroll(disable)
  for (int i = 0; i < nblk; ++i) {
    const int j = blk_at(i), buf = i & 1;
    if (i + 1 < nblk) { MXA_DMA(l0 - 64 + 32 * blk_at(i + 1), buf ^ 1); }
    if (i > 0) { if (i + 1 < nblk) asm volatile("s_waitcnt vmcnt(8)" ::: "memory"); else asm volatile("s_waitcnt vmcnt(0)" ::: "memory"); }
    const lds_cptr Kb = wl3 + buf * BUFB, Vb = vrd + buf * BUFB;
    const int dk = -64 + 32 * j;
    if (j <= 4) step(oa0, oa1, ma, la, q0, Kb, Vb, al, (float)(r32 - 4 * hi - dk), sl2, i == 0, r32, hi);
    if (j >= 1) step(ob0, ob1, mb, lb, q1, Kb, Vb, al, (float)(32 + r32 - 4 * hi - dk), sl2, i == 0, r32, hi);
    asm volatile("s_waitcnt lgkmcnt(0)" ::: "memory");
  }
#undef MXA_DMA
#pragma unroll
  for (int qs = 0; qs < 2; ++qs) {
    float l_reg = qs ? lb : la; const float m_reg = qs ? mb : ma;
    { auto rr = __builtin_amdgcn_permlane32_swap(__float_as_uint(l_reg), __float_as_uint(l_reg), false, false); l_reg = __uint_as_float(rr[0]) + __uint_as_float(rr[1]); }
    if (hi == 0) { al[r32] = l_reg; const long row = rowb + (long)(l0 + qs * 32 + r32) * dil + rres; LS[row * 8 + h] = m_reg + __builtin_amdgcn_logf(l_reg); }
    asm volatile("s_waitcnt lgkmcnt(0)" ::: "memory");
    bf16_t* stg = (bf16_t*)wl;
#pragma unroll
    for (int r = 0; r < 16; ++r) { const int orow = crow(r, hi); const float rl = __builtin_amdgcn_rcpf(al[orow]);
      stg[orow * 64 + r32] = (bf16_t)(cvt_pk_bf16((qs ? ob0[r] : oa0[r]) * rl, 0.f) & 0xffffu);
      stg[orow * 64 + 32 + r32] = (bf16_t)(cvt_pk_bf16((qs ? ob1[r] : oa1[r]) * rl, 0.f) & 0xffffu); }
    asm volatile("s_waitcnt lgkmcnt(0)" ::: "memory");
#pragma unroll
    for (int i = 0; i < 4; ++i) { const int rw = i * 8 + (lane >> 3), ch = lane & 7; const u32x4 v = *(const u32x4*)(stg + rw * 64 + ch * 8);
      const long row = rowb + (long)(l0 + qs * 32 + rw) * dil + rres; *(u32x4*)(OP + row * 512 + h * 64 + ch * 8) = v; }
    asm volatile("s_waitcnt lgkmcnt(0)" ::: "memory");
  }
}
#undef KSW2
#undef VFRAG
#undef SBAR
}

__device__ __forceinline__ void p3_mixerA(const Frame& F) {
    unsigned char* ws = F.ws;
    const bf16_t* QA = (const bf16_t*)(ws + WS_QA); const bf16_t* KA = (const bf16_t*)(ws + WS_KA); const bf16_t* VA = (const bf16_t*)(ws + WS_VA);
    float* LSE = (float*)(ws + WS_LSE);
    char* wl = (char*)F.lds + F.wave * 16384; float* al = (float*)((char*)F.lds + RING_BYTES + 2048) + F.wave * 64;
    const int x = (F.G == 256) ? (F.vcu >> 5) : 0; const int ngrp = (F.G == 256) ? 8 : 1, per = 64 * 192 / ngrp;
    unsigned* qctr = F.ctl + CW_Q + 64 * x;
    for (;;) {
        unsigned ti = 0; if (lane_id() == 0) ti = atomicAdd(qctr, 1u);
        ti = (unsigned)__builtin_amdgcn_readfirstlane((int)ti);
        if (ti >= (unsigned)per) break;
        const int t = x * per + (int)ti;
        const int pair = t / 192, tt = t % 192, n = tt >> 6, idx = tt & 63;
        const int rres = (n == 0) ? 0 : (n == 1 ? (idx >> 4) : (idx >> 2)), qb = (n == 0) ? idx : (n == 1 ? (idx & 15) : (idx & 3));
        bf16_t* OP = (bf16_t*)(ws + (n == 2 ? WS_OAP2 : WS_OAP0)) + (n == 1 ? (size_t)T * 512 : 0);
        mxa::task(QA, KA, VA, OP, LSE + (size_t)n * ((size_t)T * 8), pair >> 3, pair & 7, n, rres, qb, wl, al);
    }
}
static_assert(WS_OAP1 - WS_OAP0 == (size_t)T * 512 * 2, "OAP0|OAP1 contiguous");

__device__ __forceinline__ void p35_mix(const Frame& F, const Args& a) {
    unsigned char* ws = F.ws; const int lane = lane_id();
    const bf16_t* OB = (const bf16_t*)(ws + WS_OB); const float* LSE = (const float*)(ws + WS_LSE); bf16_t* MIXED = (bf16_t*)(ws + WS_MIXED);
    const bf16_t* OAPn[3] = {(const bf16_t*)(ws + WS_OAP0), (const bf16_t*)(ws + WS_OAP1), (const bf16_t*)(ws + WS_OAP2)};
    const float* g_a = a.in[8]; const float* g_b = a.in[9];
    const int gw = F.vcu * NWAVES + F.wave, NGW = F.G * NWAVES;
    const int h = lane >> 3;
    const f32x4 ga0 = *(const f32x4*)(g_a + lane * 8), ga1 = *(const f32x4*)(g_a + lane * 8 + 4), gb0 = *(const f32x4*)(g_b + lane * 8), gb1 = *(const f32x4*)(g_b + lane * 8 + 4);
    for (int row = gw; row < T; row += NGW) {
        float ls[3]; u32x4 ov[3];
#pragma unroll
        for (int n = 0; n < 3; ++n) { ls[n] = LSE[((size_t)n * T + row) * 8 + h]; ov[n] = *(const u32x4*)(OAPn[n] + (size_t)row * 512 + lane * 8); }
        const u32x4 bv = *(const u32x4*)(OB + (size_t)row * 512 + lane * 8);
        const float mx = fmaxf(ls[0], fmaxf(ls[1], ls[2]));
        float w[3]; float wsum = 0.f;
#pragma unroll
        for (int n = 0; n < 3; ++n) { w[n] = __builtin_amdgcn_exp2f(ls[n] - mx); wsum += w[n]; }
        const float inv = 1.f / wsum;
        float oa[8] = {0.f, 0.f, 0.f, 0.f, 0.f, 0.f, 0.f, 0.f};
#pragma unroll
        for (int n = 0; n < 3; ++n) { const float wn = w[n] * inv;
#pragma unroll
            for (int j = 0; j < 4; ++j) { oa[2 * j] += wn * bf16lo(ov[n][j]); oa[2 * j + 1] += wn * bf16hi(ov[n][j]); } }
        float obv[8];
#pragma unroll
        for (int j = 0; j < 4; ++j) { obv[2 * j] = bf16lo(bv[j]); obv[2 * j + 1] = bf16hi(bv[j]); }
        float sa = 0.f, sb = 0.f;
#pragma unroll
        for (int j = 0; j < 8; ++j) { sa += oa[j] * oa[j]; sb += obv[j] * obv[j]; }
        sa = wsum64(sa); sb = wsum64(sb);
        const float ra = 1.0f / sqrtf(sa * (1.f / 512.f) + EPS), rb = 1.0f / sqrtf(sb * (1.f / 512.f) + EPS);
        u32x4 wa, wb;
        wa.x = cvt_pk_bf16(oa[0] * ra * ga0[0], oa[1] * ra * ga0[1]); wa.y = cvt_pk_bf16(oa[2] * ra * ga0[2], oa[3] * ra * ga0[3]);
        wa.z = cvt_pk_bf16(oa[4] * ra * ga1[0], oa[5] * ra * ga1[1]); wa.w = cvt_pk_bf16(oa[6] * ra * ga1[2], oa[7] * ra * ga1[3]);
        wb.x = cvt_pk_bf16(obv[0] * rb * gb0[0], obv[1] * rb * gb0[1]); wb.y = cvt_pk_bf16(obv[2] * rb * gb0[2], obv[3] * rb * gb0[3]);
        wb.z = cvt_pk_bf16(obv[4] * rb * gb1[0], obv[5] * rb * gb1[1]); wb.w = cvt_pk_bf16(obv[6] * rb * gb1[2], obv[7] * rb * gb1[3]);
        *(u32x4*)(MIXED + (size_t)row * 1024 + lane * 8) = wa;
        *(u32x4*)(MIXED + (size_t)row * 1024 + 512 + lane * 8) = wb;
    }
}

constexpr size_t WS_WRT = 4 * MiB + 512 * 1024;
constexpr size_t WS_RS = 137 * MiB;
constexpr size_t WS_GS = 141 * MiB;
constexpr size_t WS_H2B = 384 * MiB;
constexpr size_t WS_D = 448 * MiB;
constexpr int MOE_TAB = MISC_OFF + 256;
constexpr int NBUCK = 112;
constexpr int CW_BCNT = 32768;
constexpr size_t WS_HID2 = 209 * MiB;
constexpr size_t WS_BLIST = 288 * MiB;
constexpr size_t WS_SSQ2 = 136 * MiB + 256 * 1024;
constexpr int MOE_TOKL = MOE_TAB + 4096;
constexpr size_t WS_DST = 280 * MiB;

__device__ __forceinline__ void p0_router_table(const Frame& F, const Args& a) {
    const float* w_r1 = a.in[12]; const float* w_r2 = a.in[14]; const float* g_ffn = a.in[11]; bf16_t* WRH = (bf16_t*)(F.ws + WS_WRT); bf16_t* WRL = WRH + 48 * 1024;
    const int gw = F.vcu * NWAVES + F.wave, NGW = F.G * NWAVES, lane = lane_id();
    for (int idx = gw * 64 + lane; idx < 48 * 1024; idx += NGW * 64) {
        const int o = idx >> 10, k = idx & 1023;
        float w = 0.f;
        if (o < 4) w = w_r1[k * 4 + o]; else if (o < 36) w = w_r2[((size_t)((o - 4) >> 3) * 1024 + k) * 8 + ((o - 4) & 7)];
        w *= g_ffn[k];
        const unsigned hi = cvt_pk_bf16(w, 0.f) & 0xffffu; const float rem = w - __uint_as_float(hi << 16);
        WRH[idx] = (bf16_t)hi; WRL[idx] = (bf16_t)(cvt_pk_bf16(rem, 0.f) & 0xffffu);
    }
}

__device__ __forceinline__ void p4_wo(const Frame& F, const Args& a) {
    unsigned char* ws = F.ws;
    { const float* p = a.in[1]; bf16_t* P16 = (bf16_t*)(ws + WS_P16); const int gw = F.vcu * NWAVES + F.wave, NGW = F.G * NWAVES, lane = lane_id();
      for (size_t i = (size_t)gw * 64 + lane; i < (size_t)T * 256 / 8; i += (size_t)NGW * 64) {
          const f32x4 v0 = ((const f32x4*)p)[2 * i], v1 = ((const f32x4*)p)[2 * i + 1];
          u32x4 o; o.x = cvt_pk_bf16(v0.x, v0.y); o.y = cvt_pk_bf16(v0.z, v0.w); o.z = cvt_pk_bf16(v1.x, v1.y); o.w = cvt_pk_bf16(v1.z, v1.w);
          ((u32x4*)P16)[i] = o; } }
    pg::DenseSched S{(const char*)(ws + WS_MIXED), (const char*)(ws + WS_WO), 1024, 1024, T / 256, 4, F.G, (int)blockIdx.x};
    EpiStoreBf16 E{(bf16_t*)(ws + WS_D), 1024};
    pg::gemm_phase(F.lds, S, E, 1024, F.wave);
}

__device__ __forceinline__ void p5_router(const Frame& F, const Args& a) {
    unsigned char* ws = F.ws; const int lane = lane_id(), wid = F.wave;
    const float* X = a.in[0]; const bf16_t* Dm = (const bf16_t*)(ws + WS_D); const float* g_ffn = a.in[11]; const float* b_r1 = a.in[13]; const float* b_r2 = a.in[15];
    const bf16_t* WRH = (const bf16_t*)(ws + WS_WRT); const bf16_t* WRL = WRH + 48 * 1024; bf16_t* MU = (bf16_t*)(ws + WS_M);
    int* LIST = (int*)(ws + WS_LIST); float* RS = (float*)(ws + WS_RS); float* GS = (float*)(ws + WS_GS);
    unsigned* cnt = F.ctl + CW_CNT;
    LAS int* LG = (LAS int*)(F.lds);
    LAS int* SSQ_ = (LAS int*)(F.lds + 26 * 1024);
    LAS unsigned* hist = (LAS unsigned*)(F.lds + 27 * 1024);
    LAS unsigned* gbase = hist + 160;
    int* DST = (int*)(ws + WS_DST); int* BLIST = (int*)(ws + WS_BLIST); unsigned* bcnt = F.ctl + CW_BCNT;
    const int tr = lane & 15, kg = lane >> 4, tid = wid * 64 + lane;
    const int kw = 128 * wid;
    for (int chunk = F.vcu; chunk < T / 128; chunk += F.G) {
        const int base = chunk * 128;
        for (int i = tid; i < 128 * 49 + 128; i += 512) { if (i < 128 * 49) LG[i] = 0; else SSQ_[i - 128 * 49] = 0; }
        if (tid < 32 + NBUCK) hist[tid] = 0u;
        __syncthreads();
        bf16x8 bh[4][3], bl[4][3];
#pragma unroll
        for (int ks = 0; ks < 4; ++ks)
#pragma unroll
            for (int nb = 0; nb < 3; ++nb) { const size_t wo = (size_t)(nb * 16 + tr) * 1024 + kw + ks * 32 + 8 * kg; bh[ks][nb] = *(const bf16x8*)(WRH + wo); bl[ks][nb] = *(const bf16x8*)(WRL + wo); }
#pragma unroll 2
        for (int mb = 0; mb < 8; ++mb) {
            const size_t ro = (size_t)(base + 16 * mb + tr) * 1024 + kw + 8 * kg;
            f32x4 acc0 = {0.f, 0.f, 0.f, 0.f}, acc1 = acc0, acc2 = acc0; float ss = 0.f;
#pragma unroll
            for (int ks = 0; ks < 4; ++ks) {
                f32x4 v0 = __builtin_nontemporal_load((const f32x4*)(X + ro + ks * 32)), v1 = __builtin_nontemporal_load((const f32x4*)(X + ro + ks * 32 + 4));
                { const u32x4 dd = *(const u32x4*)(Dm + ro + ks * 32);
                  v0[0] += bf16lo(dd.x); v0[1] += bf16hi(dd.x); v0[2] += bf16lo(dd.y); v0[3] += bf16hi(dd.y); v1[0] += bf16lo(dd.z); v1[1] += bf16hi(dd.z); v1[2] += bf16lo(dd.w); v1[3] += bf16hi(dd.w); }
                ss += (v0[0] * v0[0] + v0[1] * v0[1]) + (v0[2] * v0[2] + v0[3] * v0[3]) + (v1[0] * v1[0] + v1[1] * v1[1]) + (v1[2] * v1[2] + v1[3] * v1[3]);
                u32x4 hi; hi.x = cvt_pk_bf16(v0[0], v0[1]); hi.y = cvt_pk_bf16(v0[2], v0[3]); hi.z = cvt_pk_bf16(v1[0], v1[1]); hi.w = cvt_pk_bf16(v1[2], v1[3]);
                u32x4 lo; lo.x = cvt_pk_bf16(v0[0] - bf16lo(hi.x), v0[1] - bf16hi(hi.x)); lo.y = cvt_pk_bf16(v0[2] - bf16lo(hi.y), v0[3] - bf16hi(hi.y));
                lo.z = cvt_pk_bf16(v1[0] - bf16lo(hi.z), v1[1] - bf16hi(hi.z)); lo.w = cvt_pk_bf16(v1[2] - bf16lo(hi.w), v1[3] - bf16hi(hi.w));
                *(u32x4*)(MU + ro + ks * 32) = hi;
                const bf16x8 ah = __builtin_bit_cast(bf16x8, hi), al = __builtin_bit_cast(bf16x8, lo);
                acc0 = __builtin_amdgcn_mfma_f32_16x16x32_bf16(ah, bh[ks][0], acc0, 0, 0, 0); acc0 = __builtin_amdgcn_mfma_f32_16x16x32_bf16(al, bh[ks][0], acc0, 0, 0, 0); acc0 = __builtin_amdgcn_mfma_f32_16x16x32_bf16(ah, bl[ks][0], acc0, 0, 0, 0);
                acc1 = __builtin_amdgcn_mfma_f32_16x16x32_bf16(ah, bh[ks][1], acc1, 0, 0, 0); acc1 = __builtin_amdgcn_mfma_f32_16x16x32_bf16(al, bh[ks][1], acc1, 0, 0, 0); acc1 = __builtin_amdgcn_mfma_f32_16x16x32_bf16(ah, bl[ks][1], acc1, 0, 0, 0);
                acc2 = __builtin_amdgcn_mfma_f32_16x16x32_bf16(ah, bh[ks][2], acc2, 0, 0, 0); acc2 = __builtin_amdgcn_mfma_f32_16x16x32_bf16(al, bh[ks][2], acc2, 0, 0, 0); acc2 = __builtin_amdgcn_mfma_f32_16x16x32_bf16(ah, bl[ks][2], acc2, 0, 0, 0);
            }
            ss += __shfl_xor(ss, 16); ss += __shfl_xor(ss, 32);
            if (kg == 0) atomicAdd((int*)(SSQ_ + 16 * mb + tr), __float2int_rn(ss * 16384.0f));
#pragma unroll
            for (int r = 0; r < 4; ++r) { const int tk = 16 * mb + 4 * kg + r;
                atomicAdd((int*)(LG + tk * 49 + tr), __float2int_rn(acc0[r] * 1048576.0f)); atomicAdd((int*)(LG + tk * 49 + 16 + tr), __float2int_rn(acc1[r] * 1048576.0f)); if (tr < 4) atomicAdd((int*)(LG + tk * 49 + 32 + tr), __float2int_rn(acc2[r] * 1048576.0f)); }
        }
        __syncthreads();
        int ea = 0, eb = 0, bk = 0, hfa = 0; unsigned la = 0u, lb = 0u, lk = 0u; float w0 = 0.f, w1 = 0.f, rstd = 0.f;
        if (tid < 128) {
            rstd = 1.0f / sqrtf((float)SSQ_[tid] * (1.f / 16384.f) * (1.f / 1024.f) + EPS);
            const LAS int* lg = LG + tid * 49; const float rq = rstd * (1.f / 1048576.f);
            const float l0 = (float)lg[0] * rq + b_r1[0], l1 = (float)lg[1] * rq + b_r1[1], l2 = (float)lg[2] * rq + b_r1[2], l3 = (float)lg[3] * rq + b_r1[3];
            int gi = 0; float gm = l0; if (l1 > gm) { gm = l1; gi = 1; } if (l2 > gm) { gm = l2; gi = 2; } if (l3 > gm) { gm = l3; gi = 3; }
            const float gs = __expf(l0 - gm) + __expf(l1 - gm) + __expf(l2 - gm) + __expf(l3 - gm);
            const float g_val = 1.0f / gs;
            float lv[8];
#pragma unroll
            for (int e = 0; e < 8; ++e) lv[e] = (float)lg[4 + 8 * gi + e] * rq + b_r2[8 * gi + e];
            int e0 = 0; float m0 = lv[0];
#pragma unroll
            for (int e = 1; e < 8; ++e) if (lv[e] > m0) { m0 = lv[e]; e0 = e; }
            int e1 = -1; float m1 = -3.0e38f;
#pragma unroll
            for (int e = 0; e < 8; ++e) if (e != e0 && lv[e] > m1) { m1 = lv[e]; e1 = e; }
            const float x1 = __expf(m1 - m0);
            w0 = g_val / (1.0f + x1); w1 = g_val * x1 / (1.0f + x1);
            ea = gi * 8 + e0; eb = gi * 8 + e1;
            la = atomicAdd((unsigned*)(hist + ea), 1u); lb = atomicAdd((unsigned*)(hist + eb), 1u);
            { const int lo = e0 < e1 ? e0 : e1, hi = e0 < e1 ? e1 : e0; bk = gi * 28 + (lo * 7 - ((lo * (lo - 1)) >> 1) + (hi - lo - 1)); hfa = e0 < e1 ? 0 : 1; }
            lk = atomicAdd((unsigned*)(hist + 32 + bk), 1u);
        }
        __syncthreads();
        if (tid < 32 + NBUCK) { const unsigned c = hist[tid]; gbase[tid] = c ? atomicAdd(tid < 32 ? cnt + 64 * tid : bcnt + 64 * (tid - 32), c) : 0u; }
        __syncthreads();
        if (tid < 128) {
            const int tok = base + tid; const int ra = (int)(gbase[ea] + la), rb = (int)(gbase[eb] + lb);
            LIST[(size_t)ea * T + ra] = tok; RS[(size_t)ea * T + ra] = rstd; GS[(size_t)ea * T + ra] = w0;
            LIST[(size_t)eb * T + rb] = tok; RS[(size_t)eb * T + rb] = rstd; GS[(size_t)eb * T + rb] = w1;
            const int rk2 = (int)(gbase[32 + bk] + lk);
            DST[(size_t)ea * T + ra] = (bk << 17) | (rk2 << 1) | hfa; DST[(size_t)eb * T + rb] = (bk << 17) | (rk2 << 1) | (hfa ^ 1);
            BLIST[(size_t)bk * T + rk2] = tok;
        }
        __syncthreads();
    }
}

__device__ __forceinline__ void moe_build_tables(const Frame& F) {
    LAS int* tab = (LAS int*)(F.lds + MOE_TAB);
    const int tid = F.wave * 64 + lane_id();
    if (tid < 32 + NBUCK) tab[512 + tid] = (int)__hip_atomic_load(tid < 32 ? F.ctl + CW_CNT + 64 * tid : F.ctl + CW_BCNT + 64 * (tid - 32), __ATOMIC_RELAXED, __HIP_MEMORY_SCOPE_AGENT);
    __syncthreads();
    if (tid <= 32) { int off = 0, cp = 0;
        for (int j = 0; j < tid; ++j) { const int nch = (tab[512 + j] + 255) >> 8; off += nch * 256; cp += nch; }
        tab[tid] = off; tab[80 + tid] = cp; if (tid < 32) tab[40 + tid] = tab[512 + tid]; }
    else if (tid >= 64 && tid <= 64 + NBUCK) { const int b = tid - 64; int o = 0, p = 0;
        for (int j = 0; j < b; ++j) { const int c = tab[512 + 32 + j]; o += c; p += (c + 255) >> 8; }
        tab[128 + b] = o; tab[384 + b] = p; if (b < NBUCK) tab[256 + b] = tab[512 + 32 + b]; }
    __syncthreads();
}
struct MoeSched1 {
    static constexpr bool GATHER = true; static constexpr int KSPLIT = 0;
    const char* A; const char* Bt; const int* LIST; LAS const int* tab; int G, c;
    __device__ __forceinline__ int a_ld() const { return 1024; }
    __device__ __forceinline__ const char* abase() const { return A; }
    __device__ __forceinline__ bool next(int i, pg::Unit& u) const {
        const int nun = tab[80 + 32] * 2; const long L = (long)i * G + c; if (L >= nun) return false;
        const int ci = (int)L >> 1; u.pn = (int)L & 1;
        int e = 0;
#pragma unroll 1
        for (int k = 1; k < 32; ++k) if (tab[80 + k] <= ci) e = k;
        u.aux = e; u.pm = ci - tab[80 + e]; return true;
    }
    __device__ __forceinline__ void addr(const pg::Unit&, const char*&, const char*&) const {}
    __device__ __forceinline__ void addr_g(const pg::Unit& u, const int (&R)[2], const int (&C)[2], unsigned (&aoff)[2][2], const char*& bbase) const {
        const int e = u.aux, cn = tab[40 + e];
#pragma unroll
        for (int h = 0; h < 2; ++h)
#pragma unroll
            for (int i = 0; i < 2; ++i) { const int rk = u.pm * 256 + h * 128 + R[i]; const int tok = (rk < cn) ? LIST[(size_t)e * T + rk] : 0; aoff[h][i] = (unsigned)((tok * 1024 + C[i]) * 2); }
        bbase = Bt + ((size_t)e * 512 + (size_t)u.pn * 256) * 1024 * 2;
    }
};
struct EpiMoe1 {
    bf16_t* HID2; const float* RS; const float* GS; const int* DST; LAS const int* tab;
    __device__ __forceinline__ void operator()(const f32x4 (&acc)[2][2][4][2], const pg::Unit& u, int wr, int wc, int fr, int fq, LAS unsigned char* stage, int wid) const {
        const int e = u.aux, cn = tab[40 + e];
        float rsv[2][4], gsv[2][4]; int dsv[2][4];
#pragma unroll
        for (int ai = 0; ai < 2; ++ai)
#pragma unroll
            for (int m = 0; m < 4; ++m) { const int rk = u.pm * 256 + ai * 128 + wr * 64 + m * 16 + fr; const bool ok = rk < cn; const size_t o = (size_t)e * T + rk;
                rsv[ai][m] = ok ? RS[o] : 0.f; gsv[ai][m] = ok ? GS[o] : 0.f; dsv[ai][m] = ok ? DST[o] : -1; }
#pragma unroll
        for (int ai = 0; ai < 2; ++ai)
#pragma unroll
            for (int m = 0; m < 4; ++m) { const int d = dsv[ai][m];
                if (d >= 0) { const float rs = rsv[ai][m], gt = gsv[ai][m]; float hv[8];
                    const int row2 = tab[128 + (d >> 17)] + ((d >> 1) & 0xffff), half = d & 1;
#pragma unroll
                    for (int n = 0; n < 2; ++n)
#pragma unroll
                        for (int j = 0; j < 4; ++j) { const float gg = acc[ai][0][m][n][j] * rs, uu = acc[ai][1][m][n][j] * (rs * gt); hv[4 * n + j] = gg / (1.0f + __expf(-gg)) * uu; }
                    u32x4 w; w.x = cvt_pk_bf16(hv[0], hv[1]); w.y = cvt_pk_bf16(hv[2], hv[3]); w.z = cvt_pk_bf16(hv[4], hv[5]); w.w = cvt_pk_bf16(hv[6], hv[7]);
                    *(u32x4*)(HID2 + (size_t)row2 * 512 + half * 256 + u.pn * 128 + wc * 32 + 8 * fq) = w; } }
    }
};
struct MoeSched2 {
    static constexpr bool GATHER = false; static constexpr int KSPLIT = 4;
    const char* A; const char* Bt; LAS const int* tab; int G, c;
    __device__ __forceinline__ int a_ld() const { return 512; }
    __device__ __forceinline__ const char* abase() const { return A; }
    __device__ __forceinline__ bool next(int i, pg::Unit& u) const {
        const int nun = tab[384 + NBUCK] * 4; const long L = (long)i * G + c; if (L >= nun) return false;
        const int ci = (int)L >> 2; u.pn = (int)L & 3;
        const int l = lane_id();
        const unsigned long long m0 = __builtin_amdgcn_ballot_w64(tab[384 + l] <= ci), m1 = __builtin_amdgcn_ballot_w64(l + 64 < NBUCK && tab[384 + 64 + l] <= ci);
        const int b = __builtin_popcountll(m0) + __builtin_popcountll(m1) - 1;
        u.aux = b; u.pm = ci - tab[384 + b]; return true;
    }
    __device__ __forceinline__ void addr(const pg::Unit& u, const char*& abase_, const char*& bbase, const char*& bbase2) const {
        const int b = u.aux, g = b / 28, p = b % 28;
        int lo = 0, rem = p;
#pragma unroll 1
        while (rem >= 7 - lo) { rem -= 7 - lo; ++lo; }
        const int hi = lo + 1 + rem;
        abase_ = A + (size_t)(tab[128 + b] + u.pm * 256) * 512 * 2;
        bbase = Bt + ((size_t)(g * 8 + lo) * 1024 + (size_t)u.pn * 256) * 256 * 2;
        bbase2 = Bt + ((size_t)(g * 8 + hi) * 1024 + (size_t)u.pn * 256) * 256 * 2; }
    __device__ __forceinline__ void addr_g(const pg::Unit&, const int (&)[2], const int (&)[2], unsigned (&)[2][2], const char*&) const {}
};
__device__ __forceinline__ void moe2_fetch(LAS const int* tokl, const bf16_t* MU, size_t colo, int wid, int rsub, int ai, int m, int (&tk)[2], u32x4 (&mv)[2]) {
#pragma unroll
    for (int i = 0; i < 2; ++i) { const int r2 = 4 * wid + 2 * i + rsub, trow = 128 * ai + 64 * (r2 >> 4) + 16 * m + (r2 & 15);
        tk[i] = tokl[trow]; mv[i] = (u32x4){0u, 0u, 0u, 0u};
        if (tk[i] >= 0) mv[i] = *(const u32x4*)(MU + (size_t)tk[i] * 1024 + colo); }
}
struct EpiMoe2 {
    bf16_t* H2B; const bf16_t* MU; const int* BLIST; float* SSQ2; LAS const int* tab; LAS int* tokl;
    __device__ __forceinline__ void operator()(const f32x4 (&acc)[2][2][4][2], const pg::Unit& u, int wr, int wc, int fr, int fq, LAS unsigned char* stage, int wid) const {
        const int b = u.aux, lane = fr + 16 * fq, rk0 = u.pm * 256, nvalid = tab[256 + b] - rk0, tid = wid * 64 + lane;
        if (tid < 256) tokl[tid] = (tid < nvalid) ? BLIST[(size_t)b * T + rk0 + tid] : -1;
        asm volatile("s_waitcnt lgkmcnt(0)\n\ts_barrier" ::: "memory");
        const int ch = lane & 31, rsub = lane >> 5, rr = 16 * wr + fr; const size_t colo = (size_t)u.pn * 256 + ch * 8;
        int tk[2]; u32x4 mv[2];
        moe2_fetch(tokl, MU, colo, wid, rsub, 0, 0, tk, mv);
#pragma unroll
        for (int it = 0; it < 8; ++it) { const int ai = it >> 2, m = it & 3;
            u32x4 w[2];
#pragma unroll
            for (int bj = 0; bj < 2; ++bj) { const f32x4 v0 = acc[ai][bj][m][0], v1 = acc[ai][bj][m][1];
                w[bj].x = cvt_pk_bf16(v0[0], v0[1]); w[bj].y = cvt_pk_bf16(v0[2], v0[3]); w[bj].z = cvt_pk_bf16(v1[0], v1[1]); w[bj].w = cvt_pk_bf16(v1[2], v1[3]); }
            *(LAS u32x4*)(stage + rr * pg::EPI_ROWB + (32 * wc + 8 * fq) * 2) = w[0];
            *(LAS u32x4*)(stage + rr * pg::EPI_ROWB + (128 + 32 * wc + 8 * fq) * 2) = w[1];
            asm volatile("s_waitcnt lgkmcnt(0)\n\ts_barrier" ::: "memory");
            int tkn[2] = {-1, -1}; u32x4 mvn[2] = {(u32x4){0u, 0u, 0u, 0u}, (u32x4){0u, 0u, 0u, 0u}};
            if (it < 7) moe2_fetch(tokl, MU, colo, wid, rsub, (it + 1) >> 2, (it + 1) & 3, tkn, mvn);
#pragma unroll
            for (int i = 0; i < 2; ++i) { const int r2 = 4 * wid + 2 * i + rsub;
                const u32x4 v = *(const LAS u32x4*)(stage + r2 * pg::EPI_ROWB + ch * 16); const u32x4 hh = mv[i];
                float h[8]; h[0] = bf16lo(v.x) + bf16lo(hh.x); h[1] = bf16hi(v.x) + bf16hi(hh.x); h[2] = bf16lo(v.y) + bf16lo(hh.y); h[3] = bf16hi(v.y) + bf16hi(hh.y);
                h[4] = bf16lo(v.z) + bf16lo(hh.z); h[5] = bf16hi(v.z) + bf16hi(hh.z); h[6] = bf16lo(v.w) + bf16lo(hh.w); h[7] = bf16hi(v.w) + bf16hi(hh.w);
                float ss = ((h[0] * h[0] + h[1] * h[1]) + (h[2] * h[2] + h[3] * h[3])) + ((h[4] * h[4] + h[5] * h[5]) + (h[6] * h[6] + h[7] * h[7]));
                if (tk[i] < 0) ss = 0.f;
                ss += __shfl_xor(ss, 16); ss += __shfl_xor(ss, 8); ss += __shfl_xor(ss, 4); ss += __shfl_xor(ss, 2); ss += __shfl_xor(ss, 1);
                if (tk[i] >= 0) { u32x4 o; o.x = cvt_pk_bf16(h[0], h[1]); o.y = cvt_pk_bf16(h[2], h[3]); o.z = cvt_pk_bf16(h[4], h[5]); o.w = cvt_pk_bf16(h[6], h[7]);
                    *(u32x4*)(H2B + (size_t)tk[i] * 1024 + colo) = o;
                    if (ch == 0) SSQ2[(size_t)tk[i] * 4 + u.pn] = ss; } }
            asm volatile("s_waitcnt lgkmcnt(0)\n\ts_barrier" ::: "memory");
#pragma unroll
            for (int i = 0; i < 2; ++i) { tk[i] = tkn[i]; mv[i] = mvn[i]; }
        }
    }
};
__device__ __forceinline__ void p6a_moe_up(const Frame& F) {
    unsigned char* ws = F.ws; moe_build_tables(F);
    LAS const int* tab = (LAS const int*)(F.lds + MOE_TAB);
    MoeSched1 S{(const char*)(ws + WS_M), (const char*)(ws + WS_WGU), (const int*)(ws + WS_LIST), tab, F.G, F.vcu};
    EpiMoe1 E{(bf16_t*)(ws + WS_HID2), (const float*)(ws + WS_RS), (const float*)(ws + WS_GS), (const int*)(ws + WS_DST), tab};
    pg::gemm_phase(F.lds, S, E, 1024, F.wave);
    pp_units(F, F.vcu, tab[80 + 32] * 2);
}
__device__ __forceinline__ void p6b_moe_down(const Frame& F) {
    unsigned char* ws = F.ws; moe_build_tables(F);
    LAS const int* tab = (LAS const int*)(F.lds + MOE_TAB);
    MoeSched2 S{(const char*)(ws + WS_HID2), (const char*)(ws + WS_WD), tab, F.G, F.vcu};
    EpiMoe2 E{(bf16_t*)(ws + WS_H2B), (const bf16_t*)(ws + WS_M), (const int*)(ws + WS_BLIST), (float*)(ws + WS_SSQ2), tab, (LAS int*)(F.lds + MOE_TOKL)};
    pg::gemm_phase(F.lds, S, E, 512, F.wave);
}
struct EpiPle {
    bf16_t* G; const bf16_t* PP; const float* RS2;
    __device__ __forceinline__ void operator()(const f32x4 (&acc)[2][2][4][2], const pg::Unit& u, int wr, int wc, int fr, int fq, LAS unsigned char* stage, int wid) const {
        float rs[2][4];
#pragma unroll
        for (int ai = 0; ai < 2; ++ai)
#pragma unroll
            for (int m = 0; m < 4; ++m) { const f32x4 q = *(const f32x4*)(RS2 + (size_t)(u.pm * 256 + ai * 128 + wr * 64 + m * 16 + fr) * 4);
                rs[ai][m] = -1.0f / sqrtf(((q[0] + q[1]) + (q[2] + q[3])) * (1.f / 1024.f) + EPS);
                if (m == 3) asm volatile("" : "+v"(rs[ai][0]), "+v"(rs[ai][1]), "+v"(rs[ai][2]), "+v"(rs[ai][3]) :: "memory"); }
#pragma unroll
        for (int ai = 0; ai < 2; ++ai) {
            u32x4 pp[4][2];
#pragma unroll
            for (int m = 0; m < 4; ++m) { const int row = u.pm * 256 + ai * 128 + wr * 64 + m * 16 + fr;
#pragma unroll
                for (int bj = 0; bj < 2; ++bj) pp[m][bj] = *(const u32x4*)(PP + (size_t)row * 1024 + u.pn * 256 + bj * 128 + wc * 32 + 8 * fq); }
#pragma unroll
            for (int m = 0; m < 4; ++m) { const int row = u.pm * 256 + ai * 128 + wr * 64 + m * 16 + fr; const float nr = rs[ai][m];
#pragma unroll
                for (int bj = 0; bj < 2; ++bj) { const size_t off = (size_t)row * 1024 + u.pn * 256 + bj * 128 + wc * 32 + 8 * fq;
                    const u32x4 p4 = pp[m][bj];
                    const f32x4 a0 = acc[ai][bj][m][0] * nr, a1 = acc[ai][bj][m][1] * nr; u32x4 w;
                    w.x = cvt_pk_bf16(bf16lo(p4.x) / (1.0f + __expf(a0[0])), bf16hi(p4.x) / (1.0f + __expf(a0[1])));
                    w.y = cvt_pk_bf16(bf16lo(p4.y) / (1.0f + __expf(a0[2])), bf16hi(p4.y) / (1.0f + __expf(a0[3])));
                    w.z = cvt_pk_bf16(bf16lo(p4.z) / (1.0f + __expf(a1[0])), bf16hi(p4.z) / (1.0f + __expf(a1[1])));
                    w.w = cvt_pk_bf16(bf16lo(p4.w) / (1.0f + __expf(a1[2])), bf16hi(p4.w) / (1.0f + __expf(a1[3])));
                    *(u32x4*)(G + off) = w; } }
            asm volatile("" ::: "memory");
        }
    }
};
__device__ __forceinline__ void p8_ple(const Frame& F, const Args& a) {
    unsigned char* ws = F.ws;
    pg::DenseSched S{(const char*)(ws + WS_H2B), (const char*)(ws + WS_WPG), 1024, 1024, T / 256, 4, F.G, (int)blockIdx.x};
    EpiPle E{(bf16_t*)(ws + WS_D), (const bf16_t*)(ws + WS_PP), (const float*)(ws + WS_SSQ2)};
    pg::gemm_phase(F.lds, S, E, 1024, F.wave);
}
__device__ __forceinline__ void p9_final(const Frame& F, const Args& a) {
    const int lane = lane_id(); float* H = a.out; const float* gf = a.in[22]; const bf16_t* Gm = (const bf16_t*)(F.ws + WS_D); const bf16_t* H2B = (const bf16_t*)(F.ws + WS_H2B);
    const int gw = F.vcu * NWAVES + F.wave, NGW = F.G * NWAVES;
    f32x4 g[4];
#pragma unroll
    for (int j = 0; j < 4; ++j) g[j] = ((const f32x4*)gf)[lane + 64 * j];
    for (int row = gw; row < T; row += NGW) {
        f32x4 v[4]; float s = 0.f;
#pragma unroll
        for (int j = 0; j < 4; ++j) { const u32x2 hh = ((const u32x2*)(H2B + (size_t)row * 1024))[lane + 64 * j], gg = ((const u32x2*)(Gm + (size_t)row * 1024))[lane + 64 * j];
            v[j].x = bf16lo(hh.x) + bf16lo(gg.x); v[j].y = bf16hi(hh.x) + bf16hi(gg.x); v[j].z = bf16lo(hh.y) + bf16lo(gg.y); v[j].w = bf16hi(hh.y) + bf16hi(gg.y);
            s += (v[j].x * v[j].x + v[j].y * v[j].y) + (v[j].z * v[j].z + v[j].w * v[j].w); }
        const float rstd = 1.0f / sqrtf(wsum64(s) * (1.f / 1024.f) + EPS);
#pragma unroll
        for (int j = 0; j < 4; ++j) __builtin_nontemporal_store(v[j] * rstd * g[j], (f32x4*)(H + (size_t)row * 1024) + lane + 64 * j);
    }
}

__global__ void __launch_bounds__(512, 2) mega(Args args) {
    extern __shared__ __attribute__((aligned(16))) unsigned char lds_raw[];
    Frame F;
    F.lds = (LAS unsigned char*)lds_raw;
    F.wave = __builtin_amdgcn_readfirstlane(threadIdx.x >> 6);
    F.G = gridDim.x; { const int bx = blockIdx.x; F.vcu = (F.G % 8 == 0) ? (bx % 8) * (F.G / 8) + bx / 8 : bx; }
    F.ws = args.ws; F.ctl = (unsigned*)(args.ws + WS_CTL);
    volatile LAS unsigned* MISC = (volatile LAS unsigned*)(F.lds + MISC_OFF);
    for (int u = threadIdx.x; u < (LDS_BYTES - LDSCTL_OFF) / 4; u += NWAVES * 64) ((LAS unsigned*)(F.lds + LDSCTL_OFF))[u] = 0u;
    __syncthreads();
    XcdBarrier bar = xcd_barrier_post(F.ctl + CW_BAR + args.li * XCD_BAR_WORDS, MISC + 8);
    const int lo = args.ph_lo, hi = args.ph_hi;
#define IN(k) (lo <= (k) && (k) < hi)
#define BOTH(k) (IN(k) && IN((k) + 1))
    if (IN(0)) { p0_prologue(F, args); p0_router_table(F, args); if (BOTH(0)) xcd_barrier(bar); }
    if (IN(1)) { p1_inproj(F); if (BOTH(1)) xcd_barrier(bar); }
    if (IN(2)) { p2_upproj(F); if (BOTH(2)) xcd_barrier(bar); }
    if (IN(3)) { p3_mla(F); p3_mixerA(F); if (BOTH(3)) xcd_barrier(bar); }
    if (IN(4)) { p35_mix(F, args); if (BOTH(4)) xcd_barrier(bar); }
    if (IN(5)) { p4_wo(F, args); if (BOTH(5)) xcd_barrier(bar); }
    if (IN(6)) { p5_router(F, args); if (BOTH(6)) xcd_barrier(bar); }
    if (IN(7)) { p6a_moe_up(F); if (BOTH(7)) xcd_barrier(bar); }
    if (IN(8)) { p6b_moe_down(F); if (BOTH(8)) xcd_barrier(bar); }
    if (IN(9)) { p8_ple(F, args); if (BOTH(9)) xcd_barrier(bar); }
    if (IN(10)) { p9_final(F, args); }
#undef IN
#undef BOTH
}
constexpr int NPHASES = 11;

extern "C" void kernel_launch(void* const* d_in, const int* in_sizes, int n_in, void* d_out, int out_size, void* d_ws, size_t ws_size, hipStream_t stream) {
    static int grid = 0;
    if (grid == 0) {
        if (n_in != 23 || ws_size < (size_t)512 * MiB || out_size != T * DM) { fprintf(stderr, "kernel_launch: unexpected n_in %d / ws_size %zu / out_size %d\n", n_in, ws_size, out_size); grid = -1; return; }
        int dev = 0, cus = 0;
        if (hipGetDevice(&dev) != hipSuccess || hipDeviceGetAttribute(&cus, hipDeviceAttributeMultiprocessorCount, dev) != hipSuccess) { grid = -1; return; }
        if (hipFuncSetAttribute((const void*)mega, hipFuncAttributeMaxDynamicSharedMemorySize, LDS_BYTES) != hipSuccess) { fprintf(stderr, "kernel_launch: hipFuncSetAttribute failed\n"); grid = -1; return; }
        int per_cu = 0;
        if (hipOccupancyMaxActiveBlocksPerMultiprocessor(&per_cu, (const void*)mega, NWAVES * 64, LDS_BYTES) != hipSuccess || per_cu < 1) { fprintf(stderr, "kernel_launch: occupancy query says %d\n", per_cu); }
        (void)hipGetLastError();
        grid = cus;
    }
    if (grid < 0) return;
    unsigned char* ws = (unsigned char*)d_ws;
    hipMemsetAsync(ws + WS_CTL, 0, CTL_ZERO_BYTES, stream);
    Args a{};
    for (int i = 0; i < 23; ++i) a.in[i] = (const float*)d_in[i];
    a.out = (float*)d_out; a.ws = ws; a.ph_lo = 0; a.ph_hi = NPHASES; a.li = 0; a.pad = 0;
    hipLaunchKernelGGL(mega, dim3(grid), dim3(NWAVES * 64), LDS_BYTES, stream, a);
}
```

```cpp
#include <hip/hip_runtime.h>
#include <cstdint>
#include <cstdio>
#include <cmath>

#define LAS __attribute__((address_space(3)))
#define GAS __attribute__((address_space(1)))
typedef unsigned short bf16_t;
typedef short bf16x8 __attribute__((ext_vector_type(8)));
typedef short s16x4 __attribute__((ext_vector_type(4)));
typedef float f32x2 __attribute__((ext_vector_type(2)));
typedef float f32x4 __attribute__((ext_vector_type(4)));
typedef float f32x16 __attribute__((ext_vector_type(16)));
typedef unsigned u32x2 __attribute__((ext_vector_type(2)));
typedef unsigned u32x4 __attribute__((ext_vector_type(4)));

__device__ __forceinline__ unsigned cvt_pk_bf16(float lo, float hi) { unsigned r; asm volatile("v_cvt_pk_bf16_f32 %0, %1, %2" : "=v"(r) : "v"(lo), "v"(hi)); return r; }
__device__ __forceinline__ float bf16lo(unsigned w) { return __uint_as_float(w << 16); }
__device__ __forceinline__ float bf16hi(unsigned w) { return __uint_as_float(w & 0xffff0000u); }
__device__ __forceinline__ int lane_id() { int r; asm volatile("v_mbcnt_lo_u32_b32 %0, -1, 0\n\tv_mbcnt_hi_u32_b32 %0, -1, %0" : "=v"(r)); return r; }
__device__ __forceinline__ float wsum64(float v) {
#pragma unroll
    for (int o = 1; o < 64; o <<= 1) v += __shfl_xor(v, o);
    return v;
}

namespace pg {
constexpr int BM = 256, BK = 64, HALF = 128, HTB = HALF * BK * 2, STAGE_BYTES = 8 * HTB, NXCD = 8, WGM = 8;
__host__ __device__ __forceinline__ int lds_byte(int r, int c) { const int st = (r >> 4) * 2 + (c >> 5), rr = r & 15, cc = c & 31, ob = rr * 64 + cc * 2; return st * 1024 + (ob ^ (((ob >> 9) & 1) << 5)); }
__host__ __device__ __forceinline__ void stage_rc(int b, int& R, int& C) { const int st = b / 1024, sb = b % 1024, swz = sb ^ (((sb >> 9) & 1) << 5); R = (st >> 1) * 16 + swz / 64; C = (st & 1) * 32 + (swz % 64) / 2; }
__host__ __device__ __forceinline__ int perm32(int rho) { const int n = rho >> 4, i = rho & 15; return 8 * (i >> 2) + 4 * n + (i & 3); }

struct Unit { int pm, pn, aux; };

__device__ __forceinline__ bool static_unit(int nM, int nN, int G, int c, int i, int& pm, int& pn) {
    const int nwg = nM * nN; const long L = (long)i * G + c; if (L >= nwg) return false;
    int wgid = (int)L; { const int q = nwg / NXCD, r = nwg % NXCD, xcd = wgid % NXCD, off = wgid / NXCD; wgid = (xcd < r ? xcd * (q + 1) : r * (q + 1) + (xcd - r) * q) + off; }
    const int nig = WGM * nN, gid = wgid / nig, fm = gid * WGM, gsz = (nM - fm) < WGM ? (nM - fm) : WGM;
    pm = fm + ((wgid % nig) % gsz); pn = (wgid % nig) / gsz; return true;
}

struct DenseSched {
    static constexpr bool GATHER = false; static constexpr int KSPLIT = 0;
    const char* A; const char* Bt; int lda, K, nM, nN, G, c;
    __device__ __forceinline__ bool next(int i, Unit& u) const { u.aux = 0; return static_unit(nM, nN, G, c, i, u.pm, u.pn); }
    __device__ __forceinline__ int a_ld() const { return lda; }
    __device__ __forceinline__ void addr(const Unit& u, const char*& abase, const char*& bbase) const {
        abase = A + (size_t)u.pm * BM * lda * 2; bbase = Bt + (size_t)u.pn * BM * K * 2; }
    __device__ __forceinline__ void addr_g(const Unit&, const int (&)[2], const int (&)[2], unsigned (&)[2][2], const char*&) const {}
    __device__ __forceinline__ const char* abase() const { return A; }
};

constexpr int EPI_STAGE_OFF = 139264, EPI_ROWB = 528;
template <class StoreFn>
__device__ __forceinline__ void staged_rows(LAS unsigned char* stage, u32x4 w0, u32x4 w1, int ai, int m, int wid, int lane, const StoreFn& store) {
    const int wr = wid >> 2, wc = wid & 3, fr = lane & 15, fq = lane >> 4, rr = 16 * wr + fr;
    *(LAS u32x4*)(stage + rr * EPI_ROWB + (32 * wc + 8 * fq) * 2) = w0;
    *(LAS u32x4*)(stage + rr * EPI_ROWB + (128 + 32 * wc + 8 * fq) * 2) = w1;
    asm volatile("s_waitcnt lgkmcnt(0)\n\ts_barrier" ::: "memory");
#pragma unroll
    for (int i = 0; i < 2; ++i) { const int r2 = 4 * wid + 2 * i + (lane >> 5), ch = lane & 31;
        const u32x4 v = *(const LAS u32x4*)(stage + r2 * EPI_ROWB + ch * 16);
        store(128 * ai + 64 * (r2 >> 4) + 16 * m + (r2 & 15), ch, v); }
    asm volatile("s_waitcnt lgkmcnt(0)\n\ts_barrier" ::: "memory");
}

template <class Epi, class Sched>
__device__ __forceinline__ void gemm_phase(LAS unsigned char* lds, const Sched& S, const Epi& E, int K, int wid) {
    const int lane = lane_id(), tid = wid * 64 + lane, wr = wid >> 2, wc = wid & 3, fr = lane & 15, fq = lane >> 4;
    const int nt = K / BK;
    constexpr int KSPLIT = Sched::KSPLIT;
    const int KB = KSPLIT > 0 ? KSPLIT * BK : K;
    int Rr[2], Cc[2]; unsigned voffB[2];
#pragma unroll
    for (int i = 0; i < 2; ++i) { int R, C; stage_rc(tid * 16 + i * 8192, R, C); Rr[i] = R; Cc[i] = C; const int Rb = (R & ~31) + perm32(R & 31); voffB[i] = (unsigned)(Rb * KB + C) * 2u; }
    const size_t kstep = (size_t)(BK * 2);
    const size_t hstepB = (size_t)HALF * KB * 2;
    const unsigned ldsw = (unsigned)wid * 1024u;
    const int aoff = lds_byte(wr * 64 + fr, fq * 8), boff = lds_byte(wc * 32 + fr, fq * 8);
    const char* const Ab = S.abase();
    constexpr bool GATHER = Sched::GATHER;
    unsigned voffA[2];
#pragma unroll
    for (int i = 0; i < 2; ++i) voffA[i] = (unsigned)(Rr[i] * S.a_ld() + Cc[i]) * 2u;
    const size_t hstepA = (size_t)HALF * S.a_ld() * 2;
#define PG_SA(b, h) (((b) * 2 + (h)) * HTB)
#define PG_SB(b, h) ((4 + (b) * 2 + (h)) * HTB)
#define PG_STAGEB(bufoff, gbase) do { _Pragma("unroll") for (int _i = 0; _i < 2; ++_i) \
        __builtin_amdgcn_global_load_lds((const unsigned*)((const char*)(gbase) + voffB[_i]), (LAS unsigned*)(lds + (bufoff) + ldsw + _i * 8192), 16, 0, 0); } while (0)
#define PG_STAGEA(bufoff, uptr, offs, h, kb) do { _Pragma("unroll") for (int _i = 0; _i < 2; ++_i) { \
        const char* _src; if constexpr (GATHER) _src = Ab + (size_t)(offs)[h][_i] + (kb); else _src = (uptr) + (h) * hstepA + (kb) + voffA[_i]; \
        __builtin_amdgcn_global_load_lds((const unsigned*)_src, (LAS unsigned*)(lds + (bufoff) + ldsw + _i * 8192), 16, 0, 0); } } while (0)
#define PG_LDA(dst, b, h) do { _Pragma("unroll") for (int m = 0; m < 4; ++m) _Pragma("unroll") for (int k = 0; k < 2; ++k) dst[m][k] = *(const LAS bf16x8*)(lds + PG_SA(b, h) + aoff + m * 2048 + k * 1024); } while (0)
#define PG_LDB(dst, b, h) do { _Pragma("unroll") for (int n = 0; n < 2; ++n) _Pragma("unroll") for (int k = 0; k < 2; ++k) dst[n][k] = *(const LAS bf16x8*)(lds + PG_SB(b, h) + boff + n * 2048 + k * 1024); } while (0)
#define PG_MMA(ai, bj, At, Bt_) do { __builtin_amdgcn_s_setprio(1); _Pragma("unroll") for (int m = 0; m < 4; ++m) _Pragma("unroll") for (int n = 0; n < 2; ++n) _Pragma("unroll") for (int k = 0; k < 2; ++k) \
        acc[ai][bj][m][n] = __builtin_amdgcn_mfma_f32_16x16x32_bf16(Bt_[n][k], At[m][k], acc[ai][bj][m][n], 0, 0, 0); __builtin_amdgcn_s_setprio(0); } while (0)
#define PG_WAIT_V(n) asm volatile("s_waitcnt vmcnt(" #n ")" ::: "memory")
#define PG_WAIT_L(n) asm volatile("s_waitcnt lgkmcnt(" #n ")" ::: "memory")
#define PG_BAR __builtin_amdgcn_s_barrier()
#define PG_SCHED __builtin_amdgcn_sched_barrier(0)
    Unit cur, nxt; int ui = 0;
    if (!S.next(0, cur)) return;
    f32x4 acc[2][2][4][2];
#pragma unroll
    for (int a = 0; a < 2; ++a)
#pragma unroll
        for (int b = 0; b < 2; ++b)
#pragma unroll
            for (int m = 0; m < 4; ++m)
#pragma unroll
                for (int n = 0; n < 2; ++n) acc[a][b][m][n] = (f32x4){0.f, 0.f, 0.f, 0.f};
    bf16x8 At[4][2], B0[2][2], B1[2][2];
    unsigned cao[2][2], nao[2][2]; const char* cA = nullptr; const char* nA = nullptr; const char* cB; const char* nB; const char* cB2 = nullptr; const char* nB2 = nullptr;
    if constexpr (GATHER) S.addr_g(cur, Rr, Cc, cao, cB); else if constexpr (KSPLIT > 0) S.addr(cur, cA, cB, cB2); else S.addr(cur, cA, cB);
    PG_STAGEB(PG_SB(0, 0), cB); PG_STAGEB(PG_SB(0, 1), cB + hstepB); PG_STAGEA(PG_SA(0, 0), cA, cao, 0, 0); PG_STAGEA(PG_SA(0, 1), cA, cao, 1, 0);
    if (wr == 1) PG_BAR;
    PG_WAIT_V(2); PG_BAR;
    PG_STAGEB(PG_SB(1, 0), cB + kstep); PG_STAGEA(PG_SA(1, 0), cA, cao, 0, kstep); PG_STAGEB(PG_SB(1, 1), cB + hstepB + kstep);
    PG_WAIT_V(6); PG_BAR;
    for (;;) {
        const bool has_next = S.next(ui + 1, nxt);
        if (has_next) { if constexpr (GATHER) S.addr_g(nxt, Rr, Cc, nao, nB); else if constexpr (KSPLIT > 0) S.addr(nxt, nA, nB, nB2); else S.addr(nxt, nA, nB); }
        else { nB = cB; nA = cA; nB2 = cB2;
            if constexpr (GATHER) {
#pragma unroll
                for (int h = 0; h < 2; ++h)
#pragma unroll
                    for (int i = 0; i < 2; ++i) nao[h][i] = cao[h][i]; } }
#pragma clang loop unroll(disable)
        for (int t = 0; t < nt; t += 2) {
            const bool last = (t == nt - 2);
            const size_t k1 = (size_t)(t + 1) * kstep;
            const size_t k2 = last ? 0 : (size_t)(t + 2) * kstep, k3 = k2 + kstep;
            const char* b2;
            if constexpr (KSPLIT > 0) b2 = last ? nB : ((t + 2 >= KSPLIT) ? cB2 + (size_t)(t + 2 - KSPLIT) * kstep : cB + (size_t)(t + 2) * kstep);
            else b2 = last ? nB : cB + (size_t)(t + 2) * kstep;
            const char* b3 = b2 + kstep;
            unsigned a2o[2][2]; const char* a2 = last ? nA : cA;
            if constexpr (GATHER) {
#pragma unroll
                for (int h = 0; h < 2; ++h)
#pragma unroll
                    for (int i = 0; i < 2; ++i) a2o[h][i] = last ? nao[h][i] : cao[h][i]; }
            PG_LDB(B0, 0, 0); PG_LDB(B1, 0, 1); PG_SCHED; PG_LDA(At, 0, 0); PG_STAGEA(PG_SA(1, 1), cA, cao, 1, k1);
            PG_WAIT_V(8); PG_WAIT_L(0); PG_BAR; PG_MMA(0, 0, At, B0); PG_MMA(0, 1, At, B1); PG_BAR; PG_SCHED;
            PG_LDA(At, 0, 1); PG_STAGEB(PG_SB(0, 0), b2); PG_STAGEB(PG_SB(0, 1), b2 + hstepB); PG_STAGEA(PG_SA(0, 0), a2, a2o, 0, k2);
            PG_WAIT_V(8); PG_WAIT_L(0); PG_BAR; PG_MMA(1, 0, At, B0); PG_MMA(1, 1, At, B1); PG_BAR; PG_SCHED;
            PG_LDB(B0, 1, 0); PG_LDB(B1, 1, 1); PG_SCHED; PG_LDA(At, 1, 0); PG_STAGEA(PG_SA(0, 1), a2, a2o, 1, k2);
            PG_WAIT_V(8); PG_WAIT_L(0); PG_BAR; PG_MMA(0, 0, At, B0); PG_MMA(0, 1, At, B1); PG_BAR; PG_SCHED;
            PG_LDA(At, 1, 1); PG_STAGEB(PG_SB(1, 0), b3); PG_STAGEB(PG_SB(1, 1), b3 + hstepB); PG_STAGEA(PG_SA(1, 0), a2, a2o, 0, k3);
            PG_WAIT_V(8); PG_WAIT_L(0); PG_BAR; PG_MMA(1, 0, At, B0); PG_MMA(1, 1, At, B1); PG_BAR; PG_SCHED;
        }
        if (wr == 0) PG_BAR;
        { const int l2 = lane_id();
          E(acc, cur, wr, wc, l2 & 15, l2 >> 4, lds + EPI_STAGE_OFF, wid); }
        if (!has_next) break;
#pragma unroll
        for (int a = 0; a < 2; ++a)
#pragma unroll
            for (int b = 0; b < 2; ++b)
#pragma unroll
                for (int m = 0; m < 4; ++m)
#pragma unroll
                    for (int n = 0; n < 2; ++n) acc[a][b][m][n] = (f32x4){0.f, 0.f, 0.f, 0.f};
        cur = nxt; cB = nB; cA = nA; cB2 = nB2;
        if constexpr (GATHER) {
#pragma unroll
            for (int h = 0; h < 2; ++h)
#pragma unroll
                for (int i = 0; i < 2; ++i) cao[h][i] = nao[h][i]; }
        ++ui;
        if (wr == 1) PG_BAR;
    }
    PG_WAIT_V(0);
    PG_BAR;
#undef PG_SA
#undef PG_SB
#undef PG_STAGEA
#undef PG_STAGEB
#undef PG_LDA
#undef PG_LDB
#undef PG_MMA
#undef PG_WAIT_V
#undef PG_WAIT_L
#undef PG_BAR
#undef PG_SCHED
}
}

#define XB_TMO      128
#define XB_XCNT(j)  (256  + 64 * (j))
#define XB_XSUB(j)  (1280 + 64 * (j))
#define XB_XGEN(j)  (2304 + 64 * (j))
#define XB_TOP      3328
#define XB_TOPGEN   3392
#define XCD_BAR_WORDS 3456
#define XB_SPIN_CAP (1u << 22)
__device__ __forceinline__ unsigned xb_ld(unsigned* p)              { return __hip_atomic_load(p, __ATOMIC_RELAXED, __HIP_MEMORY_SCOPE_AGENT); }
__device__ __forceinline__ unsigned xb_add(unsigned* p, unsigned v) { return __hip_atomic_fetch_add(p, v, __ATOMIC_RELAXED, __HIP_MEMORY_SCOPE_AGENT); }
__device__ __forceinline__ unsigned xb_xcc_id() { return (unsigned)__builtin_amdgcn_s_getreg((3 << 11) | 20) & 0xFu; }
#define XB_SPIN(cond, bar) do { unsigned _sp = 0; while (cond) { __builtin_amdgcn_s_sleep(1); \
    if ((++_sp & 255u) == 0u) { if (xb_ld(&(bar)[XB_TMO])) break; if (_sp > XB_SPIN_CAP) { atomicAdd(&(bar)[XB_TMO], 1u); break; } } } } while (0)
struct XcdBarrier { unsigned* bar; unsigned x; volatile LAS unsigned* st; };
__device__ __forceinline__ XcdBarrier xcd_barrier_post(unsigned* bar, volatile LAS unsigned* st) {
    XcdBarrier b; b.bar = bar; b.x = xb_xcc_id(); b.st = st;
    if (threadIdx.x == 0) (void)xb_add(&bar[XB_XCNT(b.x)], 1u);
    return b;
}
__device__ __forceinline__ void xcd_barrier_complete(unsigned* bar, unsigned x, unsigned& nloc, unsigned& nx) {
    const unsigned G = gridDim.x * gridDim.y * gridDim.z;
    unsigned sum, cnt, mine, sp = 0u;
    for (;;) {
        sum = 0u; cnt = 0u; mine = 0u;
#pragma unroll
        for (unsigned j = 0; j < 16; ++j) { const unsigned c = xb_ld(&bar[XB_XCNT(j)]); sum += c; cnt += (c > 0u) ? 1u : 0u; mine = (j == x) ? c : mine; }
        if (sum == G) break;
        __builtin_amdgcn_s_sleep(1);
        if ((++sp & 255u) == 0u) { if (xb_ld(&bar[XB_TMO])) break; if (sp > XB_SPIN_CAP) { atomicAdd(&bar[XB_TMO], 1u); break; } }
    }
    nloc = mine > 0u ? mine : 1u; nx = cnt > 0u ? cnt : 1u;
}
__device__ __forceinline__ void xcd_barrier(const XcdBarrier& b) {
    asm volatile("s_waitcnt vmcnt(0)" ::: "memory");
    __syncthreads();
    if (threadIdx.x == 0) {
        unsigned* bar = b.bar;
        __builtin_amdgcn_s_waitcnt(0);
        unsigned nloc = b.st[0], nx = b.st[1];
        if (nloc == 0u) { xcd_barrier_complete(bar, b.x, nloc, nx); b.st[0] = nloc; b.st[1] = nx; }
        const unsigned old = xb_add(&bar[XB_XSUB(b.x)], 1u);
        const unsigned gen = old / nloc;
        if (old + 1u == (gen + 1u) * nloc) {
            __builtin_amdgcn_fence(__ATOMIC_RELEASE, "agent");
            asm volatile("s_waitcnt vmcnt(0)" ::: "memory");
            const unsigned og = xb_add(&bar[XB_TOP], 1u);
            const unsigned tg = og / nx;
            if (og + 1u == (tg + 1u) * nx) xb_add(&bar[XB_TOPGEN], 1u);
            else XB_SPIN(xb_ld(&bar[XB_TOPGEN]) == tg, bar);
            __builtin_amdgcn_fence(__ATOMIC_ACQUIRE, "agent");
            xb_add(&bar[XB_XGEN(b.x)], 1u);
            asm volatile("s_waitcnt vmcnt(0)" ::: "memory");
        } else {
            XB_SPIN(xb_ld(&bar[XB_XGEN(b.x)]) == gen, bar);
            __builtin_amdgcn_fence(__ATOMIC_ACQUIRE, "agent");
            asm volatile("s_waitcnt vmcnt(0)" ::: "memory");
        }
    }
    __syncthreads();
}

constexpr int NB = 8, SEQ = 4096, T = NB * SEQ, DM = 1024;
constexpr int INW = 2208, INWP = 2304;
constexpr int QLORA = 384, KVLORA = 256;
constexpr float EPS = 1e-6f;
constexpr float LOG2E = 1.4426950408889634f;
constexpr float QA_SCALE = 0.125f * LOG2E;
constexpr float MLA_QSCALE = 0.10206207261596577f * LOG2E;
constexpr int NWAVES = 8;

constexpr size_t MiB = 1u << 20;
constexpr size_t WS_CTL = 0, CTL_ZERO_BYTES = 1 * MiB;
constexpr size_t WS_ROPE = 1 * MiB;
constexpr size_t WS_SSQ = 2 * MiB;
constexpr size_t WS_WIN = 5 * MiB, WS_WUQ = 10 * MiB, WS_WUKV = 11 * MiB, WS_WO = 12 * MiB, WS_WPG = 14 * MiB, WS_WPP = 16 * MiB, WS_WGU = 17 * MiB, WS_WD = 49 * MiB;
constexpr size_t WS_XN = 65 * MiB;
constexpr size_t WS_P16 = 305 * MiB;
constexpr size_t WS_PP = 145 * MiB;
constexpr size_t WS_QA = 209 * MiB, WS_KA = 241 * MiB, WS_VA = 273 * MiB;
static_assert(WS_KA - WS_QA == (size_t)T * 512 * 2 && WS_VA - WS_KA == (size_t)T * 512 * 2, "QA|KA|VA contiguous");
constexpr size_t WS_CQKV = 305 * MiB;
constexpr size_t WS_QB = 345 * MiB, WS_KB = 393 * MiB;
constexpr size_t WS_VB = 441 * MiB;
constexpr size_t WS_OB = 473 * MiB;
constexpr size_t WS_OAP0 = 65 * MiB, WS_OAP1 = 97 * MiB, WS_OAP2 = 305 * MiB;
constexpr size_t WS_LSE = 129 * MiB;
constexpr size_t WS_MIXED = 209 * MiB;
constexpr size_t WS_M = 65 * MiB;
constexpr size_t WS_Y = 209 * MiB;
constexpr size_t WS_HID = 353 * MiB;
constexpr size_t WS_LIST = 132 * MiB;
constexpr size_t WS_RS2 = 136 * MiB + 896 * 1024;
constexpr size_t WS_TOKINFO = 136 * MiB;
constexpr int CW_BAR = 4096, CW_CNT = 16384, CW_Q = 20480;

constexpr int RING_BYTES = 131072;
constexpr int LDSCTL_OFF = RING_BYTES, MISC_OFF = LDSCTL_OFF + 320;
constexpr int LDS_BYTES = 163840;

struct Args { const float* in[23]; float* out; unsigned char* ws; int ph_lo, ph_hi, li, pad; };
struct Frame {
    LAS unsigned char* lds;
    int wave, vcu, G;
    unsigned char* ws; unsigned* ctl;
};

__device__ __forceinline__ void p0_transpose_item(const float* __restrict__ W, int ldw, int k0, int n0, bf16_t* WT, int ldd, int drow0, const float* __restrict__ gain, LAS float* scr, int lane) {
    const int kq = lane >> 3, n4 = (lane & 7) * 4;
    f32x4 v[8];
#pragma unroll
    for (int i = 0; i < 8; ++i) v[i] = __builtin_nontemporal_load((const f32x4*)(W + (size_t)(k0 + kq + 8 * i) * ldw + n0 + n4));
#pragma unroll
    for (int i = 0; i < 8; ++i) { const int kk = kq + 8 * i; f32x4 x = v[i]; if (gain) x = x * gain[k0 + kk];
        scr[kk * 33 + n4] = x[0]; scr[kk * 33 + n4 + 1] = x[1]; scr[kk * 33 + n4 + 2] = x[2]; scr[kk * 33 + n4 + 3] = x[3]; }
    asm volatile("s_waitcnt lgkmcnt(0)" ::: "memory");
    const int c = lane & 7;
#pragma unroll
    for (int j = 0; j < 4; ++j) { const int n = (lane >> 3) + 8 * j; const LAS float* s = scr + (8 * c) * 33 + n;
        u32x4 o; o.x = cvt_pk_bf16(s[0 * 33], s[1 * 33]); o.y = cvt_pk_bf16(s[2 * 33], s[3 * 33]); o.z = cvt_pk_bf16(s[4 * 33], s[5 * 33]); o.w = cvt_pk_bf16(s[6 * 33], s[7 * 33]);
        *(u32x4*)(WT + (size_t)(drow0 + n) * ldd + k0 + 8 * c) = o; }
    asm volatile("s_waitcnt lgkmcnt(0)" ::: "memory");
}
__device__ __forceinline__ void rms_row_to_bf16(const float* xrow, const float* __restrict__ g, bf16_t* orow, int lane) {
    const f32x4* xr = (const f32x4*)xrow + lane; const f32x4* gr = (const f32x4*)g + lane;
    f32x4 v[4]; float s = 0.f;
#pragma unroll
    for (int j = 0; j < 4; ++j) { v[j] = xr[64 * j]; s += (v[j].x * v[j].x + v[j].y * v[j].y) + (v[j].z * v[j].z + v[j].w * v[j].w); }
    const float rstd = 1.0f / sqrtf(wsum64(s) * (1.f / 1024.f) + EPS);
    u32x2* o8 = (u32x2*)orow + lane;
#pragma unroll
    for (int j = 0; j < 4; ++j) { const f32x4 gg = gr[64 * j]; u32x2 w; w.x = cvt_pk_bf16(v[j].x * rstd * gg.x, v[j].y * rstd * gg.y); w.y = cvt_pk_bf16(v[j].z * rstd * gg.z, v[j].w * rstd * gg.w); o8[64 * j] = w; }
}

__device__ __forceinline__ void p0_prologue(const Frame& F, const Args& a) {
    LAS float* scr = (LAS float*)(F.lds + F.wave * 16384);
    const int gw = F.vcu * NWAVES + F.wave, NGW = F.G * NWAVES, lane = lane_id();
    unsigned char* ws = F.ws;
    const float* w_in = a.in[3]; const float* g_cq = a.in[4]; const float* w_uq = a.in[5]; const float* g_ckv = a.in[6]; const float* w_ukv = a.in[7];
    const float* w_o = a.in[10]; const float* w_eg = a.in[16]; const float* w_eu = a.in[17]; const float* w_ed = a.in[18]; const float* w_pg = a.in[20]; const float* w_pp = a.in[21];
    constexpr int I_IN = 16 * 69, I_UQ = 6 * 24, I_UKV = 4 * 32, I_O = 16 * 32, I_PG = 16 * 32, I_PP = 4 * 32, I_EG = 32 * 16 * 8, I_EU = I_EG, I_ED = 32 * 4 * 32;
    constexpr int NITEMS = I_IN + I_UQ + I_UKV + I_O + I_PG + I_PP + I_EG + I_EU + I_ED;
    for (int it = gw; it < NITEMS; it += NGW) {
        int r = it;
        if (r < I_IN) { const int kb = r / 69, nb = r % 69; p0_transpose_item(w_in, INW, 64 * kb, 32 * nb, (bf16_t*)(ws + WS_WIN), 1024, 32 * nb, nullptr, scr, lane); continue; } r -= I_IN;
        if (r < I_UQ) { const int kb = r / 24, nb = r % 24; p0_transpose_item(w_uq, 768, 64 * kb, 32 * nb, (bf16_t*)(ws + WS_WUQ), QLORA, 32 * nb, g_cq, scr, lane); continue; } r -= I_UQ;
        if (r < I_UKV) { const int kb = r / 32, nb = r % 32; p0_transpose_item(w_ukv, 1024, 64 * kb, 32 * nb, (bf16_t*)(ws + WS_WUKV), KVLORA, 32 * nb, g_ckv, scr, lane); continue; } r -= I_UKV;
        if (r < I_O) { const int kb = r / 32, nb = r % 32; p0_transpose_item(w_o, 1024, 64 * kb, 32 * nb, (bf16_t*)(ws + WS_WO), 1024, 32 * nb, nullptr, scr, lane); continue; } r -= I_O;
        if (r < I_PG) { const int kb = r / 32, nb = r % 32; p0_transpose_item(w_pg, 1024, 64 * kb, 32 * nb, (bf16_t*)(ws + WS_WPG), 1024, 32 * nb, a.in[19], scr, lane); continue; } r -= I_PG;
        if (r < I_PP) { const int kb = r / 32, nb = r % 32; p0_transpose_item(w_pp, 1024, 64 * kb, 32 * nb, (bf16_t*)(ws + WS_WPP), 256, 32 * nb, nullptr, scr, lane); continue; } r -= I_PP;
        if (r < I_EG + I_EU) {
            const int up = r >= I_EG; if (up) r -= I_EG;
            const int e = r / 128, q = r % 128, kb = q / 8, nb = q % 8, n0 = 32 * nb;
            const int drow = (n0 >> 7) * 256 + (up ? 128 : 0) + (n0 & 127);
            p0_transpose_item((up ? w_eu : w_eg) + (size_t)e * 1024 * 256, 256, 64 * kb, n0, (bf16_t*)(ws + WS_WGU) + (size_t)e * 512 * 1024, 1024, drow, a.in[11], scr, lane); continue; }
        r -= I_EG + I_EU;
        { const int e = r / 128, q = r % 128, kb = q / 32, nb = q % 32;
          p0_transpose_item(w_ed + (size_t)e * 256 * 1024, 1024, 64 * kb, 32 * nb, (bf16_t*)(ws + WS_WD) + (size_t)e * 1024 * 256, 256, 32 * nb, nullptr, scr, lane); }
    }
    for (int i = gw * 64 + lane; i < 96 * 128; i += NGW * 64) ((u32x4*)((bf16_t*)(ws + WS_WIN) + (size_t)INW * 1024))[i] = (u32x4){0u, 0u, 0u, 0u};
    { const float* x = a.in[0]; const float* g_mix = a.in[2]; bf16_t* XN = (bf16_t*)(ws + WS_XN);
      f32x4 gg[4];
#pragma unroll
      for (int j = 0; j < 4; ++j) gg[j] = ((const f32x4*)g_mix)[lane + 64 * j];
      for (int m = gw * 2; m < T; m += NGW * 2) {
          f32x4 v0[4], v1[4]; float s0 = 0.f, s1 = 0.f;
#pragma unroll
          for (int j = 0; j < 4; ++j) { v0[j] = __builtin_nontemporal_load((const f32x4*)(x + (size_t)m * DM) + lane + 64 * j); v1[j] = __builtin_nontemporal_load((const f32x4*)(x + (size_t)(m + 1) * DM) + lane + 64 * j); }
#pragma unroll
          for (int j = 0; j < 4; ++j) { s0 += (v0[j].x * v0[j].x + v0[j].y * v0[j].y) + (v0[j].z * v0[j].z + v0[j].w * v0[j].w); s1 += (v1[j].x * v1[j].x + v1[j].y * v1[j].y) + (v1[j].z * v1[j].z + v1[j].w * v1[j].w); }
          const float r0 = 1.0f / sqrtf(wsum64(s0) * (1.f / 1024.f) + EPS), r1 = 1.0f / sqrtf(wsum64(s1) * (1.f / 1024.f) + EPS);
#pragma unroll
          for (int j = 0; j < 4; ++j) { u32x2 w0, w1;
              w0.x = cvt_pk_bf16(v0[j].x * r0 * gg[j].x, v0[j].y * r0 * gg[j].y); w0.y = cvt_pk_bf16(v0[j].z * r0 * gg[j].z, v0[j].w * r0 * gg[j].w);
              w1.x = cvt_pk_bf16(v1[j].x * r1 * gg[j].x, v1[j].y * r1 * gg[j].y); w1.y = cvt_pk_bf16(v1[j].z * r1 * gg[j].z, v1[j].w * r1 * gg[j].w);
              ((u32x2*)(XN + (size_t)m * DM))[lane + 64 * j] = w0; ((u32x2*)(XN + (size_t)(m + 1) * DM))[lane + 64 * j] = w1; } } }
    { float* cs = (float*)(ws + WS_ROPE); float* sn = cs + SEQ * 16;
      for (int idx = gw * 64 + lane; idx < SEQ * 16; idx += NGW * 64) {
          const int pos = idx >> 4, i = idx & 15;
          const float inv = 1.0f / powf(10000.0f, (float)(2 * i) / 32.0f);
          const float ang = (float)pos * inv;
          cs[idx] = (float)cos((double)ang); sn[idx] = (float)sin((double)ang); } }
}

struct EpiInProj {
    bf16_t *QA, *CQKV, *KB; float* SSQ; const float* CS; const float* SN;
    __device__ __forceinline__ void operator()(const f32x4 (&acc)[2][2][4][2], const pg::Unit& u, int wr, int wc, int fr, int fq, LAS unsigned char* stage, int wid) const {
        const int pn = u.pn;
        if (pn < 6) {
            bf16_t* const tile = QA + (size_t)(pn >> 1) * ((size_t)T * 512) + (size_t)u.pm * 256 * 512 + (pn & 1) * 256; const float sc = (pn < 2) ? QA_SCALE : 1.f;
            const int lane = fr + 16 * fq;
#pragma unroll
            for (int ai = 0; ai < 2; ++ai)
#pragma unroll
                for (int m = 0; m < 4; ++m) { u32x4 w[2];
#pragma unroll
                    for (int bj = 0; bj < 2; ++bj) { const f32x4 v0 = acc[ai][bj][m][0] * sc, v1 = acc[ai][bj][m][1] * sc;
                        w[bj].x = cvt_pk_bf16(v0[0], v0[1]); w[bj].y = cvt_pk_bf16(v0[2], v0[3]); w[bj].z = cvt_pk_bf16(v1[0], v1[1]); w[bj].w = cvt_pk_bf16(v1[2], v1[3]); }
                    pg::staged_rows(stage, w[0], w[1], ai, m, wid, lane, [tile](int trow, int ch, u32x4 v) { __builtin_nontemporal_store(v, (u32x4*)(tile + (size_t)trow * 512 + ch * 8)); }); }
        } else {
#pragma unroll
            for (int ai = 0; ai < 2; ++ai)
#pragma unroll
                for (int m = 0; m < 4; ++m) { const int row = u.pm * 256 + ai * 128 + wr * 64 + m * 16 + fr;
#pragma unroll
                    for (int bj = 0; bj < 2; ++bj) {
                        const f32x4 v0 = acc[ai][bj][m][0], v1 = acc[ai][bj][m][1];
                        if (pn < 8 || bj == 0) {
                            const int col = (pn - 6) * 256 + bj * 128 + wc * 32 + 8 * fq; u32x4 w;
                            w.x = cvt_pk_bf16(v0[0], v0[1]); w.y = cvt_pk_bf16(v0[2], v0[3]); w.z = cvt_pk_bf16(v1[0], v1[1]); w.w = cvt_pk_bf16(v1[2], v1[3]);
                            *(u32x4*)(CQKV + (size_t)row * 640 + col) = w;
                            float s = (v0[0] * v0[0] + v0[1] * v0[1]) + (v0[2] * v0[2] + v0[3] * v0[3]) + (v1[0] * v1[0] + v1[1] * v1[1]) + (v1[2] * v1[2] + v1[3] * v1[3]);
                            s += __shfl_xor(s, 16); s += __shfl_xor(s, 32);
                            if (fq == 0) SSQ[(size_t)row * 20 + (pn - 6) * 8 + bj * 4 + wc] = s;
                        } else if (wc == 0) {
                            const int pos = row & (SEQ - 1); const int ci = pos * 16 + 8 * (fq & 1);
                            const f32x4 c0 = *(const f32x4*)(CS + ci), c1 = *(const f32x4*)(CS + ci + 4), s0 = *(const f32x4*)(SN + ci), s1 = *(const f32x4*)(SN + ci + 4);
                            f32x4 p0, p1;
#pragma unroll
                            for (int j = 0; j < 4; ++j) { p0[j] = __shfl_xor(v0[j], 32); p1[j] = __shfl_xor(v1[j], 32); }
                            f32x4 o0, o1;
                            if (fq < 2) { o0 = v0 * c0 - p0 * s0; o1 = v1 * c1 - p1 * s1; }
                            else        { o0 = p0 * s0 + v0 * c0; o1 = p1 * s1 + v1 * c1; }
                            u32x4 w; w.x = cvt_pk_bf16(o0[0], o0[1]); w.y = cvt_pk_bf16(o0[2], o0[3]); w.z = cvt_pk_bf16(o1[0], o1[1]); w.w = cvt_pk_bf16(o1[2], o1[3]);
#pragma unroll
                            for (int h = 0; h < 8; ++h) *(u32x4*)(KB + (size_t)row * 768 + h * 96 + 64 + 8 * fq) = w;
                        }
                    } }
        }
    }
};
struct EpiStoreBf16 {
    bf16_t* O; int ldc;
    __device__ __forceinline__ void operator()(const f32x4 (&acc)[2][2][4][2], const pg::Unit& u, int wr, int wc, int fr, int fq, LAS unsigned char* stage, int wid) const {
        const int lane = fr + 16 * fq; bf16_t* const tile = O + (size_t)u.pm * 256 * ldc + u.pn * 256; const int ld = ldc;
#pragma unroll
        for (int ai = 0; ai < 2; ++ai)
#pragma unroll
            for (int m = 0; m < 4; ++m) { u32x4 w[2];
#pragma unroll
                for (int bj = 0; bj < 2; ++bj) { const f32x4 v0 = acc[ai][bj][m][0], v1 = acc[ai][bj][m][1];
                    w[bj].x = cvt_pk_bf16(v0[0], v0[1]); w[bj].y = cvt_pk_bf16(v0[2], v0[3]); w[bj].z = cvt_pk_bf16(v1[0], v1[1]); w[bj].w = cvt_pk_bf16(v1[2], v1[3]); }
                pg::staged_rows(stage, w[0], w[1], ai, m, wid, lane, [tile, ld](int trow, int ch, u32x4 v) { __builtin_nontemporal_store(v, (u32x4*)(tile + (size_t)trow * ld + ch * 8)); }); }
    }
};
struct EpiQUp {
    bf16_t* QB; const float* SSQ; const float* CS; const float* SN;
    __device__ __forceinline__ void operator()(const f32x4 (&acc)[2][2][4][2], const pg::Unit& u, int wr, int wc, int fr, int fq, LAS unsigned char* stage, int wid) const {
        float rstd[2][4];
#pragma unroll
        for (int ai = 0; ai < 2; ++ai)
#pragma unroll
            for (int m = 0; m < 4; ++m) { const int row = u.pm * 256 + ai * 128 + wr * 64 + m * 16 + fr;
                const f32x4 q0 = *(const f32x4*)(SSQ + (size_t)row * 20), q1 = *(const f32x4*)(SSQ + (size_t)row * 20 + 4), q2 = *(const f32x4*)(SSQ + (size_t)row * 20 + 8);
                const float ss = ((q0[0] + q0[1]) + (q0[2] + q0[3])) + ((q1[0] + q1[1]) + (q1[2] + q1[3])) + ((q2[0] + q2[1]) + (q2[2] + q2[3]));
                rstd[ai][m] = 1.0f / sqrtf(ss * (1.f / 384.f) + EPS);
                if (m == 3) asm volatile("" : "+v"(rstd[ai][0]), "+v"(rstd[ai][1]), "+v"(rstd[ai][2]), "+v"(rstd[ai][3]) :: "memory"); }
        const int G0 = u.pn * 8 + wc;
        const int rbj = (G0 % 3 == 2) ? 0 : (((G0 + 4) % 3 == 2) ? 1 : -1);
#pragma unroll
        for (int ai = 0; ai < 2; ++ai)
#pragma unroll
          for (int mh = 0; mh < 2; ++mh) {
            f32x4 c0[2], c1[2], s0[2], s1[2];
#pragma unroll
            for (int m = 0; m < 2; ++m) { c0[m] = f32x4{0.f, 0.f, 0.f, 0.f}; c1[m] = c0[m]; s0[m] = c0[m]; s1[m] = c0[m]; }
            if (rbj >= 0) {
#pragma unroll
                for (int m = 0; m < 2; ++m) { const int row = u.pm * 256 + ai * 128 + wr * 64 + (2 * mh + m) * 16 + fr;
                    const int pos = row & (SEQ - 1); const int ci = pos * 16 + 8 * (fq & 1);
                    c0[m] = *(const f32x4*)(CS + ci); c1[m] = *(const f32x4*)(CS + ci + 4); s0[m] = *(const f32x4*)(SN + ci); s1[m] = *(const f32x4*)(SN + ci + 4); }
            }
#pragma unroll
            for (int mm = 0; mm < 2; ++mm) { const int m = 2 * mh + mm; const int row = u.pm * 256 + ai * 128 + wr * 64 + m * 16 + fr;
#pragma unroll
                for (int bj = 0; bj < 2; ++bj) { const int G = G0 + bj * 4;
                    f32x4 v0 = acc[ai][bj][m][0] * rstd[ai][m], v1 = acc[ai][bj][m][1] * rstd[ai][m];
                    if (bj == rbj) {
                        f32x4 p0, p1;
#pragma unroll
                        for (int j = 0; j < 4; ++j) { p0[j] = __shfl_xor(v0[j], 32); p1[j] = __shfl_xor(v1[j], 32); }
                        if (fq < 2) { v0 = v0 * c0[mm] - p0 * s0[mm]; v1 = v1 * c1[mm] - p1 * s1[mm]; }
                        else        { v0 = p0 * s0[mm] + v0 * c0[mm]; v1 = p1 * s1[mm] + v1 * c1[mm]; }
                    }
                    v0 = v0 * MLA_QSCALE; v1 = v1 * MLA_QSCALE;
                    u32x4 w; w.x = cvt_pk_bf16(v0[0], v0[1]); w.y = cvt_pk_bf16(v0[2], v0[3]); w.z = cvt_pk_bf16(v1[0], v1[1]); w.w = cvt_pk_bf16(v1[2], v1[3]);
                    *(u32x4*)(QB + (size_t)row * 768 + G * 32 + 8 * fq) = w; } }
          }
    }
};
struct EpiKVUp {
    bf16_t *KB, *VB; const float* SSQ;
    __device__ __forceinline__ void operator()(const f32x4 (&acc)[2][2][4][2], const pg::Unit& u, int wr, int wc, int fr, int fq, LAS unsigned char* stage, int wid) const {
        float rstd[2][4];
#pragma unroll
        for (int ai = 0; ai < 2; ++ai)
#pragma unroll
            for (int m = 0; m < 4; ++m) { const int row = u.pm * 256 + ai * 128 + wr * 64 + m * 16 + fr;
                const f32x4 q0 = *(const f32x4*)(SSQ + (size_t)row * 20 + 12), q1 = *(const f32x4*)(SSQ + (size_t)row * 20 + 16);
                const float ss = ((q0[0] + q0[1]) + (q0[2] + q0[3])) + ((q1[0] + q1[1]) + (q1[2] + q1[3]));
                rstd[ai][m] = 1.0f / sqrtf(ss * (1.f / 256.f) + EPS);
                if (m == 3) asm volatile("" : "+v"(rstd[ai][0]), "+v"(rstd[ai][1]), "+v"(rstd[ai][2]), "+v"(rstd[ai][3]) :: "memory"); }
#pragma unroll
        for (int ai = 0; ai < 2; ++ai)
#pragma unroll
            for (int m = 0; m < 4; ++m) { const int row = u.pm * 256 + ai * 128 + wr * 64 + m * 16 + fr;
#pragma unroll
                for (int bj = 0; bj < 2; ++bj) { const int G = u.pn * 8 + bj * 4 + wc;
                    const int h = G >> 2, part = G & 3;
                    const f32x4 v0 = acc[ai][bj][m][0] * rstd[ai][m], v1 = acc[ai][bj][m][1] * rstd[ai][m];
                    u32x4 w; w.x = cvt_pk_bf16(v0[0], v0[1]); w.y = cvt_pk_bf16(v0[2], v0[3]); w.z = cvt_pk_bf16(v1[0], v1[1]); w.w = cvt_pk_bf16(v1[2], v1[3]);
                    if (part < 2) *(u32x4*)(KB + (size_t)row * 768 + h * 96 + part * 32 + 8 * fq) = w;
                    else          *(u32x4*)(VB + (size_t)row * 512 + h * 64 + (part - 2) * 32 + 8 * fq) = w; } }
    }
};

struct PPSched {
    static constexpr bool GATHER = false; static constexpr int KSPLIT = 0;
    const char* A; const char* Bt; int q, nP;
    __device__ __forceinline__ bool next(int i, pg::Unit& u) const { if (q < 0) return false; const int L = i * nP + q; if (L >= 512) return false; u.aux = 0; u.pm = L >> 2; u.pn = L & 3; return true; }
    __device__ __forceinline__ int a_ld() const { return 256; }
    __device__ __forceinline__ void addr(const pg::Unit& u, const char*& abase, const char*& bbase) const { abase = A + (size_t)u.pm * pg::BM * 256 * 2; bbase = Bt + (size_t)u.pn * pg::BM * 256 * 2; }
    __device__ __forceinline__ void addr_g(const pg::Unit&, const int (&)[2], const int (&)[2], unsigned (&)[2][2], const char*&) const {}
    __device__ __forceinline__ const char* abase() const { return A; }
};
__device__ __forceinline__ void pp_units(const Frame& F, int c, int nun) {
    unsigned char* ws = F.ws; const int r = nun % F.G, nP = F.G - r;
    PPSched S{(const char*)(ws + WS_P16), (const char*)(ws + WS_WPP), c - r, nP};
    EpiStoreBf16 E{(bf16_t*)(ws + WS_PP), 1024};
    pg::gemm_phase(F.lds, S, E, 256, F.wave);
}
__device__ __forceinline__ void p1_inproj(const Frame& F) {
    unsigned char* ws = F.ws;
    { pg::DenseSched S{(const char*)(ws + WS_XN), (const char*)(ws + WS_WIN), 1024, 1024, T / 256, INWP / 256, F.G, (int)blockIdx.x};
      EpiInProj E{(bf16_t*)(ws + WS_QA), (bf16_t*)(ws + WS_CQKV), (bf16_t*)(ws + WS_KB), (float*)(ws + WS_SSQ), (const float*)(ws + WS_ROPE), (const float*)(ws + WS_ROPE) + SEQ * 16};
      pg::gemm_phase(F.lds, S, E, 1024, F.wave); }
}
__device__ __forceinline__ void p2_upproj(const Frame& F) {
    unsigned char* ws = F.ws;
    { pg::DenseSched S{(const char*)(ws + WS_CQKV), (const char*)(ws + WS_WUQ), 640, QLORA, T / 256, 3, F.G, (int)blockIdx.x};
      EpiQUp E{(bf16_t*)(ws + WS_QB), (const float*)(ws + WS_SSQ), (const float*)(ws + WS_ROPE), (const float*)(ws + WS_ROPE) + SEQ * 16};
      pg::gemm_phase(F.lds, S, E, QLORA, F.wave); }
    { pg::DenseSched S{(const char*)(ws + WS_CQKV) + 384 * 2, (const char*)(ws + WS_WUKV), 640, KVLORA, T / 256, 4, F.G, (int)blockIdx.x};
      EpiKVUp E{(bf16_t*)(ws + WS_KB), (bf16_t*)(ws + WS_VB), (const float*)(ws + WS_SSQ)};
      pg::gemm_phase(F.lds, S, E, KVLORA, F.wave); }
}

namespace mla {
constexpr int QBLK = 32, KVBLK = 64, LDQ = 768, LDKk = 768, LDV = 512, LDO = 512;
constexpr float SCALE = 0.10206207261596577f;
constexpr int SHM_V = KVBLK * 64 * 2  , SHM_K = KVBLK * 256  ;
#define KSWZ(row, colB) ((row) * 256 + ((colB) ^ (((row) & 15) << 4)))
#define SBAR() __builtin_amdgcn_sched_barrier(0)
__device__ __forceinline__ int crow(int r, int hi) { return (r & 3) + 8 * (r >> 2) + 4 * hi; }

__device__ __forceinline__ int v_rd_base(int lane) { return ((lane & 3) << 3) | (((lane >> 2) & 3) << 6) | (((lane >> 4) & 1) << 5) | (((lane >> 5) & 1) << 8); }
constexpr int v_rd_off(int d0, int ks, int half) { return d0 * 512 + ks * 2048 + half * 1024; }
#define MLA_EXP2(x) __builtin_amdgcn_exp2f(x)
constexpr float THR2 = 8.f;
#define MX3(a, b, c) __builtin_fmaxf(__builtin_fmaxf((a), (b)), (c))
__device__ __forceinline__ void soft4(f32x16& p0, f32x16& p1, float& m_reg, float& l_reg, f32x16& negm, f32x16* o, float* al_l, bool first, bf16x8& pa0, bf16x8& pa1, bf16x8& pa2, bf16x8& pa3, int r32, int hi) {
  float ma = MX3(p0[0], p0[1], p0[2]), mb = MX3(p0[3], p0[4], p0[5]), mc = MX3(p0[6], p0[7], p0[8]), md = MX3(p0[9], p0[10], p0[11]);
  ma = MX3(ma, p0[12], p0[13]); mb = MX3(mb, p0[14], p0[15]); mc = MX3(mc, p1[0], p1[1]); md = MX3(md, p1[2], p1[3]);
  ma = MX3(ma, p1[4], p1[5]); mb = MX3(mb, p1[6], p1[7]); mc = MX3(mc, p1[8], p1[9]); md = MX3(md, p1[10], p1[11]);
  ma = MX3(ma, p1[12], p1[13]); mb = MX3(mb, p1[14], p1[15]);
  float pmax = __builtin_fmaxf(MX3(ma, mb, mc), md);
  { auto rr = __builtin_amdgcn_permlane32_swap(__float_as_uint(pmax), __float_as_uint(pmax), false, false);
    pmax = fmaxf(__uint_as_float(rr[0]), __uint_as_float(rr[1])); }
  if (__builtin_expect(first || !__all(pmax <= THR2), 0)) {
    const float dl = first ? pmax : fmaxf(pmax, 0.f);
    m_reg += dl;
#pragma unroll
    for (int r = 0; r < 16; ++r) { p0[r] -= dl; p1[r] -= dl; negm[r] = -m_reg; }
    if (!first) { const float alpha = __builtin_amdgcn_exp2f(-dl); l_reg *= alpha;
      if (hi == 0) al_l[r32] = alpha; asm volatile("s_waitcnt lgkmcnt(0)" ::: "memory");
#pragma unroll
      for (int r = 0; r < 16; ++r) { const float a = al_l[crow(r, hi)]; o[0][r] *= a; o[1][r] *= a; } }
  }
  asm volatile("" : "+v"(negm));
#pragma unroll
  for (int r = 0; r < 16; ++r) { p0[r] = MLA_EXP2(p0[r]); p1[r] = MLA_EXP2(p1[r]); }
  float s0 = p0[0] + p1[0], s1 = p0[1] + p1[1], s2 = p0[2] + p1[2], s3 = p0[3] + p1[3];
#pragma unroll
  for (int r = 4; r < 16; r += 4) { s0 += p0[r] + p1[r]; s1 += p0[r + 1] + p1[r + 1]; s2 += p0[r + 2] + p1[r + 2]; s3 += p0[r + 3] + p1[r + 3]; }
  l_reg += (s0 + s1) + (s2 + s3);
#define PK8(P, BASE, OUT) do { u32x4 w = {cvt_pk_bf16(P[BASE + 0], P[BASE + 1]), cvt_pk_bf16(P[BASE + 2], P[BASE + 3]), cvt_pk_bf16(P[BASE + 4], P[BASE + 5]), cvt_pk_bf16(P[BASE + 6], P[BASE + 7])}; \
    OUT = __builtin_bit_cast(bf16x8, w); } while (0)
  PK8(p0, 0, pa0); PK8(p0, 8, pa1); PK8(p1, 0, pa2); PK8(p1, 8, pa3);
#undef PK8
}
#undef MX3
typedef short v4i16_t __attribute__((ext_vector_type(4)));
typedef __attribute__((address_space(3))) const char* lds_cptr;
__device__ __forceinline__ s16x4 vtr(lds_cptr p) { return __builtin_bit_cast(s16x4, __builtin_amdgcn_ds_read_tr16_b64_v4i16((__attribute__((address_space(3))) v4i16_t*)p)); }
#define VFRAG(L, H) (bf16x8){L[0], L[1], L[2], L[3], H[0], H[1], H[2], H[3]}
__device__ __forceinline__ void mprefetch(bf16x8 (&fk)[12], lds_cptr Ks, int r32, int hi) {
#define KOFF(row, d0) KSWZ(row, ((d0) * 16 + hi * 8) * 2)
#pragma unroll
  for (int d0 = 0; d0 < 6; ++d0) { fk[2 * d0] = *(const __attribute__((address_space(3))) bf16x8*)(Ks + KOFF(r32, d0)); fk[2 * d0 + 1] = *(const __attribute__((address_space(3))) bf16x8*)(Ks + KOFF(32 + r32, d0)); }
#undef KOFF
}
template <bool HAS_PV>
__device__ __forceinline__ void mstage5(f32x16* o, f32x16& p0, f32x16& p1, bf16x8 (&fk)[12], lds_cptr vp, lds_cptr Ks, const bf16x8* qr, const f32x16& negm,
                                        bf16x8 pa0, bf16x8 pa1, bf16x8 pa2, bf16x8 pa3, int r32, int hi) {
  s16x4 vl[8], vh[8];
  if (HAS_PV) {
#pragma unroll
    for (int d0 = 0; d0 < 2; ++d0)
#pragma unroll
      for (int ks = 0; ks < 4; ++ks) { vl[d0 * 4 + ks] = vtr(vp + v_rd_off(d0, ks, 0)); vh[d0 * 4 + ks] = vtr(vp + v_rd_off(d0, ks, 1)); }
    SBAR(); }
  p0 = __builtin_amdgcn_mfma_f32_32x32x16_bf16(fk[0], qr[0], negm, 0, 0, 0); p1 = __builtin_amdgcn_mfma_f32_32x32x16_bf16(fk[1], qr[0], negm, 0, 0, 0);
#pragma unroll
  for (int d0 = 1; d0 < 6; ++d0) { p0 = __builtin_amdgcn_mfma_f32_32x32x16_bf16(fk[2 * d0], qr[d0], p0, 0, 0, 0); p1 = __builtin_amdgcn_mfma_f32_32x32x16_bf16(fk[2 * d0 + 1], qr[d0], p1, 0, 0, 0); }
  if (HAS_PV) {
    SBAR();
#pragma unroll
    for (int d0 = 0; d0 < 2; ++d0) {
      o[d0] = __builtin_amdgcn_mfma_f32_32x32x16_bf16(pa0, VFRAG(vl[d0 * 4 + 0], vh[d0 * 4 + 0]), o[d0], 0, 0, 0); o[d0] = __builtin_amdgcn_mfma_f32_32x32x16_bf16(pa1, VFRAG(vl[d0 * 4 + 1], vh[d0 * 4 + 1]), o[d0], 0, 0, 0);
      o[d0] = __builtin_amdgcn_mfma_f32_32x32x16_bf16(pa2, VFRAG(vl[d0 * 4 + 2], vh[d0 * 4 + 2]), o[d0], 0, 0, 0); o[d0] = __builtin_amdgcn_mfma_f32_32x32x16_bf16(pa3, VFRAG(vl[d0 * 4 + 3], vh[d0 * 4 + 3]), o[d0], 0, 0, 0); }
  }
}
__device__ __forceinline__ void pvlast4(f32x16* o, lds_cptr vp, bf16x8 pa0, bf16x8 pa1, bf16x8 pa2, bf16x8 pa3) {
  s16x4 vl[8], vh[8];
#pragma unroll
  for (int d0 = 0; d0 < 2; ++d0)
#pragma unroll
    for (int ks = 0; ks < 4; ++ks) { vl[d0 * 4 + ks] = vtr(vp + v_rd_off(d0, ks, 0)); vh[d0 * 4 + ks] = vtr(vp + v_rd_off(d0, ks, 1)); }
#pragma unroll
  for (int d0 = 0; d0 < 2; ++d0) {
    o[d0] = __builtin_amdgcn_mfma_f32_32x32x16_bf16(pa0, VFRAG(vl[d0 * 4 + 0], vh[d0 * 4 + 0]), o[d0], 0, 0, 0); o[d0] = __builtin_amdgcn_mfma_f32_32x32x16_bf16(pa1, VFRAG(vl[d0 * 4 + 1], vh[d0 * 4 + 1]), o[d0], 0, 0, 0);
    o[d0] = __builtin_amdgcn_mfma_f32_32x32x16_bf16(pa2, VFRAG(vl[d0 * 4 + 2], vh[d0 * 4 + 2]), o[d0], 0, 0, 0); o[d0] = __builtin_amdgcn_mfma_f32_32x32x16_bf16(pa3, VFRAG(vl[d0 * 4 + 3], vh[d0 * 4 + 3]), o[d0], 0, 0, 0); }
}
constexpr int NSLOT = 4, SLOT_K = SHM_K, SLOT_V = SHM_V;
constexpr int OFF2_K = 0, OFF2_V = NSLOT * SLOT_K, OFF2_WS = OFF2_V + NSLOT * SLOT_V, LDS2_TOTAL = OFF2_WS + NWAVES * 256;
#define MLA_BAR() asm volatile("s_waitcnt lgkmcnt(0)\n\ts_barrier" ::: "memory")

__device__ __forceinline__ void unit(const bf16_t* __restrict__ Qb, const bf16_t* __restrict__ Kh, const bf16_t* __restrict__ Vh, bf16_t* __restrict__ Ob, int seq, char* lds, int wid) {
  const int lane = lane_id(), r32 = lane & 31, hi = lane >> 5;
  const bool hb = wid >= 4;
  char* K_lds = lds + OFF2_K; char* V_lds = lds + OFF2_V;
  float* al_l = (float*)(lds + OFF2_WS) + wid * 64;
  float m_reg = 0.f, l_reg = 0.f; f32x16 o[2] = {}; f32x16 negm = {}; bf16x8 qr[6];
  const bf16_t* Qw = Qb + (long)(wid * QBLK + r32) * LDQ + hi * 8;
#pragma unroll
  for (int d0 = 0; d0 < 6; ++d0) qr[d0] = *reinterpret_cast<const bf16x8*>(Qw + d0 * 16);
  unsigned koA, koB, vo; bool kvA, kvB;
  { const int rA = 8 * wid + (lane >> 4), rB = rA + 4, cp = lane & 15;
    const int cA = cp ^ (rA & 15), cB = cp ^ (rB & 15); kvA = cA < 12; kvB = cB < 12;
    koA = (unsigned)(rA * LDKk * 2 + cA * 16); koB = (unsigned)(rB * LDKk * 2 + cB * 16);
    const int jv = 64 * wid + lane, sub = jv >> 5, within = jv & 31, k = (sub >> 1) * 8 + (within >> 2), c = (sub & 1) * 32 + (within & 3) * 8;
    vo = (unsigned)(k * LDV * 2 + c * 2); }
  const __attribute__((address_space(3))) char* lds3 = (const __attribute__((address_space(3))) char*)(lds_cptr)lds;
#define DMA_TILE(u) do { const char* kt_ = (const char*)(Kh + (long)(u) * KVBLK * LDKk); const char* vt_ = (const char*)(Vh + (long)(u) * KVBLK * LDV); const int sl_ = (u) & 3; \
    if (kvA) __builtin_amdgcn_global_load_lds((const unsigned*)(kt_ + koA), (__attribute__((address_space(3))) unsigned*)(lds3 + OFF2_K + sl_ * SLOT_K + (2 * wid) * 1024), 16, 0, 0); \
    if (kvB) __builtin_amdgcn_global_load_lds((const unsigned*)(kt_ + koB), (__attribute__((address_space(3))) unsigned*)(lds3 + OFF2_K + sl_ * SLOT_K + (2 * wid + 1) * 1024), 16, 0, 0); \
    __builtin_amdgcn_global_load_lds((const unsigned*)(vt_ + vo), (__attribute__((address_space(3))) unsigned*)(lds3 + OFF2_V + sl_ * SLOT_V + wid * 1024), 16, 0, 0); } while (0)
#define DMA_WAIT() asm volatile("s_waitcnt vmcnt(0)" ::: "memory")
  const lds_cptr vp0 = (lds_cptr)V_lds + v_rd_base(lane); const lds_cptr kp0 = (lds_cptr)K_lds;
  f32x16 p0, p1; bf16x8 pa0, pa1, pa2, pa3; const int NT = seq / KVBLK;
  bf16x8 fka[12];
  DMA_WAIT();
  DMA_TILE(0); DMA_TILE(1); DMA_WAIT();
  MLA_BAR();
  if (hb) MLA_BAR();
  DMA_TILE(2);
  mprefetch(fka, kp0, r32, hi);
  mstage5<false>(o, p0, p1, fka, vp0, kp0, qr, negm, pa0, pa1, pa2, pa3, r32, hi);

  MLA_BAR();
  soft4(p0, p1, m_reg, l_reg, negm, o, al_l, true, pa0, pa1, pa2, pa3, r32, hi);
  mprefetch(fka, kp0 + SLOT_K, r32, hi);
  DMA_WAIT();
  MLA_BAR();
#pragma clang loop unroll(disable)
  for (int t = 1; t < NT; ++t) {
    if (t + 2 < NT) DMA_TILE(t + 2);
    SBAR(); mstage5<true>(o, p0, p1, fka, vp0 + ((t - 1) & 3) * SLOT_V, kp0 + (t & 3) * SLOT_K, qr, negm, pa0, pa1, pa2, pa3, r32, hi);

    MLA_BAR();
    soft4(p0, p1, m_reg, l_reg, negm, o, al_l, false, pa0, pa1, pa2, pa3, r32, hi);
    if (t + 1 < NT) mprefetch(fka, kp0 + ((t + 1) & 3) * SLOT_K, r32, hi);
    DMA_WAIT();
    MLA_BAR();
  }
  SBAR(); pvlast4(o, vp0 + ((NT - 1) & 3) * SLOT_V, pa0, pa1, pa2, pa3);
  if (!hb) MLA_BAR();
  MLA_BAR();
  { auto rr = __builtin_amdgcn_permlane32_swap(__float_as_uint(l_reg), __float_as_uint(l_reg), false, false); l_reg = __uint_as_float(rr[0]) + __uint_as_float(rr[1]); }
  if (hi == 0) al_l[r32] = l_reg; asm volatile("s_waitcnt lgkmcnt(0)" ::: "memory");
  float rli[16];
#pragma unroll
  for (int r = 0; r < 16; ++r) rli[r] = __builtin_amdgcn_rcpf(al_l[crow(r, hi)]);
  { bf16_t* stg = (bf16_t*)(lds) + wid * 2048;
#pragma unroll
    for (int r = 0; r < 16; ++r) { const int orow = crow(r, hi);
#pragma unroll
      for (int d0 = 0; d0 < 2; ++d0) stg[orow * 64 + d0 * 32 + r32] = (bf16_t)(cvt_pk_bf16(o[d0][r] * rli[r], 0.f) & 0xffffu); }
    asm volatile("s_waitcnt lgkmcnt(0)" ::: "memory");
    bf16_t* Ow = Ob + (long)(wid * QBLK) * LDO;
#pragma unroll
    for (int i = 0; i < 4; ++i) { const int row = i * 8 + (lane >> 3), ch = lane & 7; const u32x4 v = *(const u32x4*)(stg + row * 64 + ch * 8); *(u32x4*)(Ow + (long)row * LDO + ch * 8) = v; } }
  MLA_BAR();
#undef DMA_TILE
#undef DMA_WAIT
}
#undef KSWZ
#undef SBAR
}

__device__ __forceinline__ void p3_mla(const Frame& F) {
    unsigned char* ws = F.ws;
    const bf16_t* QB = (const bf16_t*)(ws + WS_QB); const bf16_t* KB = (const bf16_t*)(ws + WS_KB); const bf16_t* VB = (const bf16_t*)(ws + WS_VB); bf16_t* OB = (bf16_t*)(ws + WS_OB);
    const int G = F.G;
    if (G == 256) {
        const int x = F.vcu >> 5, c = F.vcu & 31;
        for (int i = 0; i < 4; ++i) {
            const int pair = x * 8 + 2 * i + (c >> 4), qb = c & 15, b = pair >> 3, h = pair & 7;
            const long row0 = (long)b * SEQ;
            mla::unit(QB + (row0 + qb * 256) * 768 + h * 96, KB + row0 * 768 + h * 96, VB + row0 * 512 + h * 64, OB + (row0 + qb * 256) * 512 + h * 64, SEQ, (char*)F.lds, F.wave);
        }
    } else {
        for (int u = F.vcu; u < 1024; u += G) {
            const int pair = u >> 4, qb = u & 15, b = pair >> 3, h = pair & 7; const long row0 = (long)b * SEQ;
            mla::unit(QB + (row0 + qb * 256) * 768 + h * 96, KB + row0 * 768 + h * 96, VB + row0 * 512 + h * 64, OB + (row0 + qb * 256) * 512 + h * 64, SEQ, (char*)F.lds, F.wave);
        }
    }
}

namespace mxa {
#define SBAR() __builtin_amdgcn_sched_barrier(0)
typedef short v4i16_t __attribute__((ext_vector_type(4)));
typedef __attribute__((address_space(3))) const char* lds_cptr;
__device__ __forceinline__ s16x4 vtr(lds_cptr p) { return __builtin_bit_cast(s16x4, __builtin_amdgcn_ds_read_tr16_b64_v4i16((__attribute__((address_space(3))) v4i16_t*)p)); }
__device__ __forceinline__ int crow(int r, int hi) { return (r & 3) + 8 * (r >> 2) + 4 * hi; }
#define KSW2(row, colB) ((row) * 128 + ((colB) ^ ((((row) >> 1) & 7) << 4)))
__device__ __forceinline__ int v_rd_base(int lane) { return ((lane & 3) << 3) | (((lane >> 2) & 3) << 6) | (((lane >> 4) & 1) << 5) | (((lane >> 5) & 1) << 8); }
constexpr int v_rd_off(int d0, int ks, int half) { return d0 * 512 + ks * 2048 + half * 1024; }
constexpr int BUFB = 8192;
#define VFRAG(L, H) (bf16x8){L[0], L[1], L[2], L[3], H[0], H[1], H[2], H[3]}
__device__ __forceinline__ void step(f32x16& o0, f32x16& o1, float& m_reg, float& l_reg, const bf16x8* qr, lds_cptr Kb, lds_cptr Vb, float* al_l, float basef, float sl2, bool first, int r32, int hi) {
  constexpr float THR = 8.f;
  bf16x8 kf[4]; s16x4 vl[4], vh[4];
#pragma unroll
  for (int d0 = 0; d0 < 4; ++d0) kf[d0] = *(const __attribute__((address_space(3))) bf16x8*)(Kb + KSW2(r32, (d0 * 16 + hi * 8) * 2));
#pragma unroll
  for (int d0 = 0; d0 < 2; ++d0)
#pragma unroll
    for (int ks = 0; ks < 2; ++ks) { vl[d0 * 2 + ks] = vtr(Vb + v_rd_off(d0, ks, 0)); vh[d0 * 2 + ks] = vtr(Vb + v_rd_off(d0, ks, 1)); }
  f32x16 p;
  { const float nm = first ? 0.f : -m_reg;
#pragma unroll
    for (int r = 0; r < 16; ++r) p[r] = nm; }
#pragma unroll
  for (int d0 = 0; d0 < 4; ++d0) p = __builtin_amdgcn_mfma_f32_32x32x16_bf16(kf[d0], qr[d0], p, 0, 0, 0);
  const float nsl = -sl2;
  float pmax = -1e30f;
#pragma unroll
  for (int r = 0; r < 16; ++r) {
    const float df = basef - (float)((r & 3) + 8 * (r >> 2)), ad = __builtin_fabsf(df);
    const float sv = fmaf(nsl, ad, p[r]);
    p[r] = (ad <= 64.f) ? sv : -1e30f;
    pmax = fmaxf(pmax, p[r]);
  }
  { auto rr = __builtin_amdgcn_permlane32_swap(__float_as_uint(pmax), __float_as_uint(pmax), false, false);
    pmax = fmaxf(__uint_as_float(rr[0]), __uint_as_float(rr[1])); }
  if (first || !__all(pmax <= THR)) {
    const float dl = first ? pmax : fmaxf(pmax, 0.f);
    m_reg += dl;
#pragma unroll
    for (int r = 0; r < 16; ++r) p[r] -= dl;
    if (!first) { const float alpha = __builtin_amdgcn_exp2f(-dl); l_reg *= alpha;
      if (hi == 0) al_l[r32] = alpha; asm volatile("s_waitcnt lgkmcnt(0)" ::: "memory");
#pragma unroll
      for (int r = 0; r < 16; ++r) { const float a = al_l[crow(r, hi)]; o0[r] *= a; o1[r] *= a; } }
  }
  float ps = 0.f;
#pragma unroll
  for (int r = 0; r < 16; ++r) { p[r] = __builtin_amdgcn_exp2f(p[r]); ps += p[r]; }
  l_reg += ps;
  u32x4 w0 = {cvt_pk_bf16(p[0], p[1]), cvt_pk_bf16(p[2], p[3]), cvt_pk_bf16(p[4], p[5]), cvt_pk_bf16(p[6], p[7])};
  u32x4 w1 = {cvt_pk_bf16(p[8], p[9]), cvt_pk_bf16(p[10], p[11]), cvt_pk_bf16(p[12], p[13]), cvt_pk_bf16(p[14], p[15])};
  const bf16x8 pa0 = __builtin_bit_cast(bf16x8, w0), pa1 = __builtin_bit_cast(bf16x8, w1);
  o0 = __builtin_amdgcn_mfma_f32_32x32x16_bf16(pa0, VFRAG(vl[0], vh[0]), o0, 0, 0, 0); o0 = __builtin_amdgcn_mfma_f32_32x32x16_bf16(pa1, VFRAG(vl[1], vh[1]), o0, 0, 0, 0);
  o1 = __builtin_amdgcn_mfma_f32_32x32x16_bf16(pa0, VFRAG(vl[2], vh[2]), o1, 0, 0, 0); o1 = __builtin_amdgcn_mfma_f32_32x32x16_bf16(pa1, VFRAG(vl[3], vh[3]), o1, 0, 0, 0);
}

__device__ __forceinline__ void task(const bf16_t* __restrict__ QA, const bf16_t* __restrict__ KA, const bf16_t* __restrict__ VA, bf16_t* __restrict__ OP, float* __restrict__ LS,
                                     int b, int h, int n, int rres, int qb, char* wl, float* al) {
  const int lane = lane_id(), r32 = lane & 31, hi = lane >> 5;
  const int dil = (n == 0) ? 1 : (n == 1 ? 4 : 16), L = SEQ / dil, l0 = qb * 64;
  const float sl2 = exp2f(-(float)(h + 1)) * (float)dil * LOG2E;
  const long rowb = (long)b * SEQ;
  const lds_cptr wl3 = (lds_cptr)wl;
  const lds_cptr vrd = wl3 + 4096 + v_rd_base(lane);
  asm volatile("s_waitcnt vmcnt(0)" ::: "memory");
  unsigned ko[4], vo[4];
#pragma unroll
  for (int pc = 0; pc < 4; ++pc) {
    const int kr = 8 * pc + (lane >> 3), c = (lane & 7) ^ ((kr >> 1) & 7);
    ko[pc] = (unsigned)(kr * dil * 1024 + h * 128 + c * 16);
    const int jv = 64 * pc + lane, sub = jv >> 5, within = jv & 31, vk = (sub >> 1) * 8 + (within >> 2), vc = (sub & 1) * 32 + (within & 3) * 8;
    vo[pc] = (unsigned)(vk * dil * 1024 + h * 128 + vc * 2); }
#define MXA_DMA(lk0_, buf_) do { const size_t rb_ = (size_t)(rowb + (long)(lk0_) * dil + rres) * 1024; const char* kb_ = (const char*)KA + rb_; const char* vb_ = (const char*)VA + rb_; \
    _Pragma("unroll") for (int pc = 0; pc < 4; ++pc) { \
      __builtin_amdgcn_global_load_lds((const unsigned*)(kb_ + ko[pc]), (__attribute__((address_space(3))) unsigned*)(wl3 + (buf_) * BUFB + pc * 1024), 16, 0, 0); \
      __builtin_amdgcn_global_load_lds((const unsigned*)(vb_ + vo[pc]), (__attribute__((address_space(3))) unsigned*)(wl3 + (buf_) * BUFB + 4096 + pc * 1024), 16, 0, 0); } } while (0)
  const bool has_behind = (l0 >= 64), has_ahead = (l0 + 64 < L);
  const int nblk = 2 + (has_behind ? 2 : 0) + (has_ahead ? 2 : 0);
  auto blk_at = [&](int i) -> int { if (i < 2) return 2 + i; if (has_behind && has_ahead) return (i == 2) ? 1 : (i == 3 ? 4 : (i == 4 ? 0 : 5)); if (has_behind) return (i == 2) ? 1 : 0; return (i == 2) ? 4 : 5; };
  MXA_DMA(l0, 0);
  bf16x8 q0[4], q1[4];
  { const long ra = rowb + (long)(l0 + r32) * dil + rres, rb2 = rowb + (long)(l0 + 32 + r32) * dil + rres;
#pragma unroll
    for (int d0 = 0; d0 < 4; ++d0) { q0[d0] = *reinterpret_cast<const bf16x8*>(QA + ra * 512 + h * 64 + d0 * 16 + hi * 8); q1[d0] = *reinterpret_cast<const bf16x8*>(QA + rb2 * 512 + h * 64 + d0 * 16 + hi * 8); } }
  asm volatile("s_waitcnt vmcnt(0)" ::: "memory");
  f32x16 oa0 = f32x16{}, oa1 = f32x16{}, ob0 = f32x16{}, ob1 = f32x16{};
  float ma = 0.f, la = 0.f, mb = 0.f, lb = 0.f;
#pragma clang loop unroll(disable)
  for (int i = 0; i < nblk; ++i) {
    const int j = blk_at(i), buf = i & 1;
    if (i + 1 < nblk) { MXA_DMA(l0 - 64 + 32 * blk_at(i + 1), buf ^ 1); }
    if (i > 0) { if (i + 1 < nblk) asm volatile("s_waitcnt vmcnt(8)" ::: "memory"); else asm volatile("s_waitcnt vmcnt(0)" ::: "memory"); }
    const lds_cptr Kb = wl3 + buf * BUFB, Vb = vrd + buf * BUFB;
    const int dk = -64 + 32 * j;
    if (j <= 4) step(oa0, oa1, ma, la, q0, Kb, Vb, al, (float)(r32 - 4 * hi - dk), sl2, i == 0, r32, hi);
    if (j >= 1) step(ob0, ob1, mb, lb, q1, Kb, Vb, al, (float)(32 + r32 - 4 * hi - dk), sl2, i == 0, r32, hi);
    asm volatile("s_waitcnt lgkmcnt(0)" ::: "memory");
  }
#undef MXA_DMA
#pragma unroll
  for (int qs = 0; qs < 2; ++qs) {
    float l_reg = qs ? lb : la; const float m_reg = qs ? mb : ma;
    { auto rr = __builtin_amdgcn_permlane32_swap(__float_as_uint(l_reg), __float_as_uint(l_reg), false, false); l_reg = __uint_as_float(rr[0]) + __uint_as_float(rr[1]); }
    if (hi == 0) { al[r32] = l_reg; const long row = rowb + (long)(l0 + qs * 32 + r32) * dil + rres; LS[row * 8 + h] = m_reg + __builtin_amdgcn_logf(l_reg); }
    asm volatile("s_waitcnt lgkmcnt(0)" ::: "memory");
    bf16_t* stg = (bf16_t*)wl;
#pragma unroll
    for (int r = 0; r < 16; ++r) { const int orow = crow(r, hi); const float rl = __builtin_amdgcn_rcpf(al[orow]);
      stg[orow * 64 + r32] = (bf16_t)(cvt_pk_bf16((qs ? ob0[r] : oa0[r]) * rl, 0.f) & 0xffffu);
      stg[orow * 64 + 32 + r32] = (bf16_t)(cvt_pk_bf16((qs ? ob1[r] : oa1[r]) * rl, 0.f) & 0xffffu); }
    asm volatile("s_waitcnt lgkmcnt(0)" ::: "memory");
#pragma unroll
    for (int i = 0; i < 4; ++i) { const int rw = i * 8 + (lane >> 3), ch = lane & 7; const u32x4 v = *(const u32x4*)(stg + rw * 64 + ch * 8);
      const long row = rowb + (long)(l0 + qs * 32 + rw) * dil + rres; *(u32x4*)(OP + row * 512 + h * 64 + ch * 8) = v; }
    asm volatile("s_waitcnt lgkmcnt(0)" ::: "memory");
  }
}
#undef KSW2
#undef VFRAG
#undef SBAR
}

__device__ __forceinline__ void p3_mixerA(const Frame& F) {
    unsigned char* ws = F.ws;
    const bf16_t* QA = (const bf16_t*)(ws + WS_QA); const bf16_t* KA = (const bf16_t*)(ws + WS_KA); const bf16_t* VA = (const bf16_t*)(ws + WS_VA);
    float* LSE = (float*)(ws + WS_LSE);
    char* wl = (char*)F.lds + F.wave * 16384; float* al = (float*)((char*)F.lds + RING_BYTES + 2048) + F.wave * 64;
    const int x = (F.G == 256) ? (F.vcu >> 5) : 0; const int ngrp = (F.G == 256) ? 8 : 1, per = 64 * 192 / ngrp;
    unsigned* qctr = F.ctl + CW_Q + 64 * x;
    for (;;) {
        unsigned ti = 0; if (lane_id() == 0) ti = atomicAdd(qctr, 1u);
        ti = (unsigned)__builtin_amdgcn_readfirstlane((int)ti);
        if (ti >= (unsigned)per) break;
        const int t = x * per + (int)ti;
        const int pair = t / 192, tt = t % 192, n = tt >> 6, idx = tt & 63;
        const int rres = (n == 0) ? 0 : (n == 1 ? (idx >> 4) : (idx >> 2)), qb = (n == 0) ? idx : (n == 1 ? (idx & 15) : (idx & 3));
        bf16_t* OP = (bf16_t*)(ws + (n == 2 ? WS_OAP2 : WS_OAP0)) + (n == 1 ? (size_t)T * 512 : 0);
        mxa::task(QA, KA, VA, OP, LSE + (size_t)n * ((size_t)T * 8), pair >> 3, pair & 7, n, rres, qb, wl, al);
    }
}
static_assert(WS_OAP1 - WS_OAP0 == (size_t)T * 512 * 2, "OAP0|OAP1 contiguous");

__device__ __forceinline__ void p35_mix(const Frame& F, const Args& a) {
    unsigned char* ws = F.ws; const int lane = lane_id();
    const bf16_t* OB = (const bf16_t*)(ws + WS_OB); const float* LSE = (const float*)(ws + WS_LSE); bf16_t* MIXED = (bf16_t*)(ws + WS_MIXED);
    const bf16_t* OAPn[3] = {(const bf16_t*)(ws + WS_OAP0), (const bf16_t*)(ws + WS_OAP1), (const bf16_t*)(ws + WS_OAP2)};
    const float* g_a = a.in[8]; const float* g_b = a.in[9];
    const int gw = F.vcu * NWAVES + F.wave, NGW = F.G * NWAVES;
    const int h = lane >> 3;
    const f32x4 ga0 = *(const f32x4*)(g_a + lane * 8), ga1 = *(const f32x4*)(g_a + lane * 8 + 4), gb0 = *(const f32x4*)(g_b + lane * 8), gb1 = *(const f32x4*)(g_b + lane * 8 + 4);
    for (int row = gw; row < T; row += NGW) {
        float ls[3]; u32x4 ov[3];
#pragma unroll
        for (int n = 0; n < 3; ++n) { ls[n] = LSE[((size_t)n * T + row) * 8 + h]; ov[n] = __builtin_nontemporal_load((const u32x4*)(OAPn[n] + (size_t)row * 512 + lane * 8)); }
        const u32x4 bv = __builtin_nontemporal_load((const u32x4*)(OB + (size_t)row * 512 + lane * 8));
        const float mx = fmaxf(ls[0], fmaxf(ls[1], ls[2]));
        float w[3]; float wsum = 0.f;
#pragma unroll
        for (int n = 0; n < 3; ++n) { w[n] = __builtin_amdgcn_exp2f(ls[n] - mx); wsum += w[n]; }
        const float inv = 1.f / wsum;
        float oa[8] = {0.f, 0.f, 0.f, 0.f, 0.f, 0.f, 0.f, 0.f};
#pragma unroll
        for (int n = 0; n < 3; ++n) { const float wn = w[n] * inv;
#pragma unroll
            for (int j = 0; j < 4; ++j) { oa[2 * j] += wn * bf16lo(ov[n][j]); oa[2 * j + 1] += wn * bf16hi(ov[n][j]); } }
        float obv[8];
#pragma unroll
        for (int j = 0; j < 4; ++j) { obv[2 * j] = bf16lo(bv[j]); obv[2 * j + 1] = bf16hi(bv[j]); }
        float sa = 0.f, sb = 0.f;
#pragma unroll
        for (int j = 0; j < 8; ++j) { sa += oa[j] * oa[j]; sb += obv[j] * obv[j]; }
        sa = wsum64(sa); sb = wsum64(sb);
        const float ra = 1.0f / sqrtf(sa * (1.f / 512.f) + EPS), rb = 1.0f / sqrtf(sb * (1.f / 512.f) + EPS);
        u32x4 wa, wb;
        wa.x = cvt_pk_bf16(oa[0] * ra * ga0[0], oa[1] * ra * ga0[1]); wa.y = cvt_pk_bf16(oa[2] * ra * ga0[2], oa[3] * ra * ga0[3]);
        wa.z = cvt_pk_bf16(oa[4] * ra * ga1[0], oa[5] * ra * ga1[1]); wa.w = cvt_pk_bf16(oa[6] * ra * ga1[2], oa[7] * ra * ga1[3]);
        wb.x = cvt_pk_bf16(obv[0] * rb * gb0[0], obv[1] * rb * gb0[1]); wb.y = cvt_pk_bf16(obv[2] * rb * gb0[2], obv[3] * rb * gb0[3]);
        wb.z = cvt_pk_bf16(obv[4] * rb * gb1[0], obv[5] * rb * gb1[1]); wb.w = cvt_pk_bf16(obv[6] * rb * gb1[2], obv[7] * rb * gb1[3]);
        *(u32x4*)(MIXED + (size_t)row * 1024 + lane * 8) = wa;
        *(u32x4*)(MIXED + (size_t)row * 1024 + 512 + lane * 8) = wb;
    }
}

constexpr size_t WS_WRT = 4 * MiB + 512 * 1024;
constexpr size_t WS_RS = 137 * MiB;
constexpr size_t WS_GS = 141 * MiB;
constexpr size_t WS_H2B = 384 * MiB;
constexpr size_t WS_D = 448 * MiB;
constexpr int MOE_TAB = MISC_OFF + 256;
constexpr int NBUCK = 112;
constexpr int CW_BCNT = 32768;
constexpr size_t WS_HID2 = 209 * MiB;
constexpr size_t WS_BLIST = 288 * MiB;
constexpr size_t WS_SSQ2 = 136 * MiB + 256 * 1024;
constexpr int MOE_TOKL = MOE_TAB + 4096;
constexpr size_t WS_DST = 280 * MiB;

__device__ __forceinline__ void p0_router_table(const Frame& F, const Args& a) {
    const float* w_r1 = a.in[12]; const float* w_r2 = a.in[14]; const float* g_ffn = a.in[11]; bf16_t* WRH = (bf16_t*)(F.ws + WS_WRT); bf16_t* WRL = WRH + 48 * 1024;
    const int gw = F.vcu * NWAVES + F.wave, NGW = F.G * NWAVES, lane = lane_id();
    for (int idx = gw * 64 + lane; idx < 48 * 1024; idx += NGW * 64) {
        const int o = idx >> 10, k = idx & 1023;
        float w = 0.f;
        if (o < 4) w = w_r1[k * 4 + o]; else if (o < 36) w = w_r2[((size_t)((o - 4) >> 3) * 1024 + k) * 8 + ((o - 4) & 7)];
        w *= g_ffn[k];
        const unsigned hi = cvt_pk_bf16(w, 0.f) & 0xffffu; const float rem = w - __uint_as_float(hi << 16);
        WRH[idx] = (bf16_t)hi; WRL[idx] = (bf16_t)(cvt_pk_bf16(rem, 0.f) & 0xffffu);
    }
}

__device__ __forceinline__ void p4_wo(const Frame& F, const Args& a) {
    unsigned char* ws = F.ws;
    { const float* p = a.in[1]; bf16_t* P16 = (bf16_t*)(ws + WS_P16); const int gw = F.vcu * NWAVES + F.wave, NGW = F.G * NWAVES, lane = lane_id();
      for (size_t i = (size_t)gw * 64 + lane; i < (size_t)T * 256 / 8; i += (size_t)NGW * 64) {
          const f32x4 v0 = ((const f32x4*)p)[2 * i], v1 = ((const f32x4*)p)[2 * i + 1];
          u32x4 o; o.x = cvt_pk_bf16(v0.x, v0.y); o.y = cvt_pk_bf16(v0.z, v0.w); o.z = cvt_pk_bf16(v1.x, v1.y); o.w = cvt_pk_bf16(v1.z, v1.w);
          ((u32x4*)P16)[i] = o; } }
    pg::DenseSched S{(const char*)(ws + WS_MIXED), (const char*)(ws + WS_WO), 1024, 1024, T / 256, 4, F.G, (int)blockIdx.x};
    EpiStoreBf16 E{(bf16_t*)(ws + WS_D), 1024};
    pg::gemm_phase(F.lds, S, E, 1024, F.wave);
}

__device__ __forceinline__ void p5_router(const Frame& F, const Args& a) {
    unsigned char* ws = F.ws; const int lane = lane_id(), wid = F.wave;
    const float* X = a.in[0]; const bf16_t* Dm = (const bf16_t*)(ws + WS_D); const float* g_ffn = a.in[11]; const float* b_r1 = a.in[13]; const float* b_r2 = a.in[15];
    const bf16_t* WRH = (const bf16_t*)(ws + WS_WRT); const bf16_t* WRL = WRH + 48 * 1024; bf16_t* MU = (bf16_t*)(ws + WS_M);
    int* LIST = (int*)(ws + WS_LIST); float* RS = (float*)(ws + WS_RS); float* GS = (float*)(ws + WS_GS);
    unsigned* cnt = F.ctl + CW_CNT;
    LAS int* LG = (LAS int*)(F.lds);
    LAS int* SSQ_ = (LAS int*)(F.lds + 26 * 1024);
    LAS unsigned* hist = (LAS unsigned*)(F.lds + 27 * 1024);
    LAS unsigned* gbase = hist + 160;
    int* DST = (int*)(ws + WS_DST); int* BLIST = (int*)(ws + WS_BLIST); unsigned* bcnt = F.ctl + CW_BCNT;
    const int tr = lane & 15, kg = lane >> 4, tid = wid * 64 + lane;
    const int kw = 128 * wid;
    for (int chunk = F.vcu; chunk < T / 128; chunk += F.G) {
        const int base = chunk * 128;
        for (int i = tid; i < 128 * 49 + 128; i += 512) { if (i < 128 * 49) LG[i] = 0; else SSQ_[i - 128 * 49] = 0; }
        if (tid < 32 + NBUCK) hist[tid] = 0u;
        __syncthreads();
        bf16x8 bh[4][3], bl[4][3];
#pragma unroll
        for (int ks = 0; ks < 4; ++ks)
#pragma unroll
            for (int nb = 0; nb < 3; ++nb) { const size_t wo = (size_t)(nb * 16 + tr) * 1024 + kw + ks * 32 + 8 * kg; bh[ks][nb] = *(const bf16x8*)(WRH + wo); bl[ks][nb] = *(const bf16x8*)(WRL + wo); }
#pragma unroll 2
        for (int mb = 0; mb < 8; ++mb) {
            const size_t ro = (size_t)(base + 16 * mb + tr) * 1024 + kw + 8 * kg;
            f32x4 acc0 = {0.f, 0.f, 0.f, 0.f}, acc1 = acc0, acc2 = acc0; float ss = 0.f;
#pragma unroll
            for (int ks = 0; ks < 4; ++ks) {
                f32x4 v0 = __builtin_nontemporal_load((const f32x4*)(X + ro + ks * 32)), v1 = __builtin_nontemporal_load((const f32x4*)(X + ro + ks * 32 + 4));
                { const u32x4 dd = __builtin_nontemporal_load((const u32x4*)(Dm + ro + ks * 32));
                  v0[0] += bf16lo(dd.x); v0[1] += bf16hi(dd.x); v0[2] += bf16lo(dd.y); v0[3] += bf16hi(dd.y); v1[0] += bf16lo(dd.z); v1[1] += bf16hi(dd.z); v1[2] += bf16lo(dd.w); v1[3] += bf16hi(dd.w); }
                ss += (v0[0] * v0[0] + v0[1] * v0[1]) + (v0[2] * v0[2] + v0[3] * v0[3]) + (v1[0] * v1[0] + v1[1] * v1[1]) + (v1[2] * v1[2] + v1[3] * v1[3]);
                u32x4 hi; hi.x = cvt_pk_bf16(v0[0], v0[1]); hi.y = cvt_pk_bf16(v0[2], v0[3]); hi.z = cvt_pk_bf16(v1[0], v1[1]); hi.w = cvt_pk_bf16(v1[2], v1[3]);
                u32x4 lo; lo.x = cvt_pk_bf16(v0[0] - bf16lo(hi.x), v0[1] - bf16hi(hi.x)); lo.y = cvt_pk_bf16(v0[2] - bf16lo(hi.y), v0[3] - bf16hi(hi.y));
                lo.z = cvt_pk_bf16(v1[0] - bf16lo(hi.z), v1[1] - bf16hi(hi.z)); lo.w = cvt_pk_bf16(v1[2] - bf16lo(hi.w), v1[3] - bf16hi(hi.w));
                *(u32x4*)(MU + ro + ks * 32) = hi;
                const bf16x8 ah = __builtin_bit_cast(bf16x8, hi), al = __builtin_bit_cast(bf16x8, lo);
                acc0 = __builtin_amdgcn_mfma_f32_16x16x32_bf16(ah, bh[ks][0], acc0, 0, 0, 0); acc0 = __builtin_amdgcn_mfma_f32_16x16x32_bf16(al, bh[ks][0], acc0, 0, 0, 0); acc0 = __builtin_amdgcn_mfma_f32_16x16x32_bf16(ah, bl[ks][0], acc0, 0, 0, 0);
                acc1 = __builtin_amdgcn_mfma_f32_16x16x32_bf16(ah, bh[ks][1], acc1, 0, 0, 0); acc1 = __builtin_amdgcn_mfma_f32_16x16x32_bf16(al, bh[ks][1], acc1, 0, 0, 0); acc1 = __builtin_amdgcn_mfma_f32_16x16x32_bf16(ah, bl[ks][1], acc1, 0, 0, 0);
                acc2 = __builtin_amdgcn_mfma_f32_16x16x32_bf16(ah, bh[ks][2], acc2, 0, 0, 0); acc2 = __builtin_amdgcn_mfma_f32_16x16x32_bf16(al, bh[ks][2], acc2, 0, 0, 0); acc2 = __builtin_amdgcn_mfma_f32_16x16x32_bf16(ah, bl[ks][2], acc2, 0, 0, 0);
            }
            ss += __shfl_xor(ss, 16); ss += __shfl_xor(ss, 32);
            if (kg == 0) atomicAdd((int*)(SSQ_ + 16 * mb + tr), __float2int_rn(ss * 16384.0f));
#pragma unroll
            for (int r = 0; r < 4; ++r) { const int tk = 16 * mb + 4 * kg + r;
                atomicAdd((int*)(LG + tk * 49 + tr), __float2int_rn(acc0[r] * 1048576.0f)); atomicAdd((int*)(LG + tk * 49 + 16 + tr), __float2int_rn(acc1[r] * 1048576.0f)); if (tr < 4) atomicAdd((int*)(LG + tk * 49 + 32 + tr), __float2int_rn(acc2[r] * 1048576.0f)); }
        }
        __syncthreads();
        int ea = 0, eb = 0, bk = 0, hfa = 0; unsigned la = 0u, lb = 0u, lk = 0u; float w0 = 0.f, w1 = 0.f, rstd = 0.f;
        if (tid < 128) {
            rstd = 1.0f / sqrtf((float)SSQ_[tid] * (1.f / 16384.f) * (1.f / 1024.f) + EPS);
            const LAS int* lg = LG + tid * 49; const float rq = rstd * (1.f / 1048576.f);
            const float l0 = (float)lg[0] * rq + b_r1[0], l1 = (float)lg[1] * rq + b_r1[1], l2 = (float)lg[2] * rq + b_r1[2], l3 = (float)lg[3] * rq + b_r1[3];
            int gi = 0; float gm = l0; if (l1 > gm) { gm = l1; gi = 1; } if (l2 > gm) { gm = l2; gi = 2; } if (l3 > gm) { gm = l3; gi = 3; }
            const float gs = __expf(l0 - gm) + __expf(l1 - gm) + __expf(l2 - gm) + __expf(l3 - gm);
            const float g_val = 1.0f / gs;
            float lv[8];
#pragma unroll
            for (int e = 0; e < 8; ++e) lv[e] = (float)lg[4 + 8 * gi + e] * rq + b_r2[8 * gi + e];
            int e0 = 0; float m0 = lv[0];
#pragma unroll
            for (int e = 1; e < 8; ++e) if (lv[e] > m0) { m0 = lv[e]; e0 = e; }
            int e1 = -1; float m1 = -3.0e38f;
#pragma unroll
            for (int e = 0; e < 8; ++e) if (e != e0 && lv[e] > m1) { m1 = lv[e]; e1 = e; }
            const float x1 = __expf(m1 - m0);
            w0 = g_val / (1.0f + x1); w1 = g_val * x1 / (1.0f + x1);
            ea = gi * 8 + e0; eb = gi * 8 + e1;
            la = atomicAdd((unsigned*)(hist + ea), 1u); lb = atomicAdd((unsigned*)(hist + eb), 1u);
            { const int lo = e0 < e1 ? e0 : e1, hi = e0 < e1 ? e1 : e0; bk = gi * 28 + (lo * 7 - ((lo * (lo - 1)) >> 1) + (hi - lo - 1)); hfa = e0 < e1 ? 0 : 1; }
            lk = atomicAdd((unsigned*)(hist + 32 + bk), 1u);
        }
        __syncthreads();
        if (tid < 32 + NBUCK) { const unsigned c = hist[tid]; gbase[tid] = c ? atomicAdd(tid < 32 ? cnt + 64 * tid : bcnt + 64 * (tid - 32), c) : 0u; }
        __syncthreads();
        if (tid < 128) {
            const int tok = base + tid; const int ra = (int)(gbase[ea] + la), rb = (int)(gbase[eb] + lb);
            LIST[(size_t)ea * T + ra] = tok; RS[(size_t)ea * T + ra] = rstd; GS[(size_t)ea * T + ra] = w0;
            LIST[(size_t)eb * T + rb] = tok; RS[(size_t)eb * T + rb] = rstd; GS[(size_t)eb * T + rb] = w1;
            const int rk2 = (int)(gbase[32 + bk] + lk);
            DST[(size_t)ea * T + ra] = (bk << 17) | (rk2 << 1) | hfa; DST[(size_t)eb * T + rb] = (bk << 17) | (rk2 << 1) | (hfa ^ 1);
            BLIST[(size_t)bk * T + rk2] = tok;
        }
        __syncthreads();
    }
}

__device__ __forceinline__ void moe_build_tables(const Frame& F) {
    LAS int* tab = (LAS int*)(F.lds + MOE_TAB);
    const int tid = F.wave * 64 + lane_id();
    if (tid < 32 + NBUCK) tab[512 + tid] = (int)__hip_atomic_load(tid < 32 ? F.ctl + CW_CNT + 64 * tid : F.ctl + CW_BCNT + 64 * (tid - 32), __ATOMIC_RELAXED, __HIP_MEMORY_SCOPE_AGENT);
    __syncthreads();
    if (tid <= 32) { int off = 0, cp = 0;
        for (int j = 0; j < tid; ++j) { const int nch = (tab[512 + j] + 255) >> 8; off += nch * 256; cp += nch; }
        tab[tid] = off; tab[80 + tid] = cp; if (tid < 32) tab[40 + tid] = tab[512 + tid]; }
    else if (tid >= 64 && tid <= 64 + NBUCK) { const int b = tid - 64; int o = 0, p = 0;
        for (int j = 0; j < b; ++j) { const int c = tab[512 + 32 + j]; o += c; p += (c + 255) >> 8; }
        tab[128 + b] = o; tab[384 + b] = p; if (b < NBUCK) tab[256 + b] = tab[512 + 32 + b]; }
    __syncthreads();
}
struct MoeSched1 {
    static constexpr bool GATHER = true; static constexpr int KSPLIT = 0;
    const char* A; const char* Bt; const int* LIST; LAS const int* tab; int G, c;
    __device__ __forceinline__ int a_ld() const { return 1024; }
    __device__ __forceinline__ const char* abase() const { return A; }
    __device__ __forceinline__ bool next(int i, pg::Unit& u) const {
        const int nun = tab[80 + 32] * 2; const long L = (long)i * G + c; if (L >= nun) return false;
        const int ci = (int)L >> 1; u.pn = (int)L & 1;
        int e = 0;
#pragma unroll 1
        for (int k = 1; k < 32; ++k) if (tab[80 + k] <= ci) e = k;
        u.aux = e; u.pm = ci - tab[80 + e]; return true;
    }
    __device__ __forceinline__ void addr(const pg::Unit&, const char*&, const char*&) const {}
    __device__ __forceinline__ void addr_g(const pg::Unit& u, const int (&R)[2], const int (&C)[2], unsigned (&aoff)[2][2], const char*& bbase) const {
        const int e = u.aux, cn = tab[40 + e];
#pragma unroll
        for (int h = 0; h < 2; ++h)
#pragma unroll
            for (int i = 0; i < 2; ++i) { const int rk = u.pm * 256 + h * 128 + R[i]; const int tok = (rk < cn) ? LIST[(size_t)e * T + rk] : 0; aoff[h][i] = (unsigned)((tok * 1024 + C[i]) * 2); }
        bbase = Bt + ((size_t)e * 512 + (size_t)u.pn * 256) * 1024 * 2;
    }
};
struct EpiMoe1 {
    bf16_t* HID2; const float* RS; const float* GS; const int* DST; LAS const int* tab;
    __device__ __forceinline__ void operator()(const f32x4 (&acc)[2][2][4][2], const pg::Unit& u, int wr, int wc, int fr, int fq, LAS unsigned char* stage, int wid) const {
        const int e = u.aux, cn = tab[40 + e];
        float rsv[2][4], gsv[2][4]; int dsv[2][4];
#pragma unroll
        for (int ai = 0; ai < 2; ++ai)
#pragma unroll
            for (int m = 0; m < 4; ++m) { const int rk = u.pm * 256 + ai * 128 + wr * 64 + m * 16 + fr; const bool ok = rk < cn; const size_t o = (size_t)e * T + rk;
                rsv[ai][m] = ok ? RS[o] : 0.f; gsv[ai][m] = ok ? GS[o] : 0.f; dsv[ai][m] = ok ? DST[o] : -1; }
#pragma unroll
        for (int ai = 0; ai < 2; ++ai)
#pragma unroll
            for (int m = 0; m < 4; ++m) { const int d = dsv[ai][m];
                if (d >= 0) { const float rs = rsv[ai][m], gt = gsv[ai][m]; float hv[8];
                    const int row2 = tab[128 + (d >> 17)] + ((d >> 1) & 0xffff), half = d & 1;
#pragma unroll
                    for (int n = 0; n < 2; ++n)
#pragma unroll
                        for (int j = 0; j < 4; ++j) { const float gg = acc[ai][0][m][n][j] * rs, uu = acc[ai][1][m][n][j] * (rs * gt); hv[4 * n + j] = gg / (1.0f + __expf(-gg)) * uu; }
                    u32x4 w; w.x = cvt_pk_bf16(hv[0], hv[1]); w.y = cvt_pk_bf16(hv[2], hv[3]); w.z = cvt_pk_bf16(hv[4], hv[5]); w.w = cvt_pk_bf16(hv[6], hv[7]);
                    *(u32x4*)(HID2 + (size_t)row2 * 512 + half * 256 + u.pn * 128 + wc * 32 + 8 * fq) = w; } }
    }
};
struct MoeSched2 {
    static constexpr bool GATHER = false; static constexpr int KSPLIT = 4;
    const char* A; const char* Bt; LAS const int* tab; int G, c;
    __device__ __forceinline__ int a_ld() const { return 512; }
    __device__ __forceinline__ const char* abase() const { return A; }
    __device__ __forceinline__ bool next(int i, pg::Unit& u) const {
        const int nun = tab[384 + NBUCK] * 4; const long L = (long)i * G + c; if (L >= nun) return false;
        const int ci = (int)L >> 2; u.pn = (int)L & 3;
        const int l = lane_id();
        const unsigned long long m0 = __builtin_amdgcn_ballot_w64(tab[384 + l] <= ci), m1 = __builtin_amdgcn_ballot_w64(l + 64 < NBUCK && tab[384 + 64 + l] <= ci);
        const int b = __builtin_popcountll(m0) + __builtin_popcountll(m1) - 1;
        u.aux = b; u.pm = ci - tab[384 + b]; return true;
    }
    __device__ __forceinline__ void addr(const pg::Unit& u, const char*& abase_, const char*& bbase, const char*& bbase2) const {
        const int b = u.aux, g = b / 28, p = b % 28;
        int lo = 0, rem = p;
#pragma unroll 1
        while (rem >= 7 - lo) { rem -= 7 - lo; ++lo; }
        const int hi = lo + 1 + rem;
        abase_ = A + (size_t)(tab[128 + b] + u.pm * 256) * 512 * 2;
        bbase = Bt + ((size_t)(g * 8 + lo) * 1024 + (size_t)u.pn * 256) * 256 * 2;
        bbase2 = Bt + ((size_t)(g * 8 + hi) * 1024 + (size_t)u.pn * 256) * 256 * 2; }
    __device__ __forceinline__ void addr_g(const pg::Unit&, const int (&)[2], const int (&)[2], unsigned (&)[2][2], const char*&) const {}
};
__device__ __forceinline__ void moe2_fetch(LAS const int* tokl, const bf16_t* MU, size_t colo, int wid, int rsub, int ai, int m, int (&tk)[2], u32x4 (&mv)[2]) {
#pragma unroll
    for (int i = 0; i < 2; ++i) { const int r2 = 4 * wid + 2 * i + rsub, trow = 128 * ai + 64 * (r2 >> 4) + 16 * m + (r2 & 15);
        tk[i] = tokl[trow]; mv[i] = (u32x4){0u, 0u, 0u, 0u};
        if (tk[i] >= 0) mv[i] = __builtin_nontemporal_load((const u32x4*)(MU + (size_t)tk[i] * 1024 + colo)); }
}
struct EpiMoe2 {
    bf16_t* H2B; const bf16_t* MU; const int* BLIST; float* SSQ2; LAS const int* tab; LAS int* tokl;
    __device__ __forceinline__ void operator()(const f32x4 (&acc)[2][2][4][2], const pg::Unit& u, int wr, int wc, int fr, int fq, LAS unsigned char* stage, int wid) const {
        const int b = u.aux, lane = fr + 16 * fq, rk0 = u.pm * 256, nvalid = tab[256 + b] - rk0, tid = wid * 64 + lane;
        if (tid < 256) tokl[tid] = (tid < nvalid) ? BLIST[(size_t)b * T + rk0 + tid] : -1;
        asm volatile("s_waitcnt lgkmcnt(0)\n\ts_barrier" ::: "memory");
        const int ch = lane & 31, rsub = lane >> 5, rr = 16 * wr + fr; const size_t colo = (size_t)u.pn * 256 + ch * 8;
        int tk[2]; u32x4 mv[2];
        moe2_fetch(tokl, MU, colo, wid, rsub, 0, 0, tk, mv);
#pragma unroll
        for (int it = 0; it < 8; ++it) { const int ai = it >> 2, m = it & 3;
            u32x4 w[2];
#pragma unroll
            for (int bj = 0; bj < 2; ++bj) { const f32x4 v0 = acc[ai][bj][m][0], v1 = acc[ai][bj][m][1];
                w[bj].x = cvt_pk_bf16(v0[0], v0[1]); w[bj].y = cvt_pk_bf16(v0[2], v0[3]); w[bj].z = cvt_pk_bf16(v1[0], v1[1]); w[bj].w = cvt_pk_bf16(v1[2], v1[3]); }
            *(LAS u32x4*)(stage + rr * pg::EPI_ROWB + (32 * wc + 8 * fq) * 2) = w[0];
            *(LAS u32x4*)(stage + rr * pg::EPI_ROWB + (128 + 32 * wc + 8 * fq) * 2) = w[1];
            asm volatile("s_waitcnt lgkmcnt(0)\n\ts_barrier" ::: "memory");
            int tkn[2] = {-1, -1}; u32x4 mvn[2] = {(u32x4){0u, 0u, 0u, 0u}, (u32x4){0u, 0u, 0u, 0u}};
            if (it < 7) moe2_fetch(tokl, MU, colo, wid, rsub, (it + 1) >> 2, (it + 1) & 3, tkn, mvn);
#pragma unroll
            for (int i = 0; i < 2; ++i) { const int r2 = 4 * wid + 2 * i + rsub;
                const u32x4 v = *(const LAS u32x4*)(stage + r2 * pg::EPI_ROWB + ch * 16); const u32x4 hh = mv[i];
                float h[8]; h[0] = bf16lo(v.x) + bf16lo(hh.x); h[1] = bf16hi(v.x) + bf16hi(hh.x); h[2] = bf16lo(v.y) + bf16lo(hh.y); h[3] = bf16hi(v.y) + bf16hi(hh.y);
                h[4] = bf16lo(v.z) + bf16lo(hh.z); h[5] = bf16hi(v.z) + bf16hi(hh.z); h[6] = bf16lo(v.w) + bf16lo(hh.w); h[7] = bf16hi(v.w) + bf16hi(hh.w);
                float ss = ((h[0] * h[0] + h[1] * h[1]) + (h[2] * h[2] + h[3] * h[3])) + ((h[4] * h[4] + h[5] * h[5]) + (h[6] * h[6] + h[7] * h[7]));
                if (tk[i] < 0) ss = 0.f;
                ss += __shfl_xor(ss, 16); ss += __shfl_xor(ss, 8); ss += __shfl_xor(ss, 4); ss += __shfl_xor(ss, 2); ss += __shfl_xor(ss, 1);
                if (tk[i] >= 0) { u32x4 o; o.x = cvt_pk_bf16(h[0], h[1]); o.y = cvt_pk_bf16(h[2], h[3]); o.z = cvt_pk_bf16(h[4], h[5]); o.w = cvt_pk_bf16(h[6], h[7]);
                    *(u32x4*)(H2B + (size_t)tk[i] * 1024 + colo) = o;
                    if (ch == 0) SSQ2[(size_t)tk[i] * 4 + u.pn] = ss; } }
            asm volatile("s_waitcnt lgkmcnt(0)\n\ts_barrier" ::: "memory");
#pragma unroll
            for (int i = 0; i < 2; ++i) { tk[i] = tkn[i]; mv[i] = mvn[i]; }
        }
    }
};
__device__ __forceinline__ void p6a_moe_up(const Frame& F) {
    unsigned char* ws = F.ws; moe_build_tables(F);
    LAS const int* tab = (LAS const int*)(F.lds + MOE_TAB);
    MoeSched1 S{(const char*)(ws + WS_M), (const char*)(ws + WS_WGU), (const int*)(ws + WS_LIST), tab, F.G, F.vcu};
    EpiMoe1 E{(bf16_t*)(ws + WS_HID2), (const float*)(ws + WS_RS), (const float*)(ws + WS_GS), (const int*)(ws + WS_DST), tab};
    pg::gemm_phase(F.lds, S, E, 1024, F.wave);
    pp_units(F, F.vcu, tab[80 + 32] * 2);
}
__device__ __forceinline__ void p6b_moe_down(const Frame& F) {
    unsigned char* ws = F.ws; moe_build_tables(F);
    LAS const int* tab = (LAS const int*)(F.lds + MOE_TAB);
    MoeSched2 S{(const char*)(ws + WS_HID2), (const char*)(ws + WS_WD), tab, F.G, F.vcu};
    EpiMoe2 E{(bf16_t*)(ws + WS_H2B), (const bf16_t*)(ws + WS_M), (const int*)(ws + WS_BLIST), (float*)(ws + WS_SSQ2), tab, (LAS int*)(F.lds + MOE_TOKL)};
    pg::gemm_phase(F.lds, S, E, 512, F.wave);
}
struct EpiPle {
    bf16_t* G; const bf16_t* PP; const float* RS2;
    __device__ __forceinline__ void operator()(const f32x4 (&acc)[2][2][4][2], const pg::Unit& u, int wr, int wc, int fr, int fq, LAS unsigned char* stage, int wid) const {
        float rs[2][4];
#pragma unroll
        for (int ai = 0; ai < 2; ++ai)
#pragma unroll
            for (int m = 0; m < 4; ++m) { const f32x4 q = *(const f32x4*)(RS2 + (size_t)(u.pm * 256 + ai * 128 + wr * 64 + m * 16 + fr) * 4);
                rs[ai][m] = -1.0f / sqrtf(((q[0] + q[1]) + (q[2] + q[3])) * (1.f / 1024.f) + EPS);
                if (m == 3) asm volatile("" : "+v"(rs[ai][0]), "+v"(rs[ai][1]), "+v"(rs[ai][2]), "+v"(rs[ai][3]) :: "memory"); }
#pragma unroll
        for (int ai = 0; ai < 2; ++ai) {
            u32x4 pp[4][2];
#pragma unroll
            for (int m = 0; m < 4; ++m) { const int row = u.pm * 256 + ai * 128 + wr * 64 + m * 16 + fr;
#pragma unroll
                for (int bj = 0; bj < 2; ++bj) pp[m][bj] = __builtin_nontemporal_load((const u32x4*)(PP + (size_t)row * 1024 + u.pn * 256 + bj * 128 + wc * 32 + 8 * fq)); }
#pragma unroll
            for (int m = 0; m < 4; ++m) { const int row = u.pm * 256 + ai * 128 + wr * 64 + m * 16 + fr; const float nr = rs[ai][m];
#pragma unroll
                for (int bj = 0; bj < 2; ++bj) { const size_t off = (size_t)row * 1024 + u.pn * 256 + bj * 128 + wc * 32 + 8 * fq;
                    const u32x4 p4 = pp[m][bj];
                    const f32x4 a0 = acc[ai][bj][m][0] * nr, a1 = acc[ai][bj][m][1] * nr; u32x4 w;
                    w.x = cvt_pk_bf16(bf16lo(p4.x) / (1.0f + __expf(a0[0])), bf16hi(p4.x) / (1.0f + __expf(a0[1])));
                    w.y = cvt_pk_bf16(bf16lo(p4.y) / (1.0f + __expf(a0[2])), bf16hi(p4.y) / (1.0f + __expf(a0[3])));
                    w.z = cvt_pk_bf16(bf16lo(p4.z) / (1.0f + __expf(a1[0])), bf16hi(p4.z) / (1.0f + __expf(a1[1])));
                    w.w = cvt_pk_bf16(bf16lo(p4.w) / (1.0f + __expf(a1[2])), bf16hi(p4.w) / (1.0f + __expf(a1[3])));
                    *(u32x4*)(G + off) = w; } }
            asm volatile("" ::: "memory");
        }
    }
};
__device__ __forceinline__ void p8_ple(const Frame& F, const Args& a) {
    unsigned char* ws = F.ws;
    pg::DenseSched S{(const char*)(ws + WS_H2B), (const char*)(ws + WS_WPG), 1024, 1024, T / 256, 4, F.G, (int)blockIdx.x};
    EpiPle E{(bf16_t*)(ws + WS_D), (const bf16_t*)(ws + WS_PP), (const float*)(ws + WS_SSQ2)};
    pg::gemm_phase(F.lds, S, E, 1024, F.wave);
}
__device__ __forceinline__ void p9_final(const Frame& F, const Args& a) {
    const int lane = lane_id(); float* H = a.out; const float* gf = a.in[22]; const bf16_t* Gm = (const bf16_t*)(F.ws + WS_D); const bf16_t* H2B = (const bf16_t*)(F.ws + WS_H2B);
    const int gw = F.vcu * NWAVES + F.wave, NGW = F.G * NWAVES;
    f32x4 g[4];
#pragma unroll
    for (int j = 0; j < 4; ++j) g[j] = ((const f32x4*)gf)[lane + 64 * j];
    for (int row = gw; row < T; row += NGW) {
        f32x4 v[4]; float s = 0.f;
#pragma unroll
        for (int j = 0; j < 4; ++j) { const u32x2 hh = __builtin_nontemporal_load((const u32x2*)(H2B + (size_t)row * 1024) + lane + 64 * j), gg = __builtin_nontemporal_load((const u32x2*)(Gm + (size_t)row * 1024) + lane + 64 * j);
            v[j].x = bf16lo(hh.x) + bf16lo(gg.x); v[j].y = bf16hi(hh.x) + bf16hi(gg.x); v[j].z = bf16lo(hh.y) + bf16lo(gg.y); v[j].w = bf16hi(hh.y) + bf16hi(gg.y);
            s += (v[j].x * v[j].x + v[j].y * v[j].y) + (v[j].z * v[j].z + v[j].w * v[j].w); }
        const float rstd = 1.0f / sqrtf(wsum64(s) * (1.f / 1024.f) + EPS);
#pragma unroll
        for (int j = 0; j < 4; ++j) __builtin_nontemporal_store(v[j] * rstd * g[j], (f32x4*)(H + (size_t)row * 1024) + lane + 64 * j);
    }
}

__global__ void __launch_bounds__(512, 2) mega(Args args) {
    extern __shared__ __attribute__((aligned(16))) unsigned char lds_raw[];
    Frame F;
    F.lds = (LAS unsigned char*)lds_raw;
    F.wave = __builtin_amdgcn_readfirstlane(threadIdx.x >> 6);
    F.G = gridDim.x; { const int bx = blockIdx.x; F.vcu = (F.G % 8 == 0) ? (bx % 8) * (F.G / 8) + bx / 8 : bx; }
    F.ws = args.ws; F.ctl = (unsigned*)(args.ws + WS_CTL);
    volatile LAS unsigned* MISC = (volatile LAS unsigned*)(F.lds + MISC_OFF);
    for (int u = threadIdx.x; u < (LDS_BYTES - LDSCTL_OFF) / 4; u += NWAVES * 64) ((LAS unsigned*)(F.lds + LDSCTL_OFF))[u] = 0u;
    __syncthreads();
    XcdBarrier bar = xcd_barrier_post(F.ctl + CW_BAR + args.li * XCD_BAR_WORDS, MISC + 8);
    const int lo = args.ph_lo, hi = args.ph_hi;
#define IN(k) (lo <= (k) && (k) < hi)
#define BOTH(k) (IN(k) && IN((k) + 1))
    if (IN(0)) { p0_prologue(F, args); p0_router_table(F, args); if (BOTH(0)) xcd_barrier(bar); }
    if (IN(1)) { p1_inproj(F); if (BOTH(1)) xcd_barrier(bar); }
    if (IN(2)) { p2_upproj(F); if (BOTH(2)) xcd_barrier(bar); }
    if (IN(3)) { p3_mla(F); p3_mixerA(F); if (BOTH(3)) xcd_barrier(bar); }
    if (IN(4)) { p35_mix(F, args); if (BOTH(4)) xcd_barrier(bar); }
    if (IN(5)) { p4_wo(F, args); if (BOTH(5)) xcd_barrier(bar); }
    if (IN(6)) { p5_router(F, args); if (BOTH(6)) xcd_barrier(bar); }
    if (IN(7)) { p6a_moe_up(F); if (BOTH(7)) xcd_barrier(bar); }
    if (IN(8)) { p6b_moe_down(F); if (BOTH(8)) xcd_barrier(bar); }
    if (IN(9)) { p8_ple(F, args); if (BOTH(9)) xcd_barrier(bar); }
    if (IN(10)) { p9_final(F, args); }
#undef IN
#undef BOTH
}
constexpr int NPHASES = 11;

extern "C" void kernel_launch(void* const* d_in, const int* in_sizes, int n_in, void* d_out, int out_size, void* d_ws, size_t ws_size, hipStream_t stream) {
    static int grid = 0;
    if (grid == 0) {
        if (n_in != 23 || ws_size < (size_t)512 * MiB || out_size != T * DM) { fprintf(stderr, "kernel_launch: unexpected n_in %d / ws_size %zu / out_size %d\n", n_in, ws_size, out_size); grid = -1; return; }
        int dev = 0, cus = 0;
        if (hipGetDevice(&dev) != hipSuccess || hipDeviceGetAttribute(&cus, hipDeviceAttributeMultiprocessorCount, dev) != hipSuccess) { grid = -1; return; }
        if (hipFuncSetAttribute((const void*)mega, hipFuncAttributeMaxDynamicSharedMemorySize, LDS_BYTES) != hipSuccess) { fprintf(stderr, "kernel_launch: hipFuncSetAttribute failed\n"); grid = -1; return; }
        int per_cu = 0;
        if (hipOccupancyMaxActiveBlocksPerMultiprocessor(&per_cu, (const void*)mega, NWAVES * 64, LDS_BYTES) != hipSuccess || per_cu < 1) { fprintf(stderr, "kernel_launch: occupancy query says %d\n", per_cu); }
        (void)hipGetLastError();
        grid = cus;
    }
    if (grid < 0) return;
    unsigned char* ws = (unsigned char*)d_ws;
    hipMemsetAsync(ws + WS_CTL, 0, CTL_ZERO_BYTES, stream);
    Args a{};
    for (int i = 0; i < 23; ++i) a.in[i] = (const float*)d_in[i];
    a.out = (float*)d_out; a.ws = ws; a.ph_lo = 0; a.ph_hi = NPHASES; a.li = 0; a.pad = 0;
    hipLaunchKernelGGL(mega, dim3(grid), dim3(NWAVES * 64), LDS_BYTES, stream, a);
}
```

```cpp
#include <hip/hip_runtime.h>
#include <cstdint>
#include <cstdio>
#include <cmath>

#define LAS __attribute__((address_space(3)))
#define GAS __attribute__((address_space(1)))
typedef unsigned short bf16_t;
typedef short bf16x8 __attribute__((ext_vector_type(8)));
typedef short s16x4 __attribute__((ext_vector_type(4)));
typedef float f32x2 __attribute__((ext_vector_type(2)));
typedef float f32x4 __attribute__((ext_vector_type(4)));
typedef float f32x16 __attribute__((ext_vector_type(16)));
typedef unsigned u32x2 __attribute__((ext_vector_type(2)));
typedef unsigned u32x4 __attribute__((ext_vector_type(4)));

__device__ __forceinline__ unsigned cvt_pk_bf16(float lo, float hi) { unsigned r; asm volatile("v_cvt_pk_bf16_f32 %0, %1, %2" : "=v"(r) : "v"(lo), "v"(hi)); return r; }
__device__ __forceinline__ float bf16lo(unsigned w) { return __uint_as_float(w << 16); }
__device__ __forceinline__ float bf16hi(unsigned w) { return __uint_as_float(w & 0xffff0000u); }
__device__ __forceinline__ int lane_id() { int r; asm volatile("v_mbcnt_lo_u32_b32 %0, -1, 0\n\tv_mbcnt_hi_u32_b32 %0, -1, %0" : "=v"(r)); return r; }
__device__ __forceinline__ float wsum64(float v) {
#pragma unroll
    for (int o = 1; o < 64; o <<= 1) v += __shfl_xor(v, o);
    return v;
}

namespace pg {
constexpr int BM = 256, BK = 64, HALF = 128, HTB = HALF * BK * 2, STAGE_BYTES = 8 * HTB, NXCD = 8, WGM = 8;
__host__ __device__ __forceinline__ int lds_byte(int r, int c) { const int st = (r >> 4) * 2 + (c >> 5), rr = r & 15, cc = c & 31, ob = rr * 64 + cc * 2; return st * 1024 + (ob ^ (((ob >> 9) & 1) << 5)); }
__host__ __device__ __forceinline__ void stage_rc(int b, int& R, int& C) { const int st = b / 1024, sb = b % 1024, swz = sb ^ (((sb >> 9) & 1) << 5); R = (st >> 1) * 16 + swz / 64; C = (st & 1) * 32 + (swz % 64) / 2; }
__host__ __device__ __forceinline__ int perm32(int rho) { const int n = rho >> 4, i = rho & 15; return 8 * (i >> 2) + 4 * n + (i & 3); }

struct Unit { int pm, pn, aux; };

__device__ __forceinline__ bool static_unit(int nM, int nN, int G, int c, int i, int& pm, int& pn, int wgm = WGM) {
    const int nwg = nM * nN; const long L = (long)i * G + c; if (L >= nwg) return false;
    int wgid = (int)L; { const int q = nwg / NXCD, r = nwg % NXCD, xcd = wgid % NXCD, off = wgid / NXCD; wgid = (xcd < r ? xcd * (q + 1) : r * (q + 1) + (xcd - r) * q) + off; }
    const int nig = wgm * nN, gid = wgid / nig, fm = gid * wgm, gsz = (nM - fm) < wgm ? (nM - fm) : wgm;
    pm = fm + ((wgid % nig) % gsz); pn = (wgid % nig) / gsz; return true;
}

struct DenseSched {
    static constexpr bool GATHER = false; static constexpr int KSPLIT = 0; static constexpr bool DEPS = false;
    const char* A; const char* Bt; int lda, K, nM, nN, G, c; int wgm = WGM;
    __device__ __forceinline__ bool next(int i, Unit& u) const { u.aux = 0; return static_unit(nM, nN, G, c, i, u.pm, u.pn, wgm); }
    __device__ __forceinline__ int a_ld() const { return lda; }
    __device__ __forceinline__ void addr(const Unit& u, const char*& abase, const char*& bbase) const {
        abase = A + (size_t)u.pm * BM * lda * 2; bbase = Bt + (size_t)u.pn * BM * K * 2; }
    __device__ __forceinline__ void addr_g(const Unit&, const int (&)[2], const int (&)[2], unsigned (&)[2][2], const char*&) const {}
    __device__ __forceinline__ const char* abase() const { return A; }
};

constexpr int EPI_STAGE_OFF = 139264, EPI_ROWB = 528;
template <class StoreFn>
__device__ __forceinline__ void staged_rows(LAS unsigned char* stage, u32x4 w0, u32x4 w1, int ai, int m, int wid, int lane, const StoreFn& store) {
    const int wr = wid >> 2, wc = wid & 3, fr = lane & 15, fq = lane >> 4, rr = 16 * wr + fr;
    *(LAS u32x4*)(stage + rr * EPI_ROWB + (32 * wc + 8 * fq) * 2) = w0;
    *(LAS u32x4*)(stage + rr * EPI_ROWB + (128 + 32 * wc + 8 * fq) * 2) = w1;
    asm volatile("s_waitcnt lgkmcnt(0)\n\ts_barrier" ::: "memory");
#pragma unroll
    for (int i = 0; i < 2; ++i) { const int r2 = 4 * wid + 2 * i + (lane >> 5), ch = lane & 31;
        const u32x4 v = *(const LAS u32x4*)(stage + r2 * EPI_ROWB + ch * 16);
        store(128 * ai + 64 * (r2 >> 4) + 16 * m + (r2 & 15), ch, v); }
    asm volatile("s_waitcnt lgkmcnt(0)\n\ts_barrier" ::: "memory");
}

struct NoPre {};
template <class E, class = void> struct PreOf { typedef NoPre type; static constexpr bool has = false; };
template <class E> struct PreOf<E, decltype((void)sizeof(typename E::Pre))> { typedef typename E::Pre type; static constexpr bool has = true; };
template <class Epi, class Sched>
__device__ __forceinline__ void gemm_phase(LAS unsigned char* lds, const Sched& S, const Epi& E, int K, int wid) {
    const int lane = lane_id(), tid = wid * 64 + lane, wr = wid >> 2, wc = wid & 3, fr = lane & 15, fq = lane >> 4;
    const int nt = K / BK;
    constexpr int KSPLIT = Sched::KSPLIT;
    const int KB = KSPLIT > 0 ? KSPLIT * BK : K;
    int Rr[2], Cc[2]; unsigned voffB[2];
#pragma unroll
    for (int i = 0; i < 2; ++i) { int R, C; stage_rc(tid * 16 + i * 8192, R, C); Rr[i] = R; Cc[i] = C; const int Rb = (R & ~31) + perm32(R & 31); voffB[i] = (unsigned)(Rb * KB + C) * 2u; }
    const size_t kstep = (size_t)(BK * 2);
    const size_t hstepB = (size_t)HALF * KB * 2;
    const unsigned ldsw = (unsigned)wid * 1024u;
    const int aoff = lds_byte(wr * 64 + fr, fq * 8), boff = lds_byte(wc * 32 + fr, fq * 8);
    const char* const Ab = S.abase();
    constexpr bool GATHER = Sched::GATHER;
    unsigned voffA[2];
#pragma unroll
    for (int i = 0; i < 2; ++i) voffA[i] = (unsigned)(Rr[i] * S.a_ld() + Cc[i]) * 2u;
    const size_t hstepA = (size_t)HALF * S.a_ld() * 2;
#define PG_SA(b, h) (((b) * 2 + (h)) * HTB)
#define PG_SB(b, h) ((4 + (b) * 2 + (h)) * HTB)
#define PG_STAGEB(bufoff, gbase) do { _Pragma("unroll") for (int _i = 0; _i < 2; ++_i) \
        __builtin_amdgcn_global_load_lds((const unsigned*)((const char*)(gbase) + voffB[_i]), (LAS unsigned*)(lds + (bufoff) + ldsw + _i * 8192), 16, 0, 0); } while (0)
#define PG_STAGEA(bufoff, uptr, offs, h, kb) do { _Pragma("unroll") for (int _i = 0; _i < 2; ++_i) { \
        const char* _src; if constexpr (GATHER) _src = Ab + (size_t)(offs)[h][_i] + (kb); else _src = (uptr) + (h) * hstepA + (kb) + voffA[_i]; \
        __builtin_amdgcn_global_load_lds((const unsigned*)_src, (LAS unsigned*)(lds + (bufoff) + ldsw + _i * 8192), 16, 0, 0); } } while (0)
#define PG_LDA(dst, b, h) do { _Pragma("unroll") for (int m = 0; m < 4; ++m) _Pragma("unroll") for (int k = 0; k < 2; ++k) dst[m][k] = *(const LAS bf16x8*)(lds + PG_SA(b, h) + aoff + m * 2048 + k * 1024); } while (0)
#define PG_LDB(dst, b, h) do { _Pragma("unroll") for (int n = 0; n < 2; ++n) _Pragma("unroll") for (int k = 0; k < 2; ++k) dst[n][k] = *(const LAS bf16x8*)(lds + PG_SB(b, h) + boff + n * 2048 + k * 1024); } while (0)
#define PG_MMA(ai, bj, At, Bt_) do { __builtin_amdgcn_s_setprio(1); _Pragma("unroll") for (int m = 0; m < 4; ++m) _Pragma("unroll") for (int n = 0; n < 2; ++n) _Pragma("unroll") for (int k = 0; k < 2; ++k) \
        acc[ai][bj][m][n] = __builtin_amdgcn_mfma_f32_16x16x32_bf16(Bt_[n][k], At[m][k], acc[ai][bj][m][n], 0, 0, 0); __builtin_amdgcn_s_setprio(0); } while (0)
#define PG_WAIT_V(n) asm volatile("s_waitcnt vmcnt(" #n ")" ::: "memory")
#define PG_WAIT_L(n) asm volatile("s_waitcnt lgkmcnt(" #n ")" ::: "memory")
#define PG_BAR __builtin_amdgcn_s_barrier()
#define PG_SCHED __builtin_amdgcn_sched_barrier(0)
    Unit cur, nxt; int ui = 0;
    if (!S.next(0, cur)) return;
    if constexpr (Sched::DEPS) S.acquire(cur);
    f32x4 acc[2][2][4][2];
#pragma unroll
    for (int a = 0; a < 2; ++a)
#pragma unroll
        for (int b = 0; b < 2; ++b)
#pragma unroll
            for (int m = 0; m < 4; ++m)
#pragma unroll
                for (int n = 0; n < 2; ++n) acc[a][b][m][n] = (f32x4){0.f, 0.f, 0.f, 0.f};
    bf16x8 At[4][2], B0[2][2], B1[2][2];
    typename PreOf<Epi>::type pre;
    unsigned cao[2][2], nao[2][2]; const char* cA = nullptr; const char* nA = nullptr; const char* cB; const char* nB; const char* cB2 = nullptr; const char* nB2 = nullptr;
    if constexpr (GATHER) S.addr_g(cur, Rr, Cc, cao, cB); else if constexpr (KSPLIT > 0) S.addr(cur, cA, cB, cB2); else S.addr(cur, cA, cB);
    PG_STAGEB(PG_SB(0, 0), cB); PG_STAGEB(PG_SB(0, 1), cB + hstepB); PG_STAGEA(PG_SA(0, 0), cA, cao, 0, 0); PG_STAGEA(PG_SA(0, 1), cA, cao, 1, 0);
    if (wr == 1) PG_BAR;
    PG_WAIT_V(2); PG_BAR;
    PG_STAGEB(PG_SB(1, 0), cB + kstep); PG_STAGEA(PG_SA(1, 0), cA, cao, 0, kstep); PG_STAGEB(PG_SB(1, 1), cB + hstepB + kstep);
    PG_WAIT_V(6); PG_BAR;
    for (;;) {
        const bool has_next = S.next(ui + 1, nxt);
        if constexpr (Sched::DEPS) { if (has_next) S.acquire(nxt); }
        if (has_next) { if constexpr (GATHER) S.addr_g(nxt, Rr, Cc, nao, nB); else if constexpr (KSPLIT > 0) S.addr(nxt, nA, nB, nB2); else S.addr(nxt, nA, nB); }
        else { nB = cB; nA = cA; nB2 = cB2;
            if constexpr (GATHER) {
#pragma unroll
                for (int h = 0; h < 2; ++h)
#pragma unroll
                    for (int i = 0; i < 2; ++i) nao[h][i] = cao[h][i]; } }
#pragma clang loop unroll(disable)
        for (int t = 0; t < nt; t += 2) {
            const bool last = (t == nt - 2);
            if constexpr (PreOf<Epi>::has) { if (t == nt - 6 || (nt < 6 && t == 0)) { const int l3 = lane_id(); E.prefetch(pre, cur, wr, wc, l3 & 15, l3 >> 4); } }
            const size_t k1 = (size_t)(t + 1) * kstep;
            const size_t k2 = last ? 0 : (size_t)(t + 2) * kstep, k3 = k2 + kstep;
            const char* b2;
            if constexpr (KSPLIT > 0) b2 = last ? nB : ((t + 2 >= KSPLIT) ? cB2 + (size_t)(t + 2 - KSPLIT) * kstep : cB + (size_t)(t + 2) * kstep);
            else b2 = last ? nB : cB + (size_t)(t + 2) * kstep;
            const char* b3 = b2 + kstep;
            unsigned a2o[2][2]; const char* a2 = last ? nA : cA;
            if constexpr (GATHER) {
#pragma unroll
                for (int h = 0; h < 2; ++h)
#pragma unroll
                    for (int i = 0; i < 2; ++i) a2o[h][i] = last ? nao[h][i] : cao[h][i]; }
            PG_LDB(B0, 0, 0); PG_LDB(B1, 0, 1); PG_SCHED; PG_LDA(At, 0, 0); PG_STAGEA(PG_SA(1, 1), cA, cao, 1, k1);
            PG_WAIT_V(8); PG_WAIT_L(0); PG_BAR; PG_MMA(0, 0, At, B0); PG_MMA(0, 1, At, B1); PG_BAR; PG_SCHED;
            PG_LDA(At, 0, 1); PG_STAGEB(PG_SB(0, 0), b2); PG_STAGEB(PG_SB(0, 1), b2 + hstepB); PG_STAGEA(PG_SA(0, 0), a2, a2o, 0, k2);
            PG_WAIT_V(8); PG_WAIT_L(0); PG_BAR; PG_MMA(1, 0, At, B0); PG_MMA(1, 1, At, B1); PG_BAR; PG_SCHED;
            PG_LDB(B0, 1, 0); PG_LDB(B1, 1, 1); PG_SCHED; PG_LDA(At, 1, 0); PG_STAGEA(PG_SA(0, 1), a2, a2o, 1, k2);
            PG_WAIT_V(8); PG_WAIT_L(0); PG_BAR; PG_MMA(0, 0, At, B0); PG_MMA(0, 1, At, B1); PG_BAR; PG_SCHED;
            PG_LDA(At, 1, 1); PG_STAGEB(PG_SB(1, 0), b3); PG_STAGEB(PG_SB(1, 1), b3 + hstepB); PG_STAGEA(PG_SA(1, 0), a2, a2o, 0, k3);
            PG_WAIT_V(8); PG_WAIT_L(0); PG_BAR; PG_MMA(1, 0, At, B0); PG_MMA(1, 1, At, B1); PG_BAR; PG_SCHED;
        }
        if (wr == 0) PG_BAR;
        { const int l2 = lane_id();
          if constexpr (PreOf<Epi>::has) E(acc, cur, wr, wc, l2 & 15, l2 >> 4, lds + EPI_STAGE_OFF, wid, pre); else E(acc, cur, wr, wc, l2 & 15, l2 >> 4, lds + EPI_STAGE_OFF, wid); }
        if (!has_next) break;
#pragma unroll
        for (int a = 0; a < 2; ++a)
#pragma unroll
            for (int b = 0; b < 2; ++b)
#pragma unroll
                for (int m = 0; m < 4; ++m)
#pragma unroll
                    for (int n = 0; n < 2; ++n) acc[a][b][m][n] = (f32x4){0.f, 0.f, 0.f, 0.f};
        cur = nxt; cB = nB; cA = nA; cB2 = nB2;
        if constexpr (GATHER) {
#pragma unroll
            for (int h = 0; h < 2; ++h)
#pragma unroll
                for (int i = 0; i < 2; ++i) cao[h][i] = nao[h][i]; }
        ++ui;
        if (wr == 1) PG_BAR;
    }
    PG_WAIT_V(0);
    PG_BAR;
#undef PG_SA
#undef PG_SB
#undef PG_STAGEA
#undef PG_STAGEB
#undef PG_LDA
#undef PG_LDB
#undef PG_MMA
#undef PG_WAIT_V
#undef PG_WAIT_L
#undef PG_BAR
#undef PG_SCHED
}
}

#define XB_TMO      128
#define XB_XCNT(j)  (256  + 64 * (j))
#define XB_XSUB(j)  (1280 + 64 * (j))
#define XB_XGEN(j)  (2304 + 64 * (j))
#define XB_TOP      3328
#define XB_TOPGEN   3392
#define XCD_BAR_WORDS 3456
#define XB_SPIN_CAP (1u << 22)
__device__ __forceinline__ unsigned xb_ld(unsigned* p)              { return __hip_atomic_load(p, __ATOMIC_RELAXED, __HIP_MEMORY_SCOPE_AGENT); }
__device__ __forceinline__ unsigned xb_add(unsigned* p, unsigned v) { return __hip_atomic_fetch_add(p, v, __ATOMIC_RELAXED, __HIP_MEMORY_SCOPE_AGENT); }
__device__ __forceinline__ unsigned xb_xcc_id() { return (unsigned)__builtin_amdgcn_s_getreg((3 << 11) | 20) & 0xFu; }
#define XB_SPIN(cond, bar) do { unsigned _sp = 0; while (cond) { __builtin_amdgcn_s_sleep(1); \
    if ((++_sp & 255u) == 0u) { if (xb_ld(&(bar)[XB_TMO])) break; if (_sp > XB_SPIN_CAP) { atomicAdd(&(bar)[XB_TMO], 1u); break; } } } } while (0)
struct XcdBarrier { unsigned* bar; unsigned x; volatile LAS unsigned* st; };
__device__ __forceinline__ XcdBarrier xcd_barrier_post(unsigned* bar, volatile LAS unsigned* st) {
    XcdBarrier b; b.bar = bar; b.x = xb_xcc_id(); b.st = st;
    if (threadIdx.x == 0) (void)xb_add(&bar[XB_XCNT(b.x)], 1u);
    return b;
}
__device__ __forceinline__ void xcd_barrier_complete(unsigned* bar, unsigned x, unsigned& nloc, unsigned& nx) {
    const unsigned G = gridDim.x * gridDim.y * gridDim.z;
    unsigned sum, cnt, mine, sp = 0u;
    for (;;) {
        sum = 0u; cnt = 0u; mine = 0u;
#pragma unroll
        for (unsigned j = 0; j < 16; ++j) { const unsigned c = xb_ld(&bar[XB_XCNT(j)]); sum += c; cnt += (c > 0u) ? 1u : 0u; mine = (j == x) ? c : mine; }
        if (sum == G) break;
        __builtin_amdgcn_s_sleep(1);
        if ((++sp & 255u) == 0u) { if (xb_ld(&bar[XB_TMO])) break; if (sp > XB_SPIN_CAP) { atomicAdd(&bar[XB_TMO], 1u); break; } }
    }
    nloc = mine > 0u ? mine : 1u; nx = cnt > 0u ? cnt : 1u;
}
__device__ __forceinline__ void xcd_barrier(const XcdBarrier& b) {
    asm volatile("s_waitcnt vmcnt(0)" ::: "memory");
    __syncthreads();
    if (threadIdx.x == 0) {
        unsigned* bar = b.bar;
        __builtin_amdgcn_s_waitcnt(0);
        unsigned nloc = b.st[0], nx = b.st[1];
        if (nloc == 0u) { xcd_barrier_complete(bar, b.x, nloc, nx); b.st[0] = nloc; b.st[1] = nx; }
        const unsigned old = xb_add(&bar[XB_XSUB(b.x)], 1u);
        const unsigned gen = old / nloc;
        if (old + 1u == (gen + 1u) * nloc) {
            __builtin_amdgcn_fence(__ATOMIC_RELEASE, "agent");
            asm volatile("s_waitcnt vmcnt(0)" ::: "memory");
            const unsigned og = xb_add(&bar[XB_TOP], 1u);
            const unsigned tg = og / nx;
            if (og + 1u == (tg + 1u) * nx) xb_add(&bar[XB_TOPGEN], 1u);
            else XB_SPIN(xb_ld(&bar[XB_TOPGEN]) == tg, bar);
            __builtin_amdgcn_fence(__ATOMIC_ACQUIRE, "agent");
            xb_add(&bar[XB_XGEN(b.x)], 1u);
            asm volatile("s_waitcnt vmcnt(0)" ::: "memory");
        } else {
            XB_SPIN(xb_ld(&bar[XB_XGEN(b.x)]) == gen, bar);
            __builtin_amdgcn_fence(__ATOMIC_ACQUIRE, "agent");
            asm volatile("s_waitcnt vmcnt(0)" ::: "memory");
        }
    }
    __syncthreads();
}

constexpr int NB = 8, SEQ = 4096, T = NB * SEQ, DM = 1024;
constexpr int INW = 2208, INWP = 2304;
constexpr int QLORA = 384, KVLORA = 256;
constexpr float EPS = 1e-6f;
constexpr float LOG2E = 1.4426950408889634f;
constexpr float QA_SCALE = 0.125f * LOG2E;
constexpr float MLA_QSCALE = 0.10206207261596577f * LOG2E;
constexpr int NWAVES = 8;

constexpr size_t MiB = 1u << 20;
constexpr size_t WS_CTL = 0, CTL_ZERO_BYTES = 1 * MiB;
constexpr size_t WS_ROPE = 1 * MiB;
constexpr size_t WS_SSQ = 2 * MiB;
constexpr size_t WS_WIN = 5 * MiB, WS_WUQ = 10 * MiB, WS_WUKV = 11 * MiB, WS_WO = 12 * MiB, WS_WPG = 14 * MiB, WS_WPP = 16 * MiB, WS_WGU = 17 * MiB, WS_WD = 49 * MiB;
constexpr size_t WS_XN = 65 * MiB;
constexpr size_t WS_P16 = 305 * MiB;
constexpr size_t WS_PP = 145 * MiB;
constexpr size_t WS_QA = 209 * MiB, WS_KA = 241 * MiB, WS_VA = 273 * MiB;
static_assert(WS_KA - WS_QA == (size_t)T * 512 * 2 && WS_VA - WS_KA == (size_t)T * 512 * 2, "QA|KA|VA contiguous");
constexpr size_t WS_CQKV = 305 * MiB;
constexpr size_t WS_QB = 345 * MiB, WS_KB = 393 * MiB;
constexpr size_t WS_VB = 441 * MiB;
constexpr size_t WS_OB = 473 * MiB;
constexpr size_t WS_OAP0 = 65 * MiB, WS_OAP1 = 97 * MiB, WS_OAP2 = 305 * MiB;
constexpr size_t WS_LSE = 129 * MiB;
constexpr size_t WS_MIXED = 209 * MiB;
constexpr size_t WS_M = 65 * MiB;
constexpr size_t WS_Y = 209 * MiB;
constexpr size_t WS_HID = 353 * MiB;
constexpr size_t WS_LIST = 132 * MiB;
constexpr size_t WS_RS2 = 136 * MiB + 896 * 1024;
constexpr size_t WS_TOKINFO = 136 * MiB;
constexpr int CW_BAR = 4096, CW_CNT = 16384, CW_Q = 20480;

constexpr int RING_BYTES = 131072;
constexpr int LDSCTL_OFF = RING_BYTES, MISC_OFF = LDSCTL_OFF + 320;
constexpr int LDS_BYTES = 163840;

struct Args { const float* in[23]; float* out; unsigned char* ws; int ph_lo, ph_hi, li, pad; };
struct Frame {
    LAS unsigned char* lds;
    int wave, vcu, G;
    unsigned char* ws; unsigned* ctl;
};

__device__ __forceinline__ void p0_transpose_item(const float* __restrict__ W, int ldw, int k0, int n0, bf16_t* WT, int ldd, int drow0, const float* __restrict__ gain, LAS float* scr, int lane) {
    const int kq = lane >> 3, n4 = (lane & 7) * 4;
    f32x4 v[8];
#pragma unroll
    for (int i = 0; i < 8; ++i) v[i] = __builtin_nontemporal_load((const f32x4*)(W + (size_t)(k0 + kq + 8 * i) * ldw + n0 + n4));
#pragma unroll
    for (int i = 0; i < 8; ++i) { const int kk = kq + 8 * i; f32x4 x = v[i]; if (gain) x = x * gain[k0 + kk];
        scr[kk * 33 + n4] = x[0]; scr[kk * 33 + n4 + 1] = x[1]; scr[kk * 33 + n4 + 2] = x[2]; scr[kk * 33 + n4 + 3] = x[3]; }
    asm volatile("s_waitcnt lgkmcnt(0)" ::: "memory");
    const int c = lane & 7;
#pragma unroll
    for (int j = 0; j < 4; ++j) { const int n = (lane >> 3) + 8 * j; const LAS float* s = scr + (8 * c) * 33 + n;
        u32x4 o; o.x = cvt_pk_bf16(s[0 * 33], s[1 * 33]); o.y = cvt_pk_bf16(s[2 * 33], s[3 * 33]); o.z = cvt_pk_bf16(s[4 * 33], s[5 * 33]); o.w = cvt_pk_bf16(s[6 * 33], s[7 * 33]);
        *(u32x4*)(WT + (size_t)(drow0 + n) * ldd + k0 + 8 * c) = o; }
    asm volatile("s_waitcnt lgkmcnt(0)" ::: "memory");
}
__device__ __forceinline__ void rms_row_to_bf16(const float* xrow, const float* __restrict__ g, bf16_t* orow, int lane) {
    const f32x4* xr = (const f32x4*)xrow + lane; const f32x4* gr = (const f32x4*)g + lane;
    f32x4 v[4]; float s = 0.f;
#pragma unroll
    for (int j = 0; j < 4; ++j) { v[j] = xr[64 * j]; s += (v[j].x * v[j].x + v[j].y * v[j].y) + (v[j].z * v[j].z + v[j].w * v[j].w); }
    const float rstd = 1.0f / sqrtf(wsum64(s) * (1.f / 1024.f) + EPS);
    u32x2* o8 = (u32x2*)orow + lane;
#pragma unroll
    for (int j = 0; j < 4; ++j) { const f32x4 gg = gr[64 * j]; u32x2 w; w.x = cvt_pk_bf16(v[j].x * rstd * gg.x, v[j].y * rstd * gg.y); w.y = cvt_pk_bf16(v[j].z * rstd * gg.z, v[j].w * rstd * gg.w); o8[64 * j] = w; }
}

__device__ __forceinline__ void p0_prologue(const Frame& F, const Args& a) {
    LAS float* scr = (LAS float*)(F.lds + F.wave * 16384);
    const int gw = F.vcu * NWAVES + F.wave, NGW = F.G * NWAVES, lane = lane_id();
    unsigned char* ws = F.ws;
    const float* w_in = a.in[3]; const float* g_cq = a.in[4]; const float* w_uq = a.in[5]; const float* g_ckv = a.in[6]; const float* w_ukv = a.in[7];
    const float* w_o = a.in[10]; const float* w_eg = a.in[16]; const float* w_eu = a.in[17]; const float* w_ed = a.in[18]; const float* w_pg = a.in[20]; const float* w_pp = a.in[21];
    constexpr int I_IN = 16 * 69, I_UQ = 6 * 24, I_UKV = 4 * 32, I_O = 16 * 32, I_PG = 16 * 32, I_PP = 4 * 32, I_EG = 32 * 16 * 8, I_EU = I_EG, I_ED = 32 * 4 * 32;
    constexpr int NITEMS = I_IN + I_UQ + I_UKV + I_O + I_PG + I_PP + I_EG + I_EU + I_ED;
    for (int it = gw; it < NITEMS; it += NGW) {
        int r = it;
        if (r < I_IN) { const int kb = r / 69, nb = r % 69; p0_transpose_item(w_in, INW, 64 * kb, 32 * nb, (bf16_t*)(ws + WS_WIN), 1024, 32 * nb, nullptr, scr, lane); continue; } r -= I_IN;
        if (r < I_UQ) { const int kb = r / 24, nb = r % 24; p0_transpose_item(w_uq, 768, 64 * kb, 32 * nb, (bf16_t*)(ws + WS_WUQ), QLORA, 32 * nb, g_cq, scr, lane); continue; } r -= I_UQ;
        if (r < I_UKV) { const int kb = r / 32, nb = r % 32; p0_transpose_item(w_ukv, 1024, 64 * kb, 32 * nb, (bf16_t*)(ws + WS_WUKV), KVLORA, 32 * nb, g_ckv, scr, lane); continue; } r -= I_UKV;
        if (r < I_O) { const int kb = r / 32, nb = r % 32; p0_transpose_item(w_o, 1024, 64 * kb, 32 * nb, (bf16_t*)(ws + WS_WO), 1024, 32 * nb, nullptr, scr, lane); continue; } r -= I_O;
        if (r < I_PG) { const int kb = r / 32, nb = r % 32; p0_transpose_item(w_pg, 1024, 64 * kb, 32 * nb, (bf16_t*)(ws + WS_WPG), 1024, 32 * nb, a.in[19], scr, lane); continue; } r -= I_PG;
        if (r < I_PP) { const int kb = r / 32, nb = r % 32; p0_transpose_item(w_pp, 1024, 64 * kb, 32 * nb, (bf16_t*)(ws + WS_WPP), 256, 32 * nb, nullptr, scr, lane); continue; } r -= I_PP;
        if (r < I_EG + I_EU) {
            const int up = r >= I_EG; if (up) r -= I_EG;
            const int e = r / 128, q = r % 128, kb = q / 8, nb = q % 8, n0 = 32 * nb;
            const int drow = (n0 >> 7) * 256 + (up ? 128 : 0) + (n0 & 127);
            p0_transpose_item((up ? w_eu : w_eg) + (size_t)e * 1024 * 256, 256, 64 * kb, n0, (bf16_t*)(ws + WS_WGU) + (size_t)e * 512 * 1024, 1024, drow, a.in[11], scr, lane); continue; }
        r -= I_EG + I_EU;
        { const int e = r / 128, q = r % 128, kb = q / 32, nb = q % 32;
          p0_transpose_item(w_ed + (size_t)e * 256 * 1024, 1024, 64 * kb, 32 * nb, (bf16_t*)(ws + WS_WD) + (size_t)e * 1024 * 256, 256, 32 * nb, nullptr, scr, lane); }
    }
    for (int i = gw * 64 + lane; i < 96 * 128; i += NGW * 64) ((u32x4*)((bf16_t*)(ws + WS_WIN) + (size_t)INW * 1024))[i] = (u32x4){0u, 0u, 0u, 0u};
    { const float* x = a.in[0]; const float* g_mix = a.in[2]; bf16_t* XN = (bf16_t*)(ws + WS_XN);
      f32x4 gg[4];
#pragma unroll
      for (int j = 0; j < 4; ++j) gg[j] = ((const f32x4*)g_mix)[lane + 64 * j];
      for (int m = gw * 2; m < T; m += NGW * 2) {
          f32x4 v0[4], v1[4]; float s0 = 0.f, s1 = 0.f;
#pragma unroll
          for (int j = 0; j < 4; ++j) { v0[j] = __builtin_nontemporal_load((const f32x4*)(x + (size_t)m * DM) + lane + 64 * j); v1[j] = __builtin_nontemporal_load((const f32x4*)(x + (size_t)(m + 1) * DM) + lane + 64 * j); }
#pragma unroll
          for (int j = 0; j < 4; ++j) { s0 += (v0[j].x * v0[j].x + v0[j].y * v0[j].y) + (v0[j].z * v0[j].z + v0[j].w * v0[j].w); s1 += (v1[j].x * v1[j].x + v1[j].y * v1[j].y) + (v1[j].z * v1[j].z + v1[j].w * v1[j].w); }
          const float r0 = 1.0f / sqrtf(wsum64(s0) * (1.f / 1024.f) + EPS), r1 = 1.0f / sqrtf(wsum64(s1) * (1.f / 1024.f) + EPS);
#pragma unroll
          for (int j = 0; j < 4; ++j) { u32x2 w0, w1;
              w0.x = cvt_pk_bf16(v0[j].x * r0 * gg[j].x, v0[j].y * r0 * gg[j].y); w0.y = cvt_pk_bf16(v0[j].z * r0 * gg[j].z, v0[j].w * r0 * gg[j].w);
              w1.x = cvt_pk_bf16(v1[j].x * r1 * gg[j].x, v1[j].y * r1 * gg[j].y); w1.y = cvt_pk_bf16(v1[j].z * r1 * gg[j].z, v1[j].w * r1 * gg[j].w);
              ((u32x2*)(XN + (size_t)m * DM))[lane + 64 * j] = w0; ((u32x2*)(XN + (size_t)(m + 1) * DM))[lane + 64 * j] = w1; } } }
    { float* cs = (float*)(ws + WS_ROPE); float* sn = cs + SEQ * 16;
      for (int idx = gw * 64 + lane; idx < SEQ * 16; idx += NGW * 64) {
          const int pos = idx >> 4, i = idx & 15;
          const float inv = 1.0f / powf(10000.0f, (float)(2 * i) / 32.0f);
          const float ang = (float)pos * inv;
          cs[idx] = (float)cos((double)ang); sn[idx] = (float)sin((double)ang); } }
}

struct EpiInProj {
    bf16_t *QA, *CQKV, *KB; float* SSQ; const float* CS; const float* SN;
    __device__ __forceinline__ void operator()(const f32x4 (&acc)[2][2][4][2], const pg::Unit& u, int wr, int wc, int fr, int fq, LAS unsigned char* stage, int wid) const {
        const int pn = u.pn;
        if (pn < 6) {
            bf16_t* const tile = QA + (size_t)(pn >> 1) * ((size_t)T * 512) + (size_t)u.pm * 256 * 512 + (pn & 1) * 256; const float sc = (pn < 2) ? QA_SCALE : 1.f;
            const int lane = fr + 16 * fq;
#pragma unroll
            for (int ai = 0; ai < 2; ++ai)
#pragma unroll
                for (int m = 0; m < 4; ++m) { u32x4 w[2];
#pragma unroll
                    for (int bj = 0; bj < 2; ++bj) { const f32x4 v0 = acc[ai][bj][m][0] * sc, v1 = acc[ai][bj][m][1] * sc;
                        w[bj].x = cvt_pk_bf16(v0[0], v0[1]); w[bj].y = cvt_pk_bf16(v0[2], v0[3]); w[bj].z = cvt_pk_bf16(v1[0], v1[1]); w[bj].w = cvt_pk_bf16(v1[2], v1[3]); }
                    pg::staged_rows(stage, w[0], w[1], ai, m, wid, lane, [tile](int trow, int ch, u32x4 v) { __builtin_nontemporal_store(v, (u32x4*)(tile + (size_t)trow * 512 + ch * 8)); }); }
        } else {
#pragma unroll
            for (int ai = 0; ai < 2; ++ai)
#pragma unroll
                for (int m = 0; m < 4; ++m) { const int row = u.pm * 256 + ai * 128 + wr * 64 + m * 16 + fr;
#pragma unroll
                    for (int bj = 0; bj < 2; ++bj) {
                        const f32x4 v0 = acc[ai][bj][m][0], v1 = acc[ai][bj][m][1];
                        if (pn < 8 || bj == 0) {
                            const int col = (pn - 6) * 256 + bj * 128 + wc * 32 + 8 * fq; u32x4 w;
                            w.x = cvt_pk_bf16(v0[0], v0[1]); w.y = cvt_pk_bf16(v0[2], v0[3]); w.z = cvt_pk_bf16(v1[0], v1[1]); w.w = cvt_pk_bf16(v1[2], v1[3]);
                            *(u32x4*)(CQKV + (size_t)row * 640 + col) = w;
                            float s = (v0[0] * v0[0] + v0[1] * v0[1]) + (v0[2] * v0[2] + v0[3] * v0[3]) + (v1[0] * v1[0] + v1[1] * v1[1]) + (v1[2] * v1[2] + v1[3] * v1[3]);
                            s += __shfl_xor(s, 16); s += __shfl_xor(s, 32);
                            if (fq == 0) SSQ[(size_t)row * 20 + (pn - 6) * 8 + bj * 4 + wc] = s;
                        } else if (wc == 0) {
                            const int pos = row & (SEQ - 1); const int ci = pos * 16 + 8 * (fq & 1);
                            const f32x4 c0 = *(const f32x4*)(CS + ci), c1 = *(const f32x4*)(CS + ci + 4), s0 = *(const f32x4*)(SN + ci), s1 = *(const f32x4*)(SN + ci + 4);
                            f32x4 p0, p1;
#pragma unroll
                            for (int j = 0; j < 4; ++j) { p0[j] = __shfl_xor(v0[j], 32); p1[j] = __shfl_xor(v1[j], 32); }
                            f32x4 o0, o1;
                            if (fq < 2) { o0 = v0 * c0 - p0 * s0; o1 = v1 * c1 - p1 * s1; }
                            else        { o0 = p0 * s0 + v0 * c0; o1 = p1 * s1 + v1 * c1; }
                            u32x4 w; w.x = cvt_pk_bf16(o0[0], o0[1]); w.y = cvt_pk_bf16(o0[2], o0[3]); w.z = cvt_pk_bf16(o1[0], o1[1]); w.w = cvt_pk_bf16(o1[2], o1[3]);
#pragma unroll
                            for (int h = 0; h < 8; ++h) *(u32x4*)(KB + (size_t)row * 768 + h * 96 + 64 + 8 * fq) = w;
                        }
                    } }
        }
    }
};
struct EpiStoreBf16 {
    bf16_t* O; int ldc;
    __device__ __forceinline__ void operator()(const f32x4 (&acc)[2][2][4][2], const pg::Unit& u, int wr, int wc, int fr, int fq, LAS unsigned char* stage, int wid) const {
        const int lane = fr + 16 * fq; bf16_t* const tile = O + (size_t)u.pm * 256 * ldc + u.pn * 256; const int ld = ldc;
#pragma unroll
        for (int ai = 0; ai < 2; ++ai)
#pragma unroll
            for (int m = 0; m < 4; ++m) { u32x4 w[2];
#pragma unroll
                for (int bj = 0; bj < 2; ++bj) { const f32x4 v0 = acc[ai][bj][m][0], v1 = acc[ai][bj][m][1];
                    w[bj].x = cvt_pk_bf16(v0[0], v0[1]); w[bj].y = cvt_pk_bf16(v0[2], v0[3]); w[bj].z = cvt_pk_bf16(v1[0], v1[1]); w[bj].w = cvt_pk_bf16(v1[2], v1[3]); }
                pg::staged_rows(stage, w[0], w[1], ai, m, wid, lane, [tile, ld](int trow, int ch, u32x4 v) { __builtin_nontemporal_store(v, (u32x4*)(tile + (size_t)trow * ld + ch * 8)); }); }
    }
};
struct EpiQUp {
    bf16_t* QB; const float* SSQ; const float* CS; const float* SN;
    __device__ __forceinline__ void operator()(const f32x4 (&acc)[2][2][4][2], const pg::Unit& u, int wr, int wc, int fr, int fq, LAS unsigned char* stage, int wid) const {
        float rstd[2][4];
#pragma unroll
        for (int ai = 0; ai < 2; ++ai)
#pragma unroll
            for (int m = 0; m < 4; ++m) { const int row = u.pm * 256 + ai * 128 + wr * 64 + m * 16 + fr;
                const f32x4 q0 = *(const f32x4*)(SSQ + (size_t)row * 20), q1 = *(const f32x4*)(SSQ + (size_t)row * 20 + 4), q2 = *(const f32x4*)(SSQ + (size_t)row * 20 + 8);
                const float ss = ((q0[0] + q0[1]) + (q0[2] + q0[3])) + ((q1[0] + q1[1]) + (q1[2] + q1[3])) + ((q2[0] + q2[1]) + (q2[2] + q2[3]));
                rstd[ai][m] = 1.0f / sqrtf(ss * (1.f / 384.f) + EPS);
                if (m == 3) asm volatile("" : "+v"(rstd[ai][0]), "+v"(rstd[ai][1]), "+v"(rstd[ai][2]), "+v"(rstd[ai][3]) :: "memory"); }
        const int G0 = u.pn * 8 + wc;
        const int rbj = (G0 % 3 == 2) ? 0 : (((G0 + 4) % 3 == 2) ? 1 : -1);
#pragma unroll
        for (int ai = 0; ai < 2; ++ai)
#pragma unroll
          for (int mh = 0; mh < 2; ++mh) {
            f32x4 c0[2], c1[2], s0[2], s1[2];
#pragma unroll
            for (int m = 0; m < 2; ++m) { c0[m] = f32x4{0.f, 0.f, 0.f, 0.f}; c1[m] = c0[m]; s0[m] = c0[m]; s1[m] = c0[m]; }
            if (rbj >= 0) {
#pragma unroll
                for (int m = 0; m < 2; ++m) { const int row = u.pm * 256 + ai * 128 + wr * 64 + (2 * mh + m) * 16 + fr;
                    const int pos = row & (SEQ - 1); const int ci = pos * 16 + 8 * (fq & 1);
                    c0[m] = *(const f32x4*)(CS + ci); c1[m] = *(const f32x4*)(CS + ci + 4); s0[m] = *(const f32x4*)(SN + ci); s1[m] = *(const f32x4*)(SN + ci + 4); }
            }
#pragma unroll
            for (int mm = 0; mm < 2; ++mm) { const int m = 2 * mh + mm; const int row = u.pm * 256 + ai * 128 + wr * 64 + m * 16 + fr;
#pragma unroll
                for (int bj = 0; bj < 2; ++bj) { const int G = G0 + bj * 4;
                    f32x4 v0 = acc[ai][bj][m][0] * rstd[ai][m], v1 = acc[ai][bj][m][1] * rstd[ai][m];
                    if (bj == rbj) {
                        f32x4 p0, p1;
#pragma unroll
                        for (int j = 0; j < 4; ++j) { p0[j] = __shfl_xor(v0[j], 32); p1[j] = __shfl_xor(v1[j], 32); }
                        if (fq < 2) { v0 = v0 * c0[mm] - p0 * s0[mm]; v1 = v1 * c1[mm] - p1 * s1[mm]; }
                        else        { v0 = p0 * s0[mm] + v0 * c0[mm]; v1 = p1 * s1[mm] + v1 * c1[mm]; }
                    }
                    v0 = v0 * MLA_QSCALE; v1 = v1 * MLA_QSCALE;
                    u32x4 w; w.x = cvt_pk_bf16(v0[0], v0[1]); w.y = cvt_pk_bf16(v0[2], v0[3]); w.z = cvt_pk_bf16(v1[0], v1[1]); w.w = cvt_pk_bf16(v1[2], v1[3]);
                    *(u32x4*)(QB + (size_t)row * 768 + G * 32 + 8 * fq) = w; } }
          }
    }
};
struct EpiKVUp {
    bf16_t *KB, *VB; const float* SSQ;
    __device__ __forceinline__ void operator()(const f32x4 (&acc)[2][2][4][2], const pg::Unit& u, int wr, int wc, int fr, int fq, LAS unsigned char* stage, int wid) const {
        float rstd[2][4];
#pragma unroll
        for (int ai = 0; ai < 2; ++ai)
#pragma unroll
            for (int m = 0; m < 4; ++m) { const int row = u.pm * 256 + ai * 128 + wr * 64 + m * 16 + fr;
                const f32x4 q0 = *(const f32x4*)(SSQ + (size_t)row * 20 + 12), q1 = *(const f32x4*)(SSQ + (size_t)row * 20 + 16);
                const float ss = ((q0[0] + q0[1]) + (q0[2] + q0[3])) + ((q1[0] + q1[1]) + (q1[2] + q1[3]));
                rstd[ai][m] = 1.0f / sqrtf(ss * (1.f / 256.f) + EPS);
                if (m == 3) asm volatile("" : "+v"(rstd[ai][0]), "+v"(rstd[ai][1]), "+v"(rstd[ai][2]), "+v"(rstd[ai][3]) :: "memory"); }
#pragma unroll
        for (int ai = 0; ai < 2; ++ai)
#pragma unroll
            for (int m = 0; m < 4; ++m) { const int row = u.pm * 256 + ai * 128 + wr * 64 + m * 16 + fr;
#pragma unroll
                for (int bj = 0; bj < 2; ++bj) { const int G = u.pn * 8 + bj * 4 + wc;
                    const int h = G >> 2, part = G & 3;
                    const f32x4 v0 = acc[ai][bj][m][0] * rstd[ai][m], v1 = acc[ai][bj][m][1] * rstd[ai][m];
                    u32x4 w; w.x = cvt_pk_bf16(v0[0], v0[1]); w.y = cvt_pk_bf16(v0[2], v0[3]); w.z = cvt_pk_bf16(v1[0], v1[1]); w.w = cvt_pk_bf16(v1[2], v1[3]);
                    if (part < 2) *(u32x4*)(KB + (size_t)row * 768 + h * 96 + part * 32 + 8 * fq) = w;
                    else          *(u32x4*)(VB + (size_t)row * 512 + h * 64 + (part - 2) * 32 + 8 * fq) = w; } }
    }
};

struct PPSched {
    static constexpr bool GATHER = false; static constexpr int KSPLIT = 0; static constexpr bool DEPS = false;
    const char* A; const char* Bt; int q, nP;
    __device__ __forceinline__ bool next(int i, pg::Unit& u) const { if (q < 0) return false; const int L = i * nP + q; if (L >= 512) return false; u.aux = 0; u.pm = L >> 2; u.pn = L & 3; return true; }
    __device__ __forceinline__ int a_ld() const { return 256; }
    __device__ __forceinline__ void addr(const pg::Unit& u, const char*& abase, const char*& bbase) const { abase = A + (size_t)u.pm * pg::BM * 256 * 2; bbase = Bt + (size_t)u.pn * pg::BM * 256 * 2; }
    __device__ __forceinline__ void addr_g(const pg::Unit&, const int (&)[2], const int (&)[2], unsigned (&)[2][2], const char*&) const {}
    __device__ __forceinline__ const char* abase() const { return A; }
};
__device__ __forceinline__ void pp_units(const Frame& F, int q, int nP) {
    unsigned char* ws = F.ws;
    PPSched S{(const char*)(ws + WS_P16), (const char*)(ws + WS_WPP), q, nP};
    EpiStoreBf16 E{(bf16_t*)(ws + WS_PP), 1024};
    pg::gemm_phase(F.lds, S, E, 256, F.wave);
}
__device__ __forceinline__ void p1_inproj(const Frame& F) {
    unsigned char* ws = F.ws;
    { pg::DenseSched S{(const char*)(ws + WS_XN), (const char*)(ws + WS_WIN), 1024, 1024, T / 256, INWP / 256, F.G, (int)blockIdx.x, 4};
      EpiInProj E{(bf16_t*)(ws + WS_QA), (bf16_t*)(ws + WS_CQKV), (bf16_t*)(ws + WS_KB), (float*)(ws + WS_SSQ), (const float*)(ws + WS_ROPE), (const float*)(ws + WS_ROPE) + SEQ * 16};
      pg::gemm_phase(F.lds, S, E, 1024, F.wave); }
}
__device__ __forceinline__ void p2_upproj(const Frame& F) {
    unsigned char* ws = F.ws;
    { pg::DenseSched S{(const char*)(ws + WS_CQKV), (const char*)(ws + WS_WUQ), 640, QLORA, T / 256, 3, F.G, (int)blockIdx.x};
      EpiQUp E{(bf16_t*)(ws + WS_QB), (const float*)(ws + WS_SSQ), (const float*)(ws + WS_ROPE), (const float*)(ws + WS_ROPE) + SEQ * 16};
      pg::gemm_phase(F.lds, S, E, QLORA, F.wave); }
    { pg::DenseSched S{(const char*)(ws + WS_CQKV) + 384 * 2, (const char*)(ws + WS_WUKV), 640, KVLORA, T / 256, 4, F.G, (int)blockIdx.x};
      EpiKVUp E{(bf16_t*)(ws + WS_KB), (bf16_t*)(ws + WS_VB), (const float*)(ws + WS_SSQ)};
      pg::gemm_phase(F.lds, S, E, KVLORA, F.wave); }
}

namespace mla {
constexpr int QBLK = 32, KVBLK = 64, LDQ = 768, LDKk = 768, LDV = 512, LDO = 512;
constexpr float SCALE = 0.10206207261596577f;
constexpr int SHM_V = KVBLK * 64 * 2  , SHM_K = KVBLK * 256  ;
#define KSWZ(row, colB) ((row) * 256 + ((colB) ^ (((row) & 15) << 4)))
#define SBAR() __builtin_amdgcn_sched_barrier(0)
__device__ __forceinline__ int crow(int r, int hi) { return (r & 3) + 8 * (r >> 2) + 4 * hi; }

__device__ __forceinline__ int v_rd_base(int lane) { return ((lane & 3) << 3) | (((lane >> 2) & 3) << 6) | (((lane >> 4) & 1) << 5) | (((lane >> 5) & 1) << 8); }
constexpr int v_rd_off(int d0, int ks, int half) { return d0 * 512 + ks * 2048 + half * 1024; }
#define MLA_EXP2(x) __builtin_amdgcn_exp2f(x)
constexpr float THR2 = 8.f;
#define MX3(a, b, c) __builtin_fmaxf(__builtin_fmaxf((a), (b)), (c))
__device__ __forceinline__ void soft4(f32x16& p0, f32x16& p1, float& m_reg, float& l_reg, f32x16& negm, f32x16* o, float* al_l, bool first, bf16x8& pa0, bf16x8& pa1, bf16x8& pa2, bf16x8& pa3, int r32, int hi) {
  float ma = MX3(p0[0], p0[1], p0[2]), mb = MX3(p0[3], p0[4], p0[5]), mc = MX3(p0[6], p0[7], p0[8]), md = MX3(p0[9], p0[10], p0[11]);
  ma = MX3(ma, p0[12], p0[13]); mb = MX3(mb, p0[14], p0[15]); mc = MX3(mc, p1[0], p1[1]); md = MX3(md, p1[2], p1[3]);
  ma = MX3(ma, p1[4], p1[5]); mb = MX3(mb, p1[6], p1[7]); mc = MX3(mc, p1[8], p1[9]); md = MX3(md, p1[10], p1[11]);
  ma = MX3(ma, p1[12], p1[13]); mb = MX3(mb, p1[14], p1[15]);
  float pmax = __builtin_fmaxf(MX3(ma, mb, mc), md);
  { auto rr = __builtin_amdgcn_permlane32_swap(__float_as_uint(pmax), __float_as_uint(pmax), false, false);
    pmax = fmaxf(__uint_as_float(rr[0]), __uint_as_float(rr[1])); }
  if (__builtin_expect(first || !__all(pmax <= THR2), 0)) {
    const float dl = first ? pmax : fmaxf(pmax, 0.f);
    m_reg += dl;
#pragma unroll
    for (int r = 0; r < 16; ++r) { p0[r] -= dl; p1[r] -= dl; negm[r] = -m_reg; }
    if (!first) { const float alpha = __builtin_amdgcn_exp2f(-dl); l_reg *= alpha;
      if (hi == 0) al_l[r32] = alpha; asm volatile("s_waitcnt lgkmcnt(0)" ::: "memory");
#pragma unroll
      for (int r = 0; r < 16; ++r) { const float a = al_l[crow(r, hi)]; o[0][r] *= a; o[1][r] *= a; } }
  }
  asm volatile("" : "+v"(negm));
#pragma unroll
  for (int r = 0; r < 16; ++r) { p0[r] = MLA_EXP2(p0[r]); p1[r] = MLA_EXP2(p1[r]); }
  float s0 = p0[0] + p1[0], s1 = p0[1] + p1[1], s2 = p0[2] + p1[2], s3 = p0[3] + p1[3];
#pragma unroll
  for (int r = 4; r < 16; r += 4) { s0 += p0[r] + p1[r]; s1 += p0[r + 1] + p1[r + 1]; s2 += p0[r + 2] + p1[r + 2]; s3 += p0[r + 3] + p1[r + 3]; }
  l_reg += (s0 + s1) + (s2 + s3);
#define PK8(P, BASE, OUT) do { u32x4 w = {cvt_pk_bf16(P[BASE + 0], P[BASE + 1]), cvt_pk_bf16(P[BASE + 2], P[BASE + 3]), cvt_pk_bf16(P[BASE + 4], P[BASE + 5]), cvt_pk_bf16(P[BASE + 6], P[BASE + 7])}; \
    OUT = __builtin_bit_cast(bf16x8, w); } while (0)
  PK8(p0, 0, pa0); PK8(p0, 8, pa1); PK8(p1, 0, pa2); PK8(p1, 8, pa3);
#undef PK8
}
#undef MX3
typedef short v4i16_t __attribute__((ext_vector_type(4)));
typedef __attribute__((address_space(3))) const char* lds_cptr;
__device__ __forceinline__ s16x4 vtr(lds_cptr p) { return __builtin_bit_cast(s16x4, __builtin_amdgcn_ds_read_tr16_b64_v4i16((__attribute__((address_space(3))) v4i16_t*)p)); }
#define VFRAG(L, H) (bf16x8){L[0], L[1], L[2], L[3], H[0], H[1], H[2], H[3]}
__device__ __forceinline__ void mprefetch(bf16x8 (&fk)[12], lds_cptr Ks, int r32, int hi) {
#define KOFF(row, d0) KSWZ(row, ((d0) * 16 + hi * 8) * 2)
#pragma unroll
  for (int d0 = 0; d0 < 6; ++d0) { fk[2 * d0] = *(const __attribute__((address_space(3))) bf16x8*)(Ks + KOFF(r32, d0)); fk[2 * d0 + 1] = *(const __attribute__((address_space(3))) bf16x8*)(Ks + KOFF(32 + r32, d0)); }
#undef KOFF
}
template <bool HAS_PV>
__device__ __forceinline__ void mstage5(f32x16* o, f32x16& p0, f32x16& p1, bf16x8 (&fk)[12], lds_cptr vp, lds_cptr Ks, const bf16x8* qr, const f32x16& negm,
                                        bf16x8 pa0, bf16x8 pa1, bf16x8 pa2, bf16x8 pa3, int r32, int hi) {
  s16x4 vl[8], vh[8];
  if (HAS_PV) {
#pragma unroll
    for (int d0 = 0; d0 < 2; ++d0)
#pragma unroll
      for (int ks = 0; ks < 4; ++ks) { vl[d0 * 4 + ks] = vtr(vp + v_rd_off(d0, ks, 0)); vh[d0 * 4 + ks] = vtr(vp + v_rd_off(d0, ks, 1)); }
    SBAR(); }
  p0 = __builtin_amdgcn_mfma_f32_32x32x16_bf16(fk[0], qr[0], negm, 0, 0, 0); p1 = __builtin_amdgcn_mfma_f32_32x32x16_bf16(fk[1], qr[0], negm, 0, 0, 0);
#pragma unroll
  for (int d0 = 1; d0 < 6; ++d0) { p0 = __builtin_amdgcn_mfma_f32_32x32x16_bf16(fk[2 * d0], qr[d0], p0, 0, 0, 0); p1 = __builtin_amdgcn_mfma_f32_32x32x16_bf16(fk[2 * d0 + 1], qr[d0], p1, 0, 0, 0); }
  if (HAS_PV) {
    SBAR();
#pragma unroll
    for (int d0 = 0; d0 < 2; ++d0) {
      o[d0] = __builtin_amdgcn_mfma_f32_32x32x16_bf16(pa0, VFRAG(vl[d0 * 4 + 0], vh[d0 * 4 + 0]), o[d0], 0, 0, 0); o[d0] = __builtin_amdgcn_mfma_f32_32x32x16_bf16(pa1, VFRAG(vl[d0 * 4 + 1], vh[d0 * 4 + 1]), o[d0], 0, 0, 0);
      o[d0] = __builtin_amdgcn_mfma_f32_32x32x16_bf16(pa2, VFRAG(vl[d0 * 4 + 2], vh[d0 * 4 + 2]), o[d0], 0, 0, 0); o[d0] = __builtin_amdgcn_mfma_f32_32x32x16_bf16(pa3, VFRAG(vl[d0 * 4 + 3], vh[d0 * 4 + 3]), o[d0], 0, 0, 0); }
  }
}
__device__ __forceinline__ void pvlast4(f32x16* o, lds_cptr vp, bf16x8 pa0, bf16x8 pa1, bf16x8 pa2, bf16x8 pa3) {
  s16x4 vl[8], vh[8];
#pragma unroll
  for (int d0 = 0; d0 < 2; ++d0)
#pragma unroll
    for (int ks = 0; ks < 4; ++ks) { vl[d0 * 4 + ks] = vtr(vp + v_rd_off(d0, ks, 0)); vh[d0 * 4 + ks] = vtr(vp + v_rd_off(d0, ks, 1)); }
#pragma unroll
  for (int d0 = 0; d0 < 2; ++d0) {
    o[d0] = __builtin_amdgcn_mfma_f32_32x32x16_bf16(pa0, VFRAG(vl[d0 * 4 + 0], vh[d0 * 4 + 0]), o[d0], 0, 0, 0); o[d0] = __builtin_amdgcn_mfma_f32_32x32x16_bf16(pa1, VFRAG(vl[d0 * 4 + 1], vh[d0 * 4 + 1]), o[d0], 0, 0, 0);
    o[d0] = __builtin_amdgcn_mfma_f32_32x32x16_bf16(pa2, VFRAG(vl[d0 * 4 + 2], vh[d0 * 4 + 2]), o[d0], 0, 0, 0); o[d0] = __builtin_amdgcn_mfma_f32_32x32x16_bf16(pa3, VFRAG(vl[d0 * 4 + 3], vh[d0 * 4 + 3]), o[d0], 0, 0, 0); }
}
constexpr int NSLOT = 4, SLOT_K = SHM_K, SLOT_V = SHM_V;
constexpr int OFF2_K = 0, OFF2_V = NSLOT * SLOT_K, OFF2_WS = OFF2_V + NSLOT * SLOT_V, LDS2_TOTAL = OFF2_WS + NWAVES * 256;
#define MLA_BAR() asm volatile("s_waitcnt lgkmcnt(0)\n\ts_barrier" ::: "memory")

__device__ __forceinline__ void unit(const bf16_t* __restrict__ Qb, const bf16_t* __restrict__ Kh, const bf16_t* __restrict__ Vh, bf16_t* __restrict__ Ob, int seq, char* lds, int wid) {
  const int lane = lane_id(), r32 = lane & 31, hi = lane >> 5;
  const bool hb = wid >= 4;
  char* K_lds = lds + OFF2_K; char* V_lds = lds + OFF2_V;
  float* al_l = (float*)(lds + OFF2_WS) + wid * 64;
  float m_reg = 0.f, l_reg = 0.f; f32x16 o[2] = {}; f32x16 negm = {}; bf16x8 qr[6];
  const bf16_t* Qw = Qb + (long)(wid * QBLK + r32) * LDQ + hi * 8;
#pragma unroll
  for (int d0 = 0; d0 < 6; ++d0) qr[d0] = *reinterpret_cast<const bf16x8*>(Qw + d0 * 16);
  unsigned koA, koB, vo; bool kvA, kvB;
  { const int rA = 8 * wid + (lane >> 4), rB = rA + 4, cp = lane & 15;
    const int cA = cp ^ (rA & 15), cB = cp ^ (rB & 15); kvA = cA < 12; kvB = cB < 12;
    koA = (unsigned)(rA * LDKk * 2 + cA * 16); koB = (unsigned)(rB * LDKk * 2 + cB * 16);
    const int jv = 64 * wid + lane, sub = jv >> 5, within = jv & 31, k = (sub >> 1) * 8 + (within >> 2), c = (sub & 1) * 32 + (within & 3) * 8;
    vo = (unsigned)(k * LDV * 2 + c * 2); }
  const __attribute__((address_space(3))) char* lds3 = (const __attribute__((address_space(3))) char*)(lds_cptr)lds;
#define DMA_TILE(u) do { const char* kt_ = (const char*)(Kh + (long)(u) * KVBLK * LDKk); const char* vt_ = (const char*)(Vh + (long)(u) * KVBLK * LDV); const int sl_ = (u) & 3; \
    if (kvA) __builtin_amdgcn_global_load_lds((const unsigned*)(kt_ + koA), (__attribute__((address_space(3))) unsigned*)(lds3 + OFF2_K + sl_ * SLOT_K + (2 * wid) * 1024), 16, 0, 0); \
    if (kvB) __builtin_amdgcn_global_load_lds((const unsigned*)(kt_ + koB), (__attribute__((address_space(3))) unsigned*)(lds3 + OFF2_K + sl_ * SLOT_K + (2 * wid + 1) * 1024), 16, 0, 0); \
    __builtin_amdgcn_global_load_lds((const unsigned*)(vt_ + vo), (__attribute__((address_space(3))) unsigned*)(lds3 + OFF2_V + sl_ * SLOT_V + wid * 1024), 16, 0, 0); } while (0)
#define DMA_WAIT() asm volatile("s_waitcnt vmcnt(0)" ::: "memory")
  const lds_cptr vp0 = (lds_cptr)V_lds + v_rd_base(lane); const lds_cptr kp0 = (lds_cptr)K_lds;
  f32x16 p0, p1; bf16x8 pa0, pa1, pa2, pa3; const int NT = seq / KVBLK;
  bf16x8 fka[12];
  DMA_WAIT();
  DMA_TILE(0); DMA_TILE(1); DMA_WAIT();
  MLA_BAR();
  if (hb) MLA_BAR();
  DMA_TILE(2);
  mprefetch(fka, kp0, r32, hi);
  mstage5<false>(o, p0, p1, fka, vp0, kp0, qr, negm, pa0, pa1, pa2, pa3, r32, hi);

  MLA_BAR();
  soft4(p0, p1, m_reg, l_reg, negm, o, al_l, true, pa0, pa1, pa2, pa3, r32, hi);
  mprefetch(fka, kp0 + SLOT_K, r32, hi);
  DMA_WAIT();
  MLA_BAR();
#pragma clang loop unroll(disable)
  for (int t = 1; t < NT; ++t) {
    if (t + 2 < NT) DMA_TILE(t + 2);
    SBAR(); mstage5<true>(o, p0, p1, fka, vp0 + ((t - 1) & 3) * SLOT_V, kp0 + (t & 3) * SLOT_K, qr, negm, pa0, pa1, pa2, pa3, r32, hi);

    MLA_BAR();
    soft4(p0, p1, m_reg, l_reg, negm, o, al_l, false, pa0, pa1, pa2, pa3, r32, hi);
    if (t + 1 < NT) mprefetch(fka, kp0 + ((t + 1) & 3) * SLOT_K, r32, hi);
    DMA_WAIT();
    MLA_BAR();
  }
  SBAR(); pvlast4(o, vp0 + ((NT - 1) & 3) * SLOT_V, pa0, pa1, pa2, pa3);
  if (!hb) MLA_BAR();
  MLA_BAR();
  { auto rr = __builtin_amdgcn_permlane32_swap(__float_as_uint(l_reg), __float_as_uint(l_reg), false, false); l_reg = __uint_as_float(rr[0]) + __uint_as_float(rr[1]); }
  if (hi == 0) al_l[r32] = l_reg; asm volatile("s_waitcnt lgkmcnt(0)" ::: "memory");
  float rli[16];
#pragma unroll
  for (int r = 0; r < 16; ++r) rli[r] = __builtin_amdgcn_rcpf(al_l[crow(r, hi)]);
  { bf16_t* stg = (bf16_t*)(lds) + wid * 2048;
#pragma unroll
    for (int r = 0; r < 16; ++r) { const int orow = crow(r, hi);
#pragma unroll
      for (int d0 = 0; d0 < 2; ++d0) stg[orow * 64 + d0 * 32 + r32] = (bf16_t)(cvt_pk_bf16(o[d0][r] * rli[r], 0.f) & 0xffffu); }
    asm volatile("s_waitcnt lgkmcnt(0)" ::: "memory");
    bf16_t* Ow = Ob + (long)(wid * QBLK) * LDO;
#pragma unroll
    for (int i = 0; i < 4; ++i) { const int row = i * 8 + (lane >> 3), ch = lane & 7; const u32x4 v = *(const u32x4*)(stg + row * 64 + ch * 8); *(u32x4*)(Ow + (long)row * LDO + ch * 8) = v; } }
  MLA_BAR();
#undef DMA_TILE
#undef DMA_WAIT
}
#undef KSWZ
#undef SBAR
}

__device__ __forceinline__ void p3_mla(const Frame& F) {
    unsigned char* ws = F.ws;
    const bf16_t* QB = (const bf16_t*)(ws + WS_QB); const bf16_t* KB = (const bf16_t*)(ws + WS_KB); const bf16_t* VB = (const bf16_t*)(ws + WS_VB); bf16_t* OB = (bf16_t*)(ws + WS_OB);
    const int G = F.G;
    if (G == 256) {
        const int x = F.vcu >> 5, c = F.vcu & 31;
        for (int i = 0; i < 4; ++i) {
            const int pair = x * 8 + 2 * i + (c >> 4), qb = c & 15, b = pair >> 3, h = pair & 7;
            const long row0 = (long)b * SEQ;
            mla::unit(QB + (row0 + qb * 256) * 768 + h * 96, KB + row0 * 768 + h * 96, VB + row0 * 512 + h * 64, OB + (row0 + qb * 256) * 512 + h * 64, SEQ, (char*)F.lds, F.wave);
        }
    } else {
        for (int u = F.vcu; u < 1024; u += G) {
            const int pair = u >> 4, qb = u & 15, b = pair >> 3, h = pair & 7; const long row0 = (long)b * SEQ;
            mla::unit(QB + (row0 + qb * 256) * 768 + h * 96, KB + row0 * 768 + h * 96, VB + row0 * 512 + h * 64, OB + (row0 + qb * 256) * 512 + h * 64, SEQ, (char*)F.lds, F.wave);
        }
    }
}

namespace mxa {
#define SBAR() __builtin_amdgcn_sched_barrier(0)
typedef short v4i16_t __attribute__((ext_vector_type(4)));
typedef __attribute__((address_space(3))) const char* lds_cptr;
__device__ __forceinline__ s16x4 vtr(lds_cptr p) { return __builtin_bit_cast(s16x4, __builtin_amdgcn_ds_read_tr16_b64_v4i16((__attribute__((address_space(3))) v4i16_t*)p)); }
__device__ __forceinline__ int crow(int r, int hi) { return (r & 3) + 8 * (r >> 2) + 4 * hi; }
#define KSW2(row, colB) ((row) * 128 + ((colB) ^ ((((row) >> 1) & 7) << 4)))
__device__ __forceinline__ int v_rd_base(int lane) { return ((lane & 3) << 3) | (((lane >> 2) & 3) << 6) | (((lane >> 4) & 1) << 5) | (((lane >> 5) & 1) << 8); }
constexpr int v_rd_off(int d0, int ks, int half) { return d0 * 512 + ks * 2048 + half * 1024; }
constexpr int BUFB = 8192;
#define VFRAG(L, H) (bf16x8){L[0], L[1], L[2], L[3], H[0], H[1], H[2], H[3]}
typedef __bf16 bf16x2_t __attribute__((ext_vector_type(2)));
typedef float f32x2_t __attribute__((ext_vector_type(2)));
__device__ __forceinline__ unsigned cvt2(float lo, float hi) { const f32x2_t f = {lo, hi}; return __builtin_bit_cast(unsigned, __builtin_convertvector(f, bf16x2_t)); }
__device__ __forceinline__ void step(f32x16& o0, f32x16& o1, float& m_reg, float& l_reg, const bf16x8* qr, lds_cptr Kb, lds_cptr Vb, float* al_l, float basef, float sl2, bool first, int r32, int hi) {
  constexpr float THR = 8.f;
  bf16x8 kf[4]; s16x4 vl[4], vh[4];
#pragma unroll
  for (int d0 = 0; d0 < 4; ++d0) kf[d0] = *(const __attribute__((address_space(3))) bf16x8*)(Kb + KSW2(r32, (d0 * 16 + hi * 8) * 2));
#pragma unroll
  for (int d0 = 0; d0 < 2; ++d0)
#pragma unroll
    for (int ks = 0; ks < 2; ++ks) { vl[d0 * 2 + ks] = vtr(Vb + v_rd_off(d0, ks, 0)); vh[d0 * 2 + ks] = vtr(Vb + v_rd_off(d0, ks, 1)); }
  f32x16 p;
  { const float nm = first ? 0.f : -m_reg;
#pragma unroll
    for (int r = 0; r < 16; ++r) p[r] = nm; }
#pragma unroll
  for (int d0 = 0; d0 < 4; ++d0) p = __builtin_amdgcn_mfma_f32_32x32x16_bf16(kf[d0], qr[d0], p, 0, 0, 0);
  const float nsl = -sl2;
  float pmax = -1e30f;
#pragma unroll
  for (int r = 0; r < 16; ++r) {
    const float df = basef - (float)((r & 3) + 8 * (r >> 2)), ad = __builtin_fabsf(df);
    const float sv = fmaf(nsl, ad, p[r]);
    p[r] = (ad <= 64.f) ? sv : -1e30f;
    pmax = fmaxf(pmax, p[r]);
  }
  { auto rr = __builtin_amdgcn_permlane32_swap(__float_as_uint(pmax), __float_as_uint(pmax), false, false);
    pmax = fmaxf(__uint_as_float(rr[0]), __uint_as_float(rr[1])); }
  if (first || !__all(pmax <= THR)) {
    const float dl = first ? pmax : fmaxf(pmax, 0.f);
    m_reg += dl;
#pragma unroll
    for (int r = 0; r < 16; ++r) p[r] -= dl;
    if (!first) { const float alpha = __builtin_amdgcn_exp2f(-dl); l_reg *= alpha;
      if (hi == 0) al_l[r32] = alpha; asm volatile("s_waitcnt lgkmcnt(0)" ::: "memory");
#pragma unroll
      for (int r = 0; r < 16; ++r) { const float a = al_l[crow(r, hi)]; o0[r] *= a; o1[r] *= a; } }
  }
  float ps = 0.f;
#pragma unroll
  for (int r = 0; r < 16; ++r) { p[r] = __builtin_amdgcn_exp2f(p[r]); ps += p[r]; }
  l_reg += ps;
  u32x4 w0 = {cvt2(p[0], p[1]), cvt2(p[2], p[3]), cvt2(p[4], p[5]), cvt2(p[6], p[7])};
  u32x4 w1 = {cvt2(p[8], p[9]), cvt2(p[10], p[11]), cvt2(p[12], p[13]), cvt2(p[14], p[15])};
  const bf16x8 pa0 = __builtin_bit_cast(bf16x8, w0), pa1 = __builtin_bit_cast(bf16x8, w1);
  o0 = __builtin_amdgcn_mfma_f32_32x32x16_bf16(pa0, VFRAG(vl[0], vh[0]), o0, 0, 0, 0); o0 = __builtin_amdgcn_mfma_f32_32x32x16_bf16(pa1, VFRAG(vl[1], vh[1]), o0, 0, 0, 0);
  o1 = __builtin_amdgcn_mfma_f32_32x32x16_bf16(pa0, VFRAG(vl[2], vh[2]), o1, 0, 0, 0); o1 = __builtin_amdgcn_mfma_f32_32x32x16_bf16(pa1, VFRAG(vl[3], vh[3]), o1, 0, 0, 0);
}

__device__ __forceinline__ void task(const bf16_t* __restrict__ QA, const bf16_t* __restrict__ KA, const bf16_t* __restrict__ VA, bf16_t* __restrict__ OP, float* __restrict__ LS,
                                     int b, int h, int n, int rres, int qb, char* wl, float* al) {
  const int lane = lane_id(), r32 = lane & 31, hi = lane >> 5;
  const int dil = (n == 0) ? 1 : (n == 1 ? 4 : 16), L = SEQ / dil, l0 = qb * 64;
  const float sl2 = exp2f(-(float)(h + 1)) * (float)dil * LOG2E;
  const long rowb = (long)b * SEQ;
  const lds_cptr wl3 = (lds_cptr)wl;
  const lds_cptr vrd = wl3 + 4096 + v_rd_base(lane);
  asm volatile("s_waitcnt vmcnt(0)" ::: "memory");
  unsigned ko[4], vo[4];
#pragma unroll
  for (int pc = 0; pc < 4; ++pc) {
    const int kr = 8 * pc + (lane >> 3), c = (lane & 7) ^ ((kr >> 1) & 7);
    ko[pc] = (unsigned)(kr * dil * 1024 + h * 128 + c * 16);
    const int jv = 64 * pc + lane, sub = jv >> 5, within = jv & 31, vk = (sub >> 1) * 8 + (within >> 2), vc = (sub & 1) * 32 + (within & 3) * 8;
    vo[pc] = (unsigned)(vk * dil * 1024 + h * 128 + vc * 2); }
#define MXA_DMA(lk0_, buf_) do { const size_t rb_ = (size_t)(rowb + (long)(lk0_) * dil + rres) * 1024; const char* kb_ = (const char*)KA + rb_; const char* vb_ = (const char*)VA + rb_; \
    _Pragma("unroll") for (int pc = 0; pc < 4; ++pc) { \
      __builtin_amdgcn_global_load_lds((const unsigned*)(kb_ + ko[pc]), (__attribute__((address_space(3))) unsigned*)(wl3 + (buf_) * BUFB + pc * 1024), 16, 0, 0); \
      __builtin_amdgcn_global_load_lds((const unsigned*)(vb_ + vo[pc]), (__attribute__((address_space(3))) unsigned*)(wl3 + (buf_) * BUFB + 4096 + pc * 1024), 16, 0, 0); } } while (0)
  const bool has_behind = (l0 >= 64), has_ahead = (l0 + 64 < L);
  const int nblk = 2 + (has_behind ? 2 : 0) + (has_ahead ? 2 : 0);
  auto blk_at = [&](int i) -> int { if (i < 2) return 2 + i; if (has_behind && has_ahead) return (i == 2) ? 1 : (i == 3 ? 4 : (i == 4 ? 0 : 5)); if (has_behind) return (i == 2) ? 1 : 0; return (i == 2) ? 4 : 5; };
  MXA_DMA(l0, 0);
  bf16x8 q0[4], q1[4];
  { const long ra = rowb + (long)(l0 + r32) * dil + rres, rb2 = rowb + (long)(l0 + 32 + r32) * dil + rres;
#pragma unroll
    for (int d0 = 0; d0 < 4; ++d0) { q0[d0] = *reinterpret_cast<const bf16x8*>(QA + ra * 512 + h * 64 + d0 * 16 + hi * 8); q1[d0] = *reinterpret_cast<const bf16x8*>(QA + rb2 * 512 + h * 64 + d0 * 16 + hi * 8); } }
  asm volatile("s_waitcnt vmcnt(0)" ::: "memory");
  f32x16 oa0 = f32x16{}, oa1 = f32x16{}, ob0 = f32x16{}, ob1 = f32x16{};
  float ma = 0.f, la = 0.f, mb = 0.f, lb = 0.f;
#pragma clang loop unroll(disable)
  for (int i = 0; i < nblk; ++i) {
    const int j = blk_at(i), buf = i & 1;
    if (i + 1 < nblk) { MXA_DMA(l0 - 64 + 32 * blk_at(i + 1), buf ^ 1); }
    if (i > 0) { if (i + 1 < nblk) asm volatile("s_waitcnt vmcnt(8)" ::: "memory"); else asm volatile("s_waitcnt vmcnt(0)" ::: "memory"); }
    const lds_cptr Kb = wl3 + buf * BUFB, Vb = vrd + buf * BUFB;
    const int dk = -64 + 32 * j;
    if (j <= 4) step(oa0, oa1, ma, la, q0, Kb, Vb, al, (float)(r32 - 4 * hi - dk), sl2, i == 0, r32, hi);
    if (j >= 1) step(ob0, ob1, mb, lb, q1, Kb, Vb, al, (float)(32 + r32 - 4 * hi - dk), sl2, i == 0, r32, hi);
    asm volatile("s_waitcnt lgkmcnt(0)" ::: "memory");
  }
#undef MXA_DMA
#pragma unroll
  for (int qs = 0; qs < 2; ++qs) {
    float l_reg = qs ? lb : la; const float m_reg = qs ? mb : ma;
    { auto rr = __builtin_amdgcn_permlane32_swap(__float_as_uint(l_reg), __float_as_uint(l_reg), false, false); l_reg = __uint_as_float(rr[0]) + __uint_as_float(rr[1]); }
    if (hi == 0) { al[r32] = l_reg; const long row = rowb + (long)(l0 + qs * 32 + r32) * dil + rres; LS[row * 8 + h] = m_reg + __builtin_amdgcn_logf(l_reg); }
    asm volatile("s_waitcnt lgkmcnt(0)" ::: "memory");
    bf16_t* stg = (bf16_t*)wl;
#pragma unroll
    for (int r = 0; r < 16; ++r) { const int orow = crow(r, hi); const float rl = __builtin_amdgcn_rcpf(al[orow]);
      stg[orow * 64 + r32] = (bf16_t)(cvt_pk_bf16((qs ? ob0[r] : oa0[r]) * rl, 0.f) & 0xffffu);
      stg[orow * 64 + 32 + r32] = (bf16_t)(cvt_pk_bf16((qs ? ob1[r] : oa1[r]) * rl, 0.f) & 0xffffu); }
    asm volatile("s_waitcnt lgkmcnt(0)" ::: "memory");
#pragma unroll
    for (int i = 0; i < 4; ++i) { const int rw = i * 8 + (lane >> 3), ch = lane & 7; const u32x4 v = *(const u32x4*)(stg + rw * 64 + ch * 8);
      const long row = rowb + (long)(l0 + qs * 32 + rw) * dil + rres; *(u32x4*)(OP + row * 512 + h * 64 + ch * 8) = v; }
    asm volatile("s_waitcnt lgkmcnt(0)" ::: "memory");
  }
}
#undef KSW2
#undef VFRAG
#undef SBAR
}

__device__ __forceinline__ void p3_mixerA(const Frame& F) {
    unsigned char* ws = F.ws;
    const bf16_t* QA = (const bf16_t*)(ws + WS_QA); const bf16_t* KA = (const bf16_t*)(ws + WS_KA); const bf16_t* VA = (const bf16_t*)(ws + WS_VA);
    float* LSE = (float*)(ws + WS_LSE);
    char* wl = (char*)F.lds + F.wave * 16384; float* al = (float*)((char*)F.lds + RING_BYTES + 2048) + F.wave * 64;
    const int x = (F.G == 256) ? (F.vcu >> 5) : 0; const int ngrp = (F.G == 256) ? 8 : 1, per = 64 * 192 / ngrp;
    unsigned* qctr = F.ctl + CW_Q + 64 * x;
    for (;;) {
        unsigned ti = 0; if (lane_id() == 0) ti = atomicAdd(qctr, 1u);
        ti = (unsigned)__builtin_amdgcn_readfirstlane((int)ti);
        if (ti >= (unsigned)per) break;
        const int t = x * per + (int)ti;
        const int pair = t / 192, tt = t % 192, n = tt >> 6, idx = tt & 63;
        const int rres = (n == 0) ? 0 : (n == 1 ? (idx >> 4) : (idx >> 2)), qb = (n == 0) ? idx : (n == 1 ? (idx & 15) : (idx & 3));
        bf16_t* OP = (bf16_t*)(ws + (n == 2 ? WS_OAP2 : WS_OAP0)) + (n == 1 ? (size_t)T * 512 : 0);
        mxa::task(QA, KA, VA, OP, LSE + (size_t)n * ((size_t)T * 8), pair >> 3, pair & 7, n, rres, qb, wl, al);
    }
}
static_assert(WS_OAP1 - WS_OAP0 == (size_t)T * 512 * 2, "OAP0|OAP1 contiguous");

__device__ __forceinline__ void p35_mix(const Frame& F, const Args& a) {
    unsigned char* ws = F.ws; const int lane = lane_id();
    const bf16_t* OB = (const bf16_t*)(ws + WS_OB); const float* LSE = (const float*)(ws + WS_LSE); bf16_t* MIXED = (bf16_t*)(ws + WS_MIXED);
    const bf16_t* OAPn[3] = {(const bf16_t*)(ws + WS_OAP0), (const bf16_t*)(ws + WS_OAP1), (const bf16_t*)(ws + WS_OAP2)};
    const float* g_a = a.in[8]; const float* g_b = a.in[9];
    const int gw = F.vcu * NWAVES + F.wave, NGW = F.G * NWAVES;
    const int h = lane >> 3;
    const f32x4 ga0 = *(const f32x4*)(g_a + lane * 8), ga1 = *(const f32x4*)(g_a + lane * 8 + 4), gb0 = *(const f32x4*)(g_b + lane * 8), gb1 = *(const f32x4*)(g_b + lane * 8 + 4);
    for (int row = gw; row < T; row += NGW) {
        float ls[3]; u32x4 ov[3];
#pragma unroll
        for (int n = 0; n < 3; ++n) { ls[n] = LSE[((size_t)n * T + row) * 8 + h]; ov[n] = __builtin_nontemporal_load((const u32x4*)(OAPn[n] + (size_t)row * 512 + lane * 8)); }
        const u32x4 bv = __builtin_nontemporal_load((const u32x4*)(OB + (size_t)row * 512 + lane * 8));
        const float mx = fmaxf(ls[0], fmaxf(ls[1], ls[2]));
        float w[3]; float wsum = 0.f;
#pragma unroll
        for (int n = 0; n < 3; ++n) { w[n] = __builtin_amdgcn_exp2f(ls[n] - mx); wsum += w[n]; }
        const float inv = 1.f / wsum;
        float oa[8] = {0.f, 0.f, 0.f, 0.f, 0.f, 0.f, 0.f, 0.f};
#pragma unroll
        for (int n = 0; n < 3; ++n) { const float wn = w[n] * inv;
#pragma unroll
            for (int j = 0; j < 4; ++j) { oa[2 * j] += wn * bf16lo(ov[n][j]); oa[2 * j + 1] += wn * bf16hi(ov[n][j]); } }
        float obv[8];
#pragma unroll
        for (int j = 0; j < 4; ++j) { obv[2 * j] = bf16lo(bv[j]); obv[2 * j + 1] = bf16hi(bv[j]); }
        float sa = 0.f, sb = 0.f;
#pragma unroll
        for (int j = 0; j < 8; ++j) { sa += oa[j] * oa[j]; sb += obv[j] * obv[j]; }
        sa = wsum64(sa); sb = wsum64(sb);
        const float ra = 1.0f / sqrtf(sa * (1.f / 512.f) + EPS), rb = 1.0f / sqrtf(sb * (1.f / 512.f) + EPS);
        u32x4 wa, wb;
        wa.x = cvt_pk_bf16(oa[0] * ra * ga0[0], oa[1] * ra * ga0[1]); wa.y = cvt_pk_bf16(oa[2] * ra * ga0[2], oa[3] * ra * ga0[3]);
        wa.z = cvt_pk_bf16(oa[4] * ra * ga1[0], oa[5] * ra * ga1[1]); wa.w = cvt_pk_bf16(oa[6] * ra * ga1[2], oa[7] * ra * ga1[3]);
        wb.x = cvt_pk_bf16(obv[0] * rb * gb0[0], obv[1] * rb * gb0[1]); wb.y = cvt_pk_bf16(obv[2] * rb * gb0[2], obv[3] * rb * gb0[3]);
        wb.z = cvt_pk_bf16(obv[4] * rb * gb1[0], obv[5] * rb * gb1[1]); wb.w = cvt_pk_bf16(obv[6] * rb * gb1[2], obv[7] * rb * gb1[3]);
        *(u32x4*)(MIXED + (size_t)row * 1024 + lane * 8) = wa;
        *(u32x4*)(MIXED + (size_t)row * 1024 + 512 + lane * 8) = wb;
    }
}

constexpr size_t WS_WRT = 4 * MiB + 512 * 1024;
constexpr size_t WS_RS = 137 * MiB;
constexpr size_t WS_GS = 141 * MiB;
constexpr size_t WS_H2B = 384 * MiB;
constexpr size_t WS_D = 448 * MiB;
constexpr int MOE_TAB = MISC_OFF + 256;
constexpr int NBUCK = 112;
constexpr int CW_EDONE = 40960;
constexpr int CW_BCNT = 32768;
constexpr size_t WS_HID2 = 209 * MiB;
constexpr size_t WS_BLIST = 288 * MiB;
constexpr size_t WS_SSQ2 = 136 * MiB + 256 * 1024;
constexpr int MOE_TOKL = MOE_TAB + 4096;
constexpr size_t WS_DST = 280 * MiB;

__device__ __forceinline__ void p0_router_table(const Frame& F, const Args& a) {
    const float* w_r1 = a.in[12]; const float* w_r2 = a.in[14]; const float* g_ffn = a.in[11]; bf16_t* WRH = (bf16_t*)(F.ws + WS_WRT); bf16_t* WRL = WRH + 48 * 1024;
    const int gw = F.vcu * NWAVES + F.wave, NGW = F.G * NWAVES, lane = lane_id();
    for (int idx = gw * 64 + lane; idx < 48 * 1024; idx += NGW * 64) {
        const int o = idx >> 10, k = idx & 1023;
        float w = 0.f;
        if (o < 4) w = w_r1[k * 4 + o]; else if (o < 36) w = w_r2[((size_t)((o - 4) >> 3) * 1024 + k) * 8 + ((o - 4) & 7)];
        w *= g_ffn[k];
        const unsigned hi = cvt_pk_bf16(w, 0.f) & 0xffffu; const float rem = w - __uint_as_float(hi << 16);
        WRH[idx] = (bf16_t)hi; WRL[idx] = (bf16_t)(cvt_pk_bf16(rem, 0.f) & 0xffffu);
    }
}

__device__ __forceinline__ void p4_wo(const Frame& F, const Args& a) {
    unsigned char* ws = F.ws;
    { const float* p = a.in[1]; bf16_t* P16 = (bf16_t*)(ws + WS_P16); const int gw = F.vcu * NWAVES + F.wave, NGW = F.G * NWAVES, lane = lane_id();
      for (size_t i = (size_t)gw * 64 + lane; i < (size_t)T * 256 / 8; i += (size_t)NGW * 64) {
          const f32x4 v0 = ((const f32x4*)p)[2 * i], v1 = ((const f32x4*)p)[2 * i + 1];
          u32x4 o; o.x = cvt_pk_bf16(v0.x, v0.y); o.y = cvt_pk_bf16(v0.z, v0.w); o.z = cvt_pk_bf16(v1.x, v1.y); o.w = cvt_pk_bf16(v1.z, v1.w);
          ((u32x4*)P16)[i] = o; } }
    pg::DenseSched S{(const char*)(ws + WS_MIXED), (const char*)(ws + WS_WO), 1024, 1024, T / 256, 4, F.G, (int)blockIdx.x};
    EpiStoreBf16 E{(bf16_t*)(ws + WS_D), 1024};
    pg::gemm_phase(F.lds, S, E, 1024, F.wave);
}

__device__ __forceinline__ void p5_router(const Frame& F, const Args& a) {
    unsigned char* ws = F.ws; const int lane = lane_id(), wid = F.wave;
    const float* X = a.in[0]; const bf16_t* Dm = (const bf16_t*)(ws + WS_D); const float* g_ffn = a.in[11]; const float* b_r1 = a.in[13]; const float* b_r2 = a.in[15];
    const bf16_t* WRH = (const bf16_t*)(ws + WS_WRT); const bf16_t* WRL = WRH + 48 * 1024; bf16_t* MU = (bf16_t*)(ws + WS_M);
    int* LIST = (int*)(ws + WS_LIST); float* RS = (float*)(ws + WS_RS); float* GS = (float*)(ws + WS_GS);
    unsigned* cnt = F.ctl + CW_CNT;
    LAS int* LG = (LAS int*)(F.lds);
    LAS int* SSQ_ = (LAS int*)(F.lds + 26 * 1024);
    LAS unsigned* hist = (LAS unsigned*)(F.lds + 27 * 1024);
    LAS unsigned* gbase = hist + 160;
    int* DST = (int*)(ws + WS_DST); int* BLIST = (int*)(ws + WS_BLIST); unsigned* bcnt = F.ctl + CW_BCNT;
    const int tr = lane & 15, kg = lane >> 4, tid = wid * 64 + lane;
    const int kw = 128 * wid;
    for (int chunk = F.vcu; chunk < T / 128; chunk += F.G) {
        const int base = chunk * 128;
        for (int i = tid; i < 128 * 49 + 128; i += 512) { if (i < 128 * 49) LG[i] = 0; else SSQ_[i - 128 * 49] = 0; }
        if (tid < 32 + NBUCK) hist[tid] = 0u;
        __syncthreads();
        bf16x8 bh[4][3]; LAS bf16x8* const blS = (LAS bf16x8*)(F.lds + 32 * 1024 + wid * 12288) + lane;
#pragma unroll
        for (int ks = 0; ks < 4; ++ks)
#pragma unroll
            for (int nb = 0; nb < 3; ++nb) { const size_t wo = (size_t)(nb * 16 + tr) * 1024 + kw + ks * 32 + 8 * kg; bh[ks][nb] = *(const bf16x8*)(WRH + wo); blS[(ks * 3 + nb) * 64] = *(const bf16x8*)(WRL + wo); }
        f32x4 xa[2][4], xb[2][4]; u32x4 dq[2][4];
#define RT_LOAD(BUF, MB) do { const size_t ro_ = (size_t)(base + 16 * (MB) + tr) * 1024 + kw + 8 * kg; _Pragma("unroll") for (int ks = 0; ks < 4; ++ks) { \
            xa[BUF][ks] = __builtin_nontemporal_load((const f32x4*)(X + ro_ + ks * 32)); xb[BUF][ks] = __builtin_nontemporal_load((const f32x4*)(X + ro_ + ks * 32 + 4)); \
            dq[BUF][ks] = __builtin_nontemporal_load((const u32x4*)(Dm + ro_ + ks * 32)); } } while (0)
        RT_LOAD(0, 0);
#pragma unroll 2
        for (int mb = 0; mb < 8; ++mb) {
            const int cb = mb & 1;
            if (mb + 1 < 8) { if (cb) RT_LOAD(0, mb + 1); else RT_LOAD(1, mb + 1); }
            const size_t ro = (size_t)(base + 16 * mb + tr) * 1024 + kw + 8 * kg;
            f32x4 acc0 = {0.f, 0.f, 0.f, 0.f}, acc1 = acc0, acc2 = acc0; float ss = 0.f;
#pragma unroll
            for (int ks = 0; ks < 4; ++ks) {
                f32x4 v0 = xa[cb][ks], v1 = xb[cb][ks];
                { const u32x4 dd = dq[cb][ks];
                  v0[0] += bf16lo(dd.x); v0[1] += bf16hi(dd.x); v0[2] += bf16lo(dd.y); v0[3] += bf16hi(dd.y); v1[0] += bf16lo(dd.z); v1[1] += bf16hi(dd.z); v1[2] += bf16lo(dd.w); v1[3] += bf16hi(dd.w); }
                ss += (v0[0] * v0[0] + v0[1] * v0[1]) + (v0[2] * v0[2] + v0[3] * v0[3]) + (v1[0] * v1[0] + v1[1] * v1[1]) + (v1[2] * v1[2] + v1[3] * v1[3]);
                u32x4 hi; hi.x = cvt_pk_bf16(v0[0], v0[1]); hi.y = cvt_pk_bf16(v0[2], v0[3]); hi.z = cvt_pk_bf16(v1[0], v1[1]); hi.w = cvt_pk_bf16(v1[2], v1[3]);
                u32x4 lo; lo.x = cvt_pk_bf16(v0[0] - bf16lo(hi.x), v0[1] - bf16hi(hi.x)); lo.y = cvt_pk_bf16(v0[2] - bf16lo(hi.y), v0[3] - bf16hi(hi.y));
                lo.z = cvt_pk_bf16(v1[0] - bf16lo(hi.z), v1[1] - bf16hi(hi.z)); lo.w = cvt_pk_bf16(v1[2] - bf16lo(hi.w), v1[3] - bf16hi(hi.w));
                *(u32x4*)(MU + ro + ks * 32) = hi;
                const bf16x8 ah = __builtin_bit_cast(bf16x8, hi), al = __builtin_bit_cast(bf16x8, lo);
                const bf16x8 bl0 = blS[(ks * 3 + 0) * 64], bl1 = blS[(ks * 3 + 1) * 64], bl2 = blS[(ks * 3 + 2) * 64];
                acc0 = __builtin_amdgcn_mfma_f32_16x16x32_bf16(ah, bh[ks][0], acc0, 0, 0, 0); acc0 = __builtin_amdgcn_mfma_f32_16x16x32_bf16(al, bh[ks][0], acc0, 0, 0, 0); acc0 = __builtin_amdgcn_mfma_f32_16x16x32_bf16(ah, bl0, acc0, 0, 0, 0);
                acc1 = __builtin_amdgcn_mfma_f32_16x16x32_bf16(ah, bh[ks][1], acc1, 0, 0, 0); acc1 = __builtin_amdgcn_mfma_f32_16x16x32_bf16(al, bh[ks][1], acc1, 0, 0, 0); acc1 = __builtin_amdgcn_mfma_f32_16x16x32_bf16(ah, bl1, acc1, 0, 0, 0);
                acc2 = __builtin_amdgcn_mfma_f32_16x16x32_bf16(ah, bh[ks][2], acc2, 0, 0, 0); acc2 = __builtin_amdgcn_mfma_f32_16x16x32_bf16(al, bh[ks][2], acc2, 0, 0, 0); acc2 = __builtin_amdgcn_mfma_f32_16x16x32_bf16(ah, bl2, acc2, 0, 0, 0);
            }
            ss += __shfl_xor(ss, 16); ss += __shfl_xor(ss, 32);
            if (kg == 0) atomicAdd((int*)(SSQ_ + 16 * mb + tr), __float2int_rn(ss * 16384.0f));
#pragma unroll
            for (int r = 0; r < 4; ++r) { const int tk = 16 * mb + 4 * kg + r;
                atomicAdd((int*)(LG + tk * 49 + tr), __float2int_rn(acc0[r] * 1048576.0f)); atomicAdd((int*)(LG + tk * 49 + 16 + tr), __float2int_rn(acc1[r] * 1048576.0f)); if (tr < 4) atomicAdd((int*)(LG + tk * 49 + 32 + tr), __float2int_rn(acc2[r] * 1048576.0f)); }
        }
#undef RT_LOAD
        __syncthreads();
        int ea = 0, eb = 0, bk = 0, hfa = 0; unsigned la = 0u, lb = 0u, lk = 0u; float w0 = 0.f, w1 = 0.f, rstd = 0.f;
        if (tid < 128) {
            rstd = 1.0f / sqrtf((float)SSQ_[tid] * (1.f / 16384.f) * (1.f / 1024.f) + EPS);
            const LAS int* lg = LG + tid * 49; const float rq = rstd * (1.f / 1048576.f);
            const float l0 = (float)lg[0] * rq + b_r1[0], l1 = (float)lg[1] * rq + b_r1[1], l2 = (float)lg[2] * rq + b_r1[2], l3 = (float)lg[3] * rq + b_r1[3];
            int gi = 0; float gm = l0; if (l1 > gm) { gm = l1; gi = 1; } if (l2 > gm) { gm = l2; gi = 2; } if (l3 > gm) { gm = l3; gi = 3; }
            const float gs = __expf(l0 - gm) + __expf(l1 - gm) + __expf(l2 - gm) + __expf(l3 - gm);
            const float g_val = 1.0f / gs;
            float lv[8];
#pragma unroll
            for (int e = 0; e < 8; ++e) lv[e] = (float)lg[4 + 8 * gi + e] * rq + b_r2[8 * gi + e];
            int e0 = 0; float m0 = lv[0];
#pragma unroll
            for (int e = 1; e < 8; ++e) if (lv[e] > m0) { m0 = lv[e]; e0 = e; }
            int e1 = -1; float m1 = -3.0e38f;
#pragma unroll
            for (int e = 0; e < 8; ++e) if (e != e0 && lv[e] > m1) { m1 = lv[e]; e1 = e; }
            const float x1 = __expf(m1 - m0);
            w0 = g_val / (1.0f + x1); w1 = g_val * x1 / (1.0f + x1);
            ea = gi * 8 + e0; eb = gi * 8 + e1;
            la = atomicAdd((unsigned*)(hist + ea), 1u); lb = atomicAdd((unsigned*)(hist + eb), 1u);
            { const int lo = e0 < e1 ? e0 : e1, hi = e0 < e1 ? e1 : e0; bk = gi * 28 + (lo * 7 - ((lo * (lo - 1)) >> 1) + (hi - lo - 1)); hfa = e0 < e1 ? 0 : 1; }
            lk = atomicAdd((unsigned*)(hist + 32 + bk), 1u);
        }
        __syncthreads();
        if (tid < 32 + NBUCK) { const unsigned c = hist[tid]; gbase[tid] = c ? atomicAdd(tid < 32 ? cnt + 64 * tid : bcnt + 64 * (tid - 32), c) : 0u; }
        __syncthreads();
        if (tid < 128) {
            const int tok = base + tid; const int ra = (int)(gbase[ea] + la), rb = (int)(gbase[eb] + lb);
            LIST[(size_t)ea * T + ra] = tok; RS[(size_t)ea * T + ra] = rstd; GS[(size_t)ea * T + ra] = w0;
            LIST[(size_t)eb * T + rb] = tok; RS[(size_t)eb * T + rb] = rstd; GS[(size_t)eb * T + rb] = w1;
            const int rk2 = (int)(gbase[32 + bk] + lk);
            DST[(size_t)ea * T + ra] = (bk << 17) | (rk2 << 1) | hfa; DST[(size_t)eb * T + rb] = (bk << 17) | (rk2 << 1) | (hfa ^ 1);
            BLIST[(size_t)bk * T + rk2] = tok;
        }
        __syncthreads();
    }
}

__device__ __forceinline__ void moe_build_tables(const Frame& F) {
    LAS int* tab = (LAS int*)(F.lds + MOE_TAB);
    const int tid = F.wave * 64 + lane_id();
    if (tid < 32 + NBUCK) tab[512 + tid] = (int)__hip_atomic_load(tid < 32 ? F.ctl + CW_CNT + 64 * tid : F.ctl + CW_BCNT + 64 * (tid - 32), __ATOMIC_RELAXED, __HIP_MEMORY_SCOPE_AGENT);
    __syncthreads();
    if (tid <= 32) { int off = 0, cp = 0;
        for (int j = 0; j < tid; ++j) { const int nch = (tab[512 + j] + 255) >> 8; off += nch * 256; cp += nch; }
        tab[tid] = off; tab[80 + tid] = cp; if (tid < 32) tab[40 + tid] = tab[512 + tid]; }
    else if (tid >= 64 && tid <= 64 + NBUCK) { const int b = tid - 64; int o = 0, p = 0;
        for (int j = 0; j < b; ++j) { const int c = tab[512 + 32 + j]; o += c; p += (c + 255) >> 8; }
        tab[128 + b] = p * 256;   tab[384 + b] = p; if (b < NBUCK) tab[256 + b] = tab[512 + 32 + b]; }
    __syncthreads();
}
struct MoeSched1 {
    static constexpr bool GATHER = true; static constexpr int KSPLIT = 0; static constexpr bool DEPS = false;
    const char* A; const char* Bt; const int* LIST; LAS const int* tab; int G, c;
    __device__ __forceinline__ int a_ld() const { return 1024; }
    __device__ __forceinline__ const char* abase() const { return A; }
    __device__ __forceinline__ bool next(int i, pg::Unit& u) const {
        const int nun = tab[80 + 32] * 2; const long L = (long)i * G + c; if (L >= nun) return false;
        const int ci = (int)L >> 1; u.pn = (int)L & 1;
        int e = 0;
#pragma unroll 1
        for (int k = 1; k < 32; ++k) if (tab[80 + k] <= ci) e = k;
        u.aux = e; u.pm = ci - tab[80 + e]; return true;
    }
    __device__ __forceinline__ void addr(const pg::Unit&, const char*&, const char*&) const {}
    __device__ __forceinline__ void addr_g(const pg::Unit& u, const int (&R)[2], const int (&C)[2], unsigned (&aoff)[2][2], const char*& bbase) const {
        const int e = u.aux, cn = tab[40 + e];
#pragma unroll
        for (int h = 0; h < 2; ++h)
#pragma unroll
            for (int i = 0; i < 2; ++i) { const int rk = u.pm * 256 + h * 128 + R[i]; const int tok = (rk < cn) ? LIST[(size_t)e * T + rk] : 0; aoff[h][i] = (unsigned)((tok * 1024 + C[i]) * 2); }
        bbase = Bt + ((size_t)e * 512 + (size_t)u.pn * 256) * 1024 * 2;
    }
};
struct EpiMoe1 {
    bf16_t* HID2; const float* RS; const float* GS; const int* DST; LAS const int* tab; unsigned* edone;
    __device__ __forceinline__ void operator()(const f32x4 (&acc)[2][2][4][2], const pg::Unit& u, int wr, int wc, int fr, int fq, LAS unsigned char* stage, int wid) const {
        const int e = u.aux, cn = tab[40 + e];
        float rsv[2][4], gsv[2][4]; int dsv[2][4];
#pragma unroll
        for (int ai = 0; ai < 2; ++ai)
#pragma unroll
            for (int m = 0; m < 4; ++m) { const int rk = u.pm * 256 + ai * 128 + wr * 64 + m * 16 + fr; const bool ok = rk < cn; const size_t o = (size_t)e * T + rk;
                rsv[ai][m] = ok ? RS[o] : 0.f; gsv[ai][m] = ok ? GS[o] : 0.f; dsv[ai][m] = ok ? DST[o] : -1; }
#pragma unroll
        for (int ai = 0; ai < 2; ++ai)
#pragma unroll
            for (int m = 0; m < 4; ++m) { const int d = dsv[ai][m];
                if (d >= 0) { const float rs = rsv[ai][m], gt = gsv[ai][m]; float hv[8];
                    const int row2 = tab[128 + (d >> 17)] + ((d >> 1) & 0xffff), half = d & 1;
#pragma unroll
                    for (int n = 0; n < 2; ++n)
#pragma unroll
                        for (int j = 0; j < 4; ++j) { const float gg = acc[ai][0][m][n][j] * rs, uu = acc[ai][1][m][n][j] * (rs * gt); hv[4 * n + j] = gg * __builtin_amdgcn_rcpf(1.0f + __expf(-gg)) * uu; }
                    u32x4 w; w.x = cvt_pk_bf16(hv[0], hv[1]); w.y = cvt_pk_bf16(hv[2], hv[3]); w.z = cvt_pk_bf16(hv[4], hv[5]); w.w = cvt_pk_bf16(hv[6], hv[7]);
                    asm volatile("global_store_dwordx4 %0, %1, off sc0 sc1\n\ts_nop 7" :: "v"(HID2 + (size_t)row2 * 512 + half * 256 + u.pn * 128 + wc * 32 + 8 * fq), "v"(w) : "memory"); } }
        asm volatile("s_waitcnt vmcnt(0)\n\ts_barrier" ::: "memory");
        if (wid == 0 && fr == 0 && fq == 0) __hip_atomic_fetch_add(edone + 64 * e, 1u, __ATOMIC_RELAXED, __HIP_MEMORY_SCOPE_AGENT);
    }
};
struct MoeSched2 {
    static constexpr bool GATHER = false; static constexpr int KSPLIT = 4; static constexpr bool DEPS = true;
    const char* A; const char* Bt; LAS const int* tab; int G, c; const unsigned* edone;
    __device__ __forceinline__ void acquire(const pg::Unit& u) const {
        const int b = u.aux, g = b / 28, p = b % 28; int lo = 0, rem = p;
#pragma unroll 1
        while (rem >= 7 - lo) { rem -= 7 - lo; ++lo; }
        const int e0 = g * 8 + lo, e1 = g * 8 + lo + 1 + rem;
        const unsigned n0 = 2u * (unsigned)(tab[80 + e0 + 1] - tab[80 + e0]), n1 = 2u * (unsigned)(tab[80 + e1 + 1] - tab[80 + e1]);
        int spins = 0;
        while ((__hip_atomic_load(edone + 64 * e0, __ATOMIC_RELAXED, __HIP_MEMORY_SCOPE_AGENT) < n0 || __hip_atomic_load(edone + 64 * e1, __ATOMIC_RELAXED, __HIP_MEMORY_SCOPE_AGENT) < n1) && ++spins < (1 << 22)) __builtin_amdgcn_s_sleep(8);
    }
    __device__ __forceinline__ int a_ld() const { return 512; }
    __device__ __forceinline__ const char* abase() const { return A; }
    __device__ __forceinline__ bool next(int i, pg::Unit& u) const {
        const int nun = tab[384 + NBUCK] * 4; const long L = (long)i * G + c; if (L >= nun) return false;
        const int ci = (int)L >> 2; u.pn = (int)L & 3;
        const int l = lane_id();
        const unsigned long long m0 = __builtin_amdgcn_ballot_w64(tab[384 + l] <= ci), m1 = __builtin_amdgcn_ballot_w64(l + 64 < NBUCK && tab[384 + 64 + l] <= ci);
        const int b = __builtin_popcountll(m0) + __builtin_popcountll(m1) - 1;
        u.aux = b; u.pm = ci - tab[384 + b]; return true;
    }
    __device__ __forceinline__ void addr(const pg::Unit& u, const char*& abase_, const char*& bbase, const char*& bbase2) const {
        const int b = u.aux, g = b / 28, p = b % 28;
        int lo = 0, rem = p;
#pragma unroll 1
        while (rem >= 7 - lo) { rem -= 7 - lo; ++lo; }
        const int hi = lo + 1 + rem;
        abase_ = A + (size_t)(tab[128 + b] + u.pm * 256) * 512 * 2;
        bbase = Bt + ((size_t)(g * 8 + lo) * 1024 + (size_t)u.pn * 256) * 256 * 2;
        bbase2 = Bt + ((size_t)(g * 8 + hi) * 1024 + (size_t)u.pn * 256) * 256 * 2; }
    __device__ __forceinline__ void addr_g(const pg::Unit&, const int (&)[2], const int (&)[2], unsigned (&)[2][2], const char*&) const {}
};
__device__ __forceinline__ void moe2_fetch(LAS const int* tokl, const bf16_t* MU, size_t colo, int wid, int rsub, int ai, int m, int (&tk)[2], u32x4 (&mv)[2]) {
#pragma unroll
    for (int i = 0; i < 2; ++i) { const int r2 = 4 * wid + 2 * i + rsub, trow = 128 * ai + 64 * (r2 >> 4) + 16 * m + (r2 & 15);
        tk[i] = tokl[trow]; mv[i] = (u32x4){0u, 0u, 0u, 0u};
        if (tk[i] >= 0) mv[i] = __builtin_nontemporal_load((const u32x4*)(MU + (size_t)tk[i] * 1024 + colo)); }
}
struct EpiMoe2 {
    bf16_t* H2B; const bf16_t* MU; const int* BLIST; float* SSQ2; LAS const int* tab; LAS int* tokl;
    __device__ __forceinline__ void operator()(const f32x4 (&acc)[2][2][4][2], const pg::Unit& u, int wr, int wc, int fr, int fq, LAS unsigned char* stage, int wid) const {
        const int b = u.aux, lane = fr + 16 * fq, rk0 = u.pm * 256, nvalid = tab[256 + b] - rk0, tid = wid * 64 + lane;
        if (tid < 256) tokl[tid] = (tid < nvalid) ? BLIST[(size_t)b * T + rk0 + tid] : -1;
        asm volatile("s_waitcnt lgkmcnt(0)\n\ts_barrier" ::: "memory");
        const int ch = lane & 31, rsub = lane >> 5, rr = 16 * wr + fr; const size_t colo = (size_t)u.pn * 256 + ch * 8;
        int tka[8][2]; u32x4 mva[8][2];
#pragma unroll
        for (int it = 0; it < 8; ++it) moe2_fetch(tokl, MU, colo, wid, rsub, it >> 2, it & 3, tka[it], mva[it]);
#pragma unroll
        for (int it = 0; it < 8; ++it) { const int ai = it >> 2, m = it & 3; const int (&tk)[2] = tka[it]; const u32x4 (&mv)[2] = mva[it];
            u32x4 w[2];
#pragma unroll
            for (int bj = 0; bj < 2; ++bj) { const f32x4 v0 = acc[ai][bj][m][0], v1 = acc[ai][bj][m][1];
                w[bj].x = cvt_pk_bf16(v0[0], v0[1]); w[bj].y = cvt_pk_bf16(v0[2], v0[3]); w[bj].z = cvt_pk_bf16(v1[0], v1[1]); w[bj].w = cvt_pk_bf16(v1[2], v1[3]); }
            *(LAS u32x4*)(stage + rr * pg::EPI_ROWB + (32 * wc + 8 * fq) * 2) = w[0];
            *(LAS u32x4*)(stage + rr * pg::EPI_ROWB + (128 + 32 * wc + 8 * fq) * 2) = w[1];
            asm volatile("s_waitcnt lgkmcnt(0)\n\ts_barrier" ::: "memory");
#pragma unroll
            for (int i = 0; i < 2; ++i) { const int r2 = 4 * wid + 2 * i + rsub;
                const u32x4 v = *(const LAS u32x4*)(stage + r2 * pg::EPI_ROWB + ch * 16); const u32x4 hh = mv[i];
                float h[8]; h[0] = bf16lo(v.x) + bf16lo(hh.x); h[1] = bf16hi(v.x) + bf16hi(hh.x); h[2] = bf16lo(v.y) + bf16lo(hh.y); h[3] = bf16hi(v.y) + bf16hi(hh.y);
                h[4] = bf16lo(v.z) + bf16lo(hh.z); h[5] = bf16hi(v.z) + bf16hi(hh.z); h[6] = bf16lo(v.w) + bf16lo(hh.w); h[7] = bf16hi(v.w) + bf16hi(hh.w);
                float ss = ((h[0] * h[0] + h[1] * h[1]) + (h[2] * h[2] + h[3] * h[3])) + ((h[4] * h[4] + h[5] * h[5]) + (h[6] * h[6] + h[7] * h[7]));
                if (tk[i] < 0) ss = 0.f;
                ss += __shfl_xor(ss, 16); ss += __shfl_xor(ss, 8); ss += __shfl_xor(ss, 4); ss += __shfl_xor(ss, 2); ss += __shfl_xor(ss, 1);
                if (tk[i] >= 0) { u32x4 o; o.x = cvt_pk_bf16(h[0], h[1]); o.y = cvt_pk_bf16(h[2], h[3]); o.z = cvt_pk_bf16(h[4], h[5]); o.w = cvt_pk_bf16(h[6], h[7]);
                    *(u32x4*)(H2B + (size_t)tk[i] * 1024 + colo) = o;
                    if (ch == 0) SSQ2[(size_t)tk[i] * 4 + u.pn] = ss; } }
            asm volatile("s_waitcnt lgkmcnt(0)\n\ts_barrier" ::: "memory");
        }
    }
};
__device__ __forceinline__ void p6_moe(const Frame& F) {
    unsigned char* ws = F.ws; moe_build_tables(F);
    LAS const int* tab = (LAS const int*)(F.lds + MOE_TAB); unsigned* edone = F.ctl + CW_EDONE;
    { MoeSched1 S{(const char*)(ws + WS_M), (const char*)(ws + WS_WGU), (const int*)(ws + WS_LIST), tab, F.G, F.vcu};
      EpiMoe1 E{(bf16_t*)(ws + WS_HID2), (const float*)(ws + WS_RS), (const float*)(ws + WS_GS), (const int*)(ws + WS_DST), tab, edone};
      pg::gemm_phase(F.lds, S, E, 1024, F.wave); }
    const int G = F.G, ra = (tab[80 + 32] * 2) % G, rb = (tab[384 + NBUCK] * 4) % G, cb = (F.vcu - ra + G) % G, nP = G - ra;
    const int qpp = (F.vcu < ra) ? -1 : ((cb - rb) % nP + nP) % nP;
    { MoeSched2 S{(const char*)(ws + WS_HID2), (const char*)(ws + WS_WD), tab, F.G, cb, edone};
      EpiMoe2 E{(bf16_t*)(ws + WS_H2B), (const bf16_t*)(ws + WS_M), (const int*)(ws + WS_BLIST), (float*)(ws + WS_SSQ2), tab, (LAS int*)(F.lds + MOE_TOKL)};
      pg::gemm_phase(F.lds, S, E, 512, F.wave); }
    pp_units(F, qpp, nP);
}
struct EpiPle {
    bf16_t* G; const bf16_t* PP; const float* RS2;
    struct Pre { u32x4 pp[3][2]; };
    __device__ __forceinline__ void prefetch(Pre& pre, const pg::Unit& u, int wr, int wc, int fr, int fq) const {
#pragma unroll
        for (int m = 0; m < 3; ++m) { const int row = u.pm * 256 + wr * 64 + m * 16 + fr;
#pragma unroll
            for (int bj = 0; bj < 2; ++bj) pre.pp[m][bj] = __builtin_nontemporal_load((const u32x4*)(PP + (size_t)row * 1024 + u.pn * 256 + bj * 128 + wc * 32 + 8 * fq)); }
    }
    __device__ __forceinline__ void operator()(const f32x4 (&acc)[2][2][4][2], const pg::Unit& u, int wr, int wc, int fr, int fq, LAS unsigned char* stage, int wid, const Pre& pre) const {
        float rs[2][4];
#pragma unroll
        for (int ai = 0; ai < 2; ++ai)
#pragma unroll
            for (int m = 0; m < 4; ++m) { const f32x4 q = *(const f32x4*)(RS2 + (size_t)(u.pm * 256 + ai * 128 + wr * 64 + m * 16 + fr) * 4);
                rs[ai][m] = -1.0f / sqrtf(((q[0] + q[1]) + (q[2] + q[3])) * (1.f / 1024.f) + EPS);
                if (m == 3) asm volatile("" : "+v"(rs[ai][0]), "+v"(rs[ai][1]), "+v"(rs[ai][2]), "+v"(rs[ai][3]) :: "memory"); }
        u32x4 pp[2][4][2];
#pragma unroll
        for (int ai = 0; ai < 2; ++ai)
#pragma unroll
            for (int m = 0; m < 4; ++m) { const int row = u.pm * 256 + ai * 128 + wr * 64 + m * 16 + fr;
#pragma unroll
                for (int bj = 0; bj < 2; ++bj) { if (ai == 0 && m < 3) pp[ai][m][bj] = pre.pp[m][bj]; else pp[ai][m][bj] = __builtin_nontemporal_load((const u32x4*)(PP + (size_t)row * 1024 + u.pn * 256 + bj * 128 + wc * 32 + 8 * fq)); } }
#pragma unroll
        for (int ai = 0; ai < 2; ++ai) {
#pragma unroll
            for (int m = 0; m < 4; ++m) { const int row = u.pm * 256 + ai * 128 + wr * 64 + m * 16 + fr; const float nr = rs[ai][m];
#pragma unroll
                for (int bj = 0; bj < 2; ++bj) { const size_t off = (size_t)row * 1024 + u.pn * 256 + bj * 128 + wc * 32 + 8 * fq;
                    const u32x4 p4 = pp[ai][m][bj];
                    const f32x4 a0 = acc[ai][bj][m][0] * nr, a1 = acc[ai][bj][m][1] * nr; u32x4 w;
                    w.x = cvt_pk_bf16(bf16lo(p4.x) * __builtin_amdgcn_rcpf(1.0f + __expf(a0[0])), bf16hi(p4.x) * __builtin_amdgcn_rcpf(1.0f + __expf(a0[1])));
                    w.y = cvt_pk_bf16(bf16lo(p4.y) * __builtin_amdgcn_rcpf(1.0f + __expf(a0[2])), bf16hi(p4.y) * __builtin_amdgcn_rcpf(1.0f + __expf(a0[3])));
                    w.z = cvt_pk_bf16(bf16lo(p4.z) * __builtin_amdgcn_rcpf(1.0f + __expf(a1[0])), bf16hi(p4.z) * __builtin_amdgcn_rcpf(1.0f + __expf(a1[1])));
                    w.w = cvt_pk_bf16(bf16lo(p4.w) * __builtin_amdgcn_rcpf(1.0f + __expf(a1[2])), bf16hi(p4.w) * __builtin_amdgcn_rcpf(1.0f + __expf(a1[3])));
                    *(u32x4*)(G + off) = w; } }
            asm volatile("" ::: "memory");
        }
    }
};
__device__ __forceinline__ void p8_ple(const Frame& F, const Args& a) {
    unsigned char* ws = F.ws;
    pg::DenseSched S{(const char*)(ws + WS_H2B), (const char*)(ws + WS_WPG), 1024, 1024, T / 256, 4, F.G, (int)blockIdx.x};
    EpiPle E{(bf16_t*)(ws + WS_D), (const bf16_t*)(ws + WS_PP), (const float*)(ws + WS_SSQ2)};
    pg::gemm_phase(F.lds, S, E, 1024, F.wave);
}
__device__ __forceinline__ void p9_final(const Frame& F, const Args& a) {
    const int lane = lane_id(); float* H = a.out; const float* gf = a.in[22]; const bf16_t* Gm = (const bf16_t*)(F.ws + WS_D); const bf16_t* H2B = (const bf16_t*)(F.ws + WS_H2B);
    const int gw = F.vcu * NWAVES + F.wave, NGW = F.G * NWAVES;
    f32x4 g[4];
#pragma unroll
    for (int j = 0; j < 4; ++j) g[j] = ((const f32x4*)gf)[lane + 64 * j];
    for (int row = gw; row < T; row += NGW) {
        f32x4 v[4]; float s = 0.f;
#pragma unroll
        for (int j = 0; j < 4; ++j) { const u32x2 hh = __builtin_nontemporal_load((const u32x2*)(H2B + (size_t)row * 1024) + lane + 64 * j), gg = __builtin_nontemporal_load((const u32x2*)(Gm + (size_t)row * 1024) + lane + 64 * j);
            v[j].x = bf16lo(hh.x) + bf16lo(gg.x); v[j].y = bf16hi(hh.x) + bf16hi(gg.x); v[j].z = bf16lo(hh.y) + bf16lo(gg.y); v[j].w = bf16hi(hh.y) + bf16hi(gg.y);
            s += (v[j].x * v[j].x + v[j].y * v[j].y) + (v[j].z * v[j].z + v[j].w * v[j].w); }
        const float rstd = 1.0f / sqrtf(wsum64(s) * (1.f / 1024.f) + EPS);
#pragma unroll
        for (int j = 0; j < 4; ++j) __builtin_nontemporal_store(v[j] * rstd * g[j], (f32x4*)(H + (size_t)row * 1024) + lane + 64 * j);
    }
}

__global__ void __launch_bounds__(512, 2) mega(Args args) {
    extern __shared__ __attribute__((aligned(16))) unsigned char lds_raw[];
    Frame F;
    F.lds = (LAS unsigned char*)lds_raw;
    F.wave = __builtin_amdgcn_readfirstlane(threadIdx.x >> 6);
    F.G = gridDim.x; { const int bx = blockIdx.x; F.vcu = (F.G % 8 == 0) ? (bx % 8) * (F.G / 8) + bx / 8 : bx; }
    F.ws = args.ws; F.ctl = (unsigned*)(args.ws + WS_CTL);
    volatile LAS unsigned* MISC = (volatile LAS unsigned*)(F.lds + MISC_OFF);
    for (int u = threadIdx.x; u < (LDS_BYTES - LDSCTL_OFF) / 4; u += NWAVES * 64) ((LAS unsigned*)(F.lds + LDSCTL_OFF))[u] = 0u;
    __syncthreads();
    XcdBarrier bar = xcd_barrier_post(F.ctl + CW_BAR + args.li * XCD_BAR_WORDS, MISC + 8);
    const int lo = args.ph_lo, hi = args.ph_hi;
#define IN(k) (lo <= (k) && (k) < hi)
#define BOTH(k) (IN(k) && IN((k) + 1))
    if (IN(0)) { p0_prologue(F, args); p0_router_table(F, args); if (BOTH(0)) xcd_barrier(bar); }
    if (IN(1)) { p1_inproj(F); if (BOTH(1)) xcd_barrier(bar); }
    if (IN(2)) { p2_upproj(F); if (BOTH(2)) xcd_barrier(bar); }
    if (IN(3)) { p3_mla(F); p3_mixerA(F); if (BOTH(3)) xcd_barrier(bar); }
    if (IN(4)) { asm volatile("s_nop 0\n\ts_nop 0\n\ts_nop 0\n\ts_nop 0"); p35_mix(F, args); if (BOTH(4)) xcd_barrier(bar); }
    if (IN(5)) { p4_wo(F, args); if (BOTH(5)) xcd_barrier(bar); }
    if (IN(6)) { p5_router(F, args); if (BOTH(6)) xcd_barrier(bar); }
    if (IN(7)) { asm volatile("s_nop 0\n\ts_nop 0\n\ts_nop 0\n\ts_nop 0\n\ts_nop 0\n\ts_nop 0\n\ts_nop 0\n\ts_nop 0\n\ts_nop 0\n\ts_nop 0\n\ts_nop 0\n\ts_nop 0"); p6_moe(F); if (BOTH(7)) xcd_barrier(bar); }
    if (IN(8)) { p8_ple(F, args); if (BOTH(8)) xcd_barrier(bar); }
    if (IN(9)) { p9_final(F, args); }
#undef IN
#undef BOTH
}
constexpr int NPHASES = 10;

extern "C" void kernel_launch(void* const* d_in, const int* in_sizes, int n_in, void* d_out, int out_size, void* d_ws, size_t ws_size, hipStream_t stream) {
    static int grid = 0;
    if (grid == 0) {
        if (n_in != 23 || ws_size < (size_t)512 * MiB || out_size != T * DM) { fprintf(stderr, "kernel_launch: unexpected n_in %d / ws_size %zu / out_size %d\n", n_in, ws_size, out_size); grid = -1; return; }
        int dev = 0, cus = 0;
        if (hipGetDevice(&dev) != hipSuccess || hipDeviceGetAttribute(&cus, hipDeviceAttributeMultiprocessorCount, dev) != hipSuccess) { grid = -1; return; }
        if (hipFuncSetAttribute((const void*)mega, hipFuncAttributeMaxDynamicSharedMemorySize, LDS_BYTES) != hipSuccess) { fprintf(stderr, "kernel_launch: hipFuncSetAttribute failed\n"); grid = -1; return; }
        int per_cu = 0;
        if (hipOccupancyMaxActiveBlocksPerMultiprocessor(&per_cu, (const void*)mega, NWAVES * 64, LDS_BYTES) != hipSuccess || per_cu < 1) { fprintf(stderr, "kernel_launch: occupancy query says %d\n", per_cu); }
        (void)hipGetLastError();
        grid = cus;
    }
    if (grid < 0) return;
    unsigned char* ws = (unsigned char*)d_ws;
    hipMemsetAsync(ws + WS_CTL, 0, CTL_ZERO_BYTES, stream);
    Args a{};
    for (int i = 0; i < 23; ++i) a.in[i] = (const float*)d_in[i];
    a.out = (float*)d_out; a.ws = ws; a.ph_lo = 0; a.ph_hi = NPHASES; a.li = 0; a.pad = 0;
    hipLaunchKernelGGL(mega, dim3(grid), dim3(NWAVES * 64), LDS_BYTES, stream, a);
}
```
